# Optimizing an MI355X kernel written in HIP

```python
import math
import jax
import jax.numpy as jnp
from jax import lax
import numpy as np

D_MODEL = 1024
BATCH = 16
SEQ = 2048
DEPTH = 1

N_HEADS_A = 8
HEAD_DIM = 64
Q_RANK = 256
KV_RANK = 128
N_IDX_HEADS = 8
IDX_DIM = 64
TOPK_MAX = 256
Q_BLOCK = 128
REL_BUCKETS = 32
REL_MAX_DIST = 128
CONV_CH = 256
CONV_WIDTH = 3
N_MEM = 256
N_MEM_HEADS = 4
MIX_A = N_HEADS_A * HEAD_DIM
MIX_C = N_MEM_HEADS * HEAD_DIM
MIX_WIDTH = MIX_A + CONV_CH + MIX_C
IN_SIZES = (Q_RANK, KV_RANK, IDX_DIM, N_IDX_HEADS, CONV_CH, CONV_CH, CONV_CH, MIX_C)
IN_COLS = Q_RANK + KV_RANK + IDX_DIM + N_IDX_HEADS + 3 * CONV_CH + MIX_C
N_EXPERTS = 64
N_GROUPS = 8
TOPK_GROUPS = 4
TOP_K = 8
D_EXPERT = 256
ROUTED_SCALE = 2.5
MOE_BLOCK = 256
ALPHA = (2.0 * DEPTH) ** 0.25
BETA = (8.0 * DEPTH) ** -0.25
LN_EPS = 1e-5
RMS_EPS = 1e-6

kernel_name = 'hybrid_dsa_shortconv_memxattn_moe_deepnorm'


def layer_norm(x, g, b):
    xf = x.astype(jnp.float32)
    mu = jnp.mean(xf, axis=-1, keepdims=True)
    var = jnp.mean(jnp.square(xf - mu), axis=-1, keepdims=True)
    return ((xf - mu) * lax.rsqrt(var + LN_EPS) * g.astype(jnp.float32) + b.astype(jnp.float32)).astype(x.dtype)


def rms_norm(x, g):
    xf = x.astype(jnp.float32)
    return (xf * lax.rsqrt(jnp.mean(jnp.square(xf), axis=-1, keepdims=True) + RMS_EPS) * g.astype(jnp.float32)).astype(x.dtype)


def t5_bucket(rel):
    n = jnp.maximum(rel, 0)
    max_exact = REL_BUCKETS // 2
    nf = jnp.maximum(n.astype(jnp.float32), 1.0)
    large = max_exact + (jnp.log(nf / max_exact) / math.log(REL_MAX_DIST / max_exact) * (REL_BUCKETS - max_exact)).astype(jnp.int32)
    large = jnp.minimum(large, REL_BUCKETS - 1)
    return jnp.where(n < max_exact, n, large)


def swiglu(h, wg, wu, wd):
    return (jax.nn.silu(h @ wg) * (h @ wu)) @ wd


def dsa_attention(c_q, c_kv, k_idx, idx_w, w_uq, w_uk, w_uv, w_qidx, rel_bias):
    B, S, _ = c_q.shape
    k_sel = min(TOPK_MAX, S // 4)
    nb = S // Q_BLOCK
    q = jnp.einsum('bsr,rhd->bshd', c_q, w_uq)
    q_lat = jnp.einsum('bshd,chd->bshc', q, w_uk) * (HEAD_DIM ** -0.5)
    q_idx = jnp.einsum('bsr,rhd->bshd', c_q, w_qidx)
    idx_w = idx_w * (N_IDX_HEADS ** -0.5 * IDX_DIM ** -0.5)
    kpos = jnp.arange(S)

    def blocks(a):
        return a.reshape((B, nb, Q_BLOCK) + a.shape[2:]).swapaxes(0, 1)

    def attend_block(args):
        ql, qi, wi, start = args
        qpos = start + jnp.arange(Q_BLOCK)
        dots = jnp.einsum('bqhd,bsd->bqhs', qi, k_idx).astype(jnp.float32)
        score = jnp.einsum('bqhs,bqh->bqs', jax.nn.relu(dots), wi.astype(jnp.float32))
        score = jnp.where(kpos[None, None, :] <= qpos[None, :, None], score, -jnp.inf)
        _, sel = lax.top_k(score, k_sel)
        kv_sel = jax.vmap(lambda c, i: c[i])(c_kv, sel)
        rel = qpos[None, :, None] - sel
        bias = jnp.moveaxis(rel_bias[t5_bucket(rel)], -1, -2)
        logits = jnp.einsum('bqhc,bqkc->bqhk', ql, kv_sel).astype(jnp.float32) + bias.astype(jnp.float32)
        logits = jnp.where((rel >= 0)[:, :, None, :], logits, -jnp.inf)
        p = jax.nn.softmax(logits, axis=-1).astype(kv_sel.dtype)
        return jnp.einsum('bqhk,bqkc->bqhc', p, kv_sel)

    starts = jnp.arange(nb, dtype=jnp.int32) * Q_BLOCK
    o_lat = lax.map(attend_block, (blocks(q_lat), blocks(q_idx), blocks(idx_w), starts))
    o_lat = o_lat.swapaxes(0, 1).reshape(B, S, N_HEADS_A, KV_RANK)
    o = jnp.einsum('bshc,chd->bshd', o_lat, w_uv)
    return o.reshape(B, S, MIX_A)


def short_conv(b_gate, c_gate, h, conv_w):
    S = h.shape[1]
    u = c_gate * h
    u_pad = jnp.pad(u, ((0, 0), (CONV_WIDTH - 1, 0), (0, 0)))
    y = conv_w[0] * u_pad[:, 0:S]
    for j in range(1, CONV_WIDTH):
        y = y + conv_w[j] * u_pad[:, j:j + S]
    return b_gate * y


def memory_attention(q_in, mem, w_mem_k, w_mem_v):
    B, S, _ = q_in.shape
    q = q_in.reshape(B, S, N_MEM_HEADS, HEAD_DIM)
    k = (mem @ w_mem_k).reshape(B, -1, N_MEM_HEADS, HEAD_DIM)
    v = (mem @ w_mem_v).reshape(B, -1, N_MEM_HEADS, HEAD_DIM)
    logits = jnp.einsum('bshd,bmhd->bhsm', q, k).astype(jnp.float32) * (HEAD_DIM ** -0.5)
    p = jax.nn.softmax(logits, axis=-1).astype(v.dtype)
    return jnp.einsum('bhsm,bmhd->bshd', p, v).reshape(B, S, MIX_C)


def route(xt, w_router, router_bias):
    T = xt.shape[0]
    s = jax.nn.sigmoid(xt.astype(jnp.float32) @ w_router.astype(jnp.float32))
    s_choice = s + router_bias.astype(jnp.float32)
    grp = s_choice.reshape(T, N_GROUPS, N_EXPERTS // N_GROUPS)
    grp_score = jnp.sum(lax.top_k(grp, 2)[0], axis=-1)
    _, gidx = lax.top_k(grp_score, TOPK_GROUPS)
    gmask = jnp.any(gidx[..., None] == jnp.arange(N_GROUPS), axis=-2)
    emask = jnp.repeat(gmask, N_EXPERTS // N_GROUPS, axis=-1)
    _, top_idx = lax.top_k(jnp.where(emask, s_choice, -jnp.inf), TOP_K)
    top_s = jnp.take_along_axis(s, top_idx, axis=-1)
    top_w = top_s / jnp.sum(top_s, axis=-1, keepdims=True) * ROUTED_SCALE
    return top_idx, top_w


def routed_experts(xt, top_idx, top_w, w_gate, w_up, w_down):
    T, D = xt.shape
    n_slots = T * TOP_K
    flat_e = top_idx.reshape(-1)
    order = jnp.argsort(flat_e)
    sorted_e = flat_e[order]
    counts = jnp.bincount(flat_e, length=N_EXPERTS)
    padded = (counts + MOE_BLOCK - 1) // MOE_BLOCK * MOE_BLOCK
    pad_end = jnp.cumsum(padded)
    pad_start = pad_end - padded
    grp_start = jnp.cumsum(counts) - counts
    dest = pad_start[sorted_e] + (jnp.arange(n_slots) - grp_start[sorted_e])
    n_blocks = -(-n_slots // MOE_BLOCK) + N_EXPERTS
    n_rows = n_blocks * MOE_BLOCK
    row_tok = jnp.full((n_rows,), T, jnp.int32).at[dest].set((order // TOP_K).astype(jnp.int32))
    row_w = jnp.zeros((n_rows,), xt.dtype).at[dest].set(top_w.reshape(-1)[order])
    block_e = jnp.minimum(jnp.searchsorted(pad_end, jnp.arange(n_blocks) * MOE_BLOCK, side='right'), N_EXPERTS - 1)
    xt_pad = jnp.concatenate([xt, jnp.zeros((1, D), xt.dtype)], axis=0)

    def expert_block(acc, blk):
        tok, wt, e = blk
        y = swiglu(xt_pad[tok], w_gate[e], w_up[e], w_down[e]) * wt[:, None]
        return acc.at[tok].add(y), None

    acc, _ = lax.scan(expert_block, jnp.zeros((T + 1, D), xt.dtype),
                      (row_tok.reshape(n_blocks, MOE_BLOCK), row_w.reshape(n_blocks, MOE_BLOCK), block_e))
    return acc[:T]


def moe_ffn(x, w_router, router_bias, w_e_gate, w_e_up, w_e_down, w_s_gate, w_s_up, w_s_down):
    B, S, D = x.shape
    xt = x.reshape(B * S, D)
    top_idx, top_w = route(xt, w_router, router_bias)
    routed = routed_experts(xt, top_idx, top_w.astype(xt.dtype), w_e_gate, w_e_up, w_e_down)
    shared = swiglu(xt, w_s_gate, w_s_up, w_s_down)
    return (routed + shared).reshape(B, S, D)


def hybrid_layer(x, mem, w_in, q_norm_g, kv_norm_g, w_uq, w_uk, w_uv, w_qidx, rel_bias, conv_w,
                 w_mem_k, w_mem_v, w_out, ln1_g, ln1_b, w_router, router_bias, w_e_gate, w_e_up,
                 w_e_down, w_s_gate, w_s_up, w_s_down, ln2_g, ln2_b):
    proj = x @ w_in
    c_q, c_kv, k_idx, idx_w, g_b, g_c, h_conv, q_mem = jnp.split(proj, np.cumsum(IN_SIZES)[:-1], axis=-1)
    c_q = rms_norm(c_q, q_norm_g)
    c_kv = rms_norm(c_kv, kv_norm_g)
    y_a = dsa_attention(c_q, c_kv, k_idx, idx_w, w_uq, w_uk, w_uv, w_qidx, rel_bias)
    y_b = short_conv(g_b, g_c, h_conv, conv_w)
    y_c = memory_attention(q_mem, mem, w_mem_k, w_mem_v)
    mix = jnp.concatenate([y_a, y_b, y_c], axis=-1) @ w_out
    x = layer_norm(ALPHA * x + mix, ln1_g, ln1_b)
    ffn = moe_ffn(x, w_router, router_bias, w_e_gate, w_e_up, w_e_down, w_s_gate, w_s_up, w_s_down)
    return layer_norm(ALPHA * x + ffn, ln2_g, ln2_b)


def setup_inputs(seed: int = 0) -> dict:
    key = jax.random.key(seed)
    ks = iter(jax.random.split(key, 32))
    L = DEPTH

    def nrm(shape, fan_in, scale=1.0):
        return jax.random.normal(next(ks), shape, jnp.float32) * (scale * fan_in ** -0.5)

    def gain(shape):
        return 1.0 + 0.05 * jax.random.normal(next(ks), shape, jnp.float32)

    def small(shape, s):
        return s * jax.random.normal(next(ks), shape, jnp.float32)

    return {
        'x': jax.random.normal(next(ks), (BATCH, SEQ, D_MODEL), jnp.float32),
        'mem': jax.random.normal(next(ks), (BATCH, N_MEM, D_MODEL), jnp.float32),
        'w_in': nrm((L, D_MODEL, IN_COLS), D_MODEL),
        'q_norm_g': gain((L, Q_RANK)),
        'kv_norm_g': gain((L, KV_RANK)),
        'w_uq': nrm((L, Q_RANK, N_HEADS_A, HEAD_DIM), Q_RANK),
        'w_uk': nrm((L, KV_RANK, N_HEADS_A, HEAD_DIM), KV_RANK),
        'w_uv': nrm((L, KV_RANK, N_HEADS_A, HEAD_DIM), KV_RANK, BETA),
        'w_qidx': nrm((L, Q_RANK, N_IDX_HEADS, IDX_DIM), Q_RANK),
        'rel_bias': small((REL_BUCKETS, N_HEADS_A), 0.5),
        'conv_w': nrm((L, CONV_WIDTH, CONV_CH), CONV_WIDTH),
        'w_mem_k': nrm((L, D_MODEL, MIX_C), D_MODEL),
        'w_mem_v': nrm((L, D_MODEL, MIX_C), D_MODEL, BETA),
        'w_out': nrm((L, MIX_WIDTH, D_MODEL), MIX_WIDTH, BETA),
        'ln1_g': gain((L, D_MODEL)),
        'ln1_b': small((L, D_MODEL), 0.02),
        'w_router': nrm((L, D_MODEL, N_EXPERTS), D_MODEL),
        'router_bias': small((L, N_EXPERTS), 0.01),
        'w_e_gate': nrm((L, N_EXPERTS, D_MODEL, D_EXPERT), D_MODEL),
        'w_e_up': nrm((L, N_EXPERTS, D_MODEL, D_EXPERT), D_MODEL),
        'w_e_down': nrm((L, N_EXPERTS, D_EXPERT, D_MODEL), D_EXPERT, BETA),
        'w_s_gate': nrm((L, D_MODEL, D_EXPERT), D_MODEL),
        'w_s_up': nrm((L, D_MODEL, D_EXPERT), D_MODEL),
        'w_s_down': nrm((L, D_EXPERT, D_MODEL), D_EXPERT, BETA),
        'ln2_g': gain((L, D_MODEL)),
        'ln2_b': small((L, D_MODEL), 0.02),
    }


def reference(x, mem, w_in, q_norm_g, kv_norm_g, w_uq, w_uk, w_uv, w_qidx, rel_bias, conv_w,
              w_mem_k, w_mem_v, w_out, ln1_g, ln1_b, w_router, router_bias, w_e_gate, w_e_up,
              w_e_down, w_s_gate, w_s_up, w_s_down, ln2_g, ln2_b):
    for l in range(DEPTH):
        x = hybrid_layer(x, mem, w_in[l], q_norm_g[l], kv_norm_g[l], w_uq[l], w_uk[l], w_uv[l], w_qidx[l],
                         rel_bias, conv_w[l], w_mem_k[l], w_mem_v[l], w_out[l], ln1_g[l], ln1_b[l],
                         w_router[l], router_bias[l], w_e_gate[l], w_e_up[l], w_e_down[l],
                         w_s_gate[l], w_s_up[l], w_s_down[l], ln2_g[l], ln2_b[l])
    return x
```

```cpp
#include <hip/hip_runtime.h>
#include <stdint.h>
#include <stdio.h>

typedef unsigned short bf16_t;
typedef short bf16x8 __attribute__((ext_vector_type(8)));
typedef float f32x4 __attribute__((ext_vector_type(4)));
__device__ __forceinline__ float4 ldnt4(const float* p) { const f32x4 v = __builtin_nontemporal_load((const f32x4*)p); return make_float4(v[0], v[1], v[2], v[3]); }
__device__ __forceinline__ void stnt4(float* p, const float4& o) { const f32x4 v = {o.x, o.y, o.z, o.w}; __builtin_nontemporal_store(v, (f32x4*)p); }
#define LAS __attribute__((address_space(3)))

constexpr int DM = 1024, NB = 16, SEQ = 2048, T = NB * SEQ;
constexpr int NPROJ = 1536;
constexpr int NMEM = 256;
constexpr int NEXP = 64, NE1 = 65;
constexpr int DEXP = 256;
constexpr int NROUND = 4;
__host__ __device__ constexpr int rnd_tb0(int r) { return r == 0 ? 0 : 16 + 60 * r; }
__host__ __device__ constexpr int rnd_ntb(int r) { return rnd_tb0(r + 1) - rnd_tb0(r); }
__host__ __device__ constexpr int rnd_tok0(int r) { return rnd_tb0(r) * 128; }
__host__ __device__ constexpr int rnd_ntok(int r) { return rnd_ntb(r) * 128; }
__host__ __device__ constexpr int rnd_cap(int r) { return ((rnd_ntok(r) * 9 + 65 * 255 + 255) / 256) * 256; }
__host__ __device__ constexpr int rnd_cap0(int r) { return r == 0 ? 0 : rnd_cap(0) + (r - 1) * rnd_cap(1); }
constexpr int CAP = rnd_cap(0);
static_assert(rnd_tb0(NROUND) == T / 128 && rnd_cap(1) == rnd_cap(2) && rnd_cap(2) == rnd_cap(3) && rnd_cap(0) >= rnd_cap(1), "round layout");
constexpr float ALPHA = 1.189207115002721f;
constexpr float LN_EPS = 1e-5f, RMS_EPS = 1e-6f;
constexpr float IDXW_SCALE = 0.04419417382415922f;
constexpr int PC_CQ = 0, PC_CKV = 256, PC_KIDX = 384, PC_IDXW = 448, PC_GB = 512, PC_GC = 768, PC_H = 1024, PC_QM = 1280;

constexpr size_t al256(size_t x) { return (x + 255) & ~(size_t)255; }
constexpr size_t WS_W_IN_T = 0;
constexpr size_t WS_W_Q2_T = WS_W_IN_T + (size_t)1536 * 1024 * 2;
constexpr size_t WS_W_MKV_T = WS_W_Q2_T + (size_t)1536 * 256 * 2;
constexpr size_t WS_W_OUT2_T = WS_W_MKV_T + (size_t)512 * 1024 * 2;
constexpr size_t WS_W_R_T = WS_W_OUT2_T + (size_t)1024 * 1536 * 2;
constexpr size_t WS_W_EGU_T = WS_W_R_T + (size_t)128 * 3072 * 2;
constexpr size_t WS_W_ED_T = WS_W_EGU_T + (size_t)NE1 * 512 * 1024 * 2;
constexpr size_t WS_CNT = WS_W_ED_T + (size_t)NE1 * 1024 * 256 * 2;
constexpr size_t WS_CNTB = WS_CNT + 4096;
constexpr size_t WS_BAR = WS_CNTB + (size_t)256 * 64 * 4;
constexpr size_t WS_TOK_E = WS_BAR + 16384;
constexpr size_t WS_TOK_W = WS_TOK_E + (size_t)T * 8 * 4;
constexpr size_t WS_TOK_POS = WS_TOK_W + (size_t)T * 8 * 4;
constexpr size_t WS_SLOT_TOK = al256(WS_TOK_POS + (size_t)T * 9 * 4);
constexpr size_t WS_SLOT_W = WS_SLOT_TOK + (size_t)NROUND * CAP * 4;
constexpr size_t WS_X1B = al256(WS_SLOT_W + (size_t)NROUND * CAP * 4);
constexpr size_t WS_B = al256(WS_X1B + (size_t)T * 1024 * 2);
constexpr size_t WS_XB = WS_B;
constexpr size_t WS_CAT2 = WS_X1B;
constexpr size_t WS_MEMB = WS_XB + (size_t)T * 1024 * 2;
constexpr size_t WS_PROJ = WS_MEMB + (size_t)4096 * 1024 * 2;
constexpr size_t WS_KMEM = WS_PROJ + (size_t)T * NPROJ * 2;
constexpr size_t WS_VTMEM = WS_KMEM + (size_t)4096 * 256 * 2;
constexpr size_t WS_KIDX = WS_VTMEM + (size_t)256 * 4096 * 2;
constexpr size_t WS_CQN = WS_KIDX + (size_t)T * 64 * 2;
constexpr size_t WS_CKVN = WS_CQN + (size_t)T * 256 * 2;
constexpr size_t WS_Q2 = WS_CKVN + (size_t)T * 128 * 2;
constexpr size_t WS_END_EARLY = WS_Q2 + (size_t)T * 1536 * 2;
constexpr size_t WS_X1LO = WS_B;
constexpr size_t WS_LOGITS = WS_X1LO + (size_t)T * 1024 * 2;
constexpr size_t WS_X1H = al256(WS_CAT2 + (size_t)T * 1536 * 2);
constexpr size_t WS_X1L = WS_X1H + (size_t)T * 1024 * 2;
constexpr size_t WS_LNST = WS_X1L + (size_t)T * 1024 * 2;
constexpr size_t WS_YSLOT = WS_X1B;
constexpr size_t WS_HSLOT = WS_YSLOT + (size_t)CAP * 1024 * 2;
constexpr size_t WS_END_MOE = WS_HSLOT + (size_t)rnd_cap0(NROUND) * 256 * 2;
static_assert(WS_X1H + (size_t)T * 1024 * 2 <= WS_HSLOT, "x1 hi must end below HSLOT");
static_assert(WS_LNST + (size_t)128 * 4 * 256 * 8 <= WS_END_EARLY, "LN statistics must fit the early region");
constexpr size_t WS_NEED = WS_END_EARLY > WS_END_MOE ? WS_END_EARLY : WS_END_MOE;
static_assert(WS_NEED <= (size_t)4 * T * DM * 4, "workspace budget (4 x the largest tensor)");

constexpr int NTHREADS = 512;
constexpr int LDS_GEMM_H = 65536;
constexpr int LDS_MISC = 139264;
constexpr int LDS_STG = 65536;
constexpr int LDS_BYTES = 155648;
constexpr int LDS_BARW = LDS_BYTES - 16;
constexpr int WAVE_LDS = 15360;

struct Params {
    const float* in[26];
    float* out;
    unsigned char* ws;
};
typedef const __attribute__((address_space(4))) Params CParams;
__device__ __forceinline__ CParams* kargs() {
    CParams* q = (CParams*)__builtin_amdgcn_kernarg_segment_ptr();
    asm volatile("" : "+s"(q));
    return q;
}

typedef __bf16 bf16x2_t __attribute__((ext_vector_type(2)));
typedef float f32x2_t __attribute__((ext_vector_type(2)));
__device__ __forceinline__ uint32_t pk2(float a, float b) {
    const f32x2_t v = {a, b};
    return __builtin_bit_cast(uint32_t, __builtin_convertvector(v, bf16x2_t));
}
__device__ __forceinline__ bf16_t f2bf(float f) { return (bf16_t)(pk2(f, 0.f) & 0xFFFFu); }
__device__ __forceinline__ float bf2f(bf16_t h) { return __uint_as_float(((uint32_t)h) << 16); }
__device__ __forceinline__ float bflo(uint32_t w) { return __uint_as_float(w << 16); }
__device__ __forceinline__ float bfhi(uint32_t w) { return __uint_as_float(w & 0xFFFF0000u); }
__device__ __forceinline__ int lane_id() { return (int)__builtin_amdgcn_mbcnt_hi(~0u, __builtin_amdgcn_mbcnt_lo(~0u, 0u)); }
__device__ __forceinline__ int opaque_tid(int wv) { int t = wv * 64 + lane_id(); asm volatile("" : "+v"(t)); return t; }
__device__ __forceinline__ int opaque_i(int t) { asm volatile("" : "+v"(t)); return t; }
__device__ __forceinline__ size_t km_off(int row, int k, int nrows) { return ((size_t)(k >> 5) * nrows + row) * 32 + (k & 31); }
__device__ __forceinline__ void wave_sync() {
    __builtin_amdgcn_fence(__ATOMIC_RELEASE, "wavefront");
    __builtin_amdgcn_wave_barrier();
    __builtin_amdgcn_fence(__ATOMIC_ACQUIRE, "wavefront");
}
template <int CTRL> __device__ __forceinline__ float dpp_f(float x) {
    return __builtin_bit_cast(float, __builtin_amdgcn_mov_dpp(__builtin_bit_cast(int, x), CTRL, 0xf, 0xf, true));
}
__device__ __forceinline__ float xrow16_max(float x) {
    auto s = __builtin_amdgcn_permlane16_swap(__float_as_uint(x), __float_as_uint(x), false, false);
    x = fmaxf(__uint_as_float(s[0]), __uint_as_float(s[1]));
    auto t = __builtin_amdgcn_permlane32_swap(__float_as_uint(x), __float_as_uint(x), false, false);
    return fmaxf(__uint_as_float(t[0]), __uint_as_float(t[1]));
}
__device__ __forceinline__ float xrow16_sum(float x) {
    auto s = __builtin_amdgcn_permlane16_swap(__float_as_uint(x), __float_as_uint(x), false, false);
    x = __uint_as_float(s[0]) + __uint_as_float(s[1]);
    auto t = __builtin_amdgcn_permlane32_swap(__float_as_uint(x), __float_as_uint(x), false, false);
    return __uint_as_float(t[0]) + __uint_as_float(t[1]);
}
__device__ __forceinline__ float wave_sum(float v) {
    v += dpp_f<0xB1>(v); v += dpp_f<0x4E>(v); v += dpp_f<0x141>(v); v += dpp_f<0x128>(v);
    return xrow16_sum(v);
}
__device__ __forceinline__ float wave_max(float v) {
    v = fmaxf(v, dpp_f<0xB1>(v)); v = fmaxf(v, dpp_f<0x4E>(v)); v = fmaxf(v, dpp_f<0x141>(v)); v = fmaxf(v, dpp_f<0x128>(v));
    return xrow16_max(v);
}
__device__ __forceinline__ void unpack8(const uint4& v, float* f) {
    f[0] = bflo(v.x); f[1] = bfhi(v.x); f[2] = bflo(v.y); f[3] = bfhi(v.y);
    f[4] = bflo(v.z); f[5] = bfhi(v.z); f[6] = bflo(v.w); f[7] = bfhi(v.w);
}

template <int AMODE>
__device__ __forceinline__ void gemm_loop(f32x4 (&acc)[4][2], const bf16_t* a0, const bf16_t* a1, const bf16_t* a0b, const bf16_t* a1b,
                                          const bf16_t* b0, const bf16_t* b1, int nk, char* lds, const char* ldsH,
                                          int tid, int lane, int wm, int wn) {
    const int fr = lane & 15, fq = lane >> 4;
    const int r0 = tid >> 3, c = tid & 7;
    const int wo = r0 * 128 + ((c ^ ((r0 >> 1) & 7)) << 4);
    uint4 ra0, ra1, rb0, rb1;
    ra0 = ra1 = make_uint4(0, 0, 0, 0);
    if (AMODE != 1) { ra0 = *(const uint4*)a0; ra1 = *(const uint4*)a1; }
    rb0 = *(const uint4*)b0; rb1 = *(const uint4*)b1;
    __syncthreads();
    if (AMODE != 1) { *(uint4*)(lds + wo) = ra0; *(uint4*)(lds + wo + 8192) = ra1; }
    *(uint4*)(lds + 32768 + wo) = rb0; *(uint4*)(lds + 32768 + wo + 8192) = rb1;
    __syncthreads();
    const int swz = (fr >> 1) & 7;
    const int aoff = (wm * 64 + fr) * 128, boff = 32768 + (wn * 32 + fr) * 128;
    for (int kt = 0; kt < nk; ++kt) {
        const int cur = kt & 1;
        if (kt + 1 < nk) {
            const int k1 = kt + 1;
            if (AMODE == 0) { ra0 = *(const uint4*)(a0 + k1 * 64); ra1 = *(const uint4*)(a1 + k1 * 64); }
            if (AMODE == 2) {
                const int seg = k1 >> 4, ko = (k1 & 15) * 64;
                const bf16_t* p0 = (seg == 1) ? a0b : a0; const bf16_t* p1 = (seg == 1) ? a1b : a1;
                ra0 = *(const uint4*)(p0 + ko); ra1 = *(const uint4*)(p1 + ko);
            }
            rb0 = *(const uint4*)(b0 + k1 * 64); rb1 = *(const uint4*)(b1 + k1 * 64);
        }
        const char* pa = (AMODE == 1) ? (ldsH + kt * 16384 + aoff) : (lds + cur * 16384 + aoff);
        const char* pb = lds + cur * 16384 + boff;
#pragma unroll
        for (int kk = 0; kk < 2; ++kk) {
            const int ch = ((kk * 4 + fq) ^ swz) << 4;
            bf16x8 af[4], bfv[2];
#pragma unroll
            for (int mi = 0; mi < 4; ++mi) af[mi] = *(const bf16x8*)(pa + mi * 2048 + ch);
#pragma unroll
            for (int ni = 0; ni < 2; ++ni) bfv[ni] = *(const bf16x8*)(pb + ni * 2048 + ch);
#pragma unroll
            for (int mi = 0; mi < 4; ++mi)
#pragma unroll
                for (int ni = 0; ni < 2; ++ni)
                    acc[mi][ni] = __builtin_amdgcn_mfma_f32_16x16x32_bf16(bfv[ni], af[mi], acc[mi][ni], 0, 0, 0);
        }
        if (kt + 1 < nk) {
            const int nxt = cur ^ 1;
            if (AMODE != 1) { *(uint4*)(lds + nxt * 16384 + wo) = ra0; *(uint4*)(lds + nxt * 16384 + wo + 8192) = ra1; }
            *(uint4*)(lds + 32768 + nxt * 16384 + wo) = rb0; *(uint4*)(lds + 32768 + nxt * 16384 + wo + 8192) = rb1;
        }
        __syncthreads();
    }
}
template <int NK, bool ROUTER>
__device__ __forceinline__ void pf_kloop(f32x4 (&acc)[4][2], const bf16_t* a0, const bf16_t* a1, const bf16_t* a0b, const bf16_t* a1b,
                                             const bf16_t* b0, const bf16_t* b1, char* lds, int tid, int lane, int wm, int wn) {
    static_assert(NK % 4 == 0, "unrolled by 4");
    const int fr = lane & 15, fq = lane >> 4;
    const int r0 = tid >> 3, c = tid & 7;
    const int wo = r0 * 128 + ((c ^ ((r0 >> 1) & 7)) << 4);
    uint4 ra0_0, ra1_0, rb0_0, rb1_0, ra0_1, ra1_1, rb0_1, rb1_1, ra0_2, ra1_2, rb0_2, rb1_2, ra0_3, ra1_3, rb0_3, rb1_3;
#define RT_LOAD(s, k) do { const int k_ = (k); const int seg_ = ROUTER ? (k_ >> 4) : 0, ko_ = ROUTER ? (k_ & 15) * 64 : k_ * 64; const bf16_t* p0_ = (seg_ == 1) ? a0b : a0; const bf16_t* p1_ = (seg_ == 1) ? a1b : a1; \
        ra0_##s = *(const uint4*)(p0_ + ko_); ra1_##s = *(const uint4*)(p1_ + ko_); rb0_##s = *(const uint4*)(b0 + k_ * 64); rb1_##s = *(const uint4*)(b1 + k_ * 64); } while (0)
#define RT_STORE(s, buf) do { *(uint4*)(lds + (buf) * 16384 + wo) = ra0_##s; *(uint4*)(lds + (buf) * 16384 + wo + 8192) = ra1_##s; \
        *(uint4*)(lds + 32768 + (buf) * 16384 + wo) = rb0_##s; *(uint4*)(lds + 32768 + (buf) * 16384 + wo + 8192) = rb1_##s; } while (0)
#define RT_BAR() do { asm volatile("s_waitcnt lgkmcnt(0)" ::: "memory"); __builtin_amdgcn_s_barrier(); asm volatile("" ::: "memory"); } while (0)
    RT_LOAD(0, 0); RT_LOAD(1, 1); RT_LOAD(2, 2); RT_LOAD(3, 3);
    __syncthreads();
    RT_STORE(0, 0);
    RT_BAR();
    const int swz = (fr >> 1) & 7;
    const int aoff = (wm * 64 + fr) * 128, boff = 32768 + (wn * 32 + fr) * 128;
#define RT_STEP(j, jn) do { const int k = kt + (j); \
        RT_LOAD(j, (k + 4 < NK) ? k + 4 : NK - 1);     \
        const char* pa = lds + ((j) & 1) * 16384 + aoff; const char* pb = lds + ((j) & 1) * 16384 + boff; \
        _Pragma("unroll") for (int kk = 0; kk < 2; ++kk) { \
            const int ch = ((kk * 4 + fq) ^ swz) << 4; \
            bf16x8 af[4], bfv[2]; \
            _Pragma("unroll") for (int mi = 0; mi < 4; ++mi) af[mi] = *(const bf16x8*)(pa + mi * 2048 + ch); \
            _Pragma("unroll") for (int ni = 0; ni < 2; ++ni) bfv[ni] = *(const bf16x8*)(pb + ni * 2048 + ch); \
            _Pragma("unroll") for (int mi = 0; mi < 4; ++mi) _Pragma("unroll") for (int ni = 0; ni < 2; ++ni) \
                acc[mi][ni] = __builtin_amdgcn_mfma_f32_16x16x32_bf16(bfv[ni], af[mi], acc[mi][ni], 0, 0, 0); } \
        RT_STORE(jn, ((j) + 1) & 1); \
        RT_BAR(); } while (0)
    for (int kt = 0; kt < NK; kt += 4) {
        RT_STEP(0, 1); RT_STEP(1, 2); RT_STEP(2, 3); RT_STEP(3, 0);
    }
#undef RT_STEP
#undef RT_BAR
#undef RT_LOAD
#undef RT_STORE
}
__device__ __forceinline__ void acc_zero(f32x4 (&acc)[4][2]) {
#pragma unroll
    for (int mi = 0; mi < 4; ++mi)
#pragma unroll
        for (int ni = 0; ni < 2; ++ni) acc[mi][ni] = (f32x4){0.f, 0.f, 0.f, 0.f};
}
template <int OMODE>
__device__ __forceinline__ void gemm_item_bf16(const bf16_t* A, int lda, const bf16_t* Bt, int ldb, int nk, bf16_t* C, int ldc, int m0, int n0,
                                               char* lds, int tid, int lane, int wm, int wn) {
    const int r0 = tid >> 3, c = tid & 7;
    f32x4 acc[4][2]; acc_zero(acc);
    const bf16_t* a0 = A + (size_t)(m0 + r0) * lda + c * 8; const bf16_t* a1 = a0 + (size_t)64 * lda;
    const bf16_t* b0 = Bt + (size_t)(n0 + r0) * ldb + c * 8; const bf16_t* b1 = b0 + (size_t)64 * ldb;
    pf_kloop<16, false>(acc, a0, a1, a0, a1, b0, b1, lds, tid, lane, wm, wn);
    const int fr = lane & 15, fq = lane >> 4;
#pragma unroll
    for (int mi = 0; mi < 4; ++mi)
#pragma unroll
        for (int ni = 0; ni < 2; ++ni) {
            const int m = m0 + wm * 64 + mi * 16 + fr, n = n0 + wn * 32 + ni * 16 + 4 * fq;
            uint2 o; o.x = pk2(acc[mi][ni][0], acc[mi][ni][1]); o.y = pk2(acc[mi][ni][2], acc[mi][ni][3]);
            size_t off;
            if (OMODE == 0) off = (size_t)m * ldc + n;
            else if (OMODE == 1) {
                const int b = m >> 8, key = m & 255, h = n >> 6, d = n & 63;
                off = ((size_t)((((b * 4 + h) * 16 + (key >> 4)) * 2 + (d >> 5)) * 64 + ((d & 31) >> 3) * 16 + (key & 15))) * 8 + (d & 7);
            } else {
                const int h = m >> 6, d = m & 63, b = n >> 8, key = n & 255, k32 = key & 31;
                off = ((size_t)((((b * 4 + h) * 8 + (key >> 5)) * 4 + (d >> 4)) * 64 + ((k32 & 15) >> 2) * 16 + (d & 15))) * 8 + ((k32 >> 4) * 4);
            }
            *(uint2*)(C + off) = o;
        }
}

namespace g8 {
constexpr int HTB = 8192;
__device__ __forceinline__ int lds_byte(int r, int c) { const int ob = (r & 15) * 64 + c * 2; return (r >> 4) * 1024 + (ob ^ (((ob >> 9) & 1) << 5)); }
__device__ __forceinline__ void stage_rc(int b, int& R, int& C) { const int st = b / 1024, sb = b % 1024, swz = sb ^ (((sb >> 9) & 1) << 5); R = st * 16 + swz / 64; C = (swz % 64) / 2; }
struct Src { __amdgpu_buffer_rsrc_t ra, rb; unsigned ao[2]; unsigned bo; unsigned bh; unsigned akt, bkt; };
__device__ __forceinline__ __amdgpu_buffer_rsrc_t make_rsrc(const void* p) {
    const unsigned long long a = (unsigned long long)p;
    const unsigned lo = __builtin_amdgcn_readfirstlane((unsigned)a), hi = __builtin_amdgcn_readfirstlane((unsigned)(a >> 32));
    return __builtin_amdgcn_make_buffer_rsrc((void*)(((unsigned long long)hi << 32) | lo), 0, 0x7FFFFFFF, 0x00020000);
}
#define G8_SA(b,h) (lds + ((b) * 2 + (h)) * g8::HTB)
#define G8_SB(b,h) (lds + (4 + (b) * 2 + (h)) * g8::HTB)
#define G8_KOFF(kt, ktstride, segstride) ((((kt) & sg.mask) * (ktstride)) + (((kt) >> sg.lg) * (segstride)))
#define G8_STAGE_A(b,h,kt) __builtin_amdgcn_raw_ptr_buffer_load_lds(s.ra, (LAS void*)(G8_SA(b,h) + wv * 1024), 16, s.ao[h], G8_KOFF(kt, s.akt, sg.aseg), 0, AAUX)
#define G8_STAGE_B(b,h,kt) __builtin_amdgcn_raw_ptr_buffer_load_lds(s.rb, (LAS void*)(G8_SB(b,h) + wv * 1024), 16, s.bo, G8_KOFF(kt, s.bkt, sg.bseg) + (h) * s.bh, 0, 0)
#define G8_LDA(dst,b,h) do { _Pragma("unroll") for (int m = 0; m < 4; ++m) \
    dst[m] = *(const bf16x8*)(G8_SA(b,h) + g8::lds_byte(wr * 64 + m * 16 + fr, fq * 8)); } while (0)
#define G8_LDB(dst,b,h) do { _Pragma("unroll") for (int n = 0; n < 2; ++n) \
    dst[n] = *(const bf16x8*)(G8_SB(b,h) + g8::lds_byte(wc * 32 + n * 16 + fr, fq * 8)); } while (0)
#define G8_MMA(ai,bj,At,Bt) do { __builtin_amdgcn_s_setprio(1); \
    _Pragma("unroll") for (int m = 0; m < 4; ++m) _Pragma("unroll") for (int n = 0; n < 2; ++n) \
      acc[ai][bj][m][n] = __builtin_amdgcn_mfma_f32_16x16x32_bf16(Bt[n], At[m], acc[ai][bj][m][n], 0, 0, 0); \
    __builtin_amdgcn_s_setprio(0); } while (0)
#define G8_WAIT_V(n) asm volatile("s_waitcnt vmcnt(" #n ")" ::: "memory")
#define G8_WAIT_L(n) asm volatile("s_waitcnt lgkmcnt(" #n ")" ::: "memory")
#define G8_BAR __builtin_amdgcn_s_barrier()
#define G8_SCHED __builtin_amdgcn_sched_barrier(0)

__device__ __forceinline__ void zero_acc(f32x4 (&acc)[2][2][4][2]) {
#pragma unroll
    for (int a = 0; a < 2; ++a)
#pragma unroll
        for (int b = 0; b < 2; ++b)
#pragma unroll
            for (int m = 0; m < 4; ++m)
#pragma unroll
                for (int n = 0; n < 2; ++n) acc[a][b][m][n] = (f32x4){0.f, 0.f, 0.f, 0.f};
}
struct Seg { int mask, lg; unsigned aseg, bseg; };
__device__ __forceinline__ Seg one_seg() { Seg g; g.mask = 0x7FFFFFFF; g.lg = 30; g.aseg = 0u; g.bseg = 0u; return g; }
struct NoFlush { __device__ __forceinline__ void operator()(f32x4 (&)[2][2][4][2], int) const {} };
template <int AAUX = 0>
__device__ __forceinline__ void kloop_issue(const Src& s, char* lds, int wv, const Seg sg = one_seg()) {
    G8_STAGE_B(0, 0, 0); G8_STAGE_A(0, 0, 0);
    G8_STAGE_B(0, 1, 0); G8_STAGE_A(0, 1, 0);
}
template <class Flush, int AAUX = 0>
__device__ __forceinline__ void kloop_ms(f32x4 (&acc)[2][2][4][2], const Src& s, int nt, char* lds, int tid, int wv, const Seg sg, const Flush& flush) {
    const int lane = tid & 63, wr = wv >> 2, wc = wv & 3, fr = lane & 15, fq = lane >> 4;
    bf16x8 At[4], B0[2], B1[2];
    if (wr == 1) G8_BAR;
    G8_WAIT_V(0); G8_BAR;
    G8_STAGE_B(1, 0, 1); G8_STAGE_A(1, 0, 1); G8_STAGE_B(1, 1, 1);
    G8_WAIT_V(3); G8_BAR;
    bool drain = false;
    for (int t = 0; t < nt - 2; t += 2) {
        G8_LDB(B0, 0, 0); G8_SCHED; G8_LDA(At, 0, 0); G8_STAGE_A(1, 1, t + 1);
        G8_WAIT_L(4); G8_BAR; G8_WAIT_L(0); G8_MMA(0, 0, At, B0); G8_BAR; G8_SCHED;
        G8_LDB(B1, 0, 1); G8_STAGE_B(0, 0, t + 2);
        G8_BAR; G8_WAIT_L(0); G8_MMA(0, 1, At, B1); G8_BAR;
        G8_LDA(At, 0, 1); G8_STAGE_A(0, 0, t + 2);
        G8_BAR; G8_WAIT_L(0); G8_MMA(1, 0, At, B0); G8_BAR; G8_SCHED;
        G8_STAGE_B(0, 1, t + 2);
        if (drain) { G8_WAIT_V(0); drain = false; } else { G8_WAIT_V(3); }
        G8_BAR; G8_MMA(1, 1, At, B1); G8_BAR;
        G8_LDB(B0, 1, 0); G8_SCHED; G8_LDA(At, 1, 0); G8_STAGE_A(0, 1, t + 2);
        G8_WAIT_L(4); G8_BAR; G8_WAIT_L(0); G8_MMA(0, 0, At, B0); G8_BAR; G8_SCHED;
        G8_LDB(B1, 1, 1); G8_STAGE_B(1, 0, t + 3);
        G8_BAR; G8_WAIT_L(0); G8_MMA(0, 1, At, B1); G8_BAR;
        G8_LDA(At, 1, 1); G8_STAGE_A(1, 0, t + 3);
        G8_BAR; G8_WAIT_L(0); G8_MMA(1, 0, At, B0); G8_BAR; G8_SCHED;
        G8_STAGE_B(1, 1, t + 3);
        G8_WAIT_V(3); G8_BAR; G8_MMA(1, 1, At, B1); G8_BAR;
        if (((t + 2) & sg.mask) == 0) {
            flush(acc, ((t + 2) >> sg.lg) - 1);
            zero_acc(acc);
            drain = true;
        }
    }
    { G8_LDB(B0, 0, 0); G8_LDA(At, 0, 0); G8_STAGE_A(1, 1, nt - 1);
      G8_BAR; G8_WAIT_L(0); G8_MMA(0, 0, At, B0); G8_BAR;
      G8_LDB(B1, 0, 1); G8_BAR; G8_WAIT_L(0); G8_MMA(0, 1, At, B1); G8_BAR;
      G8_LDA(At, 0, 1); G8_WAIT_V(2); G8_BAR; G8_WAIT_L(0); G8_MMA(1, 0, At, B0); G8_MMA(1, 1, At, B1); G8_BAR; }
    { G8_LDB(B0, 1, 0); G8_LDA(At, 1, 0); G8_WAIT_V(1); G8_BAR; G8_WAIT_L(0); G8_MMA(0, 0, At, B0); G8_BAR;
      G8_LDB(B1, 1, 1); G8_WAIT_V(0); G8_BAR; G8_WAIT_L(0); G8_MMA(0, 1, At, B1); G8_BAR;
      G8_LDA(At, 1, 1); G8_BAR; G8_WAIT_L(0); G8_MMA(1, 0, At, B0); G8_MMA(1, 1, At, B1); G8_BAR; }
    if (wr == 0) G8_BAR;
}
template <int AAUX = 0>
__device__ __forceinline__ void kloop(f32x4 (&acc)[2][2][4][2], const Src& s, int nt, char* lds, int tid, int wv) {
    kloop_ms<NoFlush, AAUX>(acc, s, nt, lds, tid, wv, one_seg(), NoFlush());
}
__device__ __forceinline__ void acc_zero(f32x4 (&acc)[2][2][4][2]) {
#pragma unroll
    for (int a = 0; a < 2; ++a)
#pragma unroll
        for (int b = 0; b < 2; ++b)
#pragma unroll
            for (int m = 0; m < 4; ++m)
#pragma unroll
                for (int n = 0; n < 2; ++n) acc[a][b][m][n] = (f32x4){0.f, 0.f, 0.f, 0.f};
}
__device__ __forceinline__ void dense_src(Src& s, const bf16_t* A, int lda, int brow, const bf16_t* B, int ldb, int bcol, int tid) {
    s.ra = make_rsrc(A); s.rb = make_rsrc(B); s.bh = (unsigned)(128 * ldb * 2); s.akt = 64u; s.bkt = 64u;
    int R, C; stage_rc(tid * 16, R, C);
    s.bo = (unsigned)((bcol + R) * ldb + C) * 2u;
#pragma unroll
    for (int h = 0; h < 2; ++h) s.ao[h] = (unsigned)((brow + h * 128 + R) * lda + C) * 2u;
}
__device__ __forceinline__ void km_src(Src& s, const bf16_t* A, int anrows, int brow, const bf16_t* B, int bnrows, int bcol, int tid) {
    s.ra = make_rsrc(A); s.rb = make_rsrc(B); s.bh = 128u * 64u; s.akt = (unsigned)anrows * 64u; s.bkt = (unsigned)bnrows * 64u;
    int R, C; stage_rc(tid * 16, R, C);
    s.bo = (unsigned)((bcol + R) * 32 + C) * 2u;
#pragma unroll
    for (int h = 0; h < 2; ++h) s.ao[h] = (unsigned)((brow + h * 128 + R) * 32 + C) * 2u;
}
}

__device__ __forceinline__ void tconv_tile(const float* src, const float* src2, int ld_src, bf16_t* dst, int ld_dst, int k0, int n0, int mode, float* tl, int tid, int kmrows = 0, int kmrow0 = 0, int kmk0 = 0) {
    __syncthreads();
    {
        const int nn = tid & 63, kb = tid >> 6;
        const int np = n0 + nn;
        const float* s = src; int sc = np;
        if (mode == 1) sc = (np < 456) ? np : (np < 512 ? -1 : np - 56);
        if (mode == 2) { s = ((np >> 4) & 1) ? src2 : src; sc = 16 * (np >> 5) + (np & 15); }
#pragma unroll
        for (int i = 0; i < 8; ++i) {
            const int kk = kb + i * 8;
            tl[kk * 65 + nn] = (sc >= 0) ? s[(size_t)(k0 + kk) * ld_src + sc] : 0.f;
        }
    }
    __syncthreads();
    {
        const int n2 = tid >> 3, kc = tid & 7;
        const float* s = tl + (kc * 8) * 65 + n2;
        uint4 o; o.x = pk2(s[0], s[65]); o.y = pk2(s[130], s[195]); o.z = pk2(s[260], s[325]); o.w = pk2(s[390], s[455]);
        if (kmrows) *(uint4*)(dst + km_off(kmrow0 + n0 + n2, kmk0 + k0 + kc * 8, kmrows)) = o;
        else *(uint4*)(dst + (size_t)(n0 + n2) * ld_dst + k0 + kc * 8) = o;
    }
}

__device__ __forceinline__ void tconv_wave(const float* src, const float* src2, int ld_src, bf16_t* dst, int kmrows, int k0, int n0, int mode, float* scr, int lane) {
    const int nn = lane & 31, np = n0 + nn, par = lane >> 5;
    const float* s = src; int sc = np;
    if (mode == 2) { s = ((np >> 4) & 1) ? src2 : src; sc = 16 * (np >> 5) + (np & 15); }
    float v[32];
#pragma unroll
    for (int i = 0; i < 32; ++i) v[i] = __builtin_nontemporal_load(s + (size_t)(k0 + 2 * i + par) * ld_src + sc);
    wave_sync();
#pragma unroll
    for (int i = 0; i < 32; ++i) scr[(2 * i + par) * 33 + nn] = v[i];
    wave_sync();
    const int c = lane & 7;
#pragma unroll
    for (int j = 0; j < 4; ++j) {
        const int n = (lane >> 3) + 8 * j;
        const float* sp = scr + (8 * c) * 33 + n;
        uint4 o; o.x = pk2(sp[0], sp[33]); o.y = pk2(sp[66], sp[99]); o.z = pk2(sp[132], sp[165]); o.w = pk2(sp[198], sp[231]);
        { typedef unsigned u32x4_t __attribute__((ext_vector_type(4))); const u32x4_t ov = {o.x, o.y, o.z, o.w};
          __builtin_nontemporal_store(ov, (u32x4_t*)(dst + km_off(n0 + n, k0 + 8 * c, kmrows))); }
    }
}

constexpr int EW_GU = 16 * 16, EW_DN = 4 * 32, EW_EX = EW_GU + EW_DN, EW_ITEMS = NE1 * EW_EX;
__device__ __forceinline__ void expert_w_item(CParams& p, int it, float* scr, int lane) {
    unsigned char* ws = p.ws;
    const int e = it / EW_EX; int r = it - e * EW_EX;
    const float* wg = (e < NEXP) ? p.in[18] + (size_t)e * 1024 * 256 : p.in[21];
    const float* wu = (e < NEXP) ? p.in[19] + (size_t)e * 1024 * 256 : p.in[22];
    const float* wd = (e < NEXP) ? p.in[20] + (size_t)e * 256 * 1024 : p.in[23];
    if (r < EW_GU) tconv_wave(wg, wu, 256, (bf16_t*)(ws + WS_W_EGU_T) + (size_t)e * 512 * 1024, 512, (r & 15) * 64, (r >> 4) * 32, 2, scr, lane);
    else { r -= EW_GU; tconv_wave(wd, nullptr, 1024, (bf16_t*)(ws + WS_W_ED_T) + (size_t)e * 1024 * 256, 1024, (r & 3) * 64, (r >> 2) * 32, 0, scr, lane); }
}

__device__ __forceinline__ void phase0(CParams& p, char* lds, int wv) {
    const int tid = opaque_tid(wv), G = gridDim.x, bid = blockIdx.x;
    unsigned char* ws = p.ws;
    float* tl = (float*)lds;
    if (bid == 0) { int* cnt = (int*)(ws + WS_CNT); for (int i = tid; i < 1024; i += NTHREADS) cnt[i] = 0; }
    {
        const int lane = tid & 63, wid = tid >> 6;
        const float* x = p.in[0]; bf16_t* xb = (bf16_t*)(ws + WS_XB);
        const int tl = lane >> 3, c4 = lane & 7;
        for (int it = bid * 8 + wid; it < (T / 8) * 4; it += G * 8) {
            const int tg = it >> 2, kq = it & 3;
            const float* src = x + (size_t)(tg * 8 + tl) * 1024 + kq * 256 + c4 * 4;
            float4 v[8];
#pragma unroll
            for (int j = 0; j < 8; ++j) v[j] = ldnt4(src + j * 32);
#pragma unroll
            for (int j = 0; j < 8; ++j) {
                uint2 o; o.x = pk2(v[j].x, v[j].y); o.y = pk2(v[j].z, v[j].w);
                *(uint2*)(xb + km_off(tg * 8 + tl, (kq * 8 + j) * 32 + c4 * 4, T)) = o;
            }
        }
        const int NM = NB * NMEM * DM / 4096;
        for (int it = bid; it < NM; it += G) {
            const size_t off = (size_t)it * 4096;
            const float4 v0 = ldnt4(p.in[1] + off + tid * 8), v1 = ldnt4(p.in[1] + off + tid * 8 + 4);
            uint4 o; o.x = pk2(v0.x, v0.y); o.y = pk2(v0.z, v0.w); o.z = pk2(v1.x, v1.y); o.w = pk2(v1.z, v1.w);
            *(uint4*)((bf16_t*)(ws + WS_MEMB) + off + tid * 8) = o;
        }
    }
    {
        constexpr int I_IN = 24 * 16, I_QI = 8 * 4, I_MK = 4 * 16, I_MV = 4 * 16, I_OUT = 8 * 16;
        constexpr int NIT = I_IN + I_QI + I_MK + I_MV + I_OUT;
        for (int it = bid; it < NIT; it += G) {
            int r = it;
            if (r < I_IN) { tconv_tile(p.in[2], nullptr, 1480, (bf16_t*)(ws + WS_W_IN_T), 1024, (r % 16) * 64, (r / 16) * 64, 1, tl, tid, 1536, 0, 0); continue; } r -= I_IN;
            if (r < I_QI) { tconv_tile(p.in[8], nullptr, 512, (bf16_t*)(ws + WS_W_Q2_T), 256, (r % 4) * 64, (r / 4) * 64, 0, tl, tid, 1536, 1024, 0); continue; } r -= I_QI;
            if (r < I_MK) { tconv_tile(p.in[11], nullptr, 256, (bf16_t*)(ws + WS_W_MKV_T), 1024, (r % 16) * 64, (r / 16) * 64, 0, tl, tid); continue; } r -= I_MK;
            if (r < I_MV) { tconv_tile(p.in[12], nullptr, 256, (bf16_t*)(ws + WS_W_MKV_T) + (size_t)256 * 1024, 1024, (r % 16) * 64, (r / 16) * 64, 0, tl, tid); continue; } r -= I_MV;
            tconv_tile(p.in[13] + (size_t)512 * 1024, nullptr, 1024, (bf16_t*)(ws + WS_W_OUT2_T), 1536, (r % 8) * 64, (r / 8) * 64, 0, tl, tid, 1024, 0, 1024);
        }
        __syncthreads();
        __syncthreads();
    }
    {
        const float* wuq = p.in[5]; const float* wuk = p.in[6];
        bf16_t* dst = (bf16_t*)(ws + WS_W_Q2_T);
        for (int it = bid; it < 512; it += G) {
            const int o = it * 512 + tid, n = o >> 8, r = o & 255, h = n >> 7, cc = n & 127;
            const float* a = wuq + (size_t)r * 512 + h * 64; const float* b = wuk + (size_t)cc * 512 + h * 64;
            float s = 0.f;
#pragma unroll 4
            for (int d = 0; d < 64; d += 4) { const float4 x = *(const float4*)(a + d), y = *(const float4*)(b + d); s += x.x * y.x + x.y * y.y + x.z * y.z + x.w * y.w; }
            dst[km_off(n, r, 1536)] = f2bf(s * (0.125f * 1.4426950408889634f));
        }
    }
    {
        const float* wuv = p.in[7]; const float* wout = p.in[13];
        bf16_t* dst = (bf16_t*)(ws + WS_W_OUT2_T);
        float* Lu = tl;
        float* Lo = tl + 8192;
        for (int it = bid; it < 128; it += G) {
            const int h = it >> 4, nt = it & 15;
            __syncthreads();
#pragma unroll
            for (int i = 0; i < 16; ++i) { const int idx = tid + i * 512, cc = idx >> 6, d = idx & 63; Lu[idx] = wuv[(size_t)(cc * 8 + h) * 64 + d]; }
#pragma unroll
            for (int i = 0; i < 8; ++i) { const int idx = tid + i * 512, d = idx >> 6, n = idx & 63; Lo[idx] = wout[(size_t)(h * 64 + d) * 1024 + nt * 64 + n]; }
            __syncthreads();
            const int n = tid & 63, cg = tid >> 6;
            float acc[16];
#pragma unroll
            for (int i = 0; i < 16; ++i) acc[i] = 0.f;
            for (int d = 0; d < 64; ++d) {
                const float w = Lo[d * 64 + n];
#pragma unroll
                for (int i = 0; i < 16; ++i) acc[i] = fmaf(Lu[(cg * 16 + i) * 64 + d], w, acc[i]);
            }
            uint4 o0, o1;
            o0.x = pk2(acc[0], acc[1]); o0.y = pk2(acc[2], acc[3]); o0.z = pk2(acc[4], acc[5]); o0.w = pk2(acc[6], acc[7]);
            o1.x = pk2(acc[8], acc[9]); o1.y = pk2(acc[10], acc[11]); o1.z = pk2(acc[12], acc[13]); o1.w = pk2(acc[14], acc[15]);
            bf16_t* dp = dst + km_off(nt * 64 + n, h * 128 + cg * 16, 1024);
            *(uint4*)dp = o0; *(uint4*)(dp + 8) = o1;
        }
        __syncthreads();
    }
    {
        const float* wr = p.in[16]; bf16_t* dst = (bf16_t*)(ws + WS_W_R_T);
        for (int it = bid; it < 128; it += G) {
            const int o = it * 512 + tid, e = o >> 10, k = o & 1023;
            const float w = wr[(size_t)k * 64 + e]; const bf16_t hi = f2bf(w), lo = f2bf(w - bf2f(hi));
            dst[(size_t)e * 2048 + k] = hi; dst[(size_t)e * 2048 + 1024 + k] = hi;
            dst[(size_t)(64 + e) * 2048 + k] = lo; dst[(size_t)(64 + e) * 2048 + 1024 + k] = 0;
        }
    }
}

template <bool RESYNC>
__device__ __forceinline__ void g8_store_tile(const f32x4 (&acc)[2][2][4][2], bf16_t* C, size_t ldc, int row0, int col0, const float* w8, char* lds, int tid_, int wv) {
    const int tid = opaque_i(tid_);
    const int lane = tid & 63, wr = wv >> 2, wc = wv & 3, fr = lane & 15, fq = lane >> 4;
    char* stg = lds + LDS_STG;
    if (RESYNC) { if (wr == 0) __builtin_amdgcn_s_barrier(); }
#pragma unroll
    for (int ai = 0; ai < 2; ++ai) {
#pragma unroll
        for (int m = 0; m < 4; ++m) {
            const float sc = w8 ? w8[ai * 4 + m] : 1.f;
            char* rp = stg + (wr * 64 + m * 16 + fr) * 528 + (wc * 32 + 4 * fq) * 2;
#pragma unroll
            for (int bj = 0; bj < 2; ++bj)
#pragma unroll
                for (int n = 0; n < 2; ++n) {
                    uint2 o; o.x = pk2(acc[ai][bj][m][n][0] * sc, acc[ai][bj][m][n][1] * sc); o.y = pk2(acc[ai][bj][m][n][2] * sc, acc[ai][bj][m][n][3] * sc);
                    *(uint2*)(rp + (bj * 128 + n * 16) * 2) = o;
                }
        }
        asm volatile("s_waitcnt lgkmcnt(0)" ::: "memory"); __builtin_amdgcn_s_barrier(); asm volatile("" ::: "memory");
        uint4 v[8];
#pragma unroll
        for (int i = 0; i < 8; ++i) { const int id = tid + i * 512; v[i] = *(const uint4*)(stg + (id >> 5) * 528 + (id & 31) * 16); }
#pragma unroll
        for (int i = 0; i < 8; ++i) { const int id = tid + i * 512; *(uint4*)(C + (size_t)(row0 + ai * 128 + (id >> 5)) * ldc + col0 + (id & 31) * 8) = v[i]; }
        asm volatile("s_waitcnt lgkmcnt(0)" ::: "memory"); __builtin_amdgcn_s_barrier(); asm volatile("" ::: "memory");
    }
    if (RESYNC) { if (wr == 1) __builtin_amdgcn_s_barrier(); }
}
__device__ __forceinline__ void g8_store_proj(const f32x4 (&acc)[2][2][4][2], CParams& p, int brow, int nt, char* lds, int tid_, int wv) {
    const int tid = opaque_i(tid_);
    const int lane = tid & 63, wr = wv >> 2, wc = wv & 3, fr = lane & 15, fq = lane >> 4;
    unsigned char* ws = p.ws;
    char* stg = lds + LDS_STG;
    float* rs = (float*)(stg + 128 * 528);
    bf16_t* proj = (bf16_t*)(ws + WS_PROJ);
#pragma unroll
    for (int ai = 0; ai < 2; ++ai) {
#pragma unroll
        for (int m = 0; m < 4; ++m) {
            char* rp = stg + (wr * 64 + m * 16 + fr) * 528 + (wc * 32 + 4 * fq) * 2;
#pragma unroll
            for (int bj = 0; bj < 2; ++bj)
#pragma unroll
                for (int n = 0; n < 2; ++n) {
                    uint2 o; o.x = pk2(acc[ai][bj][m][n][0], acc[ai][bj][m][n][1]); o.y = pk2(acc[ai][bj][m][n][2], acc[ai][bj][m][n][3]);
                    *(uint2*)(rp + (bj * 128 + n * 16) * 2) = o;
                }
        }
        asm volatile("s_waitcnt lgkmcnt(0)" ::: "memory"); __builtin_amdgcn_s_barrier(); asm volatile("" ::: "memory");
        const int r0g = brow + ai * 128;
        if (nt != 0) {
            uint4 v[8];
#pragma unroll
            for (int i = 0; i < 8; ++i) { const int id = tid + i * 512; v[i] = *(const uint4*)(stg + (id >> 5) * 528 + (id & 31) * 16); }
#pragma unroll
            for (int i = 0; i < 8; ++i) { const int id = tid + i * 512; *(uint4*)(proj + (size_t)(r0g + (id >> 5)) * NPROJ + nt * 256 + (id & 31) * 8) = v[i]; }
        }
        if (nt <= 1) {
            const int row = tid >> 2, q = tid & 3;
            const int ncol = (nt == 0) ? 256 : 128, per = ncol >> 2;
            float ss = 0.f;
            for (int c = 0; c < per; c += 8) {
                float f[8]; const uint4 u = *(const uint4*)(stg + row * 528 + (q * per + c) * 2); unpack8(u, f);
#pragma unroll
                for (int j = 0; j < 8; ++j) ss = fmaf(f[j], f[j], ss);
            }
            ss += dpp_f<0xB1>(ss); ss += dpp_f<0x4E>(ss);
            if (q == 0) rs[row] = rsqrtf(ss / (float)ncol + RMS_EPS);
            asm volatile("s_waitcnt lgkmcnt(0)" ::: "memory"); __builtin_amdgcn_s_barrier(); asm volatile("" ::: "memory");
            if (nt == 0) {
                const float* gq = p.in[3]; bf16_t* cqn = (bf16_t*)(ws + WS_CQN);
#pragma unroll
                for (int i = 0; i < 8; ++i) {
                    const int id = tid + i * 512, c4 = id & 3, rw = (id >> 2) & 127, kt = id >> 9, col = kt * 32 + c4 * 8;
                    float f[8]; const uint4 u = *(const uint4*)(stg + rw * 528 + col * 2); unpack8(u, f);
                    const float r = rs[rw];
                    const float4 g0 = *(const float4*)(gq + col), g1 = *(const float4*)(gq + col + 4);
                    uint4 o; o.x = pk2(f[0] * r * g0.x, f[1] * r * g0.y); o.y = pk2(f[2] * r * g0.z, f[3] * r * g0.w); o.z = pk2(f[4] * r * g1.x, f[5] * r * g1.y); o.w = pk2(f[6] * r * g1.z, f[7] * r * g1.w);
                    *(uint4*)(cqn + km_off(r0g + rw, col, T)) = o;
                }
            } else {
                const float* gkv = p.in[4]; bf16_t* ckvn = (bf16_t*)(ws + WS_CKVN); bf16_t* kidxf = (bf16_t*)(ws + WS_KIDX);
#pragma unroll
                for (int i = 0; i < 4; ++i) {
                    const int id = tid + i * 512, rw = id >> 4, ch = id & 15, col = ch * 8;
                    float f[8]; const uint4 u = *(const uint4*)(stg + rw * 528 + col * 2); unpack8(u, f);
                    const float r = rs[rw];
                    const float4 g0 = *(const float4*)(gkv + col), g1 = *(const float4*)(gkv + col + 4);
                    uint4 o; o.x = pk2(f[0] * r * g0.x, f[1] * r * g0.y); o.y = pk2(f[2] * r * g0.z, f[3] * r * g0.w); o.z = pk2(f[4] * r * g1.x, f[5] * r * g1.y); o.w = pk2(f[6] * r * g1.z, f[7] * r * g1.w);
                    *(uint4*)(ckvn + (size_t)(r0g + rw) * 128 + col) = o;
                }
#pragma unroll
                for (int i = 0; i < 2; ++i) {
                    const int id = tid + i * 512, f16 = id & 15, fq2 = (id >> 4) & 3, kk = (id >> 6) & 1, t16 = id >> 7;
                    const uint4 u = *(const uint4*)(stg + (t16 * 16 + f16) * 528 + (128 + kk * 32 + fq2 * 8) * 2);
                    *(uint4*)(kidxf + ((size_t)(((r0g >> 4) + t16) * 2 + kk) * 64 + fq2 * 16 + f16) * 8) = u;
                }
            }
        }
        asm volatile("s_waitcnt lgkmcnt(0)" ::: "memory"); __builtin_amdgcn_s_barrier(); asm volatile("" ::: "memory");
    }
}
__device__ __forceinline__ int vblock() { const int G = gridDim.x, b = blockIdx.x; return ((G & 7) == 0) ? (b & 7) * (G >> 3) + (b >> 3) : b; }

__device__ __forceinline__ void phase1(CParams& p, char* lds, int wv) {
    const int tid = opaque_tid(wv), lane = tid & 63, wid = tid >> 6, wm = wid >> 2, wn = wid & 3;
    unsigned char* ws = p.ws;
    constexpr int I1 = (T / 256) * 6, I2 = (4096 / 128) * 2, I3 = 2 * (4096 / 128);
    {
        int it = vblock();
        g8::Src s;
        if (it < I1) { g8::km_src(s, (const bf16_t*)(ws + WS_XB), T, (it / 6) * 256, (const bf16_t*)(ws + WS_W_IN_T), 1536, (it % 6) * 256, tid); g8::kloop_issue(s, lds, wv); }
        while (it < I1) {
            const int brow = (it / 6) * 256, bcol = (it % 6) * 256;
            f32x4 acc[2][2][4][2]; g8::acc_zero(acc);
            g8::kloop(acc, s, 32, lds, tid, wv);
            it += gridDim.x;
            if (it < I1) { g8::km_src(s, (const bf16_t*)(ws + WS_XB), T, (it / 6) * 256, (const bf16_t*)(ws + WS_W_IN_T), 1536, (it % 6) * 256, tid); g8::kloop_issue(s, lds, wv); }
            g8_store_proj(acc, p, brow, bcol >> 8, lds, tid, wv);
        }
    }
    asm volatile("s_waitcnt vmcnt(0)" ::: "memory");
    __syncthreads();
    for (int it = blockIdx.x; it < I2 + I3; it += gridDim.x) {
        if (it < I2) { const int r = it; gemm_item_bf16<1>((const bf16_t*)(ws + WS_MEMB), 1024, (const bf16_t*)(ws + WS_W_MKV_T), 1024, 16, (bf16_t*)(ws + WS_KMEM), 256, (r / 2) * 128, (r % 2) * 128, lds, tid, lane, wm, wn); }
        else { const int r = it - I2;
            gemm_item_bf16<2>((const bf16_t*)(ws + WS_W_MKV_T) + (size_t)256 * 1024, 1024, (const bf16_t*)(ws + WS_MEMB), 1024, 16, (bf16_t*)(ws + WS_VTMEM), 4096, (r / 32) * 128, (r % 32) * 128, lds, tid, lane, wm, wn); }
    }
}

__device__ __forceinline__ void phase2(CParams& p, int wv) {
    const int tid = opaque_tid(wv), lane = tid & 63, wid = tid >> 6;
    unsigned char* ws = p.ws;
    const bf16_t* proj = (const bf16_t*)(ws + WS_PROJ);
    bf16_t* cqn = (bf16_t*)(ws + WS_CQN); bf16_t* ckvn = (bf16_t*)(ws + WS_CKVN);
    const float* gq = p.in[3]; const float* gkv = p.in[4];
    for (int t = blockIdx.x * 8 + wid; t < T; t += gridDim.x * 8) {
        const bf16_t* row = proj + (size_t)t * NPROJ;
        {
            const uint2 v = *(const uint2*)(row + PC_CQ + lane * 4);
            const float a = bflo(v.x), b = bfhi(v.x), c = bflo(v.y), d = bfhi(v.y);
            const float ss = wave_sum(a * a + b * b + c * c + d * d);
            const float r = rsqrtf(ss * (1.f / 256.f) + RMS_EPS);
            const float4 g = *(const float4*)(gq + lane * 4);
            uint2 o; o.x = pk2(a * r * g.x, b * r * g.y); o.y = pk2(c * r * g.z, d * r * g.w);
            *(uint2*)(cqn + km_off(t, lane * 4, T)) = o;
        }
        {
            const uint32_t v = *(const uint32_t*)(row + PC_CKV + lane * 2);
            const float a = bflo(v), b = bfhi(v);
            const float ss = wave_sum(a * a + b * b);
            const float r = rsqrtf(ss * (1.f / 128.f) + RMS_EPS);
            const float2 g = *(const float2*)(gkv + lane * 2);
            *(uint32_t*)(ckvn + (size_t)t * 128 + lane * 2) = pk2(a * r * g.x, b * r * g.y);
        }
        if (lane < 32) {
            const int dd = lane * 2;
            const size_t off = ((size_t)((t >> 4) * 2 + (dd >> 5)) * 64 + ((dd & 31) >> 3) * 16 + (t & 15)) * 8 + (dd & 7);
            *(uint32_t*)((bf16_t*)(ws + WS_KIDX) + off) = *(const uint32_t*)(row + PC_KIDX + dd);
        }
    }
}

__device__ __forceinline__ void phase3(CParams& p, char* lds, int wv) {
    const int tid = opaque_tid(wv);
    unsigned char* ws = p.ws;
    constexpr int I1 = (T / 256) * 6;
    int it = vblock();
    g8::Src s;
    if (it < I1) { g8::km_src(s, (const bf16_t*)(ws + WS_CQN), T, (it / 6) * 256, (const bf16_t*)(ws + WS_W_Q2_T), 1536, (it % 6) * 256, tid); g8::kloop_issue(s, lds, wv); }
    while (it < I1) {
        const int brow = (it / 6) * 256, bcol = (it % 6) * 256;
        f32x4 acc[2][2][4][2]; g8::acc_zero(acc);
        g8::kloop(acc, s, 8, lds, tid, wv);
        it += gridDim.x;
        if (it < I1) { g8::km_src(s, (const bf16_t*)(ws + WS_CQN), T, (it / 6) * 256, (const bf16_t*)(ws + WS_W_Q2_T), 1536, (it % 6) * 256, tid); g8::kloop_issue(s, lds, wv); }
        g8_store_tile<false>(acc, (bf16_t*)(ws + WS_Q2), 1536, brow, bcol, nullptr, lds, tid, wv);
    }
}

typedef short s16x4 __attribute__((ext_vector_type(4)));
__device__ __forceinline__ int t5_bucket(int n) {
    if (n < 16) return n;
    if (n >= 128) return 31;
    const int l = 16 + (int)(__log2f((float)n * 0.0625f) * (16.0f / 3.0f));
    return l < 31 ? l : 31;
}
__device__ __forceinline__ bf16x8 ld_frag(const bf16_t* p) { return *(const bf16x8*)p; }
__device__ __forceinline__ bf16x8 u4_as_frag(const uint4& v) { union { uint4 u; bf16x8 f; } c; c.u = v; return c.f; }

constexpr int SK_STRIDE = 2052;
constexpr int P4_SEL = 16 * SK_STRIDE * 4;
constexpr int P4_RB = P4_SEL + 16 * 256 * 2;
constexpr int P4_SELB = P4_RB + 1024;

constexpr int P4_CSCR = P4_SELB + 4096;
constexpr int P4_HIST = P4_CSCR + 2048;
template <int NREG>
__device__ __forceinline__ void select_query(const uint32_t* skrow, unsigned short* sel, unsigned char* selb, uint32_t* cscr, uint32_t* hist, int t, int lane) {
    const unsigned long long ltmask = (1ull << lane) - 1ull;
    uint32_t key[NREG];
#pragma unroll
    for (int i = 0; i < NREG; ++i) { const int s = i * 64 + lane; const uint32_t kv = skrow[s]; key[i] = (s <= t) ? kv : 0u; }
    uint32_t prefix = 0; bool exact = false;
    int nS = 0, nU = t + 1, bit = 31;
    {
        const uint32_t cand = 0x80000000u;
        int cnt = 0;
#pragma unroll
        for (int i = 0; i < NREG; ++i) cnt += __popcll(__ballot(key[i] >= cand));
        if (cnt >= 256) { prefix = cand; nU = cnt; exact = (cnt == 256); } else { nU -= cnt; nS = cnt; }
        bit = 30;
        if (!exact && nU > 64) {
            uint32_t a = 0xFFFFFFFFu, o = 0u;
#pragma unroll
            for (int i = 0; i < NREG; ++i) { const bool inU = ((key[i] ^ prefix) >> 31) == 0u && key[i] != 0u; a &= inU ? key[i] : 0xFFFFFFFFu; o |= inU ? key[i] : 0u; }
#pragma unroll
            for (int d = 1; d < 64; d <<= 1) { a &= (uint32_t)__shfl_xor((int)a, d); o |= (uint32_t)__shfl_xor((int)o, d); }
            const uint32_t diff = (a ^ o) & 0x7FFFFFFFu;
            if (diff == 0u) { prefix = a; bit = -1; }
            else {
                const int top = 31 - __clz(diff);
                const uint32_t keep = (top >= 30) ? 0u : (0x7FFFFFFFu & ~((2u << top) - 1u));
                prefix |= a & keep;
                const int nb = (top + 1 < 8) ? top + 1 : 8, shift = top + 1 - nb;
                *(uint4*)(hist + lane * 4) = make_uint4(0u, 0u, 0u, 0u);
                wave_sync();
#pragma unroll
                for (int i = 0; i < NREG; ++i) {
                    const bool inU = ((key[i] ^ prefix) >> (top + 1)) == 0u && key[i] != 0u;
                    if (inU) atomicAdd(&hist[(key[i] >> shift) & 255u], 1u);
                }
                wave_sync();
                const uint4 h4 = *(const uint4*)(hist + lane * 4);
                int suf = (int)(h4.x + h4.y + h4.z + h4.w);
#pragma unroll
                for (int d = 1; d < 64; d <<= 1) { const int v = __shfl_down(suf, d); if (lane + d < 64) suf += v; }
                const int need = 256 - nS;
                const int L = __popcll(__ballot(suf >= need)) - 1;
                const int above = (L < 63) ? __builtin_amdgcn_readlane(suf, (L + 1) & 63) : 0;
                const int hb[4] = {__builtin_amdgcn_readlane((int)h4.x, L), __builtin_amdgcn_readlane((int)h4.y, L), __builtin_amdgcn_readlane((int)h4.z, L), __builtin_amdgcn_readlane((int)h4.w, L)};
                int c = above, dig = 4 * L, inbin = 0, aboved = above;
                bool found = false;
#pragma unroll
                for (int j = 3; j >= 0; --j) { if (!found) { const int c2 = c + hb[j]; if (c2 >= need) { dig = 4 * L + j; inbin = hb[j]; aboved = c; found = true; } c = c2; } }
                prefix |= (uint32_t)dig << shift;
                nS += aboved; nU = inbin;
                exact = (nS + nU == 256);
                bit = shift - 1;
            }
        }
    }
    for (; !exact && bit >= 0 && nU > 64; --bit) {
        const uint32_t cand = prefix | (1u << bit);
        int cnt = 0;
#pragma unroll
        for (int i = 0; i < NREG; ++i) cnt += __popcll(__ballot(key[i] >= cand));
        if (cnt >= 256) { prefix = cand; nU = cnt - nS; if (cnt == 256) { exact = true; break; } }
        else { nU -= cnt - nS; nS = cnt; }
    }
    int quota = 0; bool have_quota = false;
    if (!exact && bit >= 0) {
        const int sh = bit + 1;
        int pos = 0;
        wave_sync();
#pragma unroll
        for (int i = 0; i < NREG; ++i) {
            const bool inU = (key[i] >> sh) == (prefix >> sh) && key[i] != 0u;
            const unsigned long long bu = __ballot(inU);
            if (inU) { const int d = pos + __popcll(bu & ltmask); if (d < 64) cscr[d] = key[i]; }
            pos += __popcll(bu);
        }
        wave_sync();
        const uint32_t u = (lane < pos) ? cscr[lane] : 0u;
        for (; bit >= 0; --bit) {
            const uint32_t cand = prefix | (1u << bit);
            const int cnt = nS + __popcll(__ballot(u >= cand));
            if (cnt >= 256) { prefix = cand; if (cnt == 256) { exact = true; break; } }
        }
        if (!exact) {
            if (nS + __popcll(__ballot(u >= prefix)) == 256) exact = true;
            else { quota = 256 - (nS + __popcll(__ballot(u > prefix))); have_quota = true; }
        }
    }
    if (!exact && !have_quota) {
        int cgt = 0;
#pragma unroll
        for (int i = 0; i < NREG; ++i) cgt += __popcll(__ballot(key[i] > prefix));
        quota = 256 - cgt;
    }
    int pos = 0, eqc = 0;
#pragma unroll
    for (int i = 0; i < NREG; ++i) {
        const uint32_t u = key[i];
        bool take;
        if (exact) take = (u >= prefix);
        else {
            const bool eq = (u == prefix);
            const unsigned long long beq = __ballot(eq);
            const int myeq = eqc + __popcll(beq & ltmask);
            take = (u > prefix) || (eq && myeq < quota);
            eqc += __popcll(beq);
        }
        const unsigned long long bt = __ballot(take);
        if (take) {
            const int dst = pos + __popcll(bt & ltmask); sel[dst] = (unsigned short)(i * 64 + lane);
            if (t - (i * 64 + 63) >= 128) selb[dst] = (unsigned char)31;
            else selb[dst] = (unsigned char)t5_bucket(t - (i * 64 + lane));
        }
        pos += __popcll(bt);
    }
}

__device__ __forceinline__ void dsa_item(CParams& p, int b, int t0, char* lds, int tid_in, int wv) {
    const int tid = opaque_i(tid_in);
    const int lane = tid & 63, wid = tid >> 6, fr = lane & 15, fq = lane >> 4;
    unsigned char* ws = p.ws;
    uint32_t* SK = (uint32_t*)lds;
    unsigned short* SEL = (unsigned short*)(lds + P4_SEL);
    const float* RB = (const float*)(lds + P4_RB);
    unsigned char* SELB = (unsigned char*)(lds + P4_SELB);
    const bf16_t* q2 = (const bf16_t*)(ws + WS_Q2) + ((size_t)b * SEQ + t0) * 1536;
    const bf16_t* kidx = (const bf16_t*)(ws + WS_KIDX) + (size_t)b * SEQ * 64;
    const bf16_t* ckvn = (const bf16_t*)(ws + WS_CKVN) + (size_t)b * SEQ * 128;
    __syncthreads();
    if (t0 >= 256) {
        bf16x8 qf[8][2];
#pragma unroll
        for (int h = 0; h < 8; ++h)
#pragma unroll
            for (int kk = 0; kk < 2; ++kk) qf[h][kk] = ld_frag(q2 + (size_t)fr * 1536 + 1024 + h * 64 + kk * 32 + fq * 8);
        float wv[8];
        { const uint4 v = *(const uint4*)((const bf16_t*)(ws + WS_PROJ) + ((size_t)b * SEQ + t0 + fr) * NPROJ + PC_IDXW); unpack8(v, wv); }
#pragma unroll
        for (int i = 0; i < 8; ++i) wv[i] *= IDXW_SCALE;
        const int ntile = (t0 + 16) >> 4;
        const int tq = t0 + fr;
        bf16x8 kn0 = ld_frag(kidx + (size_t)(wid * 2) * 512 + lane * 8), kn1 = ld_frag(kidx + (size_t)(wid * 2 + 1) * 512 + lane * 8);
        for (int kt = wid; kt < ntile; kt += 8) {
            const int key0 = kt * 16;
            const bf16x8 kf0 = kn0, kf1 = kn1;
            { const int kx = (kt + 8 < ntile) ? kt + 8 : kt;
              kn0 = ld_frag(kidx + (size_t)(kx * 2) * 512 + lane * 8); kn1 = ld_frag(kidx + (size_t)(kx * 2 + 1) * 512 + lane * 8); }
            float sacc[4] = {0.f, 0.f, 0.f, 0.f};
#pragma unroll
            for (int h = 0; h < 8; ++h) {
                f32x4 d = (f32x4){0.f, 0.f, 0.f, 0.f};
                d = __builtin_amdgcn_mfma_f32_16x16x32_bf16(kf0, qf[h][0], d, 0, 0, 0);
                d = __builtin_amdgcn_mfma_f32_16x16x32_bf16(kf1, qf[h][1], d, 0, 0, 0);
#pragma unroll
                for (int r = 0; r < 4; ++r) sacc[r] = fmaf(wv[h], fmaxf(d[r], 0.f), sacc[r]);
            }
            uint4 ko;
            uint32_t kk4[4];
#pragma unroll
            for (int r = 0; r < 4; ++r) {
                const int s = key0 + 4 * fq + r;
                float sc = sacc[r]; if (sc == 0.f) sc = 0.f;
                const uint32_t u = __float_as_uint(sc);
                const uint32_t key = (u & 0x80000000u) ? ~u : (u | 0x80000000u);
                kk4[r] = (s <= tq) ? key : 0u;
            }
            ko.x = kk4[0]; ko.y = kk4[1]; ko.z = kk4[2]; ko.w = kk4[3];
            *(uint4*)(SK + fr * SK_STRIDE + key0 + 4 * fq) = ko;
        }
        __syncthreads();
#pragma nounroll
        for (int qq = 0; qq < 2; ++qq) {
            const int q = wid * 2 + qq, t = t0 + q;
            uint32_t* cscr = (uint32_t*)(lds + P4_CSCR) + wid * 64;
#define DSA_SEL(N) select_query<N>(SK + q * SK_STRIDE, SEL + q * 256, SELB + q * 256, cscr, (uint32_t*)(lds + P4_HIST) + wid * 256, t, lane)
            switch (__builtin_amdgcn_readfirstlane(t0 >> 8)) {
                case 1: DSA_SEL(8); break;
                case 2: DSA_SEL(12); break;
                case 3: DSA_SEL(16); break;
                case 4: DSA_SEL(20); break;
                case 5: DSA_SEL(24); break;
                case 6: DSA_SEL(28); break;
                default: DSA_SEL(32); break;
            }
#undef DSA_SEL
        }
    } else {
        for (int qq = 0; qq < 2; ++qq) {
            const int q = wid * 2 + qq, t = t0 + q;
            for (int k = lane; k <= t; k += 64) { SEL[q * 256 + k] = (unsigned short)k; SELB[q * 256 + k] = (unsigned char)t5_bucket(t - k); }
        }
    }
    __syncthreads();
    char* vst = lds + wv * 16384;
    bf16_t* cat = (bf16_t*)(ws + WS_CAT2);
    const __amdgpu_buffer_rsrc_t rkv = g8::make_rsrc(ckvn);
#pragma nounroll
    for (int qq = 0; qq < 2; ++qq) {
        const int q = wid * 2 + qq, t = t0 + q;
        const int nsel = (t + 1 < 256) ? t + 1 : 256;
        const size_t tok = (size_t)b * SEQ + t;
        const unsigned short* selq = SEL + q * 256;
        bf16x8 qf[4];
#pragma unroll
        for (int kk = 0; kk < 4; ++kk) {
            uint4 v = make_uint4(0, 0, 0, 0);
            if (fr < 8) v = *(const uint4*)(q2 + (size_t)q * 1536 + fr * 128 + kk * 32 + fq * 8);
            qf[kk] = u4_as_frag(v);
        }
        asm volatile("" :: "v"(qf[0]), "v"(qf[1]), "v"(qf[2]), "v"(qf[3]));
        float m = -INFINITY, l = 0.f;
        f32x4 O[8];
#pragma unroll
        for (int ct = 0; ct < 8; ++ct) O[ct] = (f32x4){0.f, 0.f, 0.f, 0.f};
        const int nck = (nsel + 31) >> 5;
#define DSA_ISSUE(c) do { int sv_[8]; \
            _Pragma("unroll") for (int pc = 0; pc < 8; ++pc) sv_[pc] = (int)selq[(c) * 32 + pc * 4 + fq];     \
            _Pragma("unroll") for (int pc = 0; pc < 8; ++pc) { \
            const int row_ = pc * 4 + fq; const int k_ = (c) * 32 + row_; \
            const int s_ = (k_ < nsel) ? sv_[pc] : 0; \
            __builtin_amdgcn_raw_ptr_buffer_load_lds(rkv, (LAS void*)(vst + ((c) & 1) * 8192 + pc * 1024), 16, (unsigned)(s_ * 256 + ((fr ^ (row_ & 15)) << 4)), 0, 0, 0); } } while (0)
        DSA_ISSUE(0);
#pragma nounroll
        for (int ck = 0; ck < nck; ++ck) {
            if (ck + 1 < nck) { DSA_ISSUE(ck + 1); asm volatile("s_waitcnt vmcnt(8)" ::: "memory"); }
            else asm volatile("s_waitcnt vmcnt(0)" ::: "memory");
            const char* buf = vst + (ck & 1) * 8192;
            bf16x8 a0[4], a1[4];
#pragma unroll
            for (int kk = 0; kk < 4; ++kk) {
                const int ch = ((kk * 4 + fq) ^ fr) << 4;
                a0[kk] = *(const bf16x8*)(buf + fr * 256 + ch);
                a1[kk] = *(const bf16x8*)(buf + (16 + fr) * 256 + ch);
            }
            f32x4 d0 = (f32x4){0.f, 0.f, 0.f, 0.f}, d1 = (f32x4){0.f, 0.f, 0.f, 0.f};
#pragma unroll
            for (int kk = 0; kk < 4; ++kk) {
                d0 = __builtin_amdgcn_mfma_f32_16x16x32_bf16(a0[kk], qf[kk], d0, 0, 0, 0);
                d1 = __builtin_amdgcn_mfma_f32_16x16x32_bf16(a1[kk], qf[kk], d1, 0, 0, 0);
            }
            float lg0[4], lg1[4];
            {
                const int kb = ck * 32 + 4 * fq;
                const uint32_t bw0 = *(const uint32_t*)(SELB + q * 256 + kb), bw1 = *(const uint32_t*)(SELB + q * 256 + kb + 16);
#pragma unroll
                for (int r = 0; r < 4; ++r) {
                    const bool v0 = (kb + r) < nsel, v1 = (kb + 16 + r) < nsel;
                    const int b0 = (int)((bw0 >> (8 * r)) & 31u), b1 = (int)((bw1 >> (8 * r)) & 31u);
                    const float rb0 = RB[b0 * 8 + (fr & 7)], rb1 = RB[b1 * 8 + (fr & 7)];
                    lg0[r] = (d0[r] + rb0) + (v0 ? 0.f : -INFINITY);
                    lg1[r] = (d1[r] + rb1) + (v1 ? 0.f : -INFINITY);
                }
            }
            float cm = fmaxf(fmaxf(fmaxf(lg0[0], lg0[1]), fmaxf(lg0[2], lg0[3])), fmaxf(fmaxf(lg1[0], lg1[1]), fmaxf(lg1[2], lg1[3])));
            cm = xrow16_max(cm);
            const float mn = fmaxf(m, cm);
            const float scl = __builtin_amdgcn_exp2f(m - mn);
            float p0[4], p1[4], ls = 0.f;
#pragma unroll
            for (int r = 0; r < 4; ++r) { p0[r] = __builtin_amdgcn_exp2f(lg0[r] - mn); p1[r] = __builtin_amdgcn_exp2f(lg1[r] - mn); ls += p0[r] + p1[r]; }
            ls = xrow16_sum(ls);
            l = l * scl + ls; m = mn;
            if (__any(scl != 1.f)) {
#pragma unroll
                for (int ct = 0; ct < 8; ++ct) O[ct] = O[ct] * scl;
            }
            uint4 pf; pf.x = pk2(p0[0], p0[1]); pf.y = pk2(p0[2], p0[3]); pf.z = pk2(p1[0], p1[1]); pf.w = pk2(p1[2], p1[3]);
            const bf16x8 pfrag = u4_as_frag(pf);
#pragma unroll
            for (int ct = 0; ct < 8; ++ct) {
                const int r0 = 4 * fq + (fr >> 2), r1 = r0 + 16;
                const int chn = ct * 2 + ((fr & 3) >> 1), sub = 8 * (fr & 1);
                const s16x4 va = __builtin_amdgcn_ds_read_tr16_b64_v4i16((s16x4 LAS*)(buf + r0 * 256 + ((chn ^ (r0 & 15)) << 4) + sub));
                const s16x4 vb = __builtin_amdgcn_ds_read_tr16_b64_v4i16((s16x4 LAS*)(buf + r1 * 256 + ((chn ^ (r1 & 15)) << 4) + sub));
                bf16x8 vf; vf[0] = va[0]; vf[1] = va[1]; vf[2] = va[2]; vf[3] = va[3]; vf[4] = vb[0]; vf[5] = vb[1]; vf[6] = vb[2]; vf[7] = vb[3];
                O[ct] = __builtin_amdgcn_mfma_f32_16x16x32_bf16(vf, pfrag, O[ct], 0, 0, 0);
            }
            asm volatile("" ::: "memory");
        }
#undef DSA_ISSUE
        const float inv = 1.f / l;
        if (fr < 8) {
#pragma unroll
            for (int ct = 0; ct < 8; ++ct) {
                uint2 o; o.x = pk2(O[ct][0] * inv, O[ct][1] * inv); o.y = pk2(O[ct][2] * inv, O[ct][3] * inv);
                *(uint2*)(cat + km_off((int)tok, fr * 128 + ct * 16 + 4 * fq, T)) = o;
            }
        }
        asm volatile("s_waitcnt vmcnt(0)" ::: "memory");
    }
}

#define MA_SB() __builtin_amdgcn_sched_barrier(0)
__device__ __forceinline__ void memattn_wave(CParams& p, int b, size_t tok0, int h, int lane) {
    const int fr = lane & 15, fq = lane >> 4;
    unsigned char* ws = p.ws;
    const bf16_t* proj = (const bf16_t*)(ws + WS_PROJ) + (tok0 + fr) * NPROJ + PC_QM + h * 64;
    const bf16_t* km = (const bf16_t*)(ws + WS_KMEM) + (size_t)(b * 4 + h) * (16 * 2 * 64 * 8) + lane * 8;
    const bf16_t* vt = (const bf16_t*)(ws + WS_VTMEM) + (size_t)(b * 4 + h) * (8 * 4 * 64 * 8) + lane * 8;
    const bf16x8 qf0 = ld_frag(proj + fq * 8), qf1 = ld_frag(proj + 32 + fq * 8);
    f32x4 d[16];
    bf16x8 kb[2][8];
#pragma unroll
    for (int j = 0; j < 4; ++j) { kb[0][2 * j] = ld_frag(km + (j * 2) * 512); kb[0][2 * j + 1] = ld_frag(km + (j * 2 + 1) * 512); }
    MA_SB();
#pragma unroll
    for (int g = 0; g < 4; ++g) {
        if (g < 3) {
#pragma unroll
            for (int j = 0; j < 4; ++j) { kb[(g + 1) & 1][2 * j] = ld_frag(km + ((g * 4 + 4 + j) * 2) * 512); kb[(g + 1) & 1][2 * j + 1] = ld_frag(km + ((g * 4 + 4 + j) * 2 + 1) * 512); }
        }
        MA_SB();
#pragma unroll
        for (int j = 0; j < 4; ++j) {
            f32x4 z = (f32x4){0.f, 0.f, 0.f, 0.f};
            z = __builtin_amdgcn_mfma_f32_16x16x32_bf16(kb[g & 1][2 * j], qf0, z, 0, 0, 0);
            z = __builtin_amdgcn_mfma_f32_16x16x32_bf16(kb[g & 1][2 * j + 1], qf1, z, 0, 0, 0);
            d[g * 4 + j] = z * (0.125f * 1.4426950408889634f);
        }
        MA_SB();
    }
    bf16x8 vb[2][8];
#pragma unroll
    for (int i = 0; i < 8; ++i) vb[0][i] = ld_frag(vt + i * 512);
    MA_SB();
    float mx = -INFINITY;
#pragma unroll
    for (int kt = 0; kt < 16; ++kt) mx = fmaxf(mx, fmaxf(fmaxf(d[kt][0], d[kt][1]), fmaxf(d[kt][2], d[kt][3])));
    mx = xrow16_max(mx);
    float s = 0.f;
#pragma unroll
    for (int kt = 0; kt < 16; ++kt)
#pragma unroll
        for (int r = 0; r < 4; ++r) { d[kt][r] = __builtin_amdgcn_exp2f(d[kt][r] - mx); s += d[kt][r]; }
    s = xrow16_sum(s);
    const float inv = 1.f / s;
    f32x4 O[4];
#pragma unroll
    for (int dt = 0; dt < 4; ++dt) O[dt] = (f32x4){0.f, 0.f, 0.f, 0.f};
    MA_SB();
#pragma unroll
    for (int g = 0; g < 4; ++g) {
        if (g < 3) {
#pragma unroll
            for (int i = 0; i < 8; ++i) vb[(g + 1) & 1][i] = ld_frag(vt + ((g + 1) * 8 + i) * 512);
        }
        MA_SB();
#pragma unroll
        for (int cc = 0; cc < 2; ++cc) {
            const int c32 = g * 2 + cc;
            uint4 pf; pf.x = pk2(d[2 * c32][0], d[2 * c32][1]); pf.y = pk2(d[2 * c32][2], d[2 * c32][3]); pf.z = pk2(d[2 * c32 + 1][0], d[2 * c32 + 1][1]); pf.w = pk2(d[2 * c32 + 1][2], d[2 * c32 + 1][3]);
            const bf16x8 pfrag = u4_as_frag(pf);
#pragma unroll
            for (int dt = 0; dt < 4; ++dt) O[dt] = __builtin_amdgcn_mfma_f32_16x16x32_bf16(vb[g & 1][cc * 4 + dt], pfrag, O[dt], 0, 0, 0);
        }
        MA_SB();
    }
    bf16_t* cat = (bf16_t*)(ws + WS_CAT2);
#pragma unroll
    for (int dt = 0; dt < 4; ++dt) {
        uint2 o; o.x = pk2(O[dt][0] * inv, O[dt][1] * inv); o.y = pk2(O[dt][2] * inv, O[dt][3] * inv);
        *(uint2*)(cat + km_off((int)tok0 + fr, 1280 + h * 64 + dt * 16 + 4 * fq, T)) = o;
    }
}

__device__ __forceinline__ void conv_tokens4(CParams& p, int b, int t0, int lane) {
    unsigned char* ws = p.ws;
    const bf16_t* proj = (const bf16_t*)(ws + WS_PROJ) + (size_t)b * SEQ * NPROJ;
    const float* cw = p.in[10];
    const int c = lane * 4;
    uint2 gc[6], hh[6], gb[4];
#pragma unroll
    for (int i = 0; i < 6; ++i) {
        const int tt = t0 - 2 + i, tc = tt < 0 ? 0 : tt;
        gc[i] = *(const uint2*)(proj + (size_t)tc * NPROJ + PC_GC + c); hh[i] = *(const uint2*)(proj + (size_t)tc * NPROJ + PC_H + c);
    }
#pragma unroll
    for (int i = 0; i < 4; ++i) gb[i] = *(const uint2*)(proj + (size_t)(t0 + i) * NPROJ + PC_GB + c);
    const float4 w0 = *(const float4*)(cw + c), w1 = *(const float4*)(cw + 256 + c), w2 = *(const float4*)(cw + 512 + c);
    float u[6][4];
#pragma unroll
    for (int i = 0; i < 6; ++i) {
        const float z = (t0 - 2 + i < 0) ? 0.f : 1.f;
        u[i][0] = bflo(gc[i].x) * bflo(hh[i].x) * z; u[i][1] = bfhi(gc[i].x) * bfhi(hh[i].x) * z;
        u[i][2] = bflo(gc[i].y) * bflo(hh[i].y) * z; u[i][3] = bfhi(gc[i].y) * bfhi(hh[i].y) * z;
    }
    bf16_t* cat = (bf16_t*)(ws + WS_CAT2);
#pragma unroll
    for (int i = 0; i < 4; ++i) {
        const float y0 = fmaf(w0.x, u[i][0], fmaf(w1.x, u[i + 1][0], w2.x * u[i + 2][0]));
        const float y1 = fmaf(w0.y, u[i][1], fmaf(w1.y, u[i + 1][1], w2.y * u[i + 2][1]));
        const float y2 = fmaf(w0.z, u[i][2], fmaf(w1.z, u[i + 1][2], w2.z * u[i + 2][2]));
        const float y3 = fmaf(w0.w, u[i][3], fmaf(w1.w, u[i + 1][3], w2.w * u[i + 2][3]));
        uint2 o; o.x = pk2(bflo(gb[i].x) * y0, bfhi(gb[i].x) * y1); o.y = pk2(bflo(gb[i].y) * y2, bfhi(gb[i].y) * y3);
        *(uint2*)(cat + km_off(b * SEQ + t0 + i, 1024 + c, T)) = o;
    }
}

__device__ __forceinline__ void phase4(CParams& p, char* lds, int wv) {
    const int tid = opaque_tid(wv), lane = tid & 63, wid = tid >> 6;
    if (tid < 256) ((float*)(lds + P4_RB))[tid] = p.in[9][tid] * 1.4426950408889634f;
    const int gw = blockIdx.x * 8 + wid, NW = gridDim.x * 8;
    const int ndsa = (T / 16 - (int)blockIdx.x + (int)gridDim.x - 1) / (int)gridDim.x;
    const int new_ = (EW_ITEMS - gw + NW - 1) / NW;
    const int per = (new_ + ndsa - 1) / (ndsa > 0 ? ndsa : 1);
    int ew = gw;
    for (int i = blockIdx.x; i < T / 16; i += gridDim.x) {
        const int b = i >> 7, tau = i & 127, tile = ((b >> 1) & 1) ? 127 - tau : tau;
        dsa_item(p, b, tile * 16, lds, tid, wv);
        for (int j = 0; j < per && ew < EW_ITEMS; ++j, ew += NW) expert_w_item(p, ew, (float*)(lds + wv * 16384), opaque_i(lane));
    }
    for (; ew < EW_ITEMS; ew += NW) expert_w_item(p, ew, (float*)(lds + wv * 16384), opaque_i(lane));
    for (int i = blockIdx.x; i < T / 32; i += gridDim.x) {
        const int b = i >> 6, t0 = (i & 63) * 32 + (wid >> 2) * 16;
        memattn_wave(p, b, (size_t)b * SEQ + t0, wid & 3, opaque_i(lane));
        conv_tokens4(p, b, t0 + (wid & 3) * 4, opaque_i(lane));
    }
}

#define XB_TMO      128
#define XB_XCNT(j)  (256  + 64 * (j))
#define XB_XSUB(j)  (1280 + 64 * (j))
#define XB_XGEN(j)  (2304 + 64 * (j))
#define XB_TOP      3328
#define XB_TOPGEN   3392
#define XCD_BAR_WORDS 3456
#define XB_SPIN_CAP (1u << 22)
__device__ __forceinline__ unsigned xb_ld(unsigned* p)              { return __hip_atomic_load(p, __ATOMIC_RELAXED, __HIP_MEMORY_SCOPE_AGENT); }
__device__ __forceinline__ unsigned xb_add(unsigned* p, unsigned v) { return __hip_atomic_fetch_add(p, v, __ATOMIC_RELAXED, __HIP_MEMORY_SCOPE_AGENT); }
__device__ __forceinline__ unsigned xb_xcc_id() { return (unsigned)__builtin_amdgcn_s_getreg((3 << 11) | 20) & 0xFu; }
#define XB_SPIN(cond, bar) do { unsigned _sp = 0; while (cond) { __builtin_amdgcn_s_sleep(1); \
    if ((++_sp & 255u) == 0u) { if (xb_ld(&(bar)[XB_TMO])) break; if (_sp > XB_SPIN_CAP) { atomicAdd(&(bar)[XB_TMO], 1u); break; } } } } while (0)
__device__ __forceinline__ void phase5(CParams& p, char* lds, int wv) {
    const int tid = opaque_tid(wv);
    unsigned char* ws = p.ws;
    const float* x = p.in[0];
    constexpr int I1 = (T / 256) * 4;
    unsigned* bar = (unsigned*)(ws + WS_BAR);
    unsigned long long* lnst = (unsigned long long*)(ws + WS_LNST);
    bf16_t* x1h = (bf16_t*)(ws + WS_X1H); bf16_t* x1l = (bf16_t*)(ws + WS_X1L);
    for (int it = vblock(); it < I1; it += gridDim.x) {
        const int pm = it >> 2, pn = it & 3;
        const int brow = pm * 256, bcol = pn * 256;
        g8::Src s; g8::km_src(s, (const bf16_t*)(ws + WS_CAT2), T, brow, (const bf16_t*)(ws + WS_W_OUT2_T), 1024, bcol, tid);
        g8::kloop_issue(s, lds, wv);
        f32x4 acc[2][2][4][2]; g8::acc_zero(acc);
        g8::kloop(acc, s, 48, lds, tid, wv);
        const int te = opaque_i(tid), lane = te & 63, wr = wv >> 2, wc = wv & 3, fr = lane & 15, fq = lane >> 4;
        char* stg = lds + LDS_STG;
        float2* PS = (float2*)(stg + 32 * 1040);
        float2* SR = PS + 256;
        f32x4 vr[2][4][4];
        float4 xn[4];
#pragma unroll
        for (int i = 0; i < 4; ++i) { const int lr = wv + 8 * i; xn[i] = ldnt4(x + (size_t)(brow + (lr >> 4) * 64 + (lr & 15)) * 1024 + bcol + lane * 4); }
#pragma unroll
        for (int ai = 0; ai < 2; ++ai)
#pragma unroll
            for (int m = 0; m < 4; ++m) {
                char* rp = stg + (wr * 16 + fr) * 1040 + (wc * 32 + 4 * fq) * 4;
#pragma unroll
                for (int bj = 0; bj < 2; ++bj)
#pragma unroll
                    for (int n = 0; n < 2; ++n) *(f32x4*)(rp + (bj * 128 + n * 16) * 4) = acc[ai][bj][m][n];
                asm volatile("s_waitcnt lgkmcnt(0)" ::: "memory"); __builtin_amdgcn_s_barrier(); asm volatile("" ::: "memory");
                float4 xc[4];
#pragma unroll
                for (int i = 0; i < 4; ++i) xc[i] = xn[i];
                if (ai * 4 + m < 7) {
                    const int ai2 = (ai * 4 + m + 1) >> 2, m2 = (ai * 4 + m + 1) & 3;
#pragma unroll
                    for (int i = 0; i < 4; ++i) { const int lr = wv + 8 * i; xn[i] = ldnt4(x + (size_t)(brow + ai2 * 128 + (lr >> 4) * 64 + m2 * 16 + (lr & 15)) * 1024 + bcol + lane * 4); }
                }
#pragma unroll
                for (int i = 0; i < 4; ++i) {
                    const int lr = wv + 8 * i;
                    const f32x4 a = *(const f32x4*)(stg + lr * 1040 + lane * 16);
                    f32x4 o; o[0] = fmaf(ALPHA, xc[i].x, a[0]); o[1] = fmaf(ALPHA, xc[i].y, a[1]); o[2] = fmaf(ALPHA, xc[i].z, a[2]); o[3] = fmaf(ALPHA, xc[i].w, a[3]);
                    vr[ai][m][i] = o;
                    const float s1 = wave_sum((o[0] + o[1]) + (o[2] + o[3]));
                    const float s2 = wave_sum((o[0] * o[0] + o[1] * o[1]) + (o[2] * o[2] + o[3] * o[3]));
                    if (lane == 0) PS[ai * 128 + (lr >> 4) * 64 + m * 16 + (lr & 15)] = make_float2(s1, s2);
                }
                asm volatile("s_waitcnt lgkmcnt(0)" ::: "memory"); __builtin_amdgcn_s_barrier(); asm volatile("" ::: "memory");
            }
        if (wv < 4) {
            const float2 ps = PS[te];
            __hip_atomic_store(lnst + (size_t)(pm * 4 + pn) * 256 + te, ((unsigned long long)__float_as_uint(ps.y) << 32) | __float_as_uint(ps.x), __ATOMIC_RELAXED, __HIP_MEMORY_SCOPE_AGENT);
            asm volatile("s_waitcnt vmcnt(0)" ::: "memory");
            if (lane == 0) (void)xb_add(&bar[XCD_BAR_WORDS + 4 * pm], 1u);
            if (wv == 0) {
                XB_SPIN(xb_ld(&bar[XCD_BAR_WORDS + 4 * pm]) < 16u, bar);
                __builtin_amdgcn_fence(__ATOMIC_ACQUIRE, "agent");
            }
        }
        asm volatile("s_waitcnt vmcnt(0) lgkmcnt(0)" ::: "memory"); __builtin_amdgcn_s_barrier(); asm volatile("" ::: "memory");
        if (wv < 4) {
            float s1 = 0.f, s2 = 0.f;
#pragma unroll
            for (int t4 = 0; t4 < 4; ++t4) {
                const unsigned long long w = __hip_atomic_load(lnst + (size_t)(pm * 4 + t4) * 256 + te, __ATOMIC_RELAXED, __HIP_MEMORY_SCOPE_AGENT);
                s1 += __uint_as_float((unsigned)w); s2 += __uint_as_float((unsigned)(w >> 32));
            }
            const float mean = s1 * (1.f / 1024.f);
            const float var = fmaxf(s2 * (1.f / 1024.f) - mean * mean, 0.f);
            SR[te] = make_float2(mean, rsqrtf(var + LN_EPS));
        }
        asm volatile("s_waitcnt lgkmcnt(0)" ::: "memory"); __builtin_amdgcn_s_barrier(); asm volatile("" ::: "memory");
        {
            const float4 gg = *(const float4*)(p.in[14] + bcol + lane * 4), be = *(const float4*)(p.in[15] + bcol + lane * 4);
#pragma unroll
            for (int ai = 0; ai < 2; ++ai)
#pragma unroll
                for (int m = 0; m < 4; ++m)
#pragma unroll
                    for (int i = 0; i < 4; ++i) {
                        const int lr = wv + 8 * i, trow = ai * 128 + (lr >> 4) * 64 + m * 16 + (lr & 15);
                        const float2 sr = SR[trow];
                        const size_t go = (size_t)(brow + trow) * 1024 + bcol + lane * 4;
                        const f32x4 a = vr[ai][m][i];
                        float4 o; o.x = (a[0] - sr.x) * sr.y * gg.x + be.x; o.y = (a[1] - sr.x) * sr.y * gg.y + be.y; o.z = (a[2] - sr.x) * sr.y * gg.z + be.z; o.w = (a[3] - sr.x) * sr.y * gg.w + be.w;
                        stnt4(p.out + go, o);
                        uint2 hi; hi.x = pk2(o.x, o.y); hi.y = pk2(o.z, o.w);
                        uint2 lo; lo.x = pk2(o.x - bflo(hi.x), o.y - bfhi(hi.x)); lo.y = pk2(o.z - bflo(hi.y), o.w - bfhi(hi.y));
                        *(uint2*)(x1h + go) = hi;
                        *(uint2*)(x1l + go) = lo;
                    }
        }
        asm volatile("s_waitcnt lgkmcnt(0)" ::: "memory"); __builtin_amdgcn_s_barrier(); asm volatile("" ::: "memory");
    }
}

__device__ __forceinline__ void phase6(CParams& p, int wv) {
    const int tid = opaque_tid(wv), lane = tid & 63, wid = tid >> 6;
    unsigned char* ws = p.ws;
    const float* g = p.in[14]; const float* bb = p.in[15];
    bf16_t* x1b = (bf16_t*)(ws + WS_X1B); bf16_t* x1lo = (bf16_t*)(ws + WS_X1LO);
    for (int t0 = (blockIdx.x * 8 + wid) * 2; t0 < T; t0 += gridDim.x * 16) {
        float4 v[2][4];
#pragma unroll
        for (int u = 0; u < 2; ++u)
#pragma unroll
            for (int j = 0; j < 4; ++j) v[u][j] = ldnt4(p.out + (size_t)(t0 + u) * 1024 + lane * 4 + 256 * j);
#pragma unroll
        for (int u = 0; u < 2; ++u) {
            const int t = t0 + u;
            float* row = p.out + (size_t)t * 1024;
            float s = 0.f;
#pragma unroll
            for (int j = 0; j < 4; ++j) s += (v[u][j].x + v[u][j].y) + (v[u][j].z + v[u][j].w);
            const float mean = wave_sum(s) * (1.f / 1024.f);
            float q = 0.f;
#pragma unroll
            for (int j = 0; j < 4; ++j) { v[u][j].x -= mean; v[u][j].y -= mean; v[u][j].z -= mean; v[u][j].w -= mean; q += (v[u][j].x * v[u][j].x + v[u][j].y * v[u][j].y) + (v[u][j].z * v[u][j].z + v[u][j].w * v[u][j].w); }
            const float rstd = rsqrtf(wave_sum(q) * (1.f / 1024.f) + LN_EPS);
#pragma unroll
            for (int j = 0; j < 4; ++j) {
                const int cidx = lane * 4 + 256 * j;
                const float4 gg = *(const float4*)(g + cidx), be = *(const float4*)(bb + cidx);
                float4 o; o.x = v[u][j].x * rstd * gg.x + be.x; o.y = v[u][j].y * rstd * gg.y + be.y; o.z = v[u][j].z * rstd * gg.z + be.z; o.w = v[u][j].w * rstd * gg.w + be.w;
                stnt4(row + cidx, o);
                uint2 hi; hi.x = pk2(o.x, o.y); hi.y = pk2(o.z, o.w);
                uint2 lo; lo.x = pk2(o.x - bflo(hi.x), o.y - bfhi(hi.x)); lo.y = pk2(o.z - bflo(hi.y), o.w - bfhi(hi.y));
                *(uint2*)(x1b + (size_t)t * 1024 + cidx) = hi;
                *(uint2*)(x1lo + (size_t)t * 1024 + cidx) = lo;
            }
        }
    }
}

__device__ __forceinline__ float grp8_max(float v) {
    v = fmaxf(v, dpp_f<0xB1>(v)); v = fmaxf(v, dpp_f<0x4E>(v)); v = fmaxf(v, dpp_f<0x141>(v));
    return v;
}
constexpr int NTB = T / 128;
__device__ __forceinline__ void phase7(CParams& p, char* lds, int wv) {
    const int tid = opaque_tid(wv), lane = tid & 63, wid = tid >> 6, wm = wid >> 2, wn = wid & 3;
    unsigned char* ws = p.ws;
    const int r0 = tid >> 3, c = tid & 7, fr = lane & 15, fq = lane >> 4;
    const bf16_t* Ah = (const bf16_t*)(ws + WS_X1H); const bf16_t* Al = (const bf16_t*)(ws + WS_X1L); const bf16_t* Bt = (const bf16_t*)(ws + WS_W_R_T);
    float* lg = (float*)(lds + LDS_STG);
    const float rbias = p.in[17][lane];
    int* tok_e = (int*)(ws + WS_TOK_E); float* tok_w = (float*)(ws + WS_TOK_W);
    int* tok_pos = (int*)(ws + WS_TOK_POS);
    int* cntb = (int*)(ws + WS_CNTB);
    int* hist = (int*)(lds + LDS_MISC);
    const int grp = lane >> 3;
    for (int tb = blockIdx.x; tb < NTB; tb += gridDim.x) {
        const int m0 = tb * 128;
        f32x4 acc[4][2]; acc_zero(acc);
        const bf16_t* a0 = Ah + (size_t)(m0 + r0) * 1024 + c * 8; const bf16_t* a1 = a0 + (size_t)64 * 1024;
        const bf16_t* a0b = Al + (size_t)(m0 + r0) * 1024 + c * 8; const bf16_t* a1b = a0b + (size_t)64 * 1024;
        const bf16_t* b0 = Bt + (size_t)r0 * 2048 + c * 8; const bf16_t* b1 = b0 + (size_t)64 * 2048;
        pf_kloop<32, true>(acc, a0, a1, a0b, a1b, b0, b1, lds, tid, lane, wm, wn);
        if (wn < 2) {
#pragma unroll
            for (int mi = 0; mi < 4; ++mi)
#pragma unroll
                for (int ni = 0; ni < 2; ++ni) {
                    const int m = wm * 64 + mi * 16 + fr, n = wn * 32 + ni * 16 + 4 * fq;
                    *(f32x4*)(lg + m * 64 + n) = acc[mi][ni];
                }
        }
        if (tid < 64) hist[tid] = 0;
        __syncthreads();
        if (wn >= 2) {
#pragma unroll
            for (int mi = 0; mi < 4; ++mi)
#pragma unroll
                for (int ni = 0; ni < 2; ++ni) {
                    const int m = wm * 64 + mi * 16 + fr, n = (wn - 2) * 32 + ni * 16 + 4 * fq;
                    f32x4 v = *(const f32x4*)(lg + m * 64 + n);
                    v = v + acc[mi][ni];
                    *(f32x4*)(lg + m * 64 + n) = v;
                }
        }
        __syncthreads();
        for (int j = 0; j < 16; ++j) {
            const int tl = wid * 16 + j, t = m0 + tl;
            const float lgt = lg[tl * 64 + lane];
            const float s = 1.f / (1.f + __expf(-lgt));
            const float sc = s + rbias;
            const float m1 = grp8_max(sc);
            const bool ismax = (sc == m1);
            const unsigned long long bm = __ballot(ismax);
            const int nmax = __popcll((bm >> (grp * 8)) & 0xFFull);
            const float m2 = grp8_max(ismax ? -INFINITY : sc);
            const float gscore = m1 + (nmax >= 2 ? m1 : m2);
            int grank = 0;
#pragma unroll
            for (int g2 = 0; g2 < 8; ++g2) {
                const float o = __builtin_bit_cast(float, __builtin_amdgcn_readlane(__builtin_bit_cast(int, gscore), g2 * 8));
                grank += (o > gscore || (o == gscore && g2 < grp)) ? 1 : 0;
            }
            float mv = (grank < 4) ? sc : -INFINITY;
            unsigned long long selm = 0ull;
#pragma unroll
            for (int i8 = 0; i8 < 8; ++i8) {
                const float mx = wave_max(mv);
                const unsigned long long bmx = __ballot(mv == mx);
                const unsigned long long low = bmx & (0ull - bmx);
                selm |= low;
                if ((low >> lane) & 1ull) mv = -INFINITY;
            }
            const bool selq = (selm >> lane) & 1ull;
            const int rank = __popcll(selm & ((1ull << lane) - 1ull));
            const float ssum = wave_sum(selq ? s : 0.f);
            if (selq) {
                tok_e[(size_t)t * 8 + rank] = lane;
                tok_w[(size_t)t * 8 + rank] = s / ssum * 2.5f;
                tok_pos[(size_t)t * 9 + rank] = atomicAdd(&hist[lane], 1);
            }
        }
        __syncthreads();
        if (tid < 64) cntb[tb * 64 + tid] = hist[tid];
        __syncthreads();
    }
}

__device__ __forceinline__ int cntb_partial(const int* cntb, int i0, int i1, int tid) {
    const int e = tid & 63, part = tid >> 6;
    int c = 0;
#pragma unroll 8
    for (int i = i0 + part; i < i1; i += 8) c += cntb[i * 64 + e];
    return c;
}
__device__ __forceinline__ void round_tables(CParams& p, int r, int* misc, int tid) {
    const int* cntb = (const int*)(p.ws + WS_CNTB) + (size_t)rnd_tb0(r) * 64;
    __syncthreads();
    if (tid < 64) misc[tid] = 0;
    if (tid == 64) misc[64] = rnd_ntok(r);
    __syncthreads();
    { const int c = cntb_partial(cntb, 0, rnd_ntb(r), tid); atomicAdd(&misc[tid & 63], c); }
    __syncthreads();
    if (tid < 64) {
        const int nb = (misc[tid] + 255) >> 8;
        int incl = nb;
#pragma unroll
        for (int d = 1; d < 64; d <<= 1) { const int v = __shfl_up(incl, d); if (tid >= d) incl += v; }
        const int excl = incl - nb;
        misc[80 + tid] = excl * 256; misc[160 + tid] = excl;
        if (tid == 63) { misc[80 + 64] = incl * 256; misc[160 + 64] = incl; misc[160 + NE1] = incl + ((rnd_ntok(r) + 255) >> 8); }
    }
    __syncthreads();
}
__device__ __forceinline__ int find_expert(const int* misc, int blk) {
    int lo = 0, hi = NE1;
#pragma unroll
    for (int i = 0; i < 7; ++i) { const int mid = (lo + hi) >> 1; if (mid < hi && misc[160 + mid] <= blk) lo = mid; else hi = mid; if (hi - lo <= 1) break; }
    while (lo + 1 <= NEXP && misc[160 + lo + 1] <= blk) ++lo;
    return lo;
}

__device__ __forceinline__ void phase9(CParams& p, char* lds, int wv) {
    const int tid = opaque_tid(wv);
    unsigned char* ws = p.ws;
    int* misc = (int*)(lds + LDS_MISC);
    const int* tok_e = (const int*)(ws + WS_TOK_E); const float* tok_w = (const float*)(ws + WS_TOK_W);
    int* tok_pos = (int*)(ws + WS_TOK_POS);
    const int* cntb = (const int*)(ws + WS_CNTB);
    for (int tb = blockIdx.x; tb < NTB; tb += gridDim.x) {
        const int r = (tb >= rnd_tb0(1) ? 1 : 0) + (tb >= rnd_tb0(2) ? 1 : 0) + (tb >= rnd_tb0(3) ? 1 : 0);
        round_tables(p, r, misc, tid);
        if (tid < 64) misc[256 + tid] = 0;
        __syncthreads();
        { const int c = cntb_partial(cntb, rnd_tb0(r), tb, tid); atomicAdd(&misc[256 + (tid & 63)], c); }
        __syncthreads();
        int* slot_tok = (int*)(ws + WS_SLOT_TOK) + (size_t)r * CAP; float* slot_w = (float*)(ws + WS_SLOT_W) + (size_t)r * CAP;
        for (int i = tid; i < 128 * 8; i += NTHREADS) {
            const int t = tb * 128 + (i >> 3), k = i & 7;
            const int e = tok_e[(size_t)t * 8 + k];
            const int pos = misc[80 + e] + misc[256 + e] + tok_pos[(size_t)t * 9 + k];
            slot_tok[pos] = t; slot_w[pos] = tok_w[(size_t)t * 8 + k];
            tok_pos[(size_t)t * 9 + k] = pos;
        }
        if (tid < 128) {
            const int t = tb * 128 + tid, pos = misc[80 + NEXP] + (t - rnd_tok0(r));
            slot_tok[pos] = t; slot_w[pos] = 1.f;
            tok_pos[(size_t)t * 9 + 8] = pos;
        }
    }
}

struct GuItem { int r, pos0, e, nt2, nvalid; };
__device__ __forceinline__ GuItem gu_decode(const int* misc0, const int (&nbase)[NROUND + 1], int git) {
    GuItem d;
    int r = 0;
#pragma unroll
    for (int rr = 1; rr < NROUND; ++rr) r += (git >= nbase[rr]) ? 1 : 0;
    int lbase = nbase[0];
#pragma unroll
    for (int rr = 1; rr < NROUND; ++rr) lbase = (r >= rr) ? nbase[rr] : lbase;
    const int it = git - lbase;
    const int* misc = misc0 + r * 256;
    const int blk = it >> 1; d.nt2 = it & 1; d.r = r;
    const int e = find_expert(misc, blk);
    d.e = __builtin_amdgcn_readfirstlane(e);
    const int rb = __builtin_amdgcn_readfirstlane(blk - misc[160 + d.e]);
    d.pos0 = __builtin_amdgcn_readfirstlane(misc[80 + d.e] + rb * 256);
    d.nvalid = __builtin_amdgcn_readfirstlane(min(256, misc[d.e] - rb * 256));
    return d;
}
constexpr int GU_AAUX = 0;
__device__ __forceinline__ void phase_gu(CParams& p, char* lds, int wv) {
    const int tid = opaque_tid(wv);
    unsigned char* ws = p.ws;
    int* misc0 = (int*)(lds + LDS_MISC);
    int nbase[NROUND + 1]; nbase[0] = 0;
#pragma unroll
    for (int r = 0; r < NROUND; ++r) { round_tables(p, r, misc0 + r * 256, tid); nbase[r + 1] = nbase[r] + __builtin_amdgcn_readfirstlane(misc0[r * 256 + 160 + NE1]) * 2; }
    const int nitems = nbase[NROUND];
    int sR, sC; g8::stage_rc(tid * 16, sR, sC);
    const __amdgpu_buffer_rsrc_t rx = g8::make_rsrc(ws + WS_X1H);
    int git = vblock();
    GuItem d; d.r = 0; d.pos0 = 0; d.e = 0; d.nt2 = 0; d.nvalid = 1;
    int tok0 = 0, tok1 = 0;
    g8::Src s;
    if (git < nitems) {
        d = gu_decode(misc0, nbase, git);
        const int* slot_tok = (const int*)(ws + WS_SLOT_TOK) + (size_t)d.r * CAP;
        tok0 = slot_tok[d.pos0 + min(sR, d.nvalid - 1)]; tok1 = slot_tok[d.pos0 + min(128 + sR, d.nvalid - 1)];
        s.ra = rx; s.rb = g8::make_rsrc((const bf16_t*)(ws + WS_W_EGU_T) + (size_t)d.e * 512 * 1024); s.bh = 128u * 64u; s.akt = 64u; s.bkt = 512u * 64u;
        s.ao[0] = (unsigned)(tok0 * 1024 + sC) * 2u; s.ao[1] = (unsigned)(tok1 * 1024 + sC) * 2u;
        s.bo = (unsigned)((d.nt2 * 256 + sR) * 32 + sC) * 2u;
        g8::kloop_issue<GU_AAUX>(s, lds, wv);
    }
    while (git < nitems) {
        const GuItem c = d;
        const int gnext = git + gridDim.x;
        if (gnext < nitems) {
            d = gu_decode(misc0, nbase, gnext);
            const int* slot_tok = (const int*)(ws + WS_SLOT_TOK) + (size_t)d.r * CAP;
            tok0 = slot_tok[d.pos0 + min(sR, d.nvalid - 1)]; tok1 = slot_tok[d.pos0 + min(128 + sR, d.nvalid - 1)];
        }
        f32x4 acc[2][2][4][2]; g8::acc_zero(acc);
        g8::kloop<GU_AAUX>(acc, s, 32, lds, tid, wv);
        git = gnext;
        if (git < nitems) {
            s.rb = g8::make_rsrc((const bf16_t*)(ws + WS_W_EGU_T) + (size_t)d.e * 512 * 1024);
            s.ao[0] = (unsigned)(tok0 * 1024 + sC) * 2u; s.ao[1] = (unsigned)(tok1 * 1024 + sC) * 2u;
            s.bo = (unsigned)((d.nt2 * 256 + sR) * 32 + sC) * 2u;
            g8::kloop_issue<GU_AAUX>(s, lds, wv);
        }
        bf16_t* hslot = (bf16_t*)(ws + WS_HSLOT) + (size_t)rnd_cap0(c.r) * 256;
        {
            const int te = opaque_i(tid), lane = te & 63, wr = wv >> 2, wc = wv & 3, fr = lane & 15, fq = lane >> 4;
            char* stg = lds + LDS_STG;
#pragma unroll
            for (int ai = 0; ai < 2; ++ai)
#pragma unroll
                for (int m = 0; m < 4; ++m) {
                    char* rp = stg + (ai * 128 + wr * 64 + m * 16 + fr) * 272 + (wc * 16 + 4 * fq) * 2;
#pragma unroll
                    for (int bj = 0; bj < 2; ++bj) {
                        float hv[4];
#pragma unroll
                        for (int j = 0; j < 4; ++j) { const float g = acc[ai][bj][m][0][j], u = acc[ai][bj][m][1][j]; hv[j] = g / (1.f + __expf(-g)) * u; }
                        uint2 o; o.x = pk2(hv[0], hv[1]); o.y = pk2(hv[2], hv[3]);
                        *(uint2*)(rp + bj * 128) = o;
                    }
                }
            asm volatile("s_waitcnt lgkmcnt(0)" ::: "memory"); __builtin_amdgcn_s_barrier(); asm volatile("" ::: "memory");
            uint4 v[8];
#pragma unroll
            for (int i = 0; i < 8; ++i) { const int id = te + i * 512; v[i] = *(const uint4*)(stg + (id >> 4) * 272 + (id & 15) * 16); }
#pragma unroll
            for (int i = 0; i < 8; ++i) { const int id = te + i * 512; typedef unsigned u32x4_t __attribute__((ext_vector_type(4))); const u32x4_t ov = {v[i].x, v[i].y, v[i].z, v[i].w};
                __builtin_nontemporal_store(ov, (u32x4_t*)(hslot + km_off(c.pos0 + (id >> 4), c.nt2 * 128 + (id & 15) * 8, rnd_cap(c.r)))); }
            asm volatile("s_waitcnt lgkmcnt(0)" ::: "memory"); __builtin_amdgcn_s_barrier(); asm volatile("" ::: "memory");
        }
    }
    asm volatile("s_waitcnt vmcnt(0)" ::: "memory");
}
struct DownItem { int pos0, e, half; };
__device__ __forceinline__ DownItem down_decode(const int* misc, int it, int n2) {
    DownItem d; int blk = it >> 1; d.half = it & 1;
    if (it >= n2) { const int q = (n2 << 1) + (it - n2); blk = q >> 2; d.half = 2 + (q & 3); }
    const int e = find_expert(misc, blk);
    d.e = __builtin_amdgcn_readfirstlane(e);
    const int rb = __builtin_amdgcn_readfirstlane(blk - misc[160 + d.e]);
    d.pos0 = __builtin_amdgcn_readfirstlane(misc[80 + d.e] + rb * 256);
    return d;
}
struct DownFlush {
    bf16_t* yslot; char* lds; int pos0, half, tid, wv; float w[8];
    __device__ __forceinline__ void operator()(f32x4 (&acc)[2][2][4][2], int seg) const {
        g8_store_tile<true>(acc, yslot, 1024, pos0, (half * 2 + seg) * 256, w, lds, tid, wv);
    }
    __device__ __forceinline__ void last(f32x4 (&acc)[2][2][4][2]) const {
        g8_store_tile<false>(acc, yslot, 1024, pos0, (half * 2 + 1) * 256, w, lds, tid, wv);
    }
};
__device__ __forceinline__ void phase_down(CParams& p, int r, char* lds, int wv) {
    const int tid = opaque_tid(wv);
    unsigned char* ws = p.ws;
    int* misc = (int*)(lds + LDS_MISC);
    round_tables(p, r, misc, tid);
    const int nit2 = __builtin_amdgcn_readfirstlane(misc[160 + NE1]) * 2;
    const int n2 = (nit2 / (int)gridDim.x) * (int)gridDim.x;
    const int nitems = n2 + (nit2 - n2) * 2;
    const float* slot_w = (const float*)(ws + WS_SLOT_W) + (size_t)r * CAP;
    const bf16_t* hs = (const bf16_t*)(ws + WS_HSLOT) + (size_t)rnd_cap0(r) * 256;
    const bf16_t* wed = (const bf16_t*)(ws + WS_W_ED_T);
    const int lane0 = tid & 63, wr0 = wv >> 2, fr0 = lane0 & 15;
    g8::Seg sg; sg.mask = 7; sg.lg = 3; sg.aseg = 0u; sg.bseg = 256u * 64u;
    int it = vblock();
    g8::Src s; DownItem d; float w[8];
    d.pos0 = 0; d.e = 0; d.half = 0;
#pragma unroll
    for (int i = 0; i < 8; ++i) w[i] = 0.f;
    if (it < nitems) {
        d = down_decode(misc, it, n2);
#pragma unroll
        for (int i = 0; i < 8; ++i) w[i] = slot_w[d.pos0 + (i >> 2) * 128 + wr0 * 64 + (i & 3) * 16 + fr0];
        g8::km_src(s, hs, rnd_cap(r), d.pos0, wed + (size_t)d.e * 1024 * 256, 1024, d.half < 2 ? d.half * 512 : (d.half - 2) * 256, tid);
        g8::kloop_issue(s, lds, wv, sg);
        asm volatile("" :: "v"(w[0]), "v"(w[1]), "v"(w[2]), "v"(w[3]), "v"(w[4]), "v"(w[5]), "v"(w[6]), "v"(w[7]));
    }
    while (it < nitems) {
        const int single = d.half >= 2;
        const int ct_last = single ? d.half - 2 : d.half * 2 + 1;
        DownFlush fl; fl.yslot = (bf16_t*)(ws + WS_YSLOT); fl.lds = lds; fl.pos0 = d.pos0; fl.half = d.half; fl.tid = tid; fl.wv = wv;
#pragma unroll
        for (int i = 0; i < 8; ++i) fl.w[i] = w[i];
        f32x4 acc[2][2][4][2]; g8::acc_zero(acc);
        g8::kloop_ms(acc, s, single ? 8 : 16, lds, tid, wv, sg, fl);
        it += gridDim.x;
        if (it < nitems) {
            d = down_decode(misc, it, n2);
#pragma unroll
            for (int i = 0; i < 8; ++i) w[i] = slot_w[d.pos0 + (i >> 2) * 128 + wr0 * 64 + (i & 3) * 16 + fr0];
            g8::km_src(s, hs, rnd_cap(r), d.pos0, wed + (size_t)d.e * 1024 * 256, 1024, d.half < 2 ? d.half * 512 : (d.half - 2) * 256, tid);
            g8::kloop_issue(s, lds, wv, sg);
        }
        g8_store_tile<false>(acc, fl.yslot, 1024, fl.pos0, ct_last * 256, fl.w, lds, tid, wv);
        if (it < nitems) asm volatile("" :: "v"(w[0]), "v"(w[1]), "v"(w[2]), "v"(w[3]), "v"(w[4]), "v"(w[5]), "v"(w[6]), "v"(w[7]));
    }
    asm volatile("s_waitcnt vmcnt(0)" ::: "memory");
}

__device__ __forceinline__ void phase_combine(CParams& p, int r, int wv) {
    const int tid = opaque_tid(wv), lane = tid & 63, wid = tid >> 6;
    unsigned char* ws = p.ws;
    const float* g = p.in[24]; const float* bb = p.in[25];
    const int* tok_pos = (const int*)(ws + WS_TOK_POS);
    const bf16_t* yslot = (const bf16_t*)(ws + WS_YSLOT);
    for (int i = blockIdx.x * 8 + wid; i < rnd_ntok(r); i += gridDim.x * 8) {
        const int t = rnd_tok0(r) + i;
        float* row = p.out + (size_t)t * 1024;
        float4 v[4];
#pragma unroll
        for (int j = 0; j < 4; ++j) { v[j] = ldnt4(row + lane * 4 + 256 * j); v[j].x *= ALPHA; v[j].y *= ALPHA; v[j].z *= ALPHA; v[j].w *= ALPHA; }
        int pos[9];
#pragma unroll
        for (int k = 0; k < 9; ++k) pos[k] = tok_pos[(size_t)t * 9 + k];
        uint2 y[9][4];
#pragma unroll
        for (int k = 0; k < 9; ++k)
#pragma unroll
            for (int j = 0; j < 4; ++j) { const unsigned long long w64 = __builtin_nontemporal_load((const unsigned long long*)(yslot + (size_t)pos[k] * 1024 + lane * 4 + 256 * j)); y[k][j].x = (uint32_t)w64; y[k][j].y = (uint32_t)(w64 >> 32); }
#pragma unroll
        for (int k = 0; k < 9; ++k)
#pragma unroll
            for (int j = 0; j < 4; ++j) { v[j].x += bflo(y[k][j].x); v[j].y += bfhi(y[k][j].x); v[j].z += bflo(y[k][j].y); v[j].w += bfhi(y[k][j].y); }
        float s = 0.f;
#pragma unroll
        for (int j = 0; j < 4; ++j) s += (v[j].x + v[j].y) + (v[j].z + v[j].w);
        const float mean = wave_sum(s) * (1.f / 1024.f);
        float q = 0.f;
#pragma unroll
        for (int j = 0; j < 4; ++j) { v[j].x -= mean; v[j].y -= mean; v[j].z -= mean; v[j].w -= mean; q += (v[j].x * v[j].x + v[j].y * v[j].y) + (v[j].z * v[j].z + v[j].w * v[j].w); }
        const float rstd = rsqrtf(wave_sum(q) * (1.f / 1024.f) + LN_EPS);
#pragma unroll
        for (int j = 0; j < 4; ++j) {
            const int cidx = lane * 4 + 256 * j;
            const float4 gg = *(const float4*)(g + cidx), be = *(const float4*)(bb + cidx);
            float4 o; o.x = v[j].x * rstd * gg.x + be.x; o.y = v[j].y * rstd * gg.y + be.y; o.z = v[j].z * rstd * gg.z + be.z; o.w = v[j].w * rstd * gg.w + be.w;
            stnt4(row + cidx, o);
        }
    }
}

struct XcdBarrier { unsigned* bar; unsigned x; volatile LAS unsigned* st; };
__device__ __forceinline__ XcdBarrier xcd_barrier_post(unsigned* bar, volatile LAS unsigned* st) {
    XcdBarrier b; b.bar = bar; b.x = xb_xcc_id(); b.st = st;
    if (threadIdx.x == 0) (void)xb_add(&bar[XB_XCNT(b.x)], 1u);
    return b;
}
__device__ __forceinline__ void xcd_barrier_complete(unsigned* bar, unsigned x, unsigned& nloc, unsigned& nx) {
    const unsigned G = gridDim.x * gridDim.y * gridDim.z;
    unsigned sum, cnt, mine, sp = 0u;
    for (;;) {
        sum = 0u; cnt = 0u; mine = 0u;
#pragma unroll
        for (unsigned j = 0; j < 16; ++j) { const unsigned c = xb_ld(&bar[XB_XCNT(j)]); sum += c; cnt += (c > 0u) ? 1u : 0u; mine = (j == x) ? c : mine; }
        if (sum == G) break;
        __builtin_amdgcn_s_sleep(1);
        if ((++sp & 255u) == 0u) { if (xb_ld(&bar[XB_TMO])) break; if (sp > XB_SPIN_CAP) { atomicAdd(&bar[XB_TMO], 1u); break; } }
    }
    nloc = mine > 0u ? mine : 1u; nx = cnt > 0u ? cnt : 1u;
}
__device__ __forceinline__ void xcd_barrier(const XcdBarrier& b, int wv) {
    asm volatile("s_waitcnt vmcnt(0)" ::: "memory");
    __syncthreads();
    if (wv == 0 && lane_id() == 0) {
        unsigned* bar = b.bar;
        __builtin_amdgcn_s_waitcnt(0);
        unsigned nloc = b.st[0], nx = b.st[1];
        if (nloc == 0u) { xcd_barrier_complete(bar, b.x, nloc, nx); b.st[0] = nloc; b.st[1] = nx; }
        const unsigned old = xb_add(&bar[XB_XSUB(b.x)], 1u);
        const unsigned gen = old / nloc;
        if (old + 1u == (gen + 1u) * nloc) {
            __builtin_amdgcn_fence(__ATOMIC_RELEASE, "agent");
            asm volatile("s_waitcnt vmcnt(0)" ::: "memory");
            const unsigned og = xb_add(&bar[XB_TOP], 1u);
            const unsigned tg = og / nx;
            if (og + 1u == (tg + 1u) * nx) xb_add(&bar[XB_TOPGEN], 1u);
            else XB_SPIN(xb_ld(&bar[XB_TOPGEN]) == tg, bar);
            __builtin_amdgcn_fence(__ATOMIC_ACQUIRE, "agent");
            xb_add(&bar[XB_XGEN(b.x)], 1u);
            asm volatile("s_waitcnt vmcnt(0)" ::: "memory");
        } else {
            XB_SPIN(xb_ld(&bar[XB_XGEN(b.x)]) == gen, bar);
            __builtin_amdgcn_fence(__ATOMIC_ACQUIRE, "agent");
            asm volatile("s_waitcnt vmcnt(0)" ::: "memory");
        }
    }
    __syncthreads();
}

__global__ void __launch_bounds__(NTHREADS) fwd_megakernel(Params p_unused) {
    extern __shared__ __attribute__((aligned(16))) char lds[];
    volatile LAS unsigned* st = (volatile LAS unsigned*)(lds + LDS_BARW);
    const int wv = __builtin_amdgcn_readfirstlane((int)(threadIdx.x >> 6));
    if (threadIdx.x == 0) { st[0] = 0u; st[1] = 0u; st[2] = 0u; st[3] = 0u; }
    __syncthreads();
    const XcdBarrier gb = xcd_barrier_post((unsigned*)(kargs()->ws + WS_BAR), st);
    phase0(*kargs(), lds, wv);
    xcd_barrier(gb, wv);
    phase1(*kargs(), lds, wv);
    xcd_barrier(gb, wv);
    phase3(*kargs(), lds, wv);
    xcd_barrier(gb, wv);
    phase4(*kargs(), lds, wv);
    xcd_barrier(gb, wv);
    phase5(*kargs(), lds, wv);
    xcd_barrier(gb, wv);
    phase7(*kargs(), lds, wv);
    xcd_barrier(gb, wv);
    phase9(*kargs(), lds, wv);
    xcd_barrier(gb, wv);
    phase_gu(*kargs(), lds, wv);
    xcd_barrier(gb, wv);
    for (int r = 0; r < NROUND; ++r) {
        phase_down(*kargs(), r, lds, wv);
        xcd_barrier(gb, wv);
        phase_combine(*kargs(), r, wv);
        if (r + 1 < NROUND) xcd_barrier(gb, wv);
    }
}

extern "C" void kernel_launch(void* const* d_in, const int* in_sizes, int n_in, void* d_out, int out_size, void* d_ws, size_t ws_size, hipStream_t stream) {
    static int grid_blocks = 0;
    if (grid_blocks == 0) {
        if (n_in != 26 || out_size != T * DM || ws_size < WS_NEED) {
            fprintf(stderr, "kernel_launch: unexpected shapes (n_in %d out %d ws %zu need %zu)\n", n_in, out_size, ws_size, (size_t)WS_NEED);
            grid_blocks = -1; return;
        }
        int dev = 0, cus = 0, per_cu = 0;
        hipGetDevice(&dev);
        hipDeviceGetAttribute(&cus, hipDeviceAttributeMultiprocessorCount, dev);
        hipFuncSetAttribute((const void*)fwd_megakernel, hipFuncAttributeMaxDynamicSharedMemorySize, LDS_BYTES);
        hipOccupancyMaxActiveBlocksPerMultiprocessor(&per_cu, (const void*)fwd_megakernel, NTHREADS, LDS_BYTES);
        if (per_cu < 1) { fprintf(stderr, "kernel_launch: occupancy query says %d blocks per CU\n", per_cu); grid_blocks = -1; return; }
        grid_blocks = cus * 1;
    }
    if (grid_blocks < 0) return;
    Params p{};
    for (int i = 0; i < 26; ++i) p.in[i] = (const float*)d_in[i];
    p.out = (float*)d_out; p.ws = (unsigned char*)d_ws;
    if (hipMemsetAsync((char*)d_ws + WS_BAR, 0, 16384, stream) != hipSuccess) { fprintf(stderr, "kernel_launch: memset of barrier words failed\n"); return; }
    void* args[] = {&p};
    hipError_t e = hipLaunchCooperativeKernel((const void*)fwd_megakernel, dim3(grid_blocks), dim3(NTHREADS), args, LDS_BYTES, stream);
    if (e != hipSuccess) fprintf(stderr, "cooperative launch failed: %s (grid %d)\n", hipGetErrorString(e), grid_blocks);
}
```

```cpp
#include <hip/hip_runtime.h>
#include <stdint.h>
#include <stdio.h>

typedef unsigned short bf16_t;
typedef short bf16x8 __attribute__((ext_vector_type(8)));
typedef float f32x4 __attribute__((ext_vector_type(4)));
__device__ __forceinline__ float4 ldnt4(const float* p) { const f32x4 v = __builtin_nontemporal_load((const f32x4*)p); return make_float4(v[0], v[1], v[2], v[3]); }
__device__ __forceinline__ void stnt4(float* p, const float4& o) { const f32x4 v = {o.x, o.y, o.z, o.w}; __builtin_nontemporal_store(v, (f32x4*)p); }
#define LAS __attribute__((address_space(3)))

constexpr int DM = 1024, NB = 16, SEQ = 2048, T = NB * SEQ;
constexpr int NPROJ = 1536;
constexpr int NMEM = 256;
constexpr int NEXP = 64, NE1 = 65;
constexpr int DEXP = 256;
constexpr int NROUND = 4, TR = T / NROUND;
constexpr int CAP = 90368;
constexpr float ALPHA = 1.189207115002721f;
constexpr float LN_EPS = 1e-5f, RMS_EPS = 1e-6f;
constexpr float IDXW_SCALE = 0.04419417382415922f;
constexpr int PC_CQ = 0, PC_CKV = 256, PC_KIDX = 384, PC_IDXW = 448, PC_GB = 512, PC_GC = 768, PC_H = 1024, PC_QM = 1280;

constexpr size_t al256(size_t x) { return (x + 255) & ~(size_t)255; }
constexpr size_t WS_W_IN_T = 0;
constexpr size_t WS_W_Q2_T = WS_W_IN_T + (size_t)1536 * 1024 * 2;
constexpr size_t WS_W_MKV_T = WS_W_Q2_T + (size_t)1536 * 256 * 2;
constexpr size_t WS_W_OUT2_T = WS_W_MKV_T + (size_t)512 * 1024 * 2;
constexpr size_t WS_W_R_T = WS_W_OUT2_T + (size_t)1024 * 1536 * 2;
constexpr size_t WS_W_EGU_T = WS_W_R_T + (size_t)128 * 3072 * 2;
constexpr size_t WS_W_ED_T = WS_W_EGU_T + (size_t)NE1 * 512 * 1024 * 2;
constexpr size_t WS_CNT = WS_W_ED_T + (size_t)NE1 * 1024 * 256 * 2;
constexpr size_t WS_CNTB = WS_CNT + 4096;
constexpr size_t WS_BAR = WS_CNTB + (size_t)256 * 64 * 4;
constexpr size_t WS_TOK_E = WS_BAR + 16384;
constexpr size_t WS_TOK_W = WS_TOK_E + (size_t)T * 8 * 4;
constexpr size_t WS_TOK_POS = WS_TOK_W + (size_t)T * 8 * 4;
constexpr size_t WS_SLOT_TOK = al256(WS_TOK_POS + (size_t)T * 9 * 4);
constexpr size_t WS_SLOT_W = WS_SLOT_TOK + (size_t)NROUND * CAP * 4;
constexpr size_t WS_X1B = al256(WS_SLOT_W + (size_t)NROUND * CAP * 4);
constexpr size_t WS_B = al256(WS_X1B + (size_t)T * 1024 * 2);
constexpr size_t WS_XB = WS_B;
constexpr size_t WS_CAT2 = WS_X1B;
constexpr size_t WS_MEMB = WS_XB + (size_t)T * 1024 * 2;
constexpr size_t WS_PROJ = WS_MEMB + (size_t)4096 * 1024 * 2;
constexpr size_t WS_KMEM = WS_PROJ + (size_t)T * NPROJ * 2;
constexpr size_t WS_VTMEM = WS_KMEM + (size_t)4096 * 256 * 2;
constexpr size_t WS_KIDX = WS_VTMEM + (size_t)256 * 4096 * 2;
constexpr size_t WS_CQN = WS_KIDX + (size_t)T * 64 * 2;
constexpr size_t WS_CKVN = WS_CQN + (size_t)T * 256 * 2;
constexpr size_t WS_Q2 = WS_CKVN + (size_t)T * 128 * 2;
constexpr size_t WS_END_EARLY = WS_Q2 + (size_t)T * 1536 * 2;
constexpr size_t WS_X1LO = WS_B;
constexpr size_t WS_LOGITS = WS_X1LO + (size_t)T * 1024 * 2;
constexpr size_t WS_X1H = al256(WS_CAT2 + (size_t)T * 1536 * 2);
constexpr size_t WS_X1L = WS_X1H + (size_t)T * 1024 * 2;
constexpr size_t WS_LNST = WS_X1L + (size_t)T * 1024 * 2;
constexpr size_t WS_YSLOT = WS_X1B;
constexpr size_t WS_HSLOT = WS_YSLOT + (size_t)CAP * 1024 * 2;
constexpr size_t WS_END_MOE = WS_HSLOT + (size_t)NROUND * CAP * 256 * 2;
static_assert(WS_X1H + (size_t)T * 1024 * 2 <= WS_HSLOT, "x1 hi must end below HSLOT");
static_assert(WS_LNST + (size_t)128 * 4 * 256 * 8 <= WS_END_EARLY, "LN statistics must fit the early region");
constexpr size_t WS_NEED = WS_END_EARLY > WS_END_MOE ? WS_END_EARLY : WS_END_MOE;

constexpr int NTHREADS = 512;
constexpr int LDS_GEMM_H = 65536;
constexpr int LDS_MISC = 139264;
constexpr int LDS_STG = 65536;
constexpr int LDS_BYTES = 155648;
constexpr int LDS_BARW = LDS_BYTES - 16;
constexpr int WAVE_LDS = 15360;

struct Params {
    const float* in[26];
    float* out;
    unsigned char* ws;
};
typedef const __attribute__((address_space(4))) Params CParams;
__device__ __forceinline__ CParams* kargs() {
    CParams* q = (CParams*)__builtin_amdgcn_kernarg_segment_ptr();
    asm volatile("" : "+s"(q));
    return q;
}

typedef __bf16 bf16x2_t __attribute__((ext_vector_type(2)));
typedef float f32x2_t __attribute__((ext_vector_type(2)));
__device__ __forceinline__ uint32_t pk2(float a, float b) {
    const f32x2_t v = {a, b};
    return __builtin_bit_cast(uint32_t, __builtin_convertvector(v, bf16x2_t));
}
__device__ __forceinline__ bf16_t f2bf(float f) { return (bf16_t)(pk2(f, 0.f) & 0xFFFFu); }
__device__ __forceinline__ float bf2f(bf16_t h) { return __uint_as_float(((uint32_t)h) << 16); }
__device__ __forceinline__ float bflo(uint32_t w) { return __uint_as_float(w << 16); }
__device__ __forceinline__ float bfhi(uint32_t w) { return __uint_as_float(w & 0xFFFF0000u); }
__device__ __forceinline__ int lane_id() { return (int)__builtin_amdgcn_mbcnt_hi(~0u, __builtin_amdgcn_mbcnt_lo(~0u, 0u)); }
__device__ __forceinline__ int opaque_tid(int wv) { int t = wv * 64 + lane_id(); asm volatile("" : "+v"(t)); return t; }
__device__ __forceinline__ int opaque_i(int t) { asm volatile("" : "+v"(t)); return t; }
__device__ __forceinline__ size_t km_off(int row, int k, int nrows) { return ((size_t)(k >> 5) * nrows + row) * 32 + (k & 31); }
__device__ __forceinline__ void wave_sync() {
    __builtin_amdgcn_fence(__ATOMIC_RELEASE, "wavefront");
    __builtin_amdgcn_wave_barrier();
    __builtin_amdgcn_fence(__ATOMIC_ACQUIRE, "wavefront");
}
template <int CTRL> __device__ __forceinline__ float dpp_f(float x) {
    return __builtin_bit_cast(float, __builtin_amdgcn_mov_dpp(__builtin_bit_cast(int, x), CTRL, 0xf, 0xf, true));
}
__device__ __forceinline__ float xrow16_max(float x) {
    auto s = __builtin_amdgcn_permlane16_swap(__float_as_uint(x), __float_as_uint(x), false, false);
    x = fmaxf(__uint_as_float(s[0]), __uint_as_float(s[1]));
    auto t = __builtin_amdgcn_permlane32_swap(__float_as_uint(x), __float_as_uint(x), false, false);
    return fmaxf(__uint_as_float(t[0]), __uint_as_float(t[1]));
}
__device__ __forceinline__ float xrow16_sum(float x) {
    auto s = __builtin_amdgcn_permlane16_swap(__float_as_uint(x), __float_as_uint(x), false, false);
    x = __uint_as_float(s[0]) + __uint_as_float(s[1]);
    auto t = __builtin_amdgcn_permlane32_swap(__float_as_uint(x), __float_as_uint(x), false, false);
    return __uint_as_float(t[0]) + __uint_as_float(t[1]);
}
__device__ __forceinline__ float wave_sum(float v) {
    v += dpp_f<0xB1>(v); v += dpp_f<0x4E>(v); v += dpp_f<0x141>(v); v += dpp_f<0x128>(v);
    return xrow16_sum(v);
}
__device__ __forceinline__ float wave_max(float v) {
    v = fmaxf(v, dpp_f<0xB1>(v)); v = fmaxf(v, dpp_f<0x4E>(v)); v = fmaxf(v, dpp_f<0x141>(v)); v = fmaxf(v, dpp_f<0x128>(v));
    return xrow16_max(v);
}
__device__ __forceinline__ void unpack8(const uint4& v, float* f) {
    f[0] = bflo(v.x); f[1] = bfhi(v.x); f[2] = bflo(v.y); f[3] = bfhi(v.y);
    f[4] = bflo(v.z); f[5] = bfhi(v.z); f[6] = bflo(v.w); f[7] = bfhi(v.w);
}

template <int AMODE>
__device__ __forceinline__ void gemm_loop(f32x4 (&acc)[4][2], const bf16_t* a0, const bf16_t* a1, const bf16_t* a0b, const bf16_t* a1b,
                                          const bf16_t* b0, const bf16_t* b1, int nk, char* lds, const char* ldsH,
                                          int tid, int lane, int wm, int wn) {
    const int fr = lane & 15, fq = lane >> 4;
    const int r0 = tid >> 3, c = tid & 7;
    const int wo = r0 * 128 + ((c ^ ((r0 >> 1) & 7)) << 4);
    uint4 ra0, ra1, rb0, rb1;
    ra0 = ra1 = make_uint4(0, 0, 0, 0);
    if (AMODE != 1) { ra0 = *(const uint4*)a0; ra1 = *(const uint4*)a1; }
    rb0 = *(const uint4*)b0; rb1 = *(const uint4*)b1;
    __syncthreads();
    if (AMODE != 1) { *(uint4*)(lds + wo) = ra0; *(uint4*)(lds + wo + 8192) = ra1; }
    *(uint4*)(lds + 32768 + wo) = rb0; *(uint4*)(lds + 32768 + wo + 8192) = rb1;
    __syncthreads();
    const int swz = (fr >> 1) & 7;
    const int aoff = (wm * 64 + fr) * 128, boff = 32768 + (wn * 32 + fr) * 128;
    for (int kt = 0; kt < nk; ++kt) {
        const int cur = kt & 1;
        if (kt + 1 < nk) {
            const int k1 = kt + 1;
            if (AMODE == 0) { ra0 = *(const uint4*)(a0 + k1 * 64); ra1 = *(const uint4*)(a1 + k1 * 64); }
            if (AMODE == 2) {
                const int seg = k1 >> 4, ko = (k1 & 15) * 64;
                const bf16_t* p0 = (seg == 1) ? a0b : a0; const bf16_t* p1 = (seg == 1) ? a1b : a1;
                ra0 = *(const uint4*)(p0 + ko); ra1 = *(const uint4*)(p1 + ko);
            }
            rb0 = *(const uint4*)(b0 + k1 * 64); rb1 = *(const uint4*)(b1 + k1 * 64);
        }
        const char* pa = (AMODE == 1) ? (ldsH + kt * 16384 + aoff) : (lds + cur * 16384 + aoff);
        const char* pb = lds + cur * 16384 + boff;
#pragma unroll
        for (int kk = 0; kk < 2; ++kk) {
            const int ch = ((kk * 4 + fq) ^ swz) << 4;
            bf16x8 af[4], bfv[2];
#pragma unroll
            for (int mi = 0; mi < 4; ++mi) af[mi] = *(const bf16x8*)(pa + mi * 2048 + ch);
#pragma unroll
            for (int ni = 0; ni < 2; ++ni) bfv[ni] = *(const bf16x8*)(pb + ni * 2048 + ch);
#pragma unroll
            for (int mi = 0; mi < 4; ++mi)
#pragma unroll
                for (int ni = 0; ni < 2; ++ni)
                    acc[mi][ni] = __builtin_amdgcn_mfma_f32_16x16x32_bf16(bfv[ni], af[mi], acc[mi][ni], 0, 0, 0);
        }
        if (kt + 1 < nk) {
            const int nxt = cur ^ 1;
            if (AMODE != 1) { *(uint4*)(lds + nxt * 16384 + wo) = ra0; *(uint4*)(lds + nxt * 16384 + wo + 8192) = ra1; }
            *(uint4*)(lds + 32768 + nxt * 16384 + wo) = rb0; *(uint4*)(lds + 32768 + nxt * 16384 + wo + 8192) = rb1;
        }
        __syncthreads();
    }
}
template <int NK, bool ROUTER>
__device__ __forceinline__ void pf_kloop(f32x4 (&acc)[4][2], const bf16_t* a0, const bf16_t* a1, const bf16_t* a0b, const bf16_t* a1b,
                                             const bf16_t* b0, const bf16_t* b1, char* lds, int tid, int lane, int wm, int wn) {
    static_assert(NK % 4 == 0, "unrolled by 4");
    const int fr = lane & 15, fq = lane >> 4;
    const int r0 = tid >> 3, c = tid & 7;
    const int wo = r0 * 128 + ((c ^ ((r0 >> 1) & 7)) << 4);
    uint4 ra0_0, ra1_0, rb0_0, rb1_0, ra0_1, ra1_1, rb0_1, rb1_1, ra0_2, ra1_2, rb0_2, rb1_2, ra0_3, ra1_3, rb0_3, rb1_3;
#define RT_LOAD(s, k) do { const int k_ = (k); const int seg_ = ROUTER ? (k_ >> 4) : 0, ko_ = ROUTER ? (k_ & 15) * 64 : k_ * 64; const bf16_t* p0_ = (seg_ == 1) ? a0b : a0; const bf16_t* p1_ = (seg_ == 1) ? a1b : a1; \
        ra0_##s = *(const uint4*)(p0_ + ko_); ra1_##s = *(const uint4*)(p1_ + ko_); rb0_##s = *(const uint4*)(b0 + k_ * 64); rb1_##s = *(const uint4*)(b1 + k_ * 64); } while (0)
#define RT_STORE(s, buf) do { *(uint4*)(lds + (buf) * 16384 + wo) = ra0_##s; *(uint4*)(lds + (buf) * 16384 + wo + 8192) = ra1_##s; \
        *(uint4*)(lds + 32768 + (buf) * 16384 + wo) = rb0_##s; *(uint4*)(lds + 32768 + (buf) * 16384 + wo + 8192) = rb1_##s; } while (0)
#define RT_BAR() do { asm volatile("s_waitcnt lgkmcnt(0)" ::: "memory"); __builtin_amdgcn_s_barrier(); asm volatile("" ::: "memory"); } while (0)
    RT_LOAD(0, 0); RT_LOAD(1, 1); RT_LOAD(2, 2); RT_LOAD(3, 3);
    __syncthreads();
    RT_STORE(0, 0);
    RT_BAR();
    const int swz = (fr >> 1) & 7;
    const int aoff = (wm * 64 + fr) * 128, boff = 32768 + (wn * 32 + fr) * 128;
#define RT_STEP(j, jn) do { const int k = kt + (j); \
        RT_LOAD(j, (k + 4 < NK) ? k + 4 : NK - 1);     \
        const char* pa = lds + ((j) & 1) * 16384 + aoff; const char* pb = lds + ((j) & 1) * 16384 + boff; \
        _Pragma("unroll") for (int kk = 0; kk < 2; ++kk) { \
            const int ch = ((kk * 4 + fq) ^ swz) << 4; \
            bf16x8 af[4], bfv[2]; \
            _Pragma("unroll") for (int mi = 0; mi < 4; ++mi) af[mi] = *(const bf16x8*)(pa + mi * 2048 + ch); \
            _Pragma("unroll") for (int ni = 0; ni < 2; ++ni) bfv[ni] = *(const bf16x8*)(pb + ni * 2048 + ch); \
            _Pragma("unroll") for (int mi = 0; mi < 4; ++mi) _Pragma("unroll") for (int ni = 0; ni < 2; ++ni) \
                acc[mi][ni] = __builtin_amdgcn_mfma_f32_16x16x32_bf16(bfv[ni], af[mi], acc[mi][ni], 0, 0, 0); } \
        RT_STORE(jn, ((j) + 1) & 1); \
        RT_BAR(); } while (0)
    for (int kt = 0; kt < NK; kt += 4) {
        RT_STEP(0, 1); RT_STEP(1, 2); RT_STEP(2, 3); RT_STEP(3, 0);
    }
#undef RT_STEP
#undef RT_BAR
#undef RT_LOAD
#undef RT_STORE
}
__device__ __forceinline__ void acc_zero(f32x4 (&acc)[4][2]) {
#pragma unroll
    for (int mi = 0; mi < 4; ++mi)
#pragma unroll
        for (int ni = 0; ni < 2; ++ni) acc[mi][ni] = (f32x4){0.f, 0.f, 0.f, 0.f};
}
template <int OMODE>
__device__ __forceinline__ void gemm_item_bf16(const bf16_t* A, int lda, const bf16_t* Bt, int ldb, int nk, bf16_t* C, int ldc, int m0, int n0,
                                               char* lds, int tid, int lane, int wm, int wn) {
    const int r0 = tid >> 3, c = tid & 7;
    f32x4 acc[4][2]; acc_zero(acc);
    const bf16_t* a0 = A + (size_t)(m0 + r0) * lda + c * 8; const bf16_t* a1 = a0 + (size_t)64 * lda;
    const bf16_t* b0 = Bt + (size_t)(n0 + r0) * ldb + c * 8; const bf16_t* b1 = b0 + (size_t)64 * ldb;
    pf_kloop<16, false>(acc, a0, a1, a0, a1, b0, b1, lds, tid, lane, wm, wn);
    const int fr = lane & 15, fq = lane >> 4;
#pragma unroll
    for (int mi = 0; mi < 4; ++mi)
#pragma unroll
        for (int ni = 0; ni < 2; ++ni) {
            const int m = m0 + wm * 64 + mi * 16 + fr, n = n0 + wn * 32 + ni * 16 + 4 * fq;
            uint2 o; o.x = pk2(acc[mi][ni][0], acc[mi][ni][1]); o.y = pk2(acc[mi][ni][2], acc[mi][ni][3]);
            size_t off;
            if (OMODE == 0) off = (size_t)m * ldc + n;
            else if (OMODE == 1) {
                const int b = m >> 8, key = m & 255, h = n >> 6, d = n & 63;
                off = ((size_t)((((b * 4 + h) * 16 + (key >> 4)) * 2 + (d >> 5)) * 64 + ((d & 31) >> 3) * 16 + (key & 15))) * 8 + (d & 7);
            } else {
                const int h = m >> 6, d = m & 63, b = n >> 8, key = n & 255, k32 = key & 31;
                off = ((size_t)((((b * 4 + h) * 8 + (key >> 5)) * 4 + (d >> 4)) * 64 + ((k32 & 15) >> 2) * 16 + (d & 15))) * 8 + ((k32 >> 4) * 4);
            }
            *(uint2*)(C + off) = o;
        }
}

namespace g8 {
constexpr int HTB = 8192;
__device__ __forceinline__ int lds_byte(int r, int c) { const int ob = (r & 15) * 64 + c * 2; return (r >> 4) * 1024 + (ob ^ (((ob >> 9) & 1) << 5)); }
__device__ __forceinline__ void stage_rc(int b, int& R, int& C) { const int st = b / 1024, sb = b % 1024, swz = sb ^ (((sb >> 9) & 1) << 5); R = st * 16 + swz / 64; C = (swz % 64) / 2; }
struct Src { __amdgpu_buffer_rsrc_t ra, rb; unsigned ao[2]; unsigned bo; unsigned bh; unsigned akt, bkt; };
__device__ __forceinline__ __amdgpu_buffer_rsrc_t make_rsrc(const void* p) {
    const unsigned long long a = (unsigned long long)p;
    const unsigned lo = __builtin_amdgcn_readfirstlane((unsigned)a), hi = __builtin_amdgcn_readfirstlane((unsigned)(a >> 32));
    return __builtin_amdgcn_make_buffer_rsrc((void*)(((unsigned long long)hi << 32) | lo), 0, 0x7FFFFFFF, 0x00020000);
}
#define G8_SA(b,h) (lds + ((b) * 2 + (h)) * g8::HTB)
#define G8_SB(b,h) (lds + (4 + (b) * 2 + (h)) * g8::HTB)
#define G8_KOFF(kt, ktstride, segstride) ((((kt) & sg.mask) * (ktstride)) + (((kt) >> sg.lg) * (segstride)))
#define G8_STAGE_A(b,h,kt) __builtin_amdgcn_raw_ptr_buffer_load_lds(s.ra, (LAS void*)(G8_SA(b,h) + wv * 1024), 16, s.ao[h], G8_KOFF(kt, s.akt, sg.aseg), 0, AAUX)
#define G8_STAGE_B(b,h,kt) __builtin_amdgcn_raw_ptr_buffer_load_lds(s.rb, (LAS void*)(G8_SB(b,h) + wv * 1024), 16, s.bo, G8_KOFF(kt, s.bkt, sg.bseg) + (h) * s.bh, 0, 0)
#define G8_LDA(dst,b,h) do { _Pragma("unroll") for (int m = 0; m < 4; ++m) \
    dst[m] = *(const bf16x8*)(G8_SA(b,h) + g8::lds_byte(wr * 64 + m * 16 + fr, fq * 8)); } while (0)
#define G8_LDB(dst,b,h) do { _Pragma("unroll") for (int n = 0; n < 2; ++n) \
    dst[n] = *(const bf16x8*)(G8_SB(b,h) + g8::lds_byte(wc * 32 + n * 16 + fr, fq * 8)); } while (0)
#define G8_MMA(ai,bj,At,Bt) do { __builtin_amdgcn_s_setprio(1); \
    _Pragma("unroll") for (int m = 0; m < 4; ++m) _Pragma("unroll") for (int n = 0; n < 2; ++n) \
      acc[ai][bj][m][n] = __builtin_amdgcn_mfma_f32_16x16x32_bf16(Bt[n], At[m], acc[ai][bj][m][n], 0, 0, 0); \
    __builtin_amdgcn_s_setprio(0); } while (0)
#define G8_WAIT_V(n) asm volatile("s_waitcnt vmcnt(" #n ")" ::: "memory")
#define G8_WAIT_L(n) asm volatile("s_waitcnt lgkmcnt(" #n ")" ::: "memory")
#define G8_BAR __builtin_amdgcn_s_barrier()
#define G8_SCHED __builtin_amdgcn_sched_barrier(0)

__device__ __forceinline__ void zero_acc(f32x4 (&acc)[2][2][4][2]) {
#pragma unroll
    for (int a = 0; a < 2; ++a)
#pragma unroll
        for (int b = 0; b < 2; ++b)
#pragma unroll
            for (int m = 0; m < 4; ++m)
#pragma unroll
                for (int n = 0; n < 2; ++n) acc[a][b][m][n] = (f32x4){0.f, 0.f, 0.f, 0.f};
}
struct Seg { int mask, lg; unsigned aseg, bseg; };
__device__ __forceinline__ Seg one_seg() { Seg g; g.mask = 0x7FFFFFFF; g.lg = 30; g.aseg = 0u; g.bseg = 0u; return g; }
struct NoFlush { __device__ __forceinline__ void operator()(f32x4 (&)[2][2][4][2], int) const {} };
template <int AAUX = 0>
__device__ __forceinline__ void kloop_issue(const Src& s, char* lds, int wv, const Seg sg = one_seg()) {
    G8_STAGE_B(0, 0, 0); G8_STAGE_A(0, 0, 0);
    G8_STAGE_B(0, 1, 0); G8_STAGE_A(0, 1, 0);
}
template <class Flush, int AAUX = 0>
__device__ __forceinline__ void kloop_ms(f32x4 (&acc)[2][2][4][2], const Src& s, int nt, char* lds, int tid, int wv, const Seg sg, const Flush& flush) {
    const int lane = tid & 63, wr = wv >> 2, wc = wv & 3, fr = lane & 15, fq = lane >> 4;
    bf16x8 At[4], B0[2], B1[2];
    if (wr == 1) G8_BAR;
    G8_WAIT_V(0); G8_BAR;
    G8_STAGE_B(1, 0, 1); G8_STAGE_A(1, 0, 1); G8_STAGE_B(1, 1, 1);
    G8_WAIT_V(3); G8_BAR;
    bool drain = false;
    for (int t = 0; t < nt - 2; t += 2) {
        G8_LDB(B0, 0, 0); G8_SCHED; G8_LDA(At, 0, 0); G8_STAGE_A(1, 1, t + 1);
        G8_WAIT_L(4); G8_BAR; G8_WAIT_L(0); G8_MMA(0, 0, At, B0); G8_BAR; G8_SCHED;
        G8_LDB(B1, 0, 1); G8_STAGE_B(0, 0, t + 2);
        G8_BAR; G8_WAIT_L(0); G8_MMA(0, 1, At, B1); G8_BAR;
        G8_LDA(At, 0, 1); G8_STAGE_A(0, 0, t + 2);
        G8_BAR; G8_WAIT_L(0); G8_MMA(1, 0, At, B0); G8_BAR; G8_SCHED;
        G8_STAGE_B(0, 1, t + 2);
        if (drain) { G8_WAIT_V(0); drain = false; } else { G8_WAIT_V(3); }
        G8_BAR; G8_MMA(1, 1, At, B1); G8_BAR;
        G8_LDB(B0, 1, 0); G8_SCHED; G8_LDA(At, 1, 0); G8_STAGE_A(0, 1, t + 2);
        G8_WAIT_L(4); G8_BAR; G8_WAIT_L(0); G8_MMA(0, 0, At, B0); G8_BAR; G8_SCHED;
        G8_LDB(B1, 1, 1); G8_STAGE_B(1, 0, t + 3);
        G8_BAR; G8_WAIT_L(0); G8_MMA(0, 1, At, B1); G8_BAR;
        G8_LDA(At, 1, 1); G8_STAGE_A(1, 0, t + 3);
        G8_BAR; G8_WAIT_L(0); G8_MMA(1, 0, At, B0); G8_BAR; G8_SCHED;
        G8_STAGE_B(1, 1, t + 3);
        G8_WAIT_V(3); G8_BAR; G8_MMA(1, 1, At, B1); G8_BAR;
        if (((t + 2) & sg.mask) == 0) {
            flush(acc, ((t + 2) >> sg.lg) - 1);
            zero_acc(acc);
            drain = true;
        }
    }
    { G8_LDB(B0, 0, 0); G8_LDA(At, 0, 0); G8_STAGE_A(1, 1, nt - 1);
      G8_BAR; G8_WAIT_L(0); G8_MMA(0, 0, At, B0); G8_BAR;
      G8_LDB(B1, 0, 1); G8_BAR; G8_WAIT_L(0); G8_MMA(0, 1, At, B1); G8_BAR;
      G8_LDA(At, 0, 1); G8_WAIT_V(2); G8_BAR; G8_WAIT_L(0); G8_MMA(1, 0, At, B0); G8_MMA(1, 1, At, B1); G8_BAR; }
    { G8_LDB(B0, 1, 0); G8_LDA(At, 1, 0); G8_WAIT_V(1); G8_BAR; G8_WAIT_L(0); G8_MMA(0, 0, At, B0); G8_BAR;
      G8_LDB(B1, 1, 1); G8_WAIT_V(0); G8_BAR; G8_WAIT_L(0); G8_MMA(0, 1, At, B1); G8_BAR;
      G8_LDA(At, 1, 1); G8_BAR; G8_WAIT_L(0); G8_MMA(1, 0, At, B0); G8_MMA(1, 1, At, B1); G8_BAR; }
    if (wr == 0) G8_BAR;
}
#define LS_STAGE_A(b,h,kt) do { if (wv < 4) { \
    __builtin_amdgcn_raw_ptr_buffer_load_lds(s.ra, (LAS void*)(G8_SA(b,h) + wv * 1024), 16, s.ao[h], G8_KOFF(kt, s.akt, sg.aseg), 0, 0); \
    __builtin_amdgcn_raw_ptr_buffer_load_lds(s.ra, (LAS void*)(G8_SA(b,h) + (wv + 4) * 1024), 16, s.ao[h], G8_KOFF(kt, s.akt, sg.aseg) + 4096u, 0, 0); } } while (0)
#define LS_STAGE_B(b,h,kt) do { if (wv < 4) { \
    __builtin_amdgcn_raw_ptr_buffer_load_lds(s.rb, (LAS void*)(G8_SB(b,h) + wv * 1024), 16, s.bo, G8_KOFF(kt, s.bkt, sg.bseg) + (h) * s.bh, 0, 0); \
    __builtin_amdgcn_raw_ptr_buffer_load_lds(s.rb, (LAS void*)(G8_SB(b,h) + (wv + 4) * 1024), 16, s.bo, G8_KOFF(kt, s.bkt, sg.bseg) + (h) * s.bh + 4096u, 0, 0); } } while (0)
#define LS_WAIT_V(n) do { if (wv < 4) G8_WAIT_V(n); } while (0)
__device__ __forceinline__ void kloop_issue_ls(const Src& s, char* lds, int wv, const Seg sg) {
    LS_STAGE_B(0, 0, 0); LS_STAGE_A(0, 0, 0);
    LS_STAGE_B(0, 1, 0); LS_STAGE_A(0, 1, 0);
}
template <class Flush>
__device__ __forceinline__ void kloop_ms_ls(f32x4 (&acc)[2][2][4][2], const Src& s, int nt, char* lds, int tid, int wv, const Seg sg, const Flush& flush) {
    const int lane = tid & 63, wr = wv >> 2, wc = wv & 3, fr = lane & 15, fq = lane >> 4;
    bf16x8 At[4], B0[2], B1[2];
    if (wr == 1) G8_BAR;
    LS_WAIT_V(0); G8_BAR;
    LS_STAGE_B(1, 0, 1); LS_STAGE_A(1, 0, 1); LS_STAGE_B(1, 1, 1);
    LS_WAIT_V(6); G8_BAR;
    for (int t = 0; t < nt - 2; t += 2) {
        G8_LDB(B0, 0, 0); G8_SCHED; G8_LDA(At, 0, 0); LS_STAGE_A(1, 1, t + 1);
        G8_WAIT_L(4); G8_BAR; G8_WAIT_L(0); G8_MMA(0, 0, At, B0); G8_BAR; G8_SCHED;
        G8_LDB(B1, 0, 1); LS_STAGE_B(0, 0, t + 2);
        G8_BAR; G8_WAIT_L(0); G8_MMA(0, 1, At, B1); G8_BAR;
        G8_LDA(At, 0, 1); LS_STAGE_A(0, 0, t + 2);
        G8_BAR; G8_WAIT_L(0); G8_MMA(1, 0, At, B0); G8_BAR; G8_SCHED;
        LS_STAGE_B(0, 1, t + 2);
        LS_WAIT_V(6);
        G8_BAR; G8_MMA(1, 1, At, B1); G8_BAR;
        G8_LDB(B0, 1, 0); G8_SCHED; G8_LDA(At, 1, 0); LS_STAGE_A(0, 1, t + 2);
        G8_WAIT_L(4); G8_BAR; G8_WAIT_L(0); G8_MMA(0, 0, At, B0); G8_BAR; G8_SCHED;
        G8_LDB(B1, 1, 1); LS_STAGE_B(1, 0, t + 3);
        G8_BAR; G8_WAIT_L(0); G8_MMA(0, 1, At, B1); G8_BAR;
        G8_LDA(At, 1, 1); LS_STAGE_A(1, 0, t + 3);
        G8_BAR; G8_WAIT_L(0); G8_MMA(1, 0, At, B0); G8_BAR; G8_SCHED;
        LS_STAGE_B(1, 1, t + 3);
        LS_WAIT_V(6); G8_BAR; G8_MMA(1, 1, At, B1); G8_BAR;
        if (((t + 2) & sg.mask) == 0) {
            flush(acc, ((t + 2) >> sg.lg) - 1);
            zero_acc(acc);
        }
    }
    { G8_LDB(B0, 0, 0); G8_LDA(At, 0, 0); LS_STAGE_A(1, 1, nt - 1);
      G8_BAR; G8_WAIT_L(0); G8_MMA(0, 0, At, B0); G8_BAR;
      G8_LDB(B1, 0, 1); G8_BAR; G8_WAIT_L(0); G8_MMA(0, 1, At, B1); G8_BAR;
      G8_LDA(At, 0, 1); LS_WAIT_V(4); G8_BAR; G8_WAIT_L(0); G8_MMA(1, 0, At, B0); G8_MMA(1, 1, At, B1); G8_BAR; }
    { G8_LDB(B0, 1, 0); G8_LDA(At, 1, 0); LS_WAIT_V(2); G8_BAR; G8_WAIT_L(0); G8_MMA(0, 0, At, B0); G8_BAR;
      G8_LDB(B1, 1, 1); LS_WAIT_V(0); G8_BAR; G8_WAIT_L(0); G8_MMA(0, 1, At, B1); G8_BAR;
      G8_LDA(At, 1, 1); G8_BAR; G8_WAIT_L(0); G8_MMA(1, 0, At, B0); G8_MMA(1, 1, At, B1); G8_BAR; }
    if (wr == 0) G8_BAR;
}
template <int AAUX = 0>
__device__ __forceinline__ void kloop(f32x4 (&acc)[2][2][4][2], const Src& s, int nt, char* lds, int tid, int wv) {
    kloop_ms<NoFlush, AAUX>(acc, s, nt, lds, tid, wv, one_seg(), NoFlush());
}
__device__ __forceinline__ void acc_zero(f32x4 (&acc)[2][2][4][2]) {
#pragma unroll
    for (int a = 0; a < 2; ++a)
#pragma unroll
        for (int b = 0; b < 2; ++b)
#pragma unroll
            for (int m = 0; m < 4; ++m)
#pragma unroll
                for (int n = 0; n < 2; ++n) acc[a][b][m][n] = (f32x4){0.f, 0.f, 0.f, 0.f};
}
__device__ __forceinline__ void dense_src(Src& s, const bf16_t* A, int lda, int brow, const bf16_t* B, int ldb, int bcol, int tid) {
    s.ra = make_rsrc(A); s.rb = make_rsrc(B); s.bh = (unsigned)(128 * ldb * 2); s.akt = 64u; s.bkt = 64u;
    int R, C; stage_rc(tid * 16, R, C);
    s.bo = (unsigned)((bcol + R) * ldb + C) * 2u;
#pragma unroll
    for (int h = 0; h < 2; ++h) s.ao[h] = (unsigned)((brow + h * 128 + R) * lda + C) * 2u;
}
__device__ __forceinline__ void km_src(Src& s, const bf16_t* A, int anrows, int brow, const bf16_t* B, int bnrows, int bcol, int tid) {
    s.ra = make_rsrc(A); s.rb = make_rsrc(B); s.bh = 128u * 64u; s.akt = (unsigned)anrows * 64u; s.bkt = (unsigned)bnrows * 64u;
    int R, C; stage_rc(tid * 16, R, C);
    s.bo = (unsigned)((bcol + R) * 32 + C) * 2u;
#pragma unroll
    for (int h = 0; h < 2; ++h) s.ao[h] = (unsigned)((brow + h * 128 + R) * 32 + C) * 2u;
}
}

__device__ __forceinline__ void tconv_tile(const float* src, const float* src2, int ld_src, bf16_t* dst, int ld_dst, int k0, int n0, int mode, float* tl, int tid, int kmrows = 0, int kmrow0 = 0, int kmk0 = 0) {
    __syncthreads();
    {
        const int nn = tid & 63, kb = tid >> 6;
        const int np = n0 + nn;
        const float* s = src; int sc = np;
        if (mode == 1) sc = (np < 456) ? np : (np < 512 ? -1 : np - 56);
        if (mode == 2) { s = ((np >> 4) & 1) ? src2 : src; sc = 16 * (np >> 5) + (np & 15); }
#pragma unroll
        for (int i = 0; i < 8; ++i) {
            const int kk = kb + i * 8;
            tl[kk * 65 + nn] = (sc >= 0) ? s[(size_t)(k0 + kk) * ld_src + sc] : 0.f;
        }
    }
    __syncthreads();
    {
        const int n2 = tid >> 3, kc = tid & 7;
        const float* s = tl + (kc * 8) * 65 + n2;
        uint4 o; o.x = pk2(s[0], s[65]); o.y = pk2(s[130], s[195]); o.z = pk2(s[260], s[325]); o.w = pk2(s[390], s[455]);
        if (kmrows) *(uint4*)(dst + km_off(kmrow0 + n0 + n2, kmk0 + k0 + kc * 8, kmrows)) = o;
        else *(uint4*)(dst + (size_t)(n0 + n2) * ld_dst + k0 + kc * 8) = o;
    }
}

__device__ __forceinline__ void tconv_wave(const float* src, const float* src2, int ld_src, bf16_t* dst, int kmrows, int k0, int n0, int mode, float* scr, int lane) {
    const int nn = lane & 31, np = n0 + nn, par = lane >> 5;
    const float* s = src; int sc = np;
    if (mode == 2) { s = ((np >> 4) & 1) ? src2 : src; sc = 16 * (np >> 5) + (np & 15); }
    float v[32];
#pragma unroll
    for (int i = 0; i < 32; ++i) v[i] = __builtin_nontemporal_load(s + (size_t)(k0 + 2 * i + par) * ld_src + sc);
    wave_sync();
#pragma unroll
    for (int i = 0; i < 32; ++i) scr[(2 * i + par) * 33 + nn] = v[i];
    wave_sync();
    const int c = lane & 7;
#pragma unroll
    for (int j = 0; j < 4; ++j) {
        const int n = (lane >> 3) + 8 * j;
        const float* sp = scr + (8 * c) * 33 + n;
        uint4 o; o.x = pk2(sp[0], sp[33]); o.y = pk2(sp[66], sp[99]); o.z = pk2(sp[132], sp[165]); o.w = pk2(sp[198], sp[231]);
        { typedef unsigned u32x4_t __attribute__((ext_vector_type(4))); const u32x4_t ov = {o.x, o.y, o.z, o.w};
          __builtin_nontemporal_store(ov, (u32x4_t*)(dst + km_off(n0 + n, k0 + 8 * c, kmrows))); }
    }
}

constexpr int EW_GU = 16 * 16, EW_DN = 4 * 32, EW_EX = EW_GU + EW_DN, EW_ITEMS = NE1 * EW_EX;
__device__ __forceinline__ void expert_w_item(CParams& p, int it, float* scr, int lane) {
    unsigned char* ws = p.ws;
    const int e = it / EW_EX; int r = it - e * EW_EX;
    const float* wg = (e < NEXP) ? p.in[18] + (size_t)e * 1024 * 256 : p.in[21];
    const float* wu = (e < NEXP) ? p.in[19] + (size_t)e * 1024 * 256 : p.in[22];
    const float* wd = (e < NEXP) ? p.in[20] + (size_t)e * 256 * 1024 : p.in[23];
    if (r < EW_GU) tconv_wave(wg, wu, 256, (bf16_t*)(ws + WS_W_EGU_T) + (size_t)e * 512 * 1024, 512, (r & 15) * 64, (r >> 4) * 32, 2, scr, lane);
    else { r -= EW_GU; tconv_wave(wd, nullptr, 1024, (bf16_t*)(ws + WS_W_ED_T) + (size_t)e * 1024 * 256, 1024, (r & 3) * 64, (r >> 2) * 32, 0, scr, lane); }
}

__device__ __forceinline__ void phase0(CParams& p, char* lds, int wv) {
    const int tid = opaque_tid(wv), G = gridDim.x, bid = blockIdx.x;
    unsigned char* ws = p.ws;
    float* tl = (float*)lds;
    if (bid == 0) { int* cnt = (int*)(ws + WS_CNT); for (int i = tid; i < 1024; i += NTHREADS) cnt[i] = 0; }
    {
        const int lane = tid & 63, wid = tid >> 6;
        const float* x = p.in[0]; bf16_t* xb = (bf16_t*)(ws + WS_XB);
        const int tl = lane >> 3, c4 = lane & 7;
        for (int it = bid * 8 + wid; it < (T / 8) * 4; it += G * 8) {
            const int tg = it >> 2, kq = it & 3;
            const float* src = x + (size_t)(tg * 8 + tl) * 1024 + kq * 256 + c4 * 4;
            float4 v[8];
#pragma unroll
            for (int j = 0; j < 8; ++j) v[j] = ldnt4(src + j * 32);
#pragma unroll
            for (int j = 0; j < 8; ++j) {
                uint2 o; o.x = pk2(v[j].x, v[j].y); o.y = pk2(v[j].z, v[j].w);
                *(uint2*)(xb + km_off(tg * 8 + tl, (kq * 8 + j) * 32 + c4 * 4, T)) = o;
            }
        }
        const int NM = NB * NMEM * DM / 4096;
        for (int it = bid; it < NM; it += G) {
            const size_t off = (size_t)it * 4096;
            const float4 v0 = ldnt4(p.in[1] + off + tid * 8), v1 = ldnt4(p.in[1] + off + tid * 8 + 4);
            uint4 o; o.x = pk2(v0.x, v0.y); o.y = pk2(v0.z, v0.w); o.z = pk2(v1.x, v1.y); o.w = pk2(v1.z, v1.w);
            *(uint4*)((bf16_t*)(ws + WS_MEMB) + off + tid * 8) = o;
        }
    }
    {
        constexpr int I_IN = 24 * 16, I_QI = 8 * 4, I_MK = 4 * 16, I_MV = 4 * 16, I_OUT = 8 * 16;
        constexpr int NIT = I_IN + I_QI + I_MK + I_MV + I_OUT;
        for (int it = bid; it < NIT; it += G) {
            int r = it;
            if (r < I_IN) { tconv_tile(p.in[2], nullptr, 1480, (bf16_t*)(ws + WS_W_IN_T), 1024, (r % 16) * 64, (r / 16) * 64, 1, tl, tid, 1536, 0, 0); continue; } r -= I_IN;
            if (r < I_QI) { tconv_tile(p.in[8], nullptr, 512, (bf16_t*)(ws + WS_W_Q2_T), 256, (r % 4) * 64, (r / 4) * 64, 0, tl, tid, 1536, 1024, 0); continue; } r -= I_QI;
            if (r < I_MK) { tconv_tile(p.in[11], nullptr, 256, (bf16_t*)(ws + WS_W_MKV_T), 1024, (r % 16) * 64, (r / 16) * 64, 0, tl, tid); continue; } r -= I_MK;
            if (r < I_MV) { tconv_tile(p.in[12], nullptr, 256, (bf16_t*)(ws + WS_W_MKV_T) + (size_t)256 * 1024, 1024, (r % 16) * 64, (r / 16) * 64, 0, tl, tid); continue; } r -= I_MV;
            tconv_tile(p.in[13] + (size_t)512 * 1024, nullptr, 1024, (bf16_t*)(ws + WS_W_OUT2_T), 1536, (r % 8) * 64, (r / 8) * 64, 0, tl, tid, 1024, 0, 1024);
        }
        __syncthreads();
        __syncthreads();
    }
    {
        const float* wuq = p.in[5]; const float* wuk = p.in[6];
        bf16_t* dst = (bf16_t*)(ws + WS_W_Q2_T);
        for (int it = bid; it < 512; it += G) {
            const int o = it * 512 + tid, n = o >> 8, r = o & 255, h = n >> 7, cc = n & 127;
            const float* a = wuq + (size_t)r * 512 + h * 64; const float* b = wuk + (size_t)cc * 512 + h * 64;
            float s = 0.f;
#pragma unroll 4
            for (int d = 0; d < 64; d += 4) { const float4 x = *(const float4*)(a + d), y = *(const float4*)(b + d); s += x.x * y.x + x.y * y.y + x.z * y.z + x.w * y.w; }
            dst[km_off(n, r, 1536)] = f2bf(s * (0.125f * 1.4426950408889634f));
        }
    }
    {
        const float* wuv = p.in[7]; const float* wout = p.in[13];
        bf16_t* dst = (bf16_t*)(ws + WS_W_OUT2_T);
        float* Lu = tl;
        float* Lo = tl + 8192;
        for (int it = bid; it < 128; it += G) {
            const int h = it >> 4, nt = it & 15;
            __syncthreads();
#pragma unroll
            for (int i = 0; i < 16; ++i) { const int idx = tid + i * 512, cc = idx >> 6, d = idx & 63; Lu[idx] = wuv[(size_t)(cc * 8 + h) * 64 + d]; }
#pragma unroll
            for (int i = 0; i < 8; ++i) { const int idx = tid + i * 512, d = idx >> 6, n = idx & 63; Lo[idx] = wout[(size_t)(h * 64 + d) * 1024 + nt * 64 + n]; }
            __syncthreads();
            const int n = tid & 63, cg = tid >> 6;
            float acc[16];
#pragma unroll
            for (int i = 0; i < 16; ++i) acc[i] = 0.f;
            for (int d = 0; d < 64; ++d) {
                const float w = Lo[d * 64 + n];
#pragma unroll
                for (int i = 0; i < 16; ++i) acc[i] = fmaf(Lu[(cg * 16 + i) * 64 + d], w, acc[i]);
            }
            uint4 o0, o1;
            o0.x = pk2(acc[0], acc[1]); o0.y = pk2(acc[2], acc[3]); o0.z = pk2(acc[4], acc[5]); o0.w = pk2(acc[6], acc[7]);
            o1.x = pk2(acc[8], acc[9]); o1.y = pk2(acc[10], acc[11]); o1.z = pk2(acc[12], acc[13]); o1.w = pk2(acc[14], acc[15]);
            bf16_t* dp = dst + km_off(nt * 64 + n, h * 128 + cg * 16, 1024);
            *(uint4*)dp = o0; *(uint4*)(dp + 8) = o1;
        }
        __syncthreads();
    }
    {
        const float* wr = p.in[16]; bf16_t* dst = (bf16_t*)(ws + WS_W_R_T);
        for (int it = bid; it < 128; it += G) {
            const int o = it * 512 + tid, e = o >> 10, k = o & 1023;
            const float w = wr[(size_t)k * 64 + e]; const bf16_t hi = f2bf(w), lo = f2bf(w - bf2f(hi));
            dst[(size_t)e * 2048 + k] = hi; dst[(size_t)e * 2048 + 1024 + k] = hi;
            dst[(size_t)(64 + e) * 2048 + k] = lo; dst[(size_t)(64 + e) * 2048 + 1024 + k] = 0;
        }
    }
}

template <bool RESYNC>
__device__ __forceinline__ void g8_store_tile(const f32x4 (&acc)[2][2][4][2], bf16_t* C, size_t ldc, int row0, int col0, const float* w8, char* lds, int tid_, int wv) {
    const int tid = opaque_i(tid_);
    const int lane = tid & 63, wr = wv >> 2, wc = wv & 3, fr = lane & 15, fq = lane >> 4;
    char* stg = lds + LDS_STG;
    if (RESYNC) { if (wr == 0) __builtin_amdgcn_s_barrier(); }
#pragma unroll
    for (int ai = 0; ai < 2; ++ai) {
#pragma unroll
        for (int m = 0; m < 4; ++m) {
            const float sc = w8 ? w8[ai * 4 + m] : 1.f;
            char* rp = stg + (wr * 64 + m * 16 + fr) * 528 + (wc * 32 + 4 * fq) * 2;
#pragma unroll
            for (int bj = 0; bj < 2; ++bj)
#pragma unroll
                for (int n = 0; n < 2; ++n) {
                    uint2 o; o.x = pk2(acc[ai][bj][m][n][0] * sc, acc[ai][bj][m][n][1] * sc); o.y = pk2(acc[ai][bj][m][n][2] * sc, acc[ai][bj][m][n][3] * sc);
                    *(uint2*)(rp + (bj * 128 + n * 16) * 2) = o;
                }
        }
        asm volatile("s_waitcnt lgkmcnt(0)" ::: "memory"); __builtin_amdgcn_s_barrier(); asm volatile("" ::: "memory");
        uint4 v[8];
#pragma unroll
        for (int i = 0; i < 8; ++i) { const int id = tid + i * 512; v[i] = *(const uint4*)(stg + (id >> 5) * 528 + (id & 31) * 16); }
#pragma unroll
        for (int i = 0; i < 8; ++i) { const int id = tid + i * 512; *(uint4*)(C + (size_t)(row0 + ai * 128 + (id >> 5)) * ldc + col0 + (id & 31) * 8) = v[i]; }
        asm volatile("s_waitcnt lgkmcnt(0)" ::: "memory"); __builtin_amdgcn_s_barrier(); asm volatile("" ::: "memory");
    }
    if (RESYNC) { if (wr == 1) __builtin_amdgcn_s_barrier(); }
}
template <bool RESYNC>
__device__ __forceinline__ void g8_store_tile_ls(const f32x4 (&acc)[2][2][4][2], bf16_t* C, size_t ldc, int row0, int col0, const float* w8, char* lds, int tid_, int wv) {
    const int tid = opaque_i(tid_);
    const int lane = tid & 63, wr = wv >> 2, wc = wv & 3, fr = lane & 15, fq = lane >> 4;
    char* stg = lds + LDS_STG;
    if (RESYNC) { if (wr == 0) __builtin_amdgcn_s_barrier(); }
#pragma unroll
    for (int ai = 0; ai < 2; ++ai) {
#pragma unroll
        for (int m = 0; m < 4; ++m) {
            const float sc = w8 ? w8[ai * 4 + m] : 1.f;
            char* rp = stg + (wr * 64 + m * 16 + fr) * 528 + (wc * 32 + 4 * fq) * 2;
#pragma unroll
            for (int bj = 0; bj < 2; ++bj)
#pragma unroll
                for (int n = 0; n < 2; ++n) {
                    uint2 o; o.x = pk2(acc[ai][bj][m][n][0] * sc, acc[ai][bj][m][n][1] * sc); o.y = pk2(acc[ai][bj][m][n][2] * sc, acc[ai][bj][m][n][3] * sc);
                    *(uint2*)(rp + (bj * 128 + n * 16) * 2) = o;
                }
        }
        asm volatile("s_waitcnt lgkmcnt(0)" ::: "memory"); __builtin_amdgcn_s_barrier(); asm volatile("" ::: "memory");
        if (wv >= 4) {
#pragma unroll
            for (int hb = 0; hb < 2; ++hb) {
                uint4 v[8];
#pragma unroll
                for (int i = 0; i < 8; ++i) { const int id = (tid - 256) + (hb * 8 + i) * 256; v[i] = *(const uint4*)(stg + (id >> 5) * 528 + (id & 31) * 16); }
#pragma unroll
                for (int i = 0; i < 8; ++i) { const int id = (tid - 256) + (hb * 8 + i) * 256; *(uint4*)(C + (size_t)(row0 + ai * 128 + (id >> 5)) * ldc + col0 + (id & 31) * 8) = v[i]; }
            }
        }
        asm volatile("s_waitcnt lgkmcnt(0)" ::: "memory"); __builtin_amdgcn_s_barrier(); asm volatile("" ::: "memory");
    }
    if (RESYNC) { if (wr == 1) __builtin_amdgcn_s_barrier(); }
}
__device__ __forceinline__ void g8_store_proj(const f32x4 (&acc)[2][2][4][2], CParams& p, int brow, int nt, char* lds, int tid_, int wv) {
    const int tid = opaque_i(tid_);
    const int lane = tid & 63, wr = wv >> 2, wc = wv & 3, fr = lane & 15, fq = lane >> 4;
    unsigned char* ws = p.ws;
    char* stg = lds + LDS_STG;
    float* rs = (float*)(stg + 128 * 528);
    bf16_t* proj = (bf16_t*)(ws + WS_PROJ);
#pragma unroll
    for (int ai = 0; ai < 2; ++ai) {
#pragma unroll
        for (int m = 0; m < 4; ++m) {
            char* rp = stg + (wr * 64 + m * 16 + fr) * 528 + (wc * 32 + 4 * fq) * 2;
#pragma unroll
            for (int bj = 0; bj < 2; ++bj)
#pragma unroll
                for (int n = 0; n < 2; ++n) {
                    uint2 o; o.x = pk2(acc[ai][bj][m][n][0], acc[ai][bj][m][n][1]); o.y = pk2(acc[ai][bj][m][n][2], acc[ai][bj][m][n][3]);
                    *(uint2*)(rp + (bj * 128 + n * 16) * 2) = o;
                }
        }
        asm volatile("s_waitcnt lgkmcnt(0)" ::: "memory"); __builtin_amdgcn_s_barrier(); asm volatile("" ::: "memory");
        const int r0g = brow + ai * 128;
        if (nt != 0) {
            uint4 v[8];
#pragma unroll
            for (int i = 0; i < 8; ++i) { const int id = tid + i * 512; v[i] = *(const uint4*)(stg + (id >> 5) * 528 + (id & 31) * 16); }
#pragma unroll
            for (int i = 0; i < 8; ++i) { const int id = tid + i * 512; *(uint4*)(proj + (size_t)(r0g + (id >> 5)) * NPROJ + nt * 256 + (id & 31) * 8) = v[i]; }
        }
        if (nt <= 1) {
            const int row = tid >> 2, q = tid & 3;
            const int ncol = (nt == 0) ? 256 : 128, per = ncol >> 2;
            float ss = 0.f;
            for (int c = 0; c < per; c += 8) {
                float f[8]; const uint4 u = *(const uint4*)(stg + row * 528 + (q * per + c) * 2); unpack8(u, f);
#pragma unroll
                for (int j = 0; j < 8; ++j) ss = fmaf(f[j], f[j], ss);
            }
            ss += dpp_f<0xB1>(ss); ss += dpp_f<0x4E>(ss);
            if (q == 0) rs[row] = rsqrtf(ss / (float)ncol + RMS_EPS);
            asm volatile("s_waitcnt lgkmcnt(0)" ::: "memory"); __builtin_amdgcn_s_barrier(); asm volatile("" ::: "memory");
            if (nt == 0) {
                const float* gq = p.in[3]; bf16_t* cqn = (bf16_t*)(ws + WS_CQN);
#pragma unroll
                for (int i = 0; i < 8; ++i) {
                    const int id = tid + i * 512, c4 = id & 3, rw = (id >> 2) & 127, kt = id >> 9, col = kt * 32 + c4 * 8;
                    float f[8]; const uint4 u = *(const uint4*)(stg + rw * 528 + col * 2); unpack8(u, f);
                    const float r = rs[rw];
                    const float4 g0 = *(const float4*)(gq + col), g1 = *(const float4*)(gq + col + 4);
                    uint4 o; o.x = pk2(f[0] * r * g0.x, f[1] * r * g0.y); o.y = pk2(f[2] * r * g0.z, f[3] * r * g0.w); o.z = pk2(f[4] * r * g1.x, f[5] * r * g1.y); o.w = pk2(f[6] * r * g1.z, f[7] * r * g1.w);
                    *(uint4*)(cqn + km_off(r0g + rw, col, T)) = o;
                }
            } else {
                const float* gkv = p.in[4]; bf16_t* ckvn = (bf16_t*)(ws + WS_CKVN); bf16_t* kidxf = (bf16_t*)(ws + WS_KIDX);
#pragma unroll
                for (int i = 0; i < 4; ++i) {
                    const int id = tid + i * 512, rw = id >> 4, ch = id & 15, col = ch * 8;
                    float f[8]; const uint4 u = *(const uint4*)(stg + rw * 528 + col * 2); unpack8(u, f);
                    const float r = rs[rw];
                    const float4 g0 = *(const float4*)(gkv + col), g1 = *(const float4*)(gkv + col + 4);
                    uint4 o; o.x = pk2(f[0] * r * g0.x, f[1] * r * g0.y); o.y = pk2(f[2] * r * g0.z, f[3] * r * g0.w); o.z = pk2(f[4] * r * g1.x, f[5] * r * g1.y); o.w = pk2(f[6] * r * g1.z, f[7] * r * g1.w);
                    *(uint4*)(ckvn + (size_t)(r0g + rw) * 128 + col) = o;
                }
#pragma unroll
                for (int i = 0; i < 2; ++i) {
                    const int id = tid + i * 512, f16 = id & 15, fq2 = (id >> 4) & 3, kk = (id >> 6) & 1, t16 = id >> 7;
                    const uint4 u = *(const uint4*)(stg + (t16 * 16 + f16) * 528 + (128 + kk * 32 + fq2 * 8) * 2);
                    *(uint4*)(kidxf + ((size_t)(((r0g >> 4) + t16) * 2 + kk) * 64 + fq2 * 16 + f16) * 8) = u;
                }
            }
        }
        asm volatile("s_waitcnt lgkmcnt(0)" ::: "memory"); __builtin_amdgcn_s_barrier(); asm volatile("" ::: "memory");
    }
}
__device__ __forceinline__ int vblock() { const int G = gridDim.x, b = blockIdx.x; return ((G & 7) == 0) ? (b & 7) * (G >> 3) + (b >> 3) : b; }

__device__ __forceinline__ void phase1(CParams& p, char* lds, int wv) {
    const int tid = opaque_tid(wv), lane = tid & 63, wid = tid >> 6, wm = wid >> 2, wn = wid & 3;
    unsigned char* ws = p.ws;
    constexpr int I1 = (T / 256) * 6, I2 = (4096 / 128) * 2, I3 = 2 * (4096 / 128);
    {
        int it = vblock();
        g8::Src s;
        if (it < I1) { g8::km_src(s, (const bf16_t*)(ws + WS_XB), T, (it / 6) * 256, (const bf16_t*)(ws + WS_W_IN_T), 1536, (it % 6) * 256, tid); g8::kloop_issue(s, lds, wv); }
        while (it < I1) {
            const int brow = (it / 6) * 256, bcol = (it % 6) * 256;
            f32x4 acc[2][2][4][2]; g8::acc_zero(acc);
            g8::kloop(acc, s, 32, lds, tid, wv);
            it += gridDim.x;
            if (it < I1) { g8::km_src(s, (const bf16_t*)(ws + WS_XB), T, (it / 6) * 256, (const bf16_t*)(ws + WS_W_IN_T), 1536, (it % 6) * 256, tid); g8::kloop_issue(s, lds, wv); }
            g8_store_proj(acc, p, brow, bcol >> 8, lds, tid, wv);
        }
    }
    asm volatile("s_waitcnt vmcnt(0)" ::: "memory");
    __syncthreads();
    for (int it = blockIdx.x; it < I2 + I3; it += gridDim.x) {
        if (it < I2) { const int r = it; gemm_item_bf16<1>((const bf16_t*)(ws + WS_MEMB), 1024, (const bf16_t*)(ws + WS_W_MKV_T), 1024, 16, (bf16_t*)(ws + WS_KMEM), 256, (r / 2) * 128, (r % 2) * 128, lds, tid, lane, wm, wn); }
        else { const int r = it - I2;
            gemm_item_bf16<2>((const bf16_t*)(ws + WS_W_MKV_T) + (size_t)256 * 1024, 1024, (const bf16_t*)(ws + WS_MEMB), 1024, 16, (bf16_t*)(ws + WS_VTMEM), 4096, (r / 32) * 128, (r % 32) * 128, lds, tid, lane, wm, wn); }
    }
}

__device__ __forceinline__ void phase2(CParams& p, int wv) {
    const int tid = opaque_tid(wv), lane = tid & 63, wid = tid >> 6;
    unsigned char* ws = p.ws;
    const bf16_t* proj = (const bf16_t*)(ws + WS_PROJ);
    bf16_t* cqn = (bf16_t*)(ws + WS_CQN); bf16_t* ckvn = (bf16_t*)(ws + WS_CKVN);
    const float* gq = p.in[3]; const float* gkv = p.in[4];
    for (int t = blockIdx.x * 8 + wid; t < T; t += gridDim.x * 8) {
        const bf16_t* row = proj + (size_t)t * NPROJ;
        {
            const uint2 v = *(const uint2*)(row + PC_CQ + lane * 4);
            const float a = bflo(v.x), b = bfhi(v.x), c = bflo(v.y), d = bfhi(v.y);
            const float ss = wave_sum(a * a + b * b + c * c + d * d);
            const float r = rsqrtf(ss * (1.f / 256.f) + RMS_EPS);
            const float4 g = *(const float4*)(gq + lane * 4);
            uint2 o; o.x = pk2(a * r * g.x, b * r * g.y); o.y = pk2(c * r * g.z, d * r * g.w);
            *(uint2*)(cqn + km_off(t, lane * 4, T)) = o;
        }
        {
            const uint32_t v = *(const uint32_t*)(row + PC_CKV + lane * 2);
            const float a = bflo(v), b = bfhi(v);
            const float ss = wave_sum(a * a + b * b);
            const float r = rsqrtf(ss * (1.f / 128.f) + RMS_EPS);
            const float2 g = *(const float2*)(gkv + lane * 2);
            *(uint32_t*)(ckvn + (size_t)t * 128 + lane * 2) = pk2(a * r * g.x, b * r * g.y);
        }
        if (lane < 32) {
            const int dd = lane * 2;
            const size_t off = ((size_t)((t >> 4) * 2 + (dd >> 5)) * 64 + ((dd & 31) >> 3) * 16 + (t & 15)) * 8 + (dd & 7);
            *(uint32_t*)((bf16_t*)(ws + WS_KIDX) + off) = *(const uint32_t*)(row + PC_KIDX + dd);
        }
    }
}

__device__ __forceinline__ void phase3(CParams& p, char* lds, int wv) {
    const int tid = opaque_tid(wv);
    unsigned char* ws = p.ws;
    constexpr int I1 = (T / 256) * 6;
    int it = vblock();
    g8::Src s;
    if (it < I1) { g8::km_src(s, (const bf16_t*)(ws + WS_CQN), T, (it / 6) * 256, (const bf16_t*)(ws + WS_W_Q2_T), 1536, (it % 6) * 256, tid); g8::kloop_issue(s, lds, wv); }
    while (it < I1) {
        const int brow = (it / 6) * 256, bcol = (it % 6) * 256;
        f32x4 acc[2][2][4][2]; g8::acc_zero(acc);
        g8::kloop(acc, s, 8, lds, tid, wv);
        it += gridDim.x;
        if (it < I1) { g8::km_src(s, (const bf16_t*)(ws + WS_CQN), T, (it / 6) * 256, (const bf16_t*)(ws + WS_W_Q2_T), 1536, (it % 6) * 256, tid); g8::kloop_issue(s, lds, wv); }
        g8_store_tile<false>(acc, (bf16_t*)(ws + WS_Q2), 1536, brow, bcol, nullptr, lds, tid, wv);
    }
}

typedef short s16x4 __attribute__((ext_vector_type(4)));
__device__ __forceinline__ int t5_bucket(int n) {
    if (n < 16) return n;
    if (n >= 128) return 31;
    const int l = 16 + (int)(__log2f((float)n * 0.0625f) * (16.0f / 3.0f));
    return l < 31 ? l : 31;
}
__device__ __forceinline__ bf16x8 ld_frag(const bf16_t* p) { return *(const bf16x8*)p; }
__device__ __forceinline__ bf16x8 u4_as_frag(const uint4& v) { union { uint4 u; bf16x8 f; } c; c.u = v; return c.f; }

constexpr int SK_STRIDE = 2052;
constexpr int P4_SEL = 16 * SK_STRIDE * 4;
constexpr int P4_RB = P4_SEL + 16 * 256 * 2;
constexpr int P4_SELB = P4_RB + 1024;

constexpr int P4_CSCR = P4_SELB + 4096;
constexpr int P4_HIST = P4_CSCR + 2048;
template <int NREG>
__device__ __forceinline__ void select_query(const uint32_t* skrow, unsigned short* sel, unsigned char* selb, uint32_t* cscr, uint32_t* hist, int t, int lane) {
    const unsigned long long ltmask = (1ull << lane) - 1ull;
    uint32_t key[NREG];
#pragma unroll
    for (int i = 0; i < NREG; ++i) { const int s = i * 64 + lane; const uint32_t kv = skrow[s]; key[i] = (s <= t) ? kv : 0u; }
    uint32_t prefix = 0; bool exact = false;
    int nS = 0, nU = t + 1, bit = 31;
    {
        const uint32_t cand = 0x80000000u;
        int cnt = 0;
#pragma unroll
        for (int i = 0; i < NREG; ++i) cnt += __popcll(__ballot(key[i] >= cand));
        if (cnt >= 256) { prefix = cand; nU = cnt; exact = (cnt == 256); } else { nU -= cnt; nS = cnt; }
        bit = 30;
        if (!exact && nU > 64) {
            uint32_t a = 0xFFFFFFFFu, o = 0u;
#pragma unroll
            for (int i = 0; i < NREG; ++i) { const bool inU = ((key[i] ^ prefix) >> 31) == 0u && key[i] != 0u; a &= inU ? key[i] : 0xFFFFFFFFu; o |= inU ? key[i] : 0u; }
#pragma unroll
            for (int d = 1; d < 64; d <<= 1) { a &= (uint32_t)__shfl_xor((int)a, d); o |= (uint32_t)__shfl_xor((int)o, d); }
            const uint32_t diff = (a ^ o) & 0x7FFFFFFFu;
            if (diff == 0u) { prefix = a; bit = -1; }
            else {
                const int top = 31 - __clz(diff);
                const uint32_t keep = (top >= 30) ? 0u : (0x7FFFFFFFu & ~((2u << top) - 1u));
                prefix |= a & keep;
                const int nb = (top + 1 < 8) ? top + 1 : 8, shift = top + 1 - nb;
                *(uint4*)(hist + lane * 4) = make_uint4(0u, 0u, 0u, 0u);
                wave_sync();
#pragma unroll
                for (int i = 0; i < NREG; ++i) {
                    const bool inU = ((key[i] ^ prefix) >> (top + 1)) == 0u && key[i] != 0u;
                    if (inU) atomicAdd(&hist[(key[i] >> shift) & 255u], 1u);
                }
                wave_sync();
                const uint4 h4 = *(const uint4*)(hist + lane * 4);
                int suf = (int)(h4.x + h4.y + h4.z + h4.w);
#pragma unroll
                for (int d = 1; d < 64; d <<= 1) { const int v = __shfl_down(suf, d); if (lane + d < 64) suf += v; }
                const int need = 256 - nS;
                const int L = __popcll(__ballot(suf >= need)) - 1;
                const int above = (L < 63) ? __builtin_amdgcn_readlane(suf, (L + 1) & 63) : 0;
                const int hb[4] = {__builtin_amdgcn_readlane((int)h4.x, L), __builtin_amdgcn_readlane((int)h4.y, L), __builtin_amdgcn_readlane((int)h4.z, L), __builtin_amdgcn_readlane((int)h4.w, L)};
                int c = above, dig = 4 * L, inbin = 0, aboved = above;
                bool found = false;
#pragma unroll
                for (int j = 3; j >= 0; --j) { if (!found) { const int c2 = c + hb[j]; if (c2 >= need) { dig = 4 * L + j; inbin = hb[j]; aboved = c; found = true; } c = c2; } }
                prefix |= (uint32_t)dig << shift;
                nS += aboved; nU = inbin;
                exact = (nS + nU == 256);
                bit = shift - 1;
            }
        }
    }
    for (; !exact && bit >= 0 && nU > 64; --bit) {
        const uint32_t cand = prefix | (1u << bit);
        int cnt = 0;
#pragma unroll
        for (int i = 0; i < NREG; ++i) cnt += __popcll(__ballot(key[i] >= cand));
        if (cnt >= 256) { prefix = cand; nU = cnt - nS; if (cnt == 256) { exact = true; break; } }
        else { nU -= cnt - nS; nS = cnt; }
    }
    int quota = 0; bool have_quota = false;
    if (!exact && bit >= 0) {
        const int sh = bit + 1;
        int pos = 0;
        wave_sync();
#pragma unroll
        for (int i = 0; i < NREG; ++i) {
            const bool inU = (key[i] >> sh) == (prefix >> sh) && key[i] != 0u;
            const unsigned long long bu = __ballot(inU);
            if (inU) { const int d = pos + __popcll(bu & ltmask); if (d < 64) cscr[d] = key[i]; }
            pos += __popcll(bu);
        }
        wave_sync();
        const uint32_t u = (lane < pos) ? cscr[lane] : 0u;
        for (; bit >= 0; --bit) {
            const uint32_t cand = prefix | (1u << bit);
            const int cnt = nS + __popcll(__ballot(u >= cand));
            if (cnt >= 256) { prefix = cand; if (cnt == 256) { exact = true; break; } }
        }
        if (!exact) {
            if (nS + __popcll(__ballot(u >= prefix)) == 256) exact = true;
            else { quota = 256 - (nS + __popcll(__ballot(u > prefix))); have_quota = true; }
        }
    }
    if (!exact && !have_quota) {
        int cgt = 0;
#pragma unroll
        for (int i = 0; i < NREG; ++i) cgt += __popcll(__ballot(key[i] > prefix));
        quota = 256 - cgt;
    }
    int pos = 0, eqc = 0;
#pragma unroll
    for (int i = 0; i < NREG; ++i) {
        const uint32_t u = key[i];
        bool take;
        if (exact) take = (u >= prefix);
        else {
            const bool eq = (u == prefix);
            const unsigned long long beq = __ballot(eq);
            const int myeq = eqc + __popcll(beq & ltmask);
            take = (u > prefix) || (eq && myeq < quota);
            eqc += __popcll(beq);
        }
        const unsigned long long bt = __ballot(take);
        if (take) {
            const int dst = pos + __popcll(bt & ltmask); sel[dst] = (unsigned short)(i * 64 + lane);
            if (t - (i * 64 + 63) >= 128) selb[dst] = (unsigned char)31;
            else selb[dst] = (unsigned char)t5_bucket(t - (i * 64 + lane));
        }
        pos += __popcll(bt);
    }
}

__device__ __forceinline__ void dsa_item(CParams& p, int b, int t0, char* lds, int tid_in, int wv) {
    const int tid = opaque_i(tid_in);
    const int lane = tid & 63, wid = tid >> 6, fr = lane & 15, fq = lane >> 4;
    unsigned char* ws = p.ws;
    uint32_t* SK = (uint32_t*)lds;
    unsigned short* SEL = (unsigned short*)(lds + P4_SEL);
    const float* RB = (const float*)(lds + P4_RB);
    unsigned char* SELB = (unsigned char*)(lds + P4_SELB);
    const bf16_t* q2 = (const bf16_t*)(ws + WS_Q2) + ((size_t)b * SEQ + t0) * 1536;
    const bf16_t* kidx = (const bf16_t*)(ws + WS_KIDX) + (size_t)b * SEQ * 64;
    const bf16_t* ckvn = (const bf16_t*)(ws + WS_CKVN) + (size_t)b * SEQ * 128;
    __syncthreads();
    if (t0 >= 256) {
        bf16x8 qf[8][2];
#pragma unroll
        for (int h = 0; h < 8; ++h)
#pragma unroll
            for (int kk = 0; kk < 2; ++kk) qf[h][kk] = ld_frag(q2 + (size_t)fr * 1536 + 1024 + h * 64 + kk * 32 + fq * 8);
        float wv[8];
        { const uint4 v = *(const uint4*)((const bf16_t*)(ws + WS_PROJ) + ((size_t)b * SEQ + t0 + fr) * NPROJ + PC_IDXW); unpack8(v, wv); }
#pragma unroll
        for (int i = 0; i < 8; ++i) wv[i] *= IDXW_SCALE;
        const int ntile = (t0 + 16) >> 4;
        const int tq = t0 + fr;
        bf16x8 kn0 = ld_frag(kidx + (size_t)(wid * 2) * 512 + lane * 8), kn1 = ld_frag(kidx + (size_t)(wid * 2 + 1) * 512 + lane * 8);
        for (int kt = wid; kt < ntile; kt += 8) {
            const int key0 = kt * 16;
            const bf16x8 kf0 = kn0, kf1 = kn1;
            { const int kx = (kt + 8 < ntile) ? kt + 8 : kt;
              kn0 = ld_frag(kidx + (size_t)(kx * 2) * 512 + lane * 8); kn1 = ld_frag(kidx + (size_t)(kx * 2 + 1) * 512 + lane * 8); }
            float sacc[4] = {0.f, 0.f, 0.f, 0.f};
#pragma unroll
            for (int h = 0; h < 8; ++h) {
                f32x4 d = (f32x4){0.f, 0.f, 0.f, 0.f};
                d = __builtin_amdgcn_mfma_f32_16x16x32_bf16(kf0, qf[h][0], d, 0, 0, 0);
                d = __builtin_amdgcn_mfma_f32_16x16x32_bf16(kf1, qf[h][1], d, 0, 0, 0);
#pragma unroll
                for (int r = 0; r < 4; ++r) sacc[r] = fmaf(wv[h], fmaxf(d[r], 0.f), sacc[r]);
            }
            uint4 ko;
            uint32_t kk4[4];
#pragma unroll
            for (int r = 0; r < 4; ++r) {
                const int s = key0 + 4 * fq + r;
                float sc = sacc[r]; if (sc == 0.f) sc = 0.f;
                const uint32_t u = __float_as_uint(sc);
                const uint32_t key = (u & 0x80000000u) ? ~u : (u | 0x80000000u);
                kk4[r] = (s <= tq) ? key : 0u;
            }
            ko.x = kk4[0]; ko.y = kk4[1]; ko.z = kk4[2]; ko.w = kk4[3];
            *(uint4*)(SK + fr * SK_STRIDE + key0 + 4 * fq) = ko;
        }
        __syncthreads();
#pragma nounroll
        for (int qq = 0; qq < 2; ++qq) {
            const int q = wid * 2 + qq, t = t0 + q;
            uint32_t* cscr = (uint32_t*)(lds + P4_CSCR) + wid * 64;
#define DSA_SEL(N) select_query<N>(SK + q * SK_STRIDE, SEL + q * 256, SELB + q * 256, cscr, (uint32_t*)(lds + P4_HIST) + wid * 256, t, lane)
            switch (__builtin_amdgcn_readfirstlane(t0 >> 8)) {
                case 1: DSA_SEL(8); break;
                case 2: DSA_SEL(12); break;
                case 3: DSA_SEL(16); break;
                case 4: DSA_SEL(20); break;
                case 5: DSA_SEL(24); break;
                case 6: DSA_SEL(28); break;
                default: DSA_SEL(32); break;
            }
#undef DSA_SEL
        }
    } else {
        for (int qq = 0; qq < 2; ++qq) {
            const int q = wid * 2 + qq, t = t0 + q;
            for (int k = lane; k <= t; k += 64) { SEL[q * 256 + k] = (unsigned short)k; SELB[q * 256 + k] = (unsigned char)t5_bucket(t - k); }
        }
    }
    __syncthreads();
    char* vst = lds + wv * 16384;
    bf16_t* cat = (bf16_t*)(ws + WS_CAT2);
    const __amdgpu_buffer_rsrc_t rkv = g8::make_rsrc(ckvn);
#pragma nounroll
    for (int qq = 0; qq < 2; ++qq) {
        const int q = wid * 2 + qq, t = t0 + q;
        const int nsel = (t + 1 < 256) ? t + 1 : 256;
        const size_t tok = (size_t)b * SEQ + t;
        const unsigned short* selq = SEL + q * 256;
        bf16x8 qf[4];
#pragma unroll
        for (int kk = 0; kk < 4; ++kk) {
            uint4 v = make_uint4(0, 0, 0, 0);
            if (fr < 8) v = *(const uint4*)(q2 + (size_t)q * 1536 + fr * 128 + kk * 32 + fq * 8);
            qf[kk] = u4_as_frag(v);
        }
        asm volatile("" :: "v"(qf[0]), "v"(qf[1]), "v"(qf[2]), "v"(qf[3]));
        float m = -INFINITY, l = 0.f;
        f32x4 O[8];
#pragma unroll
        for (int ct = 0; ct < 8; ++ct) O[ct] = (f32x4){0.f, 0.f, 0.f, 0.f};
        const int nck = (nsel + 31) >> 5;
#define DSA_ISSUE(c) do { int sv_[8]; \
            _Pragma("unroll") for (int pc = 0; pc < 8; ++pc) sv_[pc] = (int)selq[(c) * 32 + pc * 4 + fq];     \
            _Pragma("unroll") for (int pc = 0; pc < 8; ++pc) { \
            const int row_ = pc * 4 + fq; const int k_ = (c) * 32 + row_; \
            const int s_ = (k_ < nsel) ? sv_[pc] : 0; \
            __builtin_amdgcn_raw_ptr_buffer_load_lds(rkv, (LAS void*)(vst + ((c) & 1) * 8192 + pc * 1024), 16, (unsigned)(s_ * 256 + ((fr ^ (row_ & 15)) << 4)), 0, 0, 0); } } while (0)
        DSA_ISSUE(0);
#pragma nounroll
        for (int ck = 0; ck < nck; ++ck) {
            if (ck + 1 < nck) { DSA_ISSUE(ck + 1); asm volatile("s_waitcnt vmcnt(8)" ::: "memory"); }
            else asm volatile("s_waitcnt vmcnt(0)" ::: "memory");
            const char* buf = vst + (ck & 1) * 8192;
            bf16x8 a0[4], a1[4];
#pragma unroll
            for (int kk = 0; kk < 4; ++kk) {
                const int ch = ((kk * 4 + fq) ^ fr) << 4;
                a0[kk] = *(const bf16x8*)(buf + fr * 256 + ch);
                a1[kk] = *(const bf16x8*)(buf + (16 + fr) * 256 + ch);
            }
            f32x4 d0 = (f32x4){0.f, 0.f, 0.f, 0.f}, d1 = (f32x4){0.f, 0.f, 0.f, 0.f};
#pragma unroll
            for (int kk = 0; kk < 4; ++kk) {
                d0 = __builtin_amdgcn_mfma_f32_16x16x32_bf16(a0[kk], qf[kk], d0, 0, 0, 0);
                d1 = __builtin_amdgcn_mfma_f32_16x16x32_bf16(a1[kk], qf[kk], d1, 0, 0, 0);
            }
            float lg0[4], lg1[4];
            {
                const int kb = ck * 32 + 4 * fq;
                const uint32_t bw0 = *(const uint32_t*)(SELB + q * 256 + kb), bw1 = *(const uint32_t*)(SELB + q * 256 + kb + 16);
#pragma unroll
                for (int r = 0; r < 4; ++r) {
                    const bool v0 = (kb + r) < nsel, v1 = (kb + 16 + r) < nsel;
                    const int b0 = (int)((bw0 >> (8 * r)) & 31u), b1 = (int)((bw1 >> (8 * r)) & 31u);
                    const float rb0 = RB[b0 * 8 + (fr & 7)], rb1 = RB[b1 * 8 + (fr & 7)];
                    lg0[r] = (d0[r] + rb0) + (v0 ? 0.f : -INFINITY);
                    lg1[r] = (d1[r] + rb1) + (v1 ? 0.f : -INFINITY);
                }
            }
            float cm = fmaxf(fmaxf(fmaxf(lg0[0], lg0[1]), fmaxf(lg0[2], lg0[3])), fmaxf(fmaxf(lg1[0], lg1[1]), fmaxf(lg1[2], lg1[3])));
            cm = xrow16_max(cm);
            const float mn = fmaxf(m, cm);
            const float scl = __builtin_amdgcn_exp2f(m - mn);
            float p0[4], p1[4], ls = 0.f;
#pragma unroll
            for (int r = 0; r < 4; ++r) { p0[r] = __builtin_amdgcn_exp2f(lg0[r] - mn); p1[r] = __builtin_amdgcn_exp2f(lg1[r] - mn); ls += p0[r] + p1[r]; }
            ls = xrow16_sum(ls);
            l = l * scl + ls; m = mn;
            if (__any(scl != 1.f)) {
#pragma unroll
                for (int ct = 0; ct < 8; ++ct) O[ct] = O[ct] * scl;
            }
            uint4 pf; pf.x = pk2(p0[0], p0[1]); pf.y = pk2(p0[2], p0[3]); pf.z = pk2(p1[0], p1[1]); pf.w = pk2(p1[2], p1[3]);
            const bf16x8 pfrag = u4_as_frag(pf);
#pragma unroll
            for (int ct = 0; ct < 8; ++ct) {
                const int r0 = 4 * fq + (fr >> 2), r1 = r0 + 16;
                const int chn = ct * 2 + ((fr & 3) >> 1), sub = 8 * (fr & 1);
                const s16x4 va = __builtin_amdgcn_ds_read_tr16_b64_v4i16((s16x4 LAS*)(buf + r0 * 256 + ((chn ^ (r0 & 15)) << 4) + sub));
                const s16x4 vb = __builtin_amdgcn_ds_read_tr16_b64_v4i16((s16x4 LAS*)(buf + r1 * 256 + ((chn ^ (r1 & 15)) << 4) + sub));
                bf16x8 vf; vf[0] = va[0]; vf[1] = va[1]; vf[2] = va[2]; vf[3] = va[3]; vf[4] = vb[0]; vf[5] = vb[1]; vf[6] = vb[2]; vf[7] = vb[3];
                O[ct] = __builtin_amdgcn_mfma_f32_16x16x32_bf16(vf, pfrag, O[ct], 0, 0, 0);
            }
            asm volatile("" ::: "memory");
        }
#undef DSA_ISSUE
        const float inv = 1.f / l;
        if (fr < 8) {
#pragma unroll
            for (int ct = 0; ct < 8; ++ct) {
                uint2 o; o.x = pk2(O[ct][0] * inv, O[ct][1] * inv); o.y = pk2(O[ct][2] * inv, O[ct][3] * inv);
                *(uint2*)(cat + km_off((int)tok, fr * 128 + ct * 16 + 4 * fq, T)) = o;
            }
        }
        asm volatile("s_waitcnt vmcnt(0)" ::: "memory");
    }
}

#define MA_SB() __builtin_amdgcn_sched_barrier(0)
__device__ __forceinline__ void memattn_wave(CParams& p, int b, size_t tok0, int h, int lane) {
    const int fr = lane & 15, fq = lane >> 4;
    unsigned char* ws = p.ws;
    const bf16_t* proj = (const bf16_t*)(ws + WS_PROJ) + (tok0 + fr) * NPROJ + PC_QM + h * 64;
    const bf16_t* km = (const bf16_t*)(ws + WS_KMEM) + (size_t)(b * 4 + h) * (16 * 2 * 64 * 8) + lane * 8;
    const bf16_t* vt = (const bf16_t*)(ws + WS_VTMEM) + (size_t)(b * 4 + h) * (8 * 4 * 64 * 8) + lane * 8;
    const bf16x8 qf0 = ld_frag(proj + fq * 8), qf1 = ld_frag(proj + 32 + fq * 8);
    f32x4 d[16];
    bf16x8 kb[2][8];
#pragma unroll
    for (int j = 0; j < 4; ++j) { kb[0][2 * j] = ld_frag(km + (j * 2) * 512); kb[0][2 * j + 1] = ld_frag(km + (j * 2 + 1) * 512); }
    MA_SB();
#pragma unroll
    for (int g = 0; g < 4; ++g) {
        if (g < 3) {
#pragma unroll
            for (int j = 0; j < 4; ++j) { kb[(g + 1) & 1][2 * j] = ld_frag(km + ((g * 4 + 4 + j) * 2) * 512); kb[(g + 1) & 1][2 * j + 1] = ld_frag(km + ((g * 4 + 4 + j) * 2 + 1) * 512); }
        }
        MA_SB();
#pragma unroll
        for (int j = 0; j < 4; ++j) {
            f32x4 z = (f32x4){0.f, 0.f, 0.f, 0.f};
            z = __builtin_amdgcn_mfma_f32_16x16x32_bf16(kb[g & 1][2 * j], qf0, z, 0, 0, 0);
            z = __builtin_amdgcn_mfma_f32_16x16x32_bf16(kb[g & 1][2 * j + 1], qf1, z, 0, 0, 0);
            d[g * 4 + j] = z * (0.125f * 1.4426950408889634f);
        }
        MA_SB();
    }
    bf16x8 vb[2][8];
#pragma unroll
    for (int i = 0; i < 8; ++i) vb[0][i] = ld_frag(vt + i * 512);
    MA_SB();
    float mx = -INFINITY;
#pragma unroll
    for (int kt = 0; kt < 16; ++kt) mx = fmaxf(mx, fmaxf(fmaxf(d[kt][0], d[kt][1]), fmaxf(d[kt][2], d[kt][3])));
    mx = xrow16_max(mx);
    float s = 0.f;
#pragma unroll
    for (int kt = 0; kt < 16; ++kt)
#pragma unroll
        for (int r = 0; r < 4; ++r) { d[kt][r] = __builtin_amdgcn_exp2f(d[kt][r] - mx); s += d[kt][r]; }
    s = xrow16_sum(s);
    const float inv = 1.f / s;
    f32x4 O[4];
#pragma unroll
    for (int dt = 0; dt < 4; ++dt) O[dt] = (f32x4){0.f, 0.f, 0.f, 0.f};
    MA_SB();
#pragma unroll
    for (int g = 0; g < 4; ++g) {
        if (g < 3) {
#pragma unroll
            for (int i = 0; i < 8; ++i) vb[(g + 1) & 1][i] = ld_frag(vt + ((g + 1) * 8 + i) * 512);
        }
        MA_SB();
#pragma unroll
        for (int cc = 0; cc < 2; ++cc) {
            const int c32 = g * 2 + cc;
            uint4 pf; pf.x = pk2(d[2 * c32][0], d[2 * c32][1]); pf.y = pk2(d[2 * c32][2], d[2 * c32][3]); pf.z = pk2(d[2 * c32 + 1][0], d[2 * c32 + 1][1]); pf.w = pk2(d[2 * c32 + 1][2], d[2 * c32 + 1][3]);
            const bf16x8 pfrag = u4_as_frag(pf);
#pragma unroll
            for (int dt = 0; dt < 4; ++dt) O[dt] = __builtin_amdgcn_mfma_f32_16x16x32_bf16(vb[g & 1][cc * 4 + dt], pfrag, O[dt], 0, 0, 0);
        }
        MA_SB();
    }
    bf16_t* cat = (bf16_t*)(ws + WS_CAT2);
#pragma unroll
    for (int dt = 0; dt < 4; ++dt) {
        uint2 o; o.x = pk2(O[dt][0] * inv, O[dt][1] * inv); o.y = pk2(O[dt][2] * inv, O[dt][3] * inv);
        *(uint2*)(cat + km_off((int)tok0 + fr, 1280 + h * 64 + dt * 16 + 4 * fq, T)) = o;
    }
}

__device__ __forceinline__ void conv_tokens4(CParams& p, int b, int t0, int lane) {
    unsigned char* ws = p.ws;
    const bf16_t* proj = (const bf16_t*)(ws + WS_PROJ) + (size_t)b * SEQ * NPROJ;
    const float* cw = p.in[10];
    const int c = lane * 4;
    uint2 gc[6], hh[6], gb[4];
#pragma unroll
    for (int i = 0; i < 6; ++i) {
        const int tt = t0 - 2 + i, tc = tt < 0 ? 0 : tt;
        gc[i] = *(const uint2*)(proj + (size_t)tc * NPROJ + PC_GC + c); hh[i] = *(const uint2*)(proj + (size_t)tc * NPROJ + PC_H + c);
    }
#pragma unroll
    for (int i = 0; i < 4; ++i) gb[i] = *(const uint2*)(proj + (size_t)(t0 + i) * NPROJ + PC_GB + c);
    const float4 w0 = *(const float4*)(cw + c), w1 = *(const float4*)(cw + 256 + c), w2 = *(const float4*)(cw + 512 + c);
    float u[6][4];
#pragma unroll
    for (int i = 0; i < 6; ++i) {
        const float z = (t0 - 2 + i < 0) ? 0.f : 1.f;
        u[i][0] = bflo(gc[i].x) * bflo(hh[i].x) * z; u[i][1] = bfhi(gc[i].x) * bfhi(hh[i].x) * z;
        u[i][2] = bflo(gc[i].y) * bflo(hh[i].y) * z; u[i][3] = bfhi(gc[i].y) * bfhi(hh[i].y) * z;
    }
    bf16_t* cat = (bf16_t*)(ws + WS_CAT2);
#pragma unroll
    for (int i = 0; i < 4; ++i) {
        const float y0 = fmaf(w0.x, u[i][0], fmaf(w1.x, u[i + 1][0], w2.x * u[i + 2][0]));
        const float y1 = fmaf(w0.y, u[i][1], fmaf(w1.y, u[i + 1][1], w2.y * u[i + 2][1]));
        const float y2 = fmaf(w0.z, u[i][2], fmaf(w1.z, u[i + 1][2], w2.z * u[i + 2][2]));
        const float y3 = fmaf(w0.w, u[i][3], fmaf(w1.w, u[i + 1][3], w2.w * u[i + 2][3]));
        uint2 o; o.x = pk2(bflo(gb[i].x) * y0, bfhi(gb[i].x) * y1); o.y = pk2(bflo(gb[i].y) * y2, bfhi(gb[i].y) * y3);
        *(uint2*)(cat + km_off(b * SEQ + t0 + i, 1024 + c, T)) = o;
    }
}

__device__ __forceinline__ void phase4(CParams& p, char* lds, int wv) {
    const int tid = opaque_tid(wv), lane = tid & 63, wid = tid >> 6;
    if (tid < 256) ((float*)(lds + P4_RB))[tid] = p.in[9][tid] * 1.4426950408889634f;
    const int gw = blockIdx.x * 8 + wid, NW = gridDim.x * 8;
    const int ndsa = (T / 16 - (int)blockIdx.x + (int)gridDim.x - 1) / (int)gridDim.x;
    const int new_ = (EW_ITEMS - gw + NW - 1) / NW;
    const int per = (new_ + ndsa - 1) / (ndsa > 0 ? ndsa : 1);
    int ew = gw;
    for (int i = blockIdx.x; i < T / 16; i += gridDim.x) {
        const int b = i >> 7, tau = i & 127, tile = ((b >> 1) & 1) ? 127 - tau : tau;
        dsa_item(p, b, tile * 16, lds, tid, wv);
        for (int j = 0; j < per && ew < EW_ITEMS; ++j, ew += NW) expert_w_item(p, ew, (float*)(lds + wv * 16384), opaque_i(lane));
    }
    for (; ew < EW_ITEMS; ew += NW) expert_w_item(p, ew, (float*)(lds + wv * 16384), opaque_i(lane));
    for (int i = blockIdx.x; i < T / 32; i += gridDim.x) {
        const int b = i >> 6, t0 = (i & 63) * 32 + (wid >> 2) * 16;
        memattn_wave(p, b, (size_t)b * SEQ + t0, wid & 3, opaque_i(lane));
        conv_tokens4(p, b, t0 + (wid & 3) * 4, opaque_i(lane));
    }
}

#define XB_TMO      128
#define XB_XCNT(j)  (256  + 64 * (j))
#define XB_XSUB(j)  (1280 + 64 * (j))
#define XB_XGEN(j)  (2304 + 64 * (j))
#define XB_TOP      3328
#define XB_TOPGEN   3392
#define XCD_BAR_WORDS 3456
#define XB_SPIN_CAP (1u << 22)
__device__ __forceinline__ unsigned xb_ld(unsigned* p)              { return __hip_atomic_load(p, __ATOMIC_RELAXED, __HIP_MEMORY_SCOPE_AGENT); }
__device__ __forceinline__ unsigned xb_add(unsigned* p, unsigned v) { return __hip_atomic_fetch_add(p, v, __ATOMIC_RELAXED, __HIP_MEMORY_SCOPE_AGENT); }
__device__ __forceinline__ unsigned xb_xcc_id() { return (unsigned)__builtin_amdgcn_s_getreg((3 << 11) | 20) & 0xFu; }
#define XB_SPIN(cond, bar) do { unsigned _sp = 0; while (cond) { __builtin_amdgcn_s_sleep(1); \
    if ((++_sp & 255u) == 0u) { if (xb_ld(&(bar)[XB_TMO])) break; if (_sp > XB_SPIN_CAP) { atomicAdd(&(bar)[XB_TMO], 1u); break; } } } } while (0)
__device__ __forceinline__ void phase5(CParams& p, char* lds, int wv) {
    const int tid = opaque_tid(wv);
    unsigned char* ws = p.ws;
    const float* x = p.in[0];
    constexpr int I1 = (T / 256) * 4;
    unsigned* bar = (unsigned*)(ws + WS_BAR);
    unsigned long long* lnst = (unsigned long long*)(ws + WS_LNST);
    bf16_t* x1h = (bf16_t*)(ws + WS_X1H); bf16_t* x1l = (bf16_t*)(ws + WS_X1L);
    for (int it = vblock(); it < I1; it += gridDim.x) {
        const int pm = it >> 2, pn = it & 3;
        const int brow = pm * 256, bcol = pn * 256;
        g8::Src s; g8::km_src(s, (const bf16_t*)(ws + WS_CAT2), T, brow, (const bf16_t*)(ws + WS_W_OUT2_T), 1024, bcol, tid);
        g8::kloop_issue(s, lds, wv);
        f32x4 acc[2][2][4][2]; g8::acc_zero(acc);
        g8::kloop(acc, s, 48, lds, tid, wv);
        const int te = opaque_i(tid), lane = te & 63, wr = wv >> 2, wc = wv & 3, fr = lane & 15, fq = lane >> 4;
        char* stg = lds + LDS_STG;
        float2* PS = (float2*)(stg + 32 * 1040);
        float2* SR = PS + 256;
        f32x4 vr[2][4][4];
        float4 xn[4];
#pragma unroll
        for (int i = 0; i < 4; ++i) { const int lr = wv + 8 * i; xn[i] = ldnt4(x + (size_t)(brow + (lr >> 4) * 64 + (lr & 15)) * 1024 + bcol + lane * 4); }
#pragma unroll
        for (int ai = 0; ai < 2; ++ai)
#pragma unroll
            for (int m = 0; m < 4; ++m) {
                char* rp = stg + (wr * 16 + fr) * 1040 + (wc * 32 + 4 * fq) * 4;
#pragma unroll
                for (int bj = 0; bj < 2; ++bj)
#pragma unroll
                    for (int n = 0; n < 2; ++n) *(f32x4*)(rp + (bj * 128 + n * 16) * 4) = acc[ai][bj][m][n];
                asm volatile("s_waitcnt lgkmcnt(0)" ::: "memory"); __builtin_amdgcn_s_barrier(); asm volatile("" ::: "memory");
                float4 xc[4];
#pragma unroll
                for (int i = 0; i < 4; ++i) xc[i] = xn[i];
                if (ai * 4 + m < 7) {
                    const int ai2 = (ai * 4 + m + 1) >> 2, m2 = (ai * 4 + m + 1) & 3;
#pragma unroll
                    for (int i = 0; i < 4; ++i) { const int lr = wv + 8 * i; xn[i] = ldnt4(x + (size_t)(brow + ai2 * 128 + (lr >> 4) * 64 + m2 * 16 + (lr & 15)) * 1024 + bcol + lane * 4); }
                }
#pragma unroll
                for (int i = 0; i < 4; ++i) {
                    const int lr = wv + 8 * i;
                    const f32x4 a = *(const f32x4*)(stg + lr * 1040 + lane * 16);
                    f32x4 o; o[0] = fmaf(ALPHA, xc[i].x, a[0]); o[1] = fmaf(ALPHA, xc[i].y, a[1]); o[2] = fmaf(ALPHA, xc[i].z, a[2]); o[3] = fmaf(ALPHA, xc[i].w, a[3]);
                    vr[ai][m][i] = o;
                    const float s1 = wave_sum((o[0] + o[1]) + (o[2] + o[3]));
                    const float s2 = wave_sum((o[0] * o[0] + o[1] * o[1]) + (o[2] * o[2] + o[3] * o[3]));
                    if (lane == 0) PS[ai * 128 + (lr >> 4) * 64 + m * 16 + (lr & 15)] = make_float2(s1, s2);
                }
                asm volatile("s_waitcnt lgkmcnt(0)" ::: "memory"); __builtin_amdgcn_s_barrier(); asm volatile("" ::: "memory");
            }
        if (wv < 4) {
            const float2 ps = PS[te];
            __hip_atomic_store(lnst + (size_t)(pm * 4 + pn) * 256 + te, ((unsigned long long)__float_as_uint(ps.y) << 32) | __float_as_uint(ps.x), __ATOMIC_RELAXED, __HIP_MEMORY_SCOPE_AGENT);
            asm volatile("s_waitcnt vmcnt(0)" ::: "memory");
            if (lane == 0) (void)xb_add(&bar[XCD_BAR_WORDS + 4 * pm], 1u);
            if (wv == 0) {
                XB_SPIN(xb_ld(&bar[XCD_BAR_WORDS + 4 * pm]) < 16u, bar);
                __builtin_amdgcn_fence(__ATOMIC_ACQUIRE, "agent");
            }
        }
        asm volatile("s_waitcnt vmcnt(0) lgkmcnt(0)" ::: "memory"); __builtin_amdgcn_s_barrier(); asm volatile("" ::: "memory");
        if (wv < 4) {
            float s1 = 0.f, s2 = 0.f;
#pragma unroll
            for (int t4 = 0; t4 < 4; ++t4) {
                const unsigned long long w = __hip_atomic_load(lnst + (size_t)(pm * 4 + t4) * 256 + te, __ATOMIC_RELAXED, __HIP_MEMORY_SCOPE_AGENT);
                s1 += __uint_as_float((unsigned)w); s2 += __uint_as_float((unsigned)(w >> 32));
            }
            const float mean = s1 * (1.f / 1024.f);
            const float var = fmaxf(s2 * (1.f / 1024.f) - mean * mean, 0.f);
            SR[te] = make_float2(mean, rsqrtf(var + LN_EPS));
        }
        asm volatile("s_waitcnt lgkmcnt(0)" ::: "memory"); __builtin_amdgcn_s_barrier(); asm volatile("" ::: "memory");
        {
            const float4 gg = *(const float4*)(p.in[14] + bcol + lane * 4), be = *(const float4*)(p.in[15] + bcol + lane * 4);
#pragma unroll
            for (int ai = 0; ai < 2; ++ai)
#pragma unroll
                for (int m = 0; m < 4; ++m)
#pragma unroll
                    for (int i = 0; i < 4; ++i) {
                        const int lr = wv + 8 * i, trow = ai * 128 + (lr >> 4) * 64 + m * 16 + (lr & 15);
                        const float2 sr = SR[trow];
                        const size_t go = (size_t)(brow + trow) * 1024 + bcol + lane * 4;
                        const f32x4 a = vr[ai][m][i];
                        float4 o; o.x = (a[0] - sr.x) * sr.y * gg.x + be.x; o.y = (a[1] - sr.x) * sr.y * gg.y + be.y; o.z = (a[2] - sr.x) * sr.y * gg.z + be.z; o.w = (a[3] - sr.x) * sr.y * gg.w + be.w;
                        stnt4(p.out + go, o);
                        uint2 hi; hi.x = pk2(o.x, o.y); hi.y = pk2(o.z, o.w);
                        uint2 lo; lo.x = pk2(o.x - bflo(hi.x), o.y - bfhi(hi.x)); lo.y = pk2(o.z - bflo(hi.y), o.w - bfhi(hi.y));
                        *(uint2*)(x1h + go) = hi;
                        *(uint2*)(x1l + go) = lo;
                    }
        }
        asm volatile("s_waitcnt lgkmcnt(0)" ::: "memory"); __builtin_amdgcn_s_barrier(); asm volatile("" ::: "memory");
    }
}

__device__ __forceinline__ void phase6(CParams& p, int wv) {
    const int tid = opaque_tid(wv), lane = tid & 63, wid = tid >> 6;
    unsigned char* ws = p.ws;
    const float* g = p.in[14]; const float* bb = p.in[15];
    bf16_t* x1b = (bf16_t*)(ws + WS_X1B); bf16_t* x1lo = (bf16_t*)(ws + WS_X1LO);
    for (int t0 = (blockIdx.x * 8 + wid) * 2; t0 < T; t0 += gridDim.x * 16) {
        float4 v[2][4];
#pragma unroll
        for (int u = 0; u < 2; ++u)
#pragma unroll
            for (int j = 0; j < 4; ++j) v[u][j] = ldnt4(p.out + (size_t)(t0 + u) * 1024 + lane * 4 + 256 * j);
#pragma unroll
        for (int u = 0; u < 2; ++u) {
            const int t = t0 + u;
            float* row = p.out + (size_t)t * 1024;
            float s = 0.f;
#pragma unroll
            for (int j = 0; j < 4; ++j) s += (v[u][j].x + v[u][j].y) + (v[u][j].z + v[u][j].w);
            const float mean = wave_sum(s) * (1.f / 1024.f);
            float q = 0.f;
#pragma unroll
            for (int j = 0; j < 4; ++j) { v[u][j].x -= mean; v[u][j].y -= mean; v[u][j].z -= mean; v[u][j].w -= mean; q += (v[u][j].x * v[u][j].x + v[u][j].y * v[u][j].y) + (v[u][j].z * v[u][j].z + v[u][j].w * v[u][j].w); }
            const float rstd = rsqrtf(wave_sum(q) * (1.f / 1024.f) + LN_EPS);
#pragma unroll
            for (int j = 0; j < 4; ++j) {
                const int cidx = lane * 4 + 256 * j;
                const float4 gg = *(const float4*)(g + cidx), be = *(const float4*)(bb + cidx);
                float4 o; o.x = v[u][j].x * rstd * gg.x + be.x; o.y = v[u][j].y * rstd * gg.y + be.y; o.z = v[u][j].z * rstd * gg.z + be.z; o.w = v[u][j].w * rstd * gg.w + be.w;
                stnt4(row + cidx, o);
                uint2 hi; hi.x = pk2(o.x, o.y); hi.y = pk2(o.z, o.w);
                uint2 lo; lo.x = pk2(o.x - bflo(hi.x), o.y - bfhi(hi.x)); lo.y = pk2(o.z - bflo(hi.y), o.w - bfhi(hi.y));
                *(uint2*)(x1b + (size_t)t * 1024 + cidx) = hi;
                *(uint2*)(x1lo + (size_t)t * 1024 + cidx) = lo;
            }
        }
    }
}

__device__ __forceinline__ float grp8_max(float v) {
    v = fmaxf(v, dpp_f<0xB1>(v)); v = fmaxf(v, dpp_f<0x4E>(v)); v = fmaxf(v, dpp_f<0x141>(v));
    return v;
}
constexpr int NTB = T / 128;
constexpr int TBR = NTB / NROUND;
__device__ __forceinline__ void phase7(CParams& p, char* lds, int wv) {
    const int tid = opaque_tid(wv), lane = tid & 63, wid = tid >> 6, wm = wid >> 2, wn = wid & 3;
    unsigned char* ws = p.ws;
    const int r0 = tid >> 3, c = tid & 7, fr = lane & 15, fq = lane >> 4;
    const bf16_t* Ah = (const bf16_t*)(ws + WS_X1H); const bf16_t* Al = (const bf16_t*)(ws + WS_X1L); const bf16_t* Bt = (const bf16_t*)(ws + WS_W_R_T);
    float* lg = (float*)(lds + LDS_STG);
    const float rbias = p.in[17][lane];
    int* tok_e = (int*)(ws + WS_TOK_E); float* tok_w = (float*)(ws + WS_TOK_W);
    int* tok_pos = (int*)(ws + WS_TOK_POS);
    int* cntb = (int*)(ws + WS_CNTB);
    int* hist = (int*)(lds + LDS_MISC);
    const int grp = lane >> 3;
    for (int tb = blockIdx.x; tb < NTB; tb += gridDim.x) {
        const int m0 = tb * 128;
        f32x4 acc[4][2]; acc_zero(acc);
        const bf16_t* a0 = Ah + (size_t)(m0 + r0) * 1024 + c * 8; const bf16_t* a1 = a0 + (size_t)64 * 1024;
        const bf16_t* a0b = Al + (size_t)(m0 + r0) * 1024 + c * 8; const bf16_t* a1b = a0b + (size_t)64 * 1024;
        const bf16_t* b0 = Bt + (size_t)r0 * 2048 + c * 8; const bf16_t* b1 = b0 + (size_t)64 * 2048;
        pf_kloop<32, true>(acc, a0, a1, a0b, a1b, b0, b1, lds, tid, lane, wm, wn);
        if (wn < 2) {
#pragma unroll
            for (int mi = 0; mi < 4; ++mi)
#pragma unroll
                for (int ni = 0; ni < 2; ++ni) {
                    const int m = wm * 64 + mi * 16 + fr, n = wn * 32 + ni * 16 + 4 * fq;
                    *(f32x4*)(lg + m * 64 + n) = acc[mi][ni];
                }
        }
        if (tid < 64) hist[tid] = 0;
        __syncthreads();
        if (wn >= 2) {
#pragma unroll
            for (int mi = 0; mi < 4; ++mi)
#pragma unroll
                for (int ni = 0; ni < 2; ++ni) {
                    const int m = wm * 64 + mi * 16 + fr, n = (wn - 2) * 32 + ni * 16 + 4 * fq;
                    f32x4 v = *(const f32x4*)(lg + m * 64 + n);
                    v = v + acc[mi][ni];
                    *(f32x4*)(lg + m * 64 + n) = v;
                }
        }
        __syncthreads();
        for (int j = 0; j < 16; ++j) {
            const int tl = wid * 16 + j, t = m0 + tl;
            const float lgt = lg[tl * 64 + lane];
            const float s = 1.f / (1.f + __expf(-lgt));
            const float sc = s + rbias;
            const float m1 = grp8_max(sc);
            const bool ismax = (sc == m1);
            const unsigned long long bm = __ballot(ismax);
            const int nmax = __popcll((bm >> (grp * 8)) & 0xFFull);
            const float m2 = grp8_max(ismax ? -INFINITY : sc);
            const float gscore = m1 + (nmax >= 2 ? m1 : m2);
            int grank = 0;
#pragma unroll
            for (int g2 = 0; g2 < 8; ++g2) {
                const float o = __builtin_bit_cast(float, __builtin_amdgcn_readlane(__builtin_bit_cast(int, gscore), g2 * 8));
                grank += (o > gscore || (o == gscore && g2 < grp)) ? 1 : 0;
            }
            float mv = (grank < 4) ? sc : -INFINITY;
            unsigned long long selm = 0ull;
#pragma unroll
            for (int i8 = 0; i8 < 8; ++i8) {
                const float mx = wave_max(mv);
                const unsigned long long bmx = __ballot(mv == mx);
                const unsigned long long low = bmx & (0ull - bmx);
                selm |= low;
                if ((low >> lane) & 1ull) mv = -INFINITY;
            }
            const bool selq = (selm >> lane) & 1ull;
            const int rank = __popcll(selm & ((1ull << lane) - 1ull));
            const float ssum = wave_sum(selq ? s : 0.f);
            if (selq) {
                tok_e[(size_t)t * 8 + rank] = lane;
                tok_w[(size_t)t * 8 + rank] = s / ssum * 2.5f;
                tok_pos[(size_t)t * 9 + rank] = atomicAdd(&hist[lane], 1);
            }
        }
        __syncthreads();
        if (tid < 64) cntb[tb * 64 + tid] = hist[tid];
        __syncthreads();
    }
}

__device__ __forceinline__ int cntb_partial(const int* cntb, int i0, int i1, int tid) {
    const int e = tid & 63, part = tid >> 6;
    int c = 0;
#pragma unroll 8
    for (int i = i0 + part; i < i1; i += 8) c += cntb[i * 64 + e];
    return c;
}
__device__ __forceinline__ void round_tables(CParams& p, int r, int* misc, int tid) {
    const int* cntb = (const int*)(p.ws + WS_CNTB) + (size_t)r * TBR * 64;
    __syncthreads();
    if (tid < 64) misc[tid] = 0;
    if (tid == 64) misc[64] = TR;
    __syncthreads();
    { const int c = cntb_partial(cntb, 0, TBR, tid); atomicAdd(&misc[tid & 63], c); }
    __syncthreads();
    if (tid < 64) {
        const int nb = (misc[tid] + 255) >> 8;
        int incl = nb;
#pragma unroll
        for (int d = 1; d < 64; d <<= 1) { const int v = __shfl_up(incl, d); if (tid >= d) incl += v; }
        const int excl = incl - nb;
        misc[80 + tid] = excl * 256; misc[160 + tid] = excl;
        if (tid == 63) { misc[80 + 64] = incl * 256; misc[160 + 64] = incl; misc[160 + NE1] = incl + ((TR + 255) >> 8); }
    }
    __syncthreads();
}
__device__ __forceinline__ int find_expert(const int* misc, int blk) {
    int lo = 0, hi = NE1;
#pragma unroll
    for (int i = 0; i < 7; ++i) { const int mid = (lo + hi) >> 1; if (mid < hi && misc[160 + mid] <= blk) lo = mid; else hi = mid; if (hi - lo <= 1) break; }
    while (lo + 1 <= NEXP && misc[160 + lo + 1] <= blk) ++lo;
    return lo;
}

__device__ __forceinline__ void phase9(CParams& p, char* lds, int wv) {
    const int tid = opaque_tid(wv);
    unsigned char* ws = p.ws;
    int* misc = (int*)(lds + LDS_MISC);
    const int* tok_e = (const int*)(ws + WS_TOK_E); const float* tok_w = (const float*)(ws + WS_TOK_W);
    int* tok_pos = (int*)(ws + WS_TOK_POS);
    const int* cntb = (const int*)(ws + WS_CNTB);
    for (int tb = blockIdx.x; tb < NTB; tb += gridDim.x) {
        const int r = tb / TBR;
        round_tables(p, r, misc, tid);
        if (tid < 64) misc[256 + tid] = 0;
        __syncthreads();
        { const int c = cntb_partial(cntb, r * TBR, tb, tid); atomicAdd(&misc[256 + (tid & 63)], c); }
        __syncthreads();
        int* slot_tok = (int*)(ws + WS_SLOT_TOK) + (size_t)r * CAP; float* slot_w = (float*)(ws + WS_SLOT_W) + (size_t)r * CAP;
        for (int i = tid; i < 128 * 8; i += NTHREADS) {
            const int t = tb * 128 + (i >> 3), k = i & 7;
            const int e = tok_e[(size_t)t * 8 + k];
            const int pos = misc[80 + e] + misc[256 + e] + tok_pos[(size_t)t * 9 + k];
            slot_tok[pos] = t; slot_w[pos] = tok_w[(size_t)t * 8 + k];
            tok_pos[(size_t)t * 9 + k] = pos;
        }
        if (tid < 128) {
            const int t = tb * 128 + tid, pos = misc[80 + NEXP] + (t - r * TR);
            slot_tok[pos] = t; slot_w[pos] = 1.f;
            tok_pos[(size_t)t * 9 + 8] = pos;
        }
    }
}

struct GuItem { int r, pos0, e, nt2, nvalid; };
__device__ __forceinline__ GuItem gu_decode(const int* misc0, const int (&nbase)[NROUND + 1], int git) {
    GuItem d;
    int r = 0;
#pragma unroll
    for (int rr = 1; rr < NROUND; ++rr) r += (git >= nbase[rr]) ? 1 : 0;
    int lbase = nbase[0];
#pragma unroll
    for (int rr = 1; rr < NROUND; ++rr) lbase = (r >= rr) ? nbase[rr] : lbase;
    const int it = git - lbase;
    const int* misc = misc0 + r * 256;
    const int blk = it >> 1; d.nt2 = it & 1; d.r = r;
    const int e = find_expert(misc, blk);
    d.e = __builtin_amdgcn_readfirstlane(e);
    const int rb = __builtin_amdgcn_readfirstlane(blk - misc[160 + d.e]);
    d.pos0 = __builtin_amdgcn_readfirstlane(misc[80 + d.e] + rb * 256);
    d.nvalid = __builtin_amdgcn_readfirstlane(min(256, misc[d.e] - rb * 256));
    return d;
}
constexpr int GU_AAUX = 0;
__device__ __forceinline__ void phase_gu(CParams& p, char* lds, int wv) {
    const int tid = opaque_tid(wv);
    unsigned char* ws = p.ws;
    int* misc0 = (int*)(lds + LDS_MISC);
    int nbase[NROUND + 1]; nbase[0] = 0;
#pragma unroll
    for (int r = 0; r < NROUND; ++r) { round_tables(p, r, misc0 + r * 256, tid); nbase[r + 1] = nbase[r] + __builtin_amdgcn_readfirstlane(misc0[r * 256 + 160 + NE1]) * 2; }
    const int nitems = nbase[NROUND];
    int sR, sC; g8::stage_rc(tid * 16, sR, sC);
    const __amdgpu_buffer_rsrc_t rx = g8::make_rsrc(ws + WS_X1H);
    int git = vblock();
    GuItem d; d.r = 0; d.pos0 = 0; d.e = 0; d.nt2 = 0; d.nvalid = 1;
    int tok0 = 0, tok1 = 0;
    g8::Src s;
    if (git < nitems) {
        d = gu_decode(misc0, nbase, git);
        const int* slot_tok = (const int*)(ws + WS_SLOT_TOK) + (size_t)d.r * CAP;
        tok0 = slot_tok[d.pos0 + min(sR, d.nvalid - 1)]; tok1 = slot_tok[d.pos0 + min(128 + sR, d.nvalid - 1)];
        s.ra = rx; s.rb = g8::make_rsrc((const bf16_t*)(ws + WS_W_EGU_T) + (size_t)d.e * 512 * 1024); s.bh = 128u * 64u; s.akt = 64u; s.bkt = 512u * 64u;
        s.ao[0] = (unsigned)(tok0 * 1024 + sC) * 2u; s.ao[1] = (unsigned)(tok1 * 1024 + sC) * 2u;
        s.bo = (unsigned)((d.nt2 * 256 + sR) * 32 + sC) * 2u;
        g8::kloop_issue<GU_AAUX>(s, lds, wv);
    }
    while (git < nitems) {
        const GuItem c = d;
        const int gnext = git + gridDim.x;
        if (gnext < nitems) {
            d = gu_decode(misc0, nbase, gnext);
            const int* slot_tok = (const int*)(ws + WS_SLOT_TOK) + (size_t)d.r * CAP;
            tok0 = slot_tok[d.pos0 + min(sR, d.nvalid - 1)]; tok1 = slot_tok[d.pos0 + min(128 + sR, d.nvalid - 1)];
        }
        f32x4 acc[2][2][4][2]; g8::acc_zero(acc);
        g8::kloop<GU_AAUX>(acc, s, 32, lds, tid, wv);
        git = gnext;
        if (git < nitems) {
            s.rb = g8::make_rsrc((const bf16_t*)(ws + WS_W_EGU_T) + (size_t)d.e * 512 * 1024);
            s.ao[0] = (unsigned)(tok0 * 1024 + sC) * 2u; s.ao[1] = (unsigned)(tok1 * 1024 + sC) * 2u;
            s.bo = (unsigned)((d.nt2 * 256 + sR) * 32 + sC) * 2u;
            g8::kloop_issue<GU_AAUX>(s, lds, wv);
        }
        bf16_t* hslot = (bf16_t*)(ws + WS_HSLOT) + (size_t)c.r * CAP * 256;
        {
            const int te = opaque_i(tid), lane = te & 63, wr = wv >> 2, wc = wv & 3, fr = lane & 15, fq = lane >> 4;
            char* stg = lds + LDS_STG;
#pragma unroll
            for (int ai = 0; ai < 2; ++ai)
#pragma unroll
                for (int m = 0; m < 4; ++m) {
                    char* rp = stg + (ai * 128 + wr * 64 + m * 16 + fr) * 272 + (wc * 16 + 4 * fq) * 2;
#pragma unroll
                    for (int bj = 0; bj < 2; ++bj) {
                        float hv[4];
#pragma unroll
                        for (int j = 0; j < 4; ++j) { const float g = acc[ai][bj][m][0][j], u = acc[ai][bj][m][1][j]; hv[j] = g / (1.f + __expf(-g)) * u; }
                        uint2 o; o.x = pk2(hv[0], hv[1]); o.y = pk2(hv[2], hv[3]);
                        *(uint2*)(rp + bj * 128) = o;
                    }
                }
            asm volatile("s_waitcnt lgkmcnt(0)" ::: "memory"); __builtin_amdgcn_s_barrier(); asm volatile("" ::: "memory");
            uint4 v[8];
#pragma unroll
            for (int i = 0; i < 8; ++i) { const int id = te + i * 512; v[i] = *(const uint4*)(stg + (id >> 4) * 272 + (id & 15) * 16); }
#pragma unroll
            for (int i = 0; i < 8; ++i) { const int id = te + i * 512; typedef unsigned u32x4_t __attribute__((ext_vector_type(4))); const u32x4_t ov = {v[i].x, v[i].y, v[i].z, v[i].w};
                __builtin_nontemporal_store(ov, (u32x4_t*)(hslot + km_off(c.pos0 + (id >> 4), c.nt2 * 128 + (id & 15) * 8, CAP))); }
            asm volatile("s_waitcnt lgkmcnt(0)" ::: "memory"); __builtin_amdgcn_s_barrier(); asm volatile("" ::: "memory");
        }
    }
    asm volatile("s_waitcnt vmcnt(0)" ::: "memory");
}
struct DownItem { int pos0, e, half; };
__device__ __forceinline__ DownItem down_decode(const int* misc, int it, int n2) {
    DownItem d; int blk = it >> 1; d.half = it & 1;
    if (it >= n2) { const int q = (n2 << 1) + (it - n2); blk = q >> 2; d.half = 2 + (q & 3); }
    const int e = find_expert(misc, blk);
    d.e = __builtin_amdgcn_readfirstlane(e);
    const int rb = __builtin_amdgcn_readfirstlane(blk - misc[160 + d.e]);
    d.pos0 = __builtin_amdgcn_readfirstlane(misc[80 + d.e] + rb * 256);
    return d;
}
struct DownFlush {
    bf16_t* yslot; char* lds; int pos0, half, tid, wv; float w[8];
    __device__ __forceinline__ void operator()(f32x4 (&acc)[2][2][4][2], int seg) const {
        g8_store_tile_ls<true>(acc, yslot, 1024, pos0, (half * 2 + seg) * 256, w, lds, tid, wv);
    }
    __device__ __forceinline__ void last(f32x4 (&acc)[2][2][4][2]) const {
        g8_store_tile_ls<false>(acc, yslot, 1024, pos0, (half * 2 + 1) * 256, w, lds, tid, wv);
    }
};
__device__ __forceinline__ void phase_down(CParams& p, int r, char* lds, int wv) {
    const int tid = opaque_tid(wv);
    unsigned char* ws = p.ws;
    int* misc = (int*)(lds + LDS_MISC);
    round_tables(p, r, misc, tid);
    const int nit2 = __builtin_amdgcn_readfirstlane(misc[160 + NE1]) * 2;
    const int n2 = (nit2 / (int)gridDim.x) * (int)gridDim.x;
    const int nitems = n2 + (nit2 - n2) * 2;
    const float* slot_w = (const float*)(ws + WS_SLOT_W) + (size_t)r * CAP;
    const bf16_t* hs = (const bf16_t*)(ws + WS_HSLOT) + (size_t)r * CAP * 256;
    const bf16_t* wed = (const bf16_t*)(ws + WS_W_ED_T);
    const int lane0 = tid & 63, wr0 = wv >> 2, fr0 = lane0 & 15;
    g8::Seg sg; sg.mask = 7; sg.lg = 3; sg.aseg = 0u; sg.bseg = 256u * 64u;
    int it = vblock();
    g8::Src s; DownItem d; float w[8];
    d.pos0 = 0; d.e = 0; d.half = 0;
#pragma unroll
    for (int i = 0; i < 8; ++i) w[i] = 0.f;
    if (it < nitems) {
        d = down_decode(misc, it, n2);
#pragma unroll
        for (int i = 0; i < 8; ++i) w[i] = slot_w[d.pos0 + (i >> 2) * 128 + wr0 * 64 + (i & 3) * 16 + fr0];
        g8::km_src(s, hs, CAP, d.pos0, wed + (size_t)d.e * 1024 * 256, 1024, d.half < 2 ? d.half * 512 : (d.half - 2) * 256, tid);
        g8::kloop_issue_ls(s, lds, wv, sg);
        asm volatile("" :: "v"(w[0]), "v"(w[1]), "v"(w[2]), "v"(w[3]), "v"(w[4]), "v"(w[5]), "v"(w[6]), "v"(w[7]));
    }
    while (it < nitems) {
        const int single = d.half >= 2;
        const int ct_last = single ? d.half - 2 : d.half * 2 + 1;
        DownFlush fl; fl.yslot = (bf16_t*)(ws + WS_YSLOT); fl.lds = lds; fl.pos0 = d.pos0; fl.half = d.half; fl.tid = tid; fl.wv = wv;
#pragma unroll
        for (int i = 0; i < 8; ++i) fl.w[i] = w[i];
        f32x4 acc[2][2][4][2]; g8::acc_zero(acc);
        g8::kloop_ms_ls(acc, s, single ? 8 : 16, lds, tid, wv, sg, fl);
        it += gridDim.x;
        if (it < nitems) {
            d = down_decode(misc, it, n2);
#pragma unroll
            for (int i = 0; i < 8; ++i) w[i] = slot_w[d.pos0 + (i >> 2) * 128 + wr0 * 64 + (i & 3) * 16 + fr0];
            g8::km_src(s, hs, CAP, d.pos0, wed + (size_t)d.e * 1024 * 256, 1024, d.half < 2 ? d.half * 512 : (d.half - 2) * 256, tid);
            g8::kloop_issue_ls(s, lds, wv, sg);
        }
        g8_store_tile_ls<false>(acc, fl.yslot, 1024, fl.pos0, ct_last * 256, fl.w, lds, tid, wv);
        if (it < nitems) asm volatile("" :: "v"(w[0]), "v"(w[1]), "v"(w[2]), "v"(w[3]), "v"(w[4]), "v"(w[5]), "v"(w[6]), "v"(w[7]));
    }
    asm volatile("s_waitcnt vmcnt(0)" ::: "memory");
}

__device__ __forceinline__ void phase_combine(CParams& p, int r, int wv) {
    const int tid = opaque_tid(wv), lane = tid & 63, wid = tid >> 6;
    unsigned char* ws = p.ws;
    const float* g = p.in[24]; const float* bb = p.in[25];
    const int* tok_pos = (const int*)(ws + WS_TOK_POS);
    const bf16_t* yslot = (const bf16_t*)(ws + WS_YSLOT);
    for (int i = blockIdx.x * 8 + wid; i < TR; i += gridDim.x * 8) {
        const int t = r * TR + i;
        float* row = p.out + (size_t)t * 1024;
        float4 v[4];
#pragma unroll
        for (int j = 0; j < 4; ++j) { v[j] = ldnt4(row + lane * 4 + 256 * j); v[j].x *= ALPHA; v[j].y *= ALPHA; v[j].z *= ALPHA; v[j].w *= ALPHA; }
        int pos[9];
#pragma unroll
        for (int k = 0; k < 9; ++k) pos[k] = tok_pos[(size_t)t * 9 + k];
        uint2 y[9][4];
#pragma unroll
        for (int k = 0; k < 9; ++k)
#pragma unroll
            for (int j = 0; j < 4; ++j) { const unsigned long long w64 = __builtin_nontemporal_load((const unsigned long long*)(yslot + (size_t)pos[k] * 1024 + lane * 4 + 256 * j)); y[k][j].x = (uint32_t)w64; y[k][j].y = (uint32_t)(w64 >> 32); }
#pragma unroll
        for (int k = 0; k < 9; ++k)
#pragma unroll
            for (int j = 0; j < 4; ++j) { v[j].x += bflo(y[k][j].x); v[j].y += bfhi(y[k][j].x); v[j].z += bflo(y[k][j].y); v[j].w += bfhi(y[k][j].y); }
        float s = 0.f;
#pragma unroll
        for (int j = 0; j < 4; ++j) s += (v[j].x + v[j].y) + (v[j].z + v[j].w);
        const float mean = wave_sum(s) * (1.f / 1024.f);
        float q = 0.f;
#pragma unroll
        for (int j = 0; j < 4; ++j) { v[j].x -= mean; v[j].y -= mean; v[j].z -= mean; v[j].w -= mean; q += (v[j].x * v[j].x + v[j].y * v[j].y) + (v[j].z * v[j].z + v[j].w * v[j].w); }
        const float rstd = rsqrtf(wave_sum(q) * (1.f / 1024.f) + LN_EPS);
#pragma unroll
        for (int j = 0; j < 4; ++j) {
            const int cidx = lane * 4 + 256 * j;
            const float4 gg = *(const float4*)(g + cidx), be = *(const float4*)(bb + cidx);
            float4 o; o.x = v[j].x * rstd * gg.x + be.x; o.y = v[j].y * rstd * gg.y + be.y; o.z = v[j].z * rstd * gg.z + be.z; o.w = v[j].w * rstd * gg.w + be.w;
            stnt4(row + cidx, o);
        }
    }
}

struct XcdBarrier { unsigned* bar; unsigned x; volatile LAS unsigned* st; };
__device__ __forceinline__ XcdBarrier xcd_barrier_post(unsigned* bar, volatile LAS unsigned* st) {
    XcdBarrier b; b.bar = bar; b.x = xb_xcc_id(); b.st = st;
    if (threadIdx.x == 0) (void)xb_add(&bar[XB_XCNT(b.x)], 1u);
    return b;
}
__device__ __forceinline__ void xcd_barrier_complete(unsigned* bar, unsigned x, unsigned& nloc, unsigned& nx) {
    const unsigned G = gridDim.x * gridDim.y * gridDim.z;
    unsigned sum, cnt, mine, sp = 0u;
    for (;;) {
        sum = 0u; cnt = 0u; mine = 0u;
#pragma unroll
        for (unsigned j = 0; j < 16; ++j) { const unsigned c = xb_ld(&bar[XB_XCNT(j)]); sum += c; cnt += (c > 0u) ? 1u : 0u; mine = (j == x) ? c : mine; }
        if (sum == G) break;
        __builtin_amdgcn_s_sleep(1);
        if ((++sp & 255u) == 0u) { if (xb_ld(&bar[XB_TMO])) break; if (sp > XB_SPIN_CAP) { atomicAdd(&bar[XB_TMO], 1u); break; } }
    }
    nloc = mine > 0u ? mine : 1u; nx = cnt > 0u ? cnt : 1u;
}
__device__ __forceinline__ void xcd_barrier(const XcdBarrier& b, int wv) {
    asm volatile("s_waitcnt vmcnt(0)" ::: "memory");
    __syncthreads();
    if (wv == 0 && lane_id() == 0) {
        unsigned* bar = b.bar;
        __builtin_amdgcn_s_waitcnt(0);
        unsigned nloc = b.st[0], nx = b.st[1];
        if (nloc == 0u) { xcd_barrier_complete(bar, b.x, nloc, nx); b.st[0] = nloc; b.st[1] = nx; }
        const unsigned old = xb_add(&bar[XB_XSUB(b.x)], 1u);
        const unsigned gen = old / nloc;
        if (old + 1u == (gen + 1u) * nloc) {
            __builtin_amdgcn_fence(__ATOMIC_RELEASE, "agent");
            asm volatile("s_waitcnt vmcnt(0)" ::: "memory");
            const unsigned og = xb_add(&bar[XB_TOP], 1u);
            const unsigned tg = og / nx;
            if (og + 1u == (tg + 1u) * nx) xb_add(&bar[XB_TOPGEN], 1u);
            else XB_SPIN(xb_ld(&bar[XB_TOPGEN]) == tg, bar);
            __builtin_amdgcn_fence(__ATOMIC_ACQUIRE, "agent");
            xb_add(&bar[XB_XGEN(b.x)], 1u);
            asm volatile("s_waitcnt vmcnt(0)" ::: "memory");
        } else {
            XB_SPIN(xb_ld(&bar[XB_XGEN(b.x)]) == gen, bar);
            __builtin_amdgcn_fence(__ATOMIC_ACQUIRE, "agent");
            asm volatile("s_waitcnt vmcnt(0)" ::: "memory");
        }
    }
    __syncthreads();
}

__global__ void __launch_bounds__(NTHREADS) fwd_megakernel(Params p_unused) {
    extern __shared__ __attribute__((aligned(16))) char lds[];
    volatile LAS unsigned* st = (volatile LAS unsigned*)(lds + LDS_BARW);
    const int wv = __builtin_amdgcn_readfirstlane((int)(threadIdx.x >> 6));
    if (threadIdx.x == 0) { st[0] = 0u; st[1] = 0u; st[2] = 0u; st[3] = 0u; }
    __syncthreads();
    const XcdBarrier gb = xcd_barrier_post((unsigned*)(kargs()->ws + WS_BAR), st);
    phase0(*kargs(), lds, wv);
    xcd_barrier(gb, wv);
    phase1(*kargs(), lds, wv);
    xcd_barrier(gb, wv);
    phase3(*kargs(), lds, wv);
    xcd_barrier(gb, wv);
    phase4(*kargs(), lds, wv);
    xcd_barrier(gb, wv);
    phase5(*kargs(), lds, wv);
    xcd_barrier(gb, wv);
    phase7(*kargs(), lds, wv);
    xcd_barrier(gb, wv);
    phase9(*kargs(), lds, wv);
    xcd_barrier(gb, wv);
    phase_gu(*kargs(), lds, wv);
    xcd_barrier(gb, wv);
    for (int r = 0; r < NROUND; ++r) {
        phase_down(*kargs(), r, lds, wv);
        xcd_barrier(gb, wv);
        phase_combine(*kargs(), r, wv);
        if (r + 1 < NROUND) xcd_barrier(gb, wv);
    }
}

extern "C" void kernel_launch(void* const* d_in, const int* in_sizes, int n_in, void* d_out, int out_size, void* d_ws, size_t ws_size, hipStream_t stream) {
    static int grid_blocks = 0;
    if (grid_blocks == 0) {
        if (n_in != 26 || out_size != T * DM || ws_size < WS_NEED) {
            fprintf(stderr, "kernel_launch: unexpected shapes (n_in %d out %d ws %zu need %zu)\n", n_in, out_size, ws_size, (size_t)WS_NEED);
            grid_blocks = -1; return;
        }
        int dev = 0, cus = 0, per_cu = 0;
        hipGetDevice(&dev);
        hipDeviceGetAttribute(&cus, hipDeviceAttributeMultiprocessorCount, dev);
        hipFuncSetAttribute((const void*)fwd_megakernel, hipFuncAttributeMaxDynamicSharedMemorySize, LDS_BYTES);
        hipOccupancyMaxActiveBlocksPerMultiprocessor(&per_cu, (const void*)fwd_megakernel, NTHREADS, LDS_BYTES);
        if (per_cu < 1) { fprintf(stderr, "kernel_launch: occupancy query says %d blocks per CU\n", per_cu); grid_blocks = -1; return; }
        grid_blocks = cus * 1;
    }
    if (grid_blocks < 0) return;
    Params p{};
    for (int i = 0; i < 26; ++i) p.in[i] = (const float*)d_in[i];
    p.out = (float*)d_out; p.ws = (unsigned char*)d_ws;
    if (hipMemsetAsync((char*)d_ws + WS_BAR, 0, 16384, stream) != hipSuccess) { fprintf(stderr, "kernel_launch: memset of barrier words failed\n"); return; }
    void* args[] = {&p};
    hipError_t e = hipLaunchCooperativeKernel((const void*)fwd_megakernel, dim3(grid_blocks), dim3(NTHREADS), args, LDS_BYTES, stream);
    if (e != hipSuccess) fprintf(stderr, "cooperative launch failed: %s (grid %d)\n", hipGetErrorString(e), grid_blocks);
}
```

```cpp
#include <hip/hip_runtime.h>
#include <stdint.h>
#include <stdio.h>

typedef unsigned short bf16_t;
typedef short bf16x8 __attribute__((ext_vector_type(8)));
typedef float f32x4 __attribute__((ext_vector_type(4)));
__device__ __forceinline__ float4 ldnt4(const float* p) { const f32x4 v = __builtin_nontemporal_load((const f32x4*)p); return make_float4(v[0], v[1], v[2], v[3]); }
__device__ __forceinline__ void stnt4(float* p, const float4& o) { const f32x4 v = {o.x, o.y, o.z, o.w}; __builtin_nontemporal_store(v, (f32x4*)p); }
#define LAS __attribute__((address_space(3)))

constexpr int DM = 1024, NB = 16, SEQ = 2048, T = NB * SEQ;
constexpr int NPROJ = 1536;
constexpr int NMEM = 256;
constexpr int NEXP = 64, NE1 = 65;
constexpr int DEXP = 256;
constexpr int NROUND = 4, TR = T / NROUND;
constexpr int CAP = 90368;
constexpr float ALPHA = 1.189207115002721f;
constexpr float LN_EPS = 1e-5f, RMS_EPS = 1e-6f;
constexpr float IDXW_SCALE = 0.04419417382415922f;
constexpr int PC_CQ = 0, PC_CKV = 256, PC_KIDX = 384, PC_IDXW = 448, PC_GB = 512, PC_GC = 768, PC_H = 1024, PC_QM = 1280;

constexpr size_t al256(size_t x) { return (x + 255) & ~(size_t)255; }
constexpr size_t WS_W_IN_T = 0;
constexpr size_t WS_W_Q2_T = WS_W_IN_T + (size_t)1536 * 1024 * 2;
constexpr size_t WS_W_MKV_T = WS_W_Q2_T + (size_t)1536 * 256 * 2;
constexpr size_t WS_W_OUT2_T = WS_W_MKV_T + (size_t)512 * 1024 * 2;
constexpr size_t WS_W_R_T = WS_W_OUT2_T + (size_t)1024 * 1536 * 2;
constexpr size_t WS_W_EGU_T = WS_W_R_T + (size_t)128 * 3072 * 2;
constexpr size_t WS_W_ED_T = WS_W_EGU_T + (size_t)NE1 * 512 * 1024 * 2;
constexpr size_t WS_CNT = WS_W_ED_T + (size_t)NE1 * 1024 * 256 * 2;
constexpr size_t WS_CNTB = WS_CNT + 4096;
constexpr size_t WS_BAR = WS_CNTB + (size_t)256 * 64 * 4;
constexpr size_t WS_TOK_E = WS_BAR + 16384;
constexpr size_t WS_TOK_W = WS_TOK_E + (size_t)T * 8 * 4;
constexpr size_t WS_TOK_POS = WS_TOK_W + (size_t)T * 8 * 4;
constexpr size_t WS_SLOT_TOK = al256(WS_TOK_POS + (size_t)T * 9 * 4);
constexpr size_t WS_SLOT_W = WS_SLOT_TOK + (size_t)NROUND * CAP * 4;
constexpr size_t WS_X1B = al256(WS_SLOT_W + (size_t)NROUND * CAP * 4);
constexpr size_t WS_B = al256(WS_X1B + (size_t)T * 1024 * 2);
constexpr size_t WS_XB = WS_B;
constexpr size_t WS_CAT2 = WS_X1B;
constexpr size_t WS_MEMB = WS_XB + (size_t)T * 1024 * 2;
constexpr size_t WS_PROJ = WS_MEMB + (size_t)4096 * 1024 * 2;
constexpr size_t WS_KMEM = WS_PROJ + (size_t)T * NPROJ * 2;
constexpr size_t WS_VTMEM = WS_KMEM + (size_t)4096 * 256 * 2;
constexpr size_t WS_KIDX = WS_VTMEM + (size_t)256 * 4096 * 2;
constexpr size_t WS_CQN = WS_KIDX + (size_t)T * 64 * 2;
constexpr size_t WS_CKVN = WS_CQN + (size_t)T * 256 * 2;
constexpr size_t WS_Q2 = WS_CKVN + (size_t)T * 128 * 2;
constexpr size_t WS_END_EARLY = WS_Q2 + (size_t)T * 1536 * 2;
constexpr size_t WS_X1LO = WS_B;
constexpr size_t WS_LOGITS = WS_X1LO + (size_t)T * 1024 * 2;
constexpr size_t WS_X1H = al256(WS_CAT2 + (size_t)T * 1536 * 2);
constexpr size_t WS_X1L = WS_X1H + (size_t)T * 1024 * 2;
constexpr size_t WS_LNST = WS_X1L + (size_t)T * 1024 * 2;
constexpr size_t WS_YSLOT = WS_X1B;
constexpr size_t WS_HSLOT = WS_YSLOT + (size_t)CAP * 1024 * 2;
constexpr size_t WS_END_MOE = WS_HSLOT + (size_t)NROUND * CAP * 256 * 2;
static_assert(WS_X1H + (size_t)T * 1024 * 2 <= WS_HSLOT, "x1 hi must end below HSLOT");
static_assert(WS_LNST + (size_t)128 * 4 * 256 * 8 <= WS_END_EARLY, "LN statistics must fit the early region");
constexpr size_t WS_NEED = WS_END_EARLY > WS_END_MOE ? WS_END_EARLY : WS_END_MOE;

constexpr int NTHREADS = 512;
constexpr int LDS_GEMM_H = 65536;
constexpr int LDS_MISC = 139264;
constexpr int LDS_STG = 65536;
constexpr int LDS_BYTES = 155648;
constexpr int LDS_BARW = LDS_BYTES - 16;
constexpr int WAVE_LDS = 15360;

struct Params {
    const float* in[26];
    float* out;
    unsigned char* ws;
};
typedef const __attribute__((address_space(4))) Params CParams;
__device__ __forceinline__ CParams* kargs() {
    CParams* q = (CParams*)__builtin_amdgcn_kernarg_segment_ptr();
    asm volatile("" : "+s"(q));
    return q;
}

typedef __bf16 bf16x2_t __attribute__((ext_vector_type(2)));
typedef float f32x2_t __attribute__((ext_vector_type(2)));
__device__ __forceinline__ uint32_t pk2(float a, float b) {
    const f32x2_t v = {a, b};
    return __builtin_bit_cast(uint32_t, __builtin_convertvector(v, bf16x2_t));
}
__device__ __forceinline__ bf16_t f2bf(float f) { return (bf16_t)(pk2(f, 0.f) & 0xFFFFu); }
__device__ __forceinline__ float bf2f(bf16_t h) { return __uint_as_float(((uint32_t)h) << 16); }
__device__ __forceinline__ float bflo(uint32_t w) { return __uint_as_float(w << 16); }
__device__ __forceinline__ float bfhi(uint32_t w) { return __uint_as_float(w & 0xFFFF0000u); }
__device__ __forceinline__ int lane_id() { return (int)__builtin_amdgcn_mbcnt_hi(~0u, __builtin_amdgcn_mbcnt_lo(~0u, 0u)); }
__device__ __forceinline__ int opaque_tid(int wv) { int t = wv * 64 + lane_id(); asm volatile("" : "+v"(t)); return t; }
__device__ __forceinline__ int opaque_i(int t) { asm volatile("" : "+v"(t)); return t; }
__device__ __forceinline__ size_t km_off(int row, int k, int nrows) { return ((size_t)(k >> 5) * nrows + row) * 32 + (k & 31); }
__device__ __forceinline__ void wave_sync() {
    __builtin_amdgcn_fence(__ATOMIC_RELEASE, "wavefront");
    __builtin_amdgcn_wave_barrier();
    __builtin_amdgcn_fence(__ATOMIC_ACQUIRE, "wavefront");
}
template <int CTRL> __device__ __forceinline__ float dpp_f(float x) {
    return __builtin_bit_cast(float, __builtin_amdgcn_mov_dpp(__builtin_bit_cast(int, x), CTRL, 0xf, 0xf, true));
}
__device__ __forceinline__ float xrow16_max(float x) {
    auto s = __builtin_amdgcn_permlane16_swap(__float_as_uint(x), __float_as_uint(x), false, false);
    x = fmaxf(__uint_as_float(s[0]), __uint_as_float(s[1]));
    auto t = __builtin_amdgcn_permlane32_swap(__float_as_uint(x), __float_as_uint(x), false, false);
    return fmaxf(__uint_as_float(t[0]), __uint_as_float(t[1]));
}
__device__ __forceinline__ float xrow16_sum(float x) {
    auto s = __builtin_amdgcn_permlane16_swap(__float_as_uint(x), __float_as_uint(x), false, false);
    x = __uint_as_float(s[0]) + __uint_as_float(s[1]);
    auto t = __builtin_amdgcn_permlane32_swap(__float_as_uint(x), __float_as_uint(x), false, false);
    return __uint_as_float(t[0]) + __uint_as_float(t[1]);
}
__device__ __forceinline__ float wave_sum(float v) {
    v += dpp_f<0xB1>(v); v += dpp_f<0x4E>(v); v += dpp_f<0x141>(v); v += dpp_f<0x128>(v);
    return xrow16_sum(v);
}
__device__ __forceinline__ float wave_max(float v) {
    v = fmaxf(v, dpp_f<0xB1>(v)); v = fmaxf(v, dpp_f<0x4E>(v)); v = fmaxf(v, dpp_f<0x141>(v)); v = fmaxf(v, dpp_f<0x128>(v));
    return xrow16_max(v);
}
__device__ __forceinline__ void unpack8(const uint4& v, float* f) {
    f[0] = bflo(v.x); f[1] = bfhi(v.x); f[2] = bflo(v.y); f[3] = bfhi(v.y);
    f[4] = bflo(v.z); f[5] = bfhi(v.z); f[6] = bflo(v.w); f[7] = bfhi(v.w);
}

template <int AMODE>
__device__ __forceinline__ void gemm_loop(f32x4 (&acc)[4][2], const bf16_t* a0, const bf16_t* a1, const bf16_t* a0b, const bf16_t* a1b,
                                          const bf16_t* b0, const bf16_t* b1, int nk, char* lds, const char* ldsH,
                                          int tid, int lane, int wm, int wn) {
    const int fr = lane & 15, fq = lane >> 4;
    const int r0 = tid >> 3, c = tid & 7;
    const int wo = r0 * 128 + ((c ^ ((r0 >> 1) & 7)) << 4);
    uint4 ra0, ra1, rb0, rb1;
    ra0 = ra1 = make_uint4(0, 0, 0, 0);
    if (AMODE != 1) { ra0 = *(const uint4*)a0; ra1 = *(const uint4*)a1; }
    rb0 = *(const uint4*)b0; rb1 = *(const uint4*)b1;
    __syncthreads();
    if (AMODE != 1) { *(uint4*)(lds + wo) = ra0; *(uint4*)(lds + wo + 8192) = ra1; }
    *(uint4*)(lds + 32768 + wo) = rb0; *(uint4*)(lds + 32768 + wo + 8192) = rb1;
    __syncthreads();
    const int swz = (fr >> 1) & 7;
    const int aoff = (wm * 64 + fr) * 128, boff = 32768 + (wn * 32 + fr) * 128;
    for (int kt = 0; kt < nk; ++kt) {
        const int cur = kt & 1;
        if (kt + 1 < nk) {
            const int k1 = kt + 1;
            if (AMODE == 0) { ra0 = *(const uint4*)(a0 + k1 * 64); ra1 = *(const uint4*)(a1 + k1 * 64); }
            if (AMODE == 2) {
                const int seg = k1 >> 4, ko = (k1 & 15) * 64;
                const bf16_t* p0 = (seg == 1) ? a0b : a0; const bf16_t* p1 = (seg == 1) ? a1b : a1;
                ra0 = *(const uint4*)(p0 + ko); ra1 = *(const uint4*)(p1 + ko);
            }
            rb0 = *(const uint4*)(b0 + k1 * 64); rb1 = *(const uint4*)(b1 + k1 * 64);
        }
        const char* pa = (AMODE == 1) ? (ldsH + kt * 16384 + aoff) : (lds + cur * 16384 + aoff);
        const char* pb = lds + cur * 16384 + boff;
#pragma unroll
        for (int kk = 0; kk < 2; ++kk) {
            const int ch = ((kk * 4 + fq) ^ swz) << 4;
            bf16x8 af[4], bfv[2];
#pragma unroll
            for (int mi = 0; mi < 4; ++mi) af[mi] = *(const bf16x8*)(pa + mi * 2048 + ch);
#pragma unroll
            for (int ni = 0; ni < 2; ++ni) bfv[ni] = *(const bf16x8*)(pb + ni * 2048 + ch);
#pragma unroll
            for (int mi = 0; mi < 4; ++mi)
#pragma unroll
                for (int ni = 0; ni < 2; ++ni)
                    acc[mi][ni] = __builtin_amdgcn_mfma_f32_16x16x32_bf16(bfv[ni], af[mi], acc[mi][ni], 0, 0, 0);
        }
        if (kt + 1 < nk) {
            const int nxt = cur ^ 1;
            if (AMODE != 1) { *(uint4*)(lds + nxt * 16384 + wo) = ra0; *(uint4*)(lds + nxt * 16384 + wo + 8192) = ra1; }
            *(uint4*)(lds + 32768 + nxt * 16384 + wo) = rb0; *(uint4*)(lds + 32768 + nxt * 16384 + wo + 8192) = rb1;
        }
        __syncthreads();
    }
}
template <int NK, bool ROUTER>
__device__ __forceinline__ void pf_kloop(f32x4 (&acc)[4][2], const bf16_t* a0, const bf16_t* a1, const bf16_t* a0b, const bf16_t* a1b,
                                             const bf16_t* b0, const bf16_t* b1, char* lds, int tid, int lane, int wm, int wn) {
    static_assert(NK % 4 == 0, "unrolled by 4");
    const int fr = lane & 15, fq = lane >> 4;
    const int r0 = tid >> 3, c = tid & 7;
    const int wo = r0 * 128 + ((c ^ ((r0 >> 1) & 7)) << 4);
    uint4 ra0_0, ra1_0, rb0_0, rb1_0, ra0_1, ra1_1, rb0_1, rb1_1, ra0_2, ra1_2, rb0_2, rb1_2, ra0_3, ra1_3, rb0_3, rb1_3;
#define RT_LOAD(s, k) do { const int k_ = (k); const int seg_ = ROUTER ? (k_ >> 4) : 0, ko_ = ROUTER ? (k_ & 15) * 64 : k_ * 64; const bf16_t* p0_ = (seg_ == 1) ? a0b : a0; const bf16_t* p1_ = (seg_ == 1) ? a1b : a1; \
        ra0_##s = *(const uint4*)(p0_ + ko_); ra1_##s = *(const uint4*)(p1_ + ko_); rb0_##s = *(const uint4*)(b0 + k_ * 64); rb1_##s = *(const uint4*)(b1 + k_ * 64); } while (0)
#define RT_STORE(s, buf) do { *(uint4*)(lds + (buf) * 16384 + wo) = ra0_##s; *(uint4*)(lds + (buf) * 16384 + wo + 8192) = ra1_##s; \
        *(uint4*)(lds + 32768 + (buf) * 16384 + wo) = rb0_##s; *(uint4*)(lds + 32768 + (buf) * 16384 + wo + 8192) = rb1_##s; } while (0)
#define RT_BAR() do { asm volatile("s_waitcnt lgkmcnt(0)" ::: "memory"); __builtin_amdgcn_s_barrier(); asm volatile("" ::: "memory"); } while (0)
    RT_LOAD(0, 0); RT_LOAD(1, 1); RT_LOAD(2, 2); RT_LOAD(3, 3);
    __syncthreads();
    RT_STORE(0, 0);
    RT_BAR();
    const int swz = (fr >> 1) & 7;
    const int aoff = (wm * 64 + fr) * 128, boff = 32768 + (wn * 32 + fr) * 128;
#define RT_STEP(j, jn) do { const int k = kt + (j); \
        RT_LOAD(j, (k + 4 < NK) ? k + 4 : NK - 1);     \
        const char* pa = lds + ((j) & 1) * 16384 + aoff; const char* pb = lds + ((j) & 1) * 16384 + boff; \
        _Pragma("unroll") for (int kk = 0; kk < 2; ++kk) { \
            const int ch = ((kk * 4 + fq) ^ swz) << 4; \
            bf16x8 af[4], bfv[2]; \
            _Pragma("unroll") for (int mi = 0; mi < 4; ++mi) af[mi] = *(const bf16x8*)(pa + mi * 2048 + ch); \
            _Pragma("unroll") for (int ni = 0; ni < 2; ++ni) bfv[ni] = *(const bf16x8*)(pb + ni * 2048 + ch); \
            _Pragma("unroll") for (int mi = 0; mi < 4; ++mi) _Pragma("unroll") for (int ni = 0; ni < 2; ++ni) \
                acc[mi][ni] = __builtin_amdgcn_mfma_f32_16x16x32_bf16(bfv[ni], af[mi], acc[mi][ni], 0, 0, 0); } \
        RT_STORE(jn, ((j) + 1) & 1); \
        RT_BAR(); } while (0)
    for (int kt = 0; kt < NK; kt += 4) {
        RT_STEP(0, 1); RT_STEP(1, 2); RT_STEP(2, 3); RT_STEP(3, 0);
    }
#undef RT_STEP
#undef RT_BAR
#undef RT_LOAD
#undef RT_STORE
}
__device__ __forceinline__ void acc_zero(f32x4 (&acc)[4][2]) {
#pragma unroll
    for (int mi = 0; mi < 4; ++mi)
#pragma unroll
        for (int ni = 0; ni < 2; ++ni) acc[mi][ni] = (f32x4){0.f, 0.f, 0.f, 0.f};
}
template <int OMODE>
__device__ __forceinline__ void gemm_item_bf16(const bf16_t* A, int lda, const bf16_t* Bt, int ldb, int nk, bf16_t* C, int ldc, int m0, int n0,
                                               char* lds, int tid, int lane, int wm, int wn) {
    const int r0 = tid >> 3, c = tid & 7;
    f32x4 acc[4][2]; acc_zero(acc);
    const bf16_t* a0 = A + (size_t)(m0 + r0) * lda + c * 8; const bf16_t* a1 = a0 + (size_t)64 * lda;
    const bf16_t* b0 = Bt + (size_t)(n0 + r0) * ldb + c * 8; const bf16_t* b1 = b0 + (size_t)64 * ldb;
    pf_kloop<16, false>(acc, a0, a1, a0, a1, b0, b1, lds, tid, lane, wm, wn);
    const int fr = lane & 15, fq = lane >> 4;
#pragma unroll
    for (int mi = 0; mi < 4; ++mi)
#pragma unroll
        for (int ni = 0; ni < 2; ++ni) {
            const int m = m0 + wm * 64 + mi * 16 + fr, n = n0 + wn * 32 + ni * 16 + 4 * fq;
            uint2 o; o.x = pk2(acc[mi][ni][0], acc[mi][ni][1]); o.y = pk2(acc[mi][ni][2], acc[mi][ni][3]);
            size_t off;
            if (OMODE == 0) off = (size_t)m * ldc + n;
            else if (OMODE == 1) {
                const int b = m >> 8, key = m & 255, h = n >> 6, d = n & 63;
                off = ((size_t)((((b * 4 + h) * 16 + (key >> 4)) * 2 + (d >> 5)) * 64 + ((d & 31) >> 3) * 16 + (key & 15))) * 8 + (d & 7);
            } else {
                const int h = m >> 6, d = m & 63, b = n >> 8, key = n & 255, k32 = key & 31;
                off = ((size_t)((((b * 4 + h) * 8 + (key >> 5)) * 4 + (d >> 4)) * 64 + ((k32 & 15) >> 2) * 16 + (d & 15))) * 8 + ((k32 >> 4) * 4);
            }
            *(uint2*)(C + off) = o;
        }
}

namespace g8 {
constexpr int HTB = 8192;
__device__ __forceinline__ int lds_byte(int r, int c) { const int ob = (r & 15) * 64 + c * 2; return (r >> 4) * 1024 + (ob ^ (((ob >> 9) & 1) << 5)); }
__device__ __forceinline__ void stage_rc(int b, int& R, int& C) { const int st = b / 1024, sb = b % 1024, swz = sb ^ (((sb >> 9) & 1) << 5); R = st * 16 + swz / 64; C = (swz % 64) / 2; }
struct Src { __amdgpu_buffer_rsrc_t ra, rb; unsigned ao[2]; unsigned bo; unsigned bh; unsigned akt, bkt; };
__device__ __forceinline__ __amdgpu_buffer_rsrc_t make_rsrc(const void* p) {
    const unsigned long long a = (unsigned long long)p;
    const unsigned lo = __builtin_amdgcn_readfirstlane((unsigned)a), hi = __builtin_amdgcn_readfirstlane((unsigned)(a >> 32));
    return __builtin_amdgcn_make_buffer_rsrc((void*)(((unsigned long long)hi << 32) | lo), 0, 0x7FFFFFFF, 0x00020000);
}
#define G8_SA(b,h) (lds + ((b) * 2 + (h)) * g8::HTB)
#define G8_SB(b,h) (lds + (4 + (b) * 2 + (h)) * g8::HTB)
#define G8_KOFF(kt, ktstride, segstride) ((((kt) & sg.mask) * (ktstride)) + (((kt) >> sg.lg) * (segstride)))
#define G8_STAGE_A(b,h,kt) __builtin_amdgcn_raw_ptr_buffer_load_lds(s.ra, (LAS void*)(G8_SA(b,h) + wv * 1024), 16, s.ao[h], G8_KOFF(kt, s.akt, sg.aseg), 0, AAUX)
#define G8_STAGE_B(b,h,kt) __builtin_amdgcn_raw_ptr_buffer_load_lds(s.rb, (LAS void*)(G8_SB(b,h) + wv * 1024), 16, s.bo, G8_KOFF(kt, s.bkt, sg.bseg) + (h) * s.bh, 0, 0)
#define G8_LDA(dst,b,h) do { _Pragma("unroll") for (int m = 0; m < 4; ++m) \
    dst[m] = *(const bf16x8*)(G8_SA(b,h) + g8::lds_byte(wr * 64 + m * 16 + fr, fq * 8)); } while (0)
#define G8_LDB(dst,b,h) do { _Pragma("unroll") for (int n = 0; n < 2; ++n) \
    dst[n] = *(const bf16x8*)(G8_SB(b,h) + g8::lds_byte(wc * 32 + n * 16 + fr, fq * 8)); } while (0)
#define G8_MMA(ai,bj,At,Bt) do { __builtin_amdgcn_s_setprio(1); \
    _Pragma("unroll") for (int m = 0; m < 4; ++m) _Pragma("unroll") for (int n = 0; n < 2; ++n) \
      acc[ai][bj][m][n] = __builtin_amdgcn_mfma_f32_16x16x32_bf16(Bt[n], At[m], acc[ai][bj][m][n], 0, 0, 0); \
    __builtin_amdgcn_s_setprio(0); } while (0)
#define G8_WAIT_V(n) asm volatile("s_waitcnt vmcnt(" #n ")" ::: "memory")
#define G8_WAIT_L(n) asm volatile("s_waitcnt lgkmcnt(" #n ")" ::: "memory")
#define G8_BAR __builtin_amdgcn_s_barrier()
#define G8_SCHED __builtin_amdgcn_sched_barrier(0)

__device__ __forceinline__ void zero_acc(f32x4 (&acc)[2][2][4][2]) {
#pragma unroll
    for (int a = 0; a < 2; ++a)
#pragma unroll
        for (int b = 0; b < 2; ++b)
#pragma unroll
            for (int m = 0; m < 4; ++m)
#pragma unroll
                for (int n = 0; n < 2; ++n) acc[a][b][m][n] = (f32x4){0.f, 0.f, 0.f, 0.f};
}
struct Seg { int mask, lg; unsigned aseg, bseg; };
__device__ __forceinline__ Seg one_seg() { Seg g; g.mask = 0x7FFFFFFF; g.lg = 30; g.aseg = 0u; g.bseg = 0u; return g; }
struct NoFlush { __device__ __forceinline__ void operator()(f32x4 (&)[2][2][4][2], int) const {} };
template <int AAUX = 0>
__device__ __forceinline__ void kloop_issue(const Src& s, char* lds, int wv, const Seg sg = one_seg()) {
    G8_STAGE_B(0, 0, 0); G8_STAGE_A(0, 0, 0);
    G8_STAGE_B(0, 1, 0); G8_STAGE_A(0, 1, 0);
}
template <class Flush, int AAUX = 0>
__device__ __forceinline__ void kloop_ms(f32x4 (&acc)[2][2][4][2], const Src& s, int nt, char* lds, int tid, int wv, const Seg sg, const Flush& flush) {
    const int lane = tid & 63, wr = wv >> 2, wc = wv & 3, fr = lane & 15, fq = lane >> 4;
    bf16x8 At[4], B0[2], B1[2];
    if (wr == 1) G8_BAR;
    G8_WAIT_V(0); G8_BAR;
    G8_STAGE_B(1, 0, 1); G8_STAGE_A(1, 0, 1); G8_STAGE_B(1, 1, 1);
    G8_WAIT_V(3); G8_BAR;
    bool drain = false;
    for (int t = 0; t < nt - 2; t += 2) {
        G8_LDB(B0, 0, 0); G8_SCHED; G8_LDA(At, 0, 0); G8_STAGE_A(1, 1, t + 1);
        G8_WAIT_L(4); G8_BAR; G8_WAIT_L(0); G8_MMA(0, 0, At, B0); G8_BAR; G8_SCHED;
        G8_LDB(B1, 0, 1); G8_STAGE_B(0, 0, t + 2);
        G8_BAR; G8_WAIT_L(0); G8_MMA(0, 1, At, B1); G8_BAR;
        G8_LDA(At, 0, 1); G8_STAGE_A(0, 0, t + 2);
        G8_BAR; G8_WAIT_L(0); G8_MMA(1, 0, At, B0); G8_BAR; G8_SCHED;
        G8_STAGE_B(0, 1, t + 2);
        if (drain) { G8_WAIT_V(0); drain = false; } else { G8_WAIT_V(3); }
        G8_BAR; G8_MMA(1, 1, At, B1); G8_BAR;
        G8_LDB(B0, 1, 0); G8_SCHED; G8_LDA(At, 1, 0); G8_STAGE_A(0, 1, t + 2);
        G8_WAIT_L(4); G8_BAR; G8_WAIT_L(0); G8_MMA(0, 0, At, B0); G8_BAR; G8_SCHED;
        G8_LDB(B1, 1, 1); G8_STAGE_B(1, 0, t + 3);
        G8_BAR; G8_WAIT_L(0); G8_MMA(0, 1, At, B1); G8_BAR;
        G8_LDA(At, 1, 1); G8_STAGE_A(1, 0, t + 3);
        G8_BAR; G8_WAIT_L(0); G8_MMA(1, 0, At, B0); G8_BAR; G8_SCHED;
        G8_STAGE_B(1, 1, t + 3);
        G8_WAIT_V(3); G8_BAR; G8_MMA(1, 1, At, B1); G8_BAR;
        if (((t + 2) & sg.mask) == 0) {
            flush(acc, ((t + 2) >> sg.lg) - 1);
            zero_acc(acc);
            drain = true;
        }
    }
    { G8_LDB(B0, 0, 0); G8_LDA(At, 0, 0); G8_STAGE_A(1, 1, nt - 1);
      G8_BAR; G8_WAIT_L(0); G8_MMA(0, 0, At, B0); G8_BAR;
      G8_LDB(B1, 0, 1); G8_BAR; G8_WAIT_L(0); G8_MMA(0, 1, At, B1); G8_BAR;
      G8_LDA(At, 0, 1); G8_WAIT_V(2); G8_BAR; G8_WAIT_L(0); G8_MMA(1, 0, At, B0); G8_MMA(1, 1, At, B1); G8_BAR; }
    { G8_LDB(B0, 1, 0); G8_LDA(At, 1, 0); G8_WAIT_V(1); G8_BAR; G8_WAIT_L(0); G8_MMA(0, 0, At, B0); G8_BAR;
      G8_LDB(B1, 1, 1); G8_WAIT_V(0); G8_BAR; G8_WAIT_L(0); G8_MMA(0, 1, At, B1); G8_BAR;
      G8_LDA(At, 1, 1); G8_BAR; G8_WAIT_L(0); G8_MMA(1, 0, At, B0); G8_MMA(1, 1, At, B1); G8_BAR; }
    if (wr == 0) G8_BAR;
}
template <int AAUX = 0>
__device__ __forceinline__ void kloop(f32x4 (&acc)[2][2][4][2], const Src& s, int nt, char* lds, int tid, int wv) {
    kloop_ms<NoFlush, AAUX>(acc, s, nt, lds, tid, wv, one_seg(), NoFlush());
}
__device__ __forceinline__ void acc_zero(f32x4 (&acc)[2][2][4][2]) {
#pragma unroll
    for (int a = 0; a < 2; ++a)
#pragma unroll
        for (int b = 0; b < 2; ++b)
#pragma unroll
            for (int m = 0; m < 4; ++m)
#pragma unroll
                for (int n = 0; n < 2; ++n) acc[a][b][m][n] = (f32x4){0.f, 0.f, 0.f, 0.f};
}
__device__ __forceinline__ void dense_src(Src& s, const bf16_t* A, int lda, int brow, const bf16_t* B, int ldb, int bcol, int tid) {
    s.ra = make_rsrc(A); s.rb = make_rsrc(B); s.bh = (unsigned)(128 * ldb * 2); s.akt = 64u; s.bkt = 64u;
    int R, C; stage_rc(tid * 16, R, C);
    s.bo = (unsigned)((bcol + R) * ldb + C) * 2u;
#pragma unroll
    for (int h = 0; h < 2; ++h) s.ao[h] = (unsigned)((brow + h * 128 + R) * lda + C) * 2u;
}
__device__ __forceinline__ void km_src(Src& s, const bf16_t* A, int anrows, int brow, const bf16_t* B, int bnrows, int bcol, int tid) {
    s.ra = make_rsrc(A); s.rb = make_rsrc(B); s.bh = 128u * 64u; s.akt = (unsigned)anrows * 64u; s.bkt = (unsigned)bnrows * 64u;
    int R, C; stage_rc(tid * 16, R, C);
    s.bo = (unsigned)((bcol + R) * 32 + C) * 2u;
#pragma unroll
    for (int h = 0; h < 2; ++h) s.ao[h] = (unsigned)((brow + h * 128 + R) * 32 + C) * 2u;
}
}

__device__ __forceinline__ void tconv_tile(const float* src, const float* src2, int ld_src, bf16_t* dst, int ld_dst, int k0, int n0, int mode, float* tl, int tid, int kmrows = 0, int kmrow0 = 0, int kmk0 = 0) {
    __syncthreads();
    {
        const int nn = tid & 63, kb = tid >> 6;
        const int np = n0 + nn;
        const float* s = src; int sc = np;
        if (mode == 1) sc = (np < 456) ? np : (np < 512 ? -1 : np - 56);
        if (mode == 2) { s = ((np >> 4) & 1) ? src2 : src; sc = 16 * (np >> 5) + (np & 15); }
#pragma unroll
        for (int i = 0; i < 8; ++i) {
            const int kk = kb + i * 8;
            tl[kk * 65 + nn] = (sc >= 0) ? s[(size_t)(k0 + kk) * ld_src + sc] : 0.f;
        }
    }
    __syncthreads();
    {
        const int n2 = tid >> 3, kc = tid & 7;
        const float* s = tl + (kc * 8) * 65 + n2;
        uint4 o; o.x = pk2(s[0], s[65]); o.y = pk2(s[130], s[195]); o.z = pk2(s[260], s[325]); o.w = pk2(s[390], s[455]);
        if (kmrows) *(uint4*)(dst + km_off(kmrow0 + n0 + n2, kmk0 + k0 + kc * 8, kmrows)) = o;
        else *(uint4*)(dst + (size_t)(n0 + n2) * ld_dst + k0 + kc * 8) = o;
    }
}

__device__ __forceinline__ void tconv_wave(const float* src, const float* src2, int ld_src, bf16_t* dst, int kmrows, int k0, int n0, int mode, float* scr, int lane) {
    const int nn = lane & 31, np = n0 + nn, par = lane >> 5;
    const float* s = src; int sc = np;
    if (mode == 2) { s = ((np >> 4) & 1) ? src2 : src; sc = 16 * (np >> 5) + (np & 15); }
    float v[32];
#pragma unroll
    for (int i = 0; i < 32; ++i) v[i] = __builtin_nontemporal_load(s + (size_t)(k0 + 2 * i + par) * ld_src + sc);
    wave_sync();
#pragma unroll
    for (int i = 0; i < 32; ++i) scr[(2 * i + par) * 33 + nn] = v[i];
    wave_sync();
    const int c = lane & 7;
#pragma unroll
    for (int j = 0; j < 4; ++j) {
        const int n = (lane >> 3) + 8 * j;
        const float* sp = scr + (8 * c) * 33 + n;
        uint4 o; o.x = pk2(sp[0], sp[33]); o.y = pk2(sp[66], sp[99]); o.z = pk2(sp[132], sp[165]); o.w = pk2(sp[198], sp[231]);
        { typedef unsigned u32x4_t __attribute__((ext_vector_type(4))); const u32x4_t ov = {o.x, o.y, o.z, o.w};
          __builtin_nontemporal_store(ov, (u32x4_t*)(dst + km_off(n0 + n, k0 + 8 * c, kmrows))); }
    }
}

constexpr int EW_GU = 16 * 16, EW_DN = 4 * 32, EW_EX = EW_GU + EW_DN, EW_ITEMS = NE1 * EW_EX;
__device__ __forceinline__ void expert_w_item(CParams& p, int it, float* scr, int lane) {
    unsigned char* ws = p.ws;
    const int e = it / EW_EX; int r = it - e * EW_EX;
    const float* wg = (e < NEXP) ? p.in[18] + (size_t)e * 1024 * 256 : p.in[21];
    const float* wu = (e < NEXP) ? p.in[19] + (size_t)e * 1024 * 256 : p.in[22];
    const float* wd = (e < NEXP) ? p.in[20] + (size_t)e * 256 * 1024 : p.in[23];
    if (r < EW_GU) tconv_wave(wg, wu, 256, (bf16_t*)(ws + WS_W_EGU_T) + (size_t)e * 512 * 1024, 512, (r & 15) * 64, (r >> 4) * 32, 2, scr, lane);
    else { r -= EW_GU; tconv_wave(wd, nullptr, 1024, (bf16_t*)(ws + WS_W_ED_T) + (size_t)e * 1024 * 256, 1024, (r & 3) * 64, (r >> 2) * 32, 0, scr, lane); }
}

__device__ __forceinline__ void phase0(CParams& p, char* lds, int wv) {
    const int tid = opaque_tid(wv), G = gridDim.x, bid = blockIdx.x;
    unsigned char* ws = p.ws;
    float* tl = (float*)lds;
    if (bid == 0) { int* cnt = (int*)(ws + WS_CNT); for (int i = tid; i < 1024; i += NTHREADS) cnt[i] = 0; }
    {
        const int lane = tid & 63, wid = tid >> 6;
        const float* x = p.in[0]; bf16_t* xb = (bf16_t*)(ws + WS_XB);
        const int tl = lane >> 3, c4 = lane & 7;
        for (int it = bid * 8 + wid; it < (T / 8) * 4; it += G * 8) {
            const int tg = it >> 2, kq = it & 3;
            const float* src = x + (size_t)(tg * 8 + tl) * 1024 + kq * 256 + c4 * 4;
            float4 v[8];
#pragma unroll
            for (int j = 0; j < 8; ++j) v[j] = ldnt4(src + j * 32);
#pragma unroll
            for (int j = 0; j < 8; ++j) {
                uint2 o; o.x = pk2(v[j].x, v[j].y); o.y = pk2(v[j].z, v[j].w);
                *(uint2*)(xb + km_off(tg * 8 + tl, (kq * 8 + j) * 32 + c4 * 4, T)) = o;
            }
        }
        const int NM = NB * NMEM * DM / 4096;
        for (int it = bid; it < NM; it += G) {
            const size_t off = (size_t)it * 4096;
            const float4 v0 = ldnt4(p.in[1] + off + tid * 8), v1 = ldnt4(p.in[1] + off + tid * 8 + 4);
            uint4 o; o.x = pk2(v0.x, v0.y); o.y = pk2(v0.z, v0.w); o.z = pk2(v1.x, v1.y); o.w = pk2(v1.z, v1.w);
            *(uint4*)((bf16_t*)(ws + WS_MEMB) + off + tid * 8) = o;
        }
    }
    {
        constexpr int I_IN = 24 * 16, I_QI = 8 * 4, I_MK = 4 * 16, I_MV = 4 * 16, I_OUT = 8 * 16;
        constexpr int NIT = I_IN + I_QI + I_MK + I_MV + I_OUT;
        for (int it = bid; it < NIT; it += G) {
            int r = it;
            if (r < I_IN) { tconv_tile(p.in[2], nullptr, 1480, (bf16_t*)(ws + WS_W_IN_T), 1024, (r % 16) * 64, (r / 16) * 64, 1, tl, tid, 1536, 0, 0); continue; } r -= I_IN;
            if (r < I_QI) { tconv_tile(p.in[8], nullptr, 512, (bf16_t*)(ws + WS_W_Q2_T), 256, (r % 4) * 64, (r / 4) * 64, 0, tl, tid, 1536, 1024, 0); continue; } r -= I_QI;
            if (r < I_MK) { tconv_tile(p.in[11], nullptr, 256, (bf16_t*)(ws + WS_W_MKV_T), 1024, (r % 16) * 64, (r / 16) * 64, 0, tl, tid); continue; } r -= I_MK;
            if (r < I_MV) { tconv_tile(p.in[12], nullptr, 256, (bf16_t*)(ws + WS_W_MKV_T) + (size_t)256 * 1024, 1024, (r % 16) * 64, (r / 16) * 64, 0, tl, tid); continue; } r -= I_MV;
            tconv_tile(p.in[13] + (size_t)512 * 1024, nullptr, 1024, (bf16_t*)(ws + WS_W_OUT2_T), 1536, (r % 8) * 64, (r / 8) * 64, 0, tl, tid, 1024, 0, 1024);
        }
        __syncthreads();
        __syncthreads();
    }
    {
        const float* wuq = p.in[5]; const float* wuk = p.in[6];
        bf16_t* dst = (bf16_t*)(ws + WS_W_Q2_T);
        for (int it = bid; it < 512; it += G) {
            const int o = it * 512 + tid, n = o >> 8, r = o & 255, h = n >> 7, cc = n & 127;
            const float* a = wuq + (size_t)r * 512 + h * 64; const float* b = wuk + (size_t)cc * 512 + h * 64;
            float s = 0.f;
#pragma unroll 4
            for (int d = 0; d < 64; d += 4) { const float4 x = *(const float4*)(a + d), y = *(const float4*)(b + d); s += x.x * y.x + x.y * y.y + x.z * y.z + x.w * y.w; }
            dst[km_off(n, r, 1536)] = f2bf(s * (0.125f * 1.4426950408889634f));
        }
    }
    {
        const float* wuv = p.in[7]; const float* wout = p.in[13];
        bf16_t* dst = (bf16_t*)(ws + WS_W_OUT2_T);
        float* Lu = tl;
        float* Lo = tl + 8192;
        for (int it = bid; it < 128; it += G) {
            const int h = it >> 4, nt = it & 15;
            __syncthreads();
#pragma unroll
            for (int i = 0; i < 16; ++i) { const int idx = tid + i * 512, cc = idx >> 6, d = idx & 63; Lu[idx] = wuv[(size_t)(cc * 8 + h) * 64 + d]; }
#pragma unroll
            for (int i = 0; i < 8; ++i) { const int idx = tid + i * 512, d = idx >> 6, n = idx & 63; Lo[idx] = wout[(size_t)(h * 64 + d) * 1024 + nt * 64 + n]; }
            __syncthreads();
            const int n = tid & 63, cg = tid >> 6;
            float acc[16];
#pragma unroll
            for (int i = 0; i < 16; ++i) acc[i] = 0.f;
            for (int d = 0; d < 64; ++d) {
                const float w = Lo[d * 64 + n];
#pragma unroll
                for (int i = 0; i < 16; ++i) acc[i] = fmaf(Lu[(cg * 16 + i) * 64 + d], w, acc[i]);
            }
            uint4 o0, o1;
            o0.x = pk2(acc[0], acc[1]); o0.y = pk2(acc[2], acc[3]); o0.z = pk2(acc[4], acc[5]); o0.w = pk2(acc[6], acc[7]);
            o1.x = pk2(acc[8], acc[9]); o1.y = pk2(acc[10], acc[11]); o1.z = pk2(acc[12], acc[13]); o1.w = pk2(acc[14], acc[15]);
            bf16_t* dp = dst + km_off(nt * 64 + n, h * 128 + cg * 16, 1024);
            *(uint4*)dp = o0; *(uint4*)(dp + 8) = o1;
        }
        __syncthreads();
    }
    {
        const float* wr = p.in[16]; bf16_t* dst = (bf16_t*)(ws + WS_W_R_T);
        for (int it = bid; it < 128; it += G) {
            const int o = it * 512 + tid, e = o >> 10, k = o & 1023;
            const float w = wr[(size_t)k * 64 + e]; const bf16_t hi = f2bf(w), lo = f2bf(w - bf2f(hi));
            dst[(size_t)e * 2048 + k] = hi; dst[(size_t)e * 2048 + 1024 + k] = hi;
            dst[(size_t)(64 + e) * 2048 + k] = lo; dst[(size_t)(64 + e) * 2048 + 1024 + k] = 0;
        }
    }
}

template <bool RESYNC>
__device__ __forceinline__ void g8_store_tile(const f32x4 (&acc)[2][2][4][2], bf16_t* C, size_t ldc, int row0, int col0, const float* w8, char* lds, int tid_, int wv) {
    const int tid = opaque_i(tid_);
    const int lane = tid & 63, wr = wv >> 2, wc = wv & 3, fr = lane & 15, fq = lane >> 4;
    char* stg = lds + LDS_STG;
    if (RESYNC) { if (wr == 0) __builtin_amdgcn_s_barrier(); }
#pragma unroll
    for (int ai = 0; ai < 2; ++ai) {
#pragma unroll
        for (int m = 0; m < 4; ++m) {
            const float sc = w8 ? w8[ai * 4 + m] : 1.f;
            char* rp = stg + (wr * 64 + m * 16 + fr) * 528 + (wc * 32 + 4 * fq) * 2;
#pragma unroll
            for (int bj = 0; bj < 2; ++bj)
#pragma unroll
                for (int n = 0; n < 2; ++n) {
                    uint2 o; o.x = pk2(acc[ai][bj][m][n][0] * sc, acc[ai][bj][m][n][1] * sc); o.y = pk2(acc[ai][bj][m][n][2] * sc, acc[ai][bj][m][n][3] * sc);
                    *(uint2*)(rp + (bj * 128 + n * 16) * 2) = o;
                }
        }
        asm volatile("s_waitcnt lgkmcnt(0)" ::: "memory"); __builtin_amdgcn_s_barrier(); asm volatile("" ::: "memory");
        uint4 v[8];
#pragma unroll
        for (int i = 0; i < 8; ++i) { const int id = tid + i * 512; v[i] = *(const uint4*)(stg + (id >> 5) * 528 + (id & 31) * 16); }
#pragma unroll
        for (int i = 0; i < 8; ++i) { const int id = tid + i * 512; *(uint4*)(C + (size_t)(row0 + ai * 128 + (id >> 5)) * ldc + col0 + (id & 31) * 8) = v[i]; }
        asm volatile("s_waitcnt lgkmcnt(0)" ::: "memory"); __builtin_amdgcn_s_barrier(); asm volatile("" ::: "memory");
    }
    if (RESYNC) { if (wr == 1) __builtin_amdgcn_s_barrier(); }
}
__device__ __forceinline__ void g8_store_proj(const f32x4 (&acc)[2][2][4][2], CParams& p, int brow, int nt, char* lds, int tid_, int wv) {
    const int tid = opaque_i(tid_);
    const int lane = tid & 63, wr = wv >> 2, wc = wv & 3, fr = lane & 15, fq = lane >> 4;
    unsigned char* ws = p.ws;
    char* stg = lds + LDS_STG;
    float* rs = (float*)(stg + 128 * 528);
    bf16_t* proj = (bf16_t*)(ws + WS_PROJ);
#pragma unroll
    for (int ai = 0; ai < 2; ++ai) {
#pragma unroll
        for (int m = 0; m < 4; ++m) {
            char* rp = stg + (wr * 64 + m * 16 + fr) * 528 + (wc * 32 + 4 * fq) * 2;
#pragma unroll
            for (int bj = 0; bj < 2; ++bj)
#pragma unroll
                for (int n = 0; n < 2; ++n) {
                    uint2 o; o.x = pk2(acc[ai][bj][m][n][0], acc[ai][bj][m][n][1]); o.y = pk2(acc[ai][bj][m][n][2], acc[ai][bj][m][n][3]);
                    *(uint2*)(rp + (bj * 128 + n * 16) * 2) = o;
                }
        }
        asm volatile("s_waitcnt lgkmcnt(0)" ::: "memory"); __builtin_amdgcn_s_barrier(); asm volatile("" ::: "memory");
        const int r0g = brow + ai * 128;
        if (nt != 0) {
            uint4 v[8];
#pragma unroll
            for (int i = 0; i < 8; ++i) { const int id = tid + i * 512; v[i] = *(const uint4*)(stg + (id >> 5) * 528 + (id & 31) * 16); }
#pragma unroll
            for (int i = 0; i < 8; ++i) { const int id = tid + i * 512; *(uint4*)(proj + (size_t)(r0g + (id >> 5)) * NPROJ + nt * 256 + (id & 31) * 8) = v[i]; }
        }
        if (nt <= 1) {
            const int row = tid >> 2, q = tid & 3;
            const int ncol = (nt == 0) ? 256 : 128, per = ncol >> 2;
            float ss = 0.f;
            for (int c = 0; c < per; c += 8) {
                float f[8]; const uint4 u = *(const uint4*)(stg + row * 528 + (q * per + c) * 2); unpack8(u, f);
#pragma unroll
                for (int j = 0; j < 8; ++j) ss = fmaf(f[j], f[j], ss);
            }
            ss += dpp_f<0xB1>(ss); ss += dpp_f<0x4E>(ss);
            if (q == 0) rs[row] = rsqrtf(ss / (float)ncol + RMS_EPS);
            asm volatile("s_waitcnt lgkmcnt(0)" ::: "memory"); __builtin_amdgcn_s_barrier(); asm volatile("" ::: "memory");
            if (nt == 0) {
                const float* gq = p.in[3]; bf16_t* cqn = (bf16_t*)(ws + WS_CQN);
#pragma unroll
                for (int i = 0; i < 8; ++i) {
                    const int id = tid + i * 512, c4 = id & 3, rw = (id >> 2) & 127, kt = id >> 9, col = kt * 32 + c4 * 8;
                    float f[8]; const uint4 u = *(const uint4*)(stg + rw * 528 + col * 2); unpack8(u, f);
                    const float r = rs[rw];
                    const float4 g0 = *(const float4*)(gq + col), g1 = *(const float4*)(gq + col + 4);
                    uint4 o; o.x = pk2(f[0] * r * g0.x, f[1] * r * g0.y); o.y = pk2(f[2] * r * g0.z, f[3] * r * g0.w); o.z = pk2(f[4] * r * g1.x, f[5] * r * g1.y); o.w = pk2(f[6] * r * g1.z, f[7] * r * g1.w);
                    *(uint4*)(cqn + km_off(r0g + rw, col, T)) = o;
                }
            } else {
                const float* gkv = p.in[4]; bf16_t* ckvn = (bf16_t*)(ws + WS_CKVN); bf16_t* kidxf = (bf16_t*)(ws + WS_KIDX);
#pragma unroll
                for (int i = 0; i < 4; ++i) {
                    const int id = tid + i * 512, rw = id >> 4, ch = id & 15, col = ch * 8;
                    float f[8]; const uint4 u = *(const uint4*)(stg + rw * 528 + col * 2); unpack8(u, f);
                    const float r = rs[rw];
                    const float4 g0 = *(const float4*)(gkv + col), g1 = *(const float4*)(gkv + col + 4);
                    uint4 o; o.x = pk2(f[0] * r * g0.x, f[1] * r * g0.y); o.y = pk2(f[2] * r * g0.z, f[3] * r * g0.w); o.z = pk2(f[4] * r * g1.x, f[5] * r * g1.y); o.w = pk2(f[6] * r * g1.z, f[7] * r * g1.w);
                    *(uint4*)(ckvn + (size_t)(r0g + rw) * 128 + col) = o;
                }
#pragma unroll
                for (int i = 0; i < 2; ++i) {
                    const int id = tid + i * 512, f16 = id & 15, fq2 = (id >> 4) & 3, kk = (id >> 6) & 1, t16 = id >> 7;
                    const uint4 u = *(const uint4*)(stg + (t16 * 16 + f16) * 528 + (128 + kk * 32 + fq2 * 8) * 2);
                    *(uint4*)(kidxf + ((size_t)(((r0g >> 4) + t16) * 2 + kk) * 64 + fq2 * 16 + f16) * 8) = u;
                }
            }
        }
        asm volatile("s_waitcnt lgkmcnt(0)" ::: "memory"); __builtin_amdgcn_s_barrier(); asm volatile("" ::: "memory");
    }
}
__device__ __forceinline__ int vblock() { const int G = gridDim.x, b = blockIdx.x; return ((G & 7) == 0) ? (b & 7) * (G >> 3) + (b >> 3) : b; }

__device__ __forceinline__ void phase1(CParams& p, char* lds, int wv) {
    const int tid = opaque_tid(wv), lane = tid & 63, wid = tid >> 6, wm = wid >> 2, wn = wid & 3;
    unsigned char* ws = p.ws;
    constexpr int I1 = (T / 256) * 6, I2 = (4096 / 128) * 2, I3 = 2 * (4096 / 128);
    {
        int it = vblock();
        g8::Src s;
        if (it < I1) { g8::km_src(s, (const bf16_t*)(ws + WS_XB), T, (it / 6) * 256, (const bf16_t*)(ws + WS_W_IN_T), 1536, (it % 6) * 256, tid); g8::kloop_issue(s, lds, wv); }
        while (it < I1) {
            const int brow = (it / 6) * 256, bcol = (it % 6) * 256;
            f32x4 acc[2][2][4][2]; g8::acc_zero(acc);
            g8::kloop(acc, s, 32, lds, tid, wv);
            it += gridDim.x;
            if (it < I1) { g8::km_src(s, (const bf16_t*)(ws + WS_XB), T, (it / 6) * 256, (const bf16_t*)(ws + WS_W_IN_T), 1536, (it % 6) * 256, tid); g8::kloop_issue(s, lds, wv); }
            g8_store_proj(acc, p, brow, bcol >> 8, lds, tid, wv);
        }
    }
    asm volatile("s_waitcnt vmcnt(0)" ::: "memory");
    __syncthreads();
    for (int it = blockIdx.x; it < I2 + I3; it += gridDim.x) {
        if (it < I2) { const int r = it; gemm_item_bf16<1>((const bf16_t*)(ws + WS_MEMB), 1024, (const bf16_t*)(ws + WS_W_MKV_T), 1024, 16, (bf16_t*)(ws + WS_KMEM), 256, (r / 2) * 128, (r % 2) * 128, lds, tid, lane, wm, wn); }
        else { const int r = it - I2;
            gemm_item_bf16<2>((const bf16_t*)(ws + WS_W_MKV_T) + (size_t)256 * 1024, 1024, (const bf16_t*)(ws + WS_MEMB), 1024, 16, (bf16_t*)(ws + WS_VTMEM), 4096, (r / 32) * 128, (r % 32) * 128, lds, tid, lane, wm, wn); }
    }
}

__device__ __forceinline__ void phase2(CParams& p, int wv) {
    const int tid = opaque_tid(wv), lane = tid & 63, wid = tid >> 6;
    unsigned char* ws = p.ws;
    const bf16_t* proj = (const bf16_t*)(ws + WS_PROJ);
    bf16_t* cqn = (bf16_t*)(ws + WS_CQN); bf16_t* ckvn = (bf16_t*)(ws + WS_CKVN);
    const float* gq = p.in[3]; const float* gkv = p.in[4];
    for (int t = blockIdx.x * 8 + wid; t < T; t += gridDim.x * 8) {
        const bf16_t* row = proj + (size_t)t * NPROJ;
        {
            const uint2 v = *(const uint2*)(row + PC_CQ + lane * 4);
            const float a = bflo(v.x), b = bfhi(v.x), c = bflo(v.y), d = bfhi(v.y);
            const float ss = wave_sum(a * a + b * b + c * c + d * d);
            const float r = rsqrtf(ss * (1.f / 256.f) + RMS_EPS);
            const float4 g = *(const float4*)(gq + lane * 4);
            uint2 o; o.x = pk2(a * r * g.x, b * r * g.y); o.y = pk2(c * r * g.z, d * r * g.w);
            *(uint2*)(cqn + km_off(t, lane * 4, T)) = o;
        }
        {
            const uint32_t v = *(const uint32_t*)(row + PC_CKV + lane * 2);
            const float a = bflo(v), b = bfhi(v);
            const float ss = wave_sum(a * a + b * b);
            const float r = rsqrtf(ss * (1.f / 128.f) + RMS_EPS);
            const float2 g = *(const float2*)(gkv + lane * 2);
            *(uint32_t*)(ckvn + (size_t)t * 128 + lane * 2) = pk2(a * r * g.x, b * r * g.y);
        }
        if (lane < 32) {
            const int dd = lane * 2;
            const size_t off = ((size_t)((t >> 4) * 2 + (dd >> 5)) * 64 + ((dd & 31) >> 3) * 16 + (t & 15)) * 8 + (dd & 7);
            *(uint32_t*)((bf16_t*)(ws + WS_KIDX) + off) = *(const uint32_t*)(row + PC_KIDX + dd);
        }
    }
}

__device__ __forceinline__ void phase3(CParams& p, char* lds, int wv) {
    const int tid = opaque_tid(wv);
    unsigned char* ws = p.ws;
    constexpr int I1 = (T / 256) * 6;
    int it = vblock();
    g8::Src s;
    if (it < I1) { g8::km_src(s, (const bf16_t*)(ws + WS_CQN), T, (it / 6) * 256, (const bf16_t*)(ws + WS_W_Q2_T), 1536, (it % 6) * 256, tid); g8::kloop_issue(s, lds, wv); }
    while (it < I1) {
        const int brow = (it / 6) * 256, bcol = (it % 6) * 256;
        f32x4 acc[2][2][4][2]; g8::acc_zero(acc);
        g8::kloop(acc, s, 8, lds, tid, wv);
        it += gridDim.x;
        if (it < I1) { g8::km_src(s, (const bf16_t*)(ws + WS_CQN), T, (it / 6) * 256, (const bf16_t*)(ws + WS_W_Q2_T), 1536, (it % 6) * 256, tid); g8::kloop_issue(s, lds, wv); }
        g8_store_tile<false>(acc, (bf16_t*)(ws + WS_Q2), 1536, brow, bcol, nullptr, lds, tid, wv);
    }
}

typedef short s16x4 __attribute__((ext_vector_type(4)));
__device__ __forceinline__ int t5_bucket(int n) {
    if (n < 16) return n;
    if (n >= 128) return 31;
    const int l = 16 + (int)(__log2f((float)n * 0.0625f) * (16.0f / 3.0f));
    return l < 31 ? l : 31;
}
__device__ __forceinline__ bf16x8 ld_frag(const bf16_t* p) { return *(const bf16x8*)p; }
__device__ __forceinline__ bf16x8 u4_as_frag(const uint4& v) { union { uint4 u; bf16x8 f; } c; c.u = v; return c.f; }

constexpr int SK_STRIDE = 2052;
constexpr int P4_SEL = 16 * SK_STRIDE * 4;
constexpr int P4_RB = P4_SEL + 16 * 256 * 2;
constexpr int P4_SELB = P4_RB + 1024;

constexpr int P4_CSCR = P4_SELB + 4096;
constexpr int P4_HIST = P4_CSCR + 2048;
template <int NREG>
__device__ __forceinline__ void select_query(const uint32_t* skrow, unsigned short* sel, unsigned char* selb, uint32_t* cscr, uint32_t* hist, int t, int lane) {
    const unsigned long long ltmask = (1ull << lane) - 1ull;
    uint32_t key[NREG];
#pragma unroll
    for (int i = 0; i < NREG; ++i) { const int s = i * 64 + lane; const uint32_t kv = skrow[s]; key[i] = (s <= t) ? kv : 0u; }
    uint32_t prefix = 0; bool exact = false;
    int nS = 0, nU = t + 1, bit = 31;
    {
        const uint32_t cand = 0x80000000u;
        int cnt = 0;
#pragma unroll
        for (int i = 0; i < NREG; ++i) cnt += __popcll(__ballot(key[i] >= cand));
        if (cnt >= 256) { prefix = cand; nU = cnt; exact = (cnt == 256); } else { nU -= cnt; nS = cnt; }
        bit = 30;
        if (!exact && nU > 64) {
            uint32_t a = 0xFFFFFFFFu, o = 0u;
#pragma unroll
            for (int i = 0; i < NREG; ++i) { const bool inU = ((key[i] ^ prefix) >> 31) == 0u && key[i] != 0u; a &= inU ? key[i] : 0xFFFFFFFFu; o |= inU ? key[i] : 0u; }
#pragma unroll
            for (int d = 1; d < 64; d <<= 1) { a &= (uint32_t)__shfl_xor((int)a, d); o |= (uint32_t)__shfl_xor((int)o, d); }
            const uint32_t diff = (a ^ o) & 0x7FFFFFFFu;
            if (diff == 0u) { prefix = a; bit = -1; }
            else {
                const int top = 31 - __clz(diff);
                const uint32_t keep = (top >= 30) ? 0u : (0x7FFFFFFFu & ~((2u << top) - 1u));
                prefix |= a & keep;
                const int nb = (top + 1 < 8) ? top + 1 : 8, shift = top + 1 - nb;
                *(uint4*)(hist + lane * 4) = make_uint4(0u, 0u, 0u, 0u);
                wave_sync();
#pragma unroll
                for (int i = 0; i < NREG; ++i) {
                    const bool inU = ((key[i] ^ prefix) >> (top + 1)) == 0u && key[i] != 0u;
                    if (inU) atomicAdd(&hist[(key[i] >> shift) & 255u], 1u);
                }
                wave_sync();
                const uint4 h4 = *(const uint4*)(hist + lane * 4);
                int suf = (int)(h4.x + h4.y + h4.z + h4.w);
#pragma unroll
                for (int d = 1; d < 64; d <<= 1) { const int v = __shfl_down(suf, d); if (lane + d < 64) suf += v; }
                const int need = 256 - nS;
                const int L = __popcll(__ballot(suf >= need)) - 1;
                const int above = (L < 63) ? __builtin_amdgcn_readlane(suf, (L + 1) & 63) : 0;
                const int hb[4] = {__builtin_amdgcn_readlane((int)h4.x, L), __builtin_amdgcn_readlane((int)h4.y, L), __builtin_amdgcn_readlane((int)h4.z, L), __builtin_amdgcn_readlane((int)h4.w, L)};
                int c = above, dig = 4 * L, inbin = 0, aboved = above;
                bool found = false;
#pragma unroll
                for (int j = 3; j >= 0; --j) { if (!found) { const int c2 = c + hb[j]; if (c2 >= need) { dig = 4 * L + j; inbin = hb[j]; aboved = c; found = true; } c = c2; } }
                prefix |= (uint32_t)dig << shift;
                nS += aboved; nU = inbin;
                exact = (nS + nU == 256);
                bit = shift - 1;
            }
        }
    }
    for (; !exact && bit >= 0 && nU > 64; --bit) {
        const uint32_t cand = prefix | (1u << bit);
        int cnt = 0;
#pragma unroll
        for (int i = 0; i < NREG; ++i) cnt += __popcll(__ballot(key[i] >= cand));
        if (cnt >= 256) { prefix = cand; nU = cnt - nS; if (cnt == 256) { exact = true; break; } }
        else { nU -= cnt - nS; nS = cnt; }
    }
    int quota = 0; bool have_quota = false;
    if (!exact && bit >= 0) {
        const int sh = bit + 1;
        int pos = 0;
        wave_sync();
#pragma unroll
        for (int i = 0; i < NREG; ++i) {
            const bool inU = (key[i] >> sh) == (prefix >> sh) && key[i] != 0u;
            const unsigned long long bu = __ballot(inU);
            if (inU) { const int d = pos + __popcll(bu & ltmask); if (d < 64) cscr[d] = key[i]; }
            pos += __popcll(bu);
        }
        wave_sync();
        const uint32_t u = (lane < pos) ? cscr[lane] : 0u;
        for (; bit >= 0; --bit) {
            const uint32_t cand = prefix | (1u << bit);
            const int cnt = nS + __popcll(__ballot(u >= cand));
            if (cnt >= 256) { prefix = cand; if (cnt == 256) { exact = true; break; } }
        }
        if (!exact) {
            if (nS + __popcll(__ballot(u >= prefix)) == 256) exact = true;
            else { quota = 256 - (nS + __popcll(__ballot(u > prefix))); have_quota = true; }
        }
    }
    if (!exact && !have_quota) {
        int cgt = 0;
#pragma unroll
        for (int i = 0; i < NREG; ++i) cgt += __popcll(__ballot(key[i] > prefix));
        quota = 256 - cgt;
    }
    int pos = 0, eqc = 0;
#pragma unroll
    for (int i = 0; i < NREG; ++i) {
        const uint32_t u = key[i];
        bool take;
        if (exact) take = (u >= prefix);
        else {
            const bool eq = (u == prefix);
            const unsigned long long beq = __ballot(eq);
            const int myeq = eqc + __popcll(beq & ltmask);
            take = (u > prefix) || (eq && myeq < quota);
            eqc += __popcll(beq);
        }
        const unsigned long long bt = __ballot(take);
        if (take) {
            const int dst = pos + __popcll(bt & ltmask); sel[dst] = (unsigned short)(i * 64 + lane);
            if (t - (i * 64 + 63) >= 128) selb[dst] = (unsigned char)31;
            else selb[dst] = (unsigned char)t5_bucket(t - (i * 64 + lane));
        }
        pos += __popcll(bt);
    }
}

__device__ __forceinline__ void dsa_item(CParams& p, int b, int t0, char* lds, int tid_in, int wv) {
    const int tid = opaque_i(tid_in);
    const int lane = tid & 63, wid = tid >> 6, fr = lane & 15, fq = lane >> 4;
    unsigned char* ws = p.ws;
    uint32_t* SK = (uint32_t*)lds;
    unsigned short* SEL = (unsigned short*)(lds + P4_SEL);
    const float* RB = (const float*)(lds + P4_RB);
    unsigned char* SELB = (unsigned char*)(lds + P4_SELB);
    const bf16_t* q2 = (const bf16_t*)(ws + WS_Q2) + ((size_t)b * SEQ + t0) * 1536;
    const bf16_t* kidx = (const bf16_t*)(ws + WS_KIDX) + (size_t)b * SEQ * 64;
    const bf16_t* ckvn = (const bf16_t*)(ws + WS_CKVN) + (size_t)b * SEQ * 128;
    __syncthreads();
    if (t0 >= 256) {
        bf16x8 qf[8][2];
#pragma unroll
        for (int h = 0; h < 8; ++h)
#pragma unroll
            for (int kk = 0; kk < 2; ++kk) qf[h][kk] = ld_frag(q2 + (size_t)fr * 1536 + 1024 + h * 64 + kk * 32 + fq * 8);
        float wv[8];
        { const uint4 v = *(const uint4*)((const bf16_t*)(ws + WS_PROJ) + ((size_t)b * SEQ + t0 + fr) * NPROJ + PC_IDXW); unpack8(v, wv); }
#pragma unroll
        for (int i = 0; i < 8; ++i) wv[i] *= IDXW_SCALE;
        const int ntile = (t0 + 16) >> 4;
        const int tq = t0 + fr;
        bf16x8 kn0 = ld_frag(kidx + (size_t)(wid * 2) * 512 + lane * 8), kn1 = ld_frag(kidx + (size_t)(wid * 2 + 1) * 512 + lane * 8);
        for (int kt = wid; kt < ntile; kt += 8) {
            const int key0 = kt * 16;
            const bf16x8 kf0 = kn0, kf1 = kn1;
            { const int kx = (kt + 8 < ntile) ? kt + 8 : kt;
              kn0 = ld_frag(kidx + (size_t)(kx * 2) * 512 + lane * 8); kn1 = ld_frag(kidx + (size_t)(kx * 2 + 1) * 512 + lane * 8); }
            float sacc[4] = {0.f, 0.f, 0.f, 0.f};
#pragma unroll
            for (int h = 0; h < 8; ++h) {
                f32x4 d = (f32x4){0.f, 0.f, 0.f, 0.f};
                d = __builtin_amdgcn_mfma_f32_16x16x32_bf16(kf0, qf[h][0], d, 0, 0, 0);
                d = __builtin_amdgcn_mfma_f32_16x16x32_bf16(kf1, qf[h][1], d, 0, 0, 0);
#pragma unroll
                for (int r = 0; r < 4; ++r) sacc[r] = fmaf(wv[h], fmaxf(d[r], 0.f), sacc[r]);
            }
            uint4 ko;
            uint32_t kk4[4];
#pragma unroll
            for (int r = 0; r < 4; ++r) {
                const int s = key0 + 4 * fq + r;
                float sc = sacc[r]; if (sc == 0.f) sc = 0.f;
                const uint32_t u = __float_as_uint(sc);
                const uint32_t key = (u & 0x80000000u) ? ~u : (u | 0x80000000u);
                kk4[r] = (s <= tq) ? key : 0u;
            }
            ko.x = kk4[0]; ko.y = kk4[1]; ko.z = kk4[2]; ko.w = kk4[3];
            *(uint4*)(SK + fr * SK_STRIDE + key0 + 4 * fq) = ko;
        }
        __syncthreads();
#pragma nounroll
        for (int qq = 0; qq < 2; ++qq) {
            const int q = wid * 2 + qq, t = t0 + q;
            uint32_t* cscr = (uint32_t*)(lds + P4_CSCR) + wid * 64;
#define DSA_SEL(N) select_query<N>(SK + q * SK_STRIDE, SEL + q * 256, SELB + q * 256, cscr, (uint32_t*)(lds + P4_HIST) + wid * 256, t, lane)
            switch (__builtin_amdgcn_readfirstlane(t0 >> 8)) {
                case 1: DSA_SEL(8); break;
                case 2: DSA_SEL(12); break;
                case 3: DSA_SEL(16); break;
                case 4: DSA_SEL(20); break;
                case 5: DSA_SEL(24); break;
                case 6: DSA_SEL(28); break;
                default: DSA_SEL(32); break;
            }
#undef DSA_SEL
        }
    } else {
        for (int qq = 0; qq < 2; ++qq) {
            const int q = wid * 2 + qq, t = t0 + q;
            for (int k = lane; k <= t; k += 64) { SEL[q * 256 + k] = (unsigned short)k; SELB[q * 256 + k] = (unsigned char)t5_bucket(t - k); }
        }
    }
    __syncthreads();
    char* vst = lds + wv * 16384;
    bf16_t* cat = (bf16_t*)(ws + WS_CAT2);
    const __amdgpu_buffer_rsrc_t rkv = g8::make_rsrc(ckvn);
#pragma nounroll
    for (int qq = 0; qq < 2; ++qq) {
        const int q = wid * 2 + qq, t = t0 + q;
        const int nsel = (t + 1 < 256) ? t + 1 : 256;
        const size_t tok = (size_t)b * SEQ + t;
        const unsigned short* selq = SEL + q * 256;
        bf16x8 qf[4];
#pragma unroll
        for (int kk = 0; kk < 4; ++kk) {
            uint4 v = make_uint4(0, 0, 0, 0);
            if (fr < 8) v = *(const uint4*)(q2 + (size_t)q * 1536 + fr * 128 + kk * 32 + fq * 8);
            qf[kk] = u4_as_frag(v);
        }
        asm volatile("" :: "v"(qf[0]), "v"(qf[1]), "v"(qf[2]), "v"(qf[3]));
        float m = -INFINITY, l = 0.f;
        f32x4 O[8];
#pragma unroll
        for (int ct = 0; ct < 8; ++ct) O[ct] = (f32x4){0.f, 0.f, 0.f, 0.f};
        const int nck = (nsel + 31) >> 5;
#define DSA_ISSUE(c) do { int sv_[8]; \
            _Pragma("unroll") for (int pc = 0; pc < 8; ++pc) sv_[pc] = (int)selq[(c) * 32 + pc * 4 + fq];     \
            _Pragma("unroll") for (int pc = 0; pc < 8; ++pc) { \
            const int row_ = pc * 4 + fq; const int k_ = (c) * 32 + row_; \
            const int s_ = (k_ < nsel) ? sv_[pc] : 0; \
            __builtin_amdgcn_raw_ptr_buffer_load_lds(rkv, (LAS void*)(vst + ((c) & 1) * 8192 + pc * 1024), 16, (unsigned)(s_ * 256 + ((fr ^ (row_ & 15)) << 4)), 0, 0, 0); } } while (0)
        DSA_ISSUE(0);
#pragma nounroll
        for (int ck = 0; ck < nck; ++ck) {
            if (ck + 1 < nck) { DSA_ISSUE(ck + 1); asm volatile("s_waitcnt vmcnt(8)" ::: "memory"); }
            else asm volatile("s_waitcnt vmcnt(0)" ::: "memory");
            const char* buf = vst + (ck & 1) * 8192;
            bf16x8 a0[4], a1[4];
#pragma unroll
            for (int kk = 0; kk < 4; ++kk) {
                const int ch = ((kk * 4 + fq) ^ fr) << 4;
                a0[kk] = *(const bf16x8*)(buf + fr * 256 + ch);
                a1[kk] = *(const bf16x8*)(buf + (16 + fr) * 256 + ch);
            }
            f32x4 d0 = (f32x4){0.f, 0.f, 0.f, 0.f}, d1 = (f32x4){0.f, 0.f, 0.f, 0.f};
#pragma unroll
            for (int kk = 0; kk < 4; ++kk) {
                d0 = __builtin_amdgcn_mfma_f32_16x16x32_bf16(a0[kk], qf[kk], d0, 0, 0, 0);
                d1 = __builtin_amdgcn_mfma_f32_16x16x32_bf16(a1[kk], qf[kk], d1, 0, 0, 0);
            }
            float lg0[4], lg1[4];
            {
                const int kb = ck * 32 + 4 * fq;
                const uint32_t bw0 = *(const uint32_t*)(SELB + q * 256 + kb), bw1 = *(const uint32_t*)(SELB + q * 256 + kb + 16);
#pragma unroll
                for (int r = 0; r < 4; ++r) {
                    const bool v0 = (kb + r) < nsel, v1 = (kb + 16 + r) < nsel;
                    const int b0 = (int)((bw0 >> (8 * r)) & 31u), b1 = (int)((bw1 >> (8 * r)) & 31u);
                    const float rb0 = RB[b0 * 8 + (fr & 7)], rb1 = RB[b1 * 8 + (fr & 7)];
                    lg0[r] = (d0[r] + rb0) + (v0 ? 0.f : -INFINITY);
                    lg1[r] = (d1[r] + rb1) + (v1 ? 0.f : -INFINITY);
                }
            }
            float cm = fmaxf(fmaxf(fmaxf(lg0[0], lg0[1]), fmaxf(lg0[2], lg0[3])), fmaxf(fmaxf(lg1[0], lg1[1]), fmaxf(lg1[2], lg1[3])));
            cm = xrow16_max(cm);
            const float mn = fmaxf(m, cm);
            const float scl = __builtin_amdgcn_exp2f(m - mn);
            float p0[4], p1[4], ls = 0.f;
#pragma unroll
            for (int r = 0; r < 4; ++r) { p0[r] = __builtin_amdgcn_exp2f(lg0[r] - mn); p1[r] = __builtin_amdgcn_exp2f(lg1[r] - mn); ls += p0[r] + p1[r]; }
            ls = xrow16_sum(ls);
            l = l * scl + ls; m = mn;
            if (__any(scl != 1.f)) {
#pragma unroll
                for (int ct = 0; ct < 8; ++ct) O[ct] = O[ct] * scl;
            }
            uint4 pf; pf.x = pk2(p0[0], p0[1]); pf.y = pk2(p0[2], p0[3]); pf.z = pk2(p1[0], p1[1]); pf.w = pk2(p1[2], p1[3]);
            const bf16x8 pfrag = u4_as_frag(pf);
#pragma unroll
            for (int ct = 0; ct < 8; ++ct) {
                const int r0 = 4 * fq + (fr >> 2), r1 = r0 + 16;
                const int chn = ct * 2 + ((fr & 3) >> 1), sub = 8 * (fr & 1);
                const s16x4 va = __builtin_amdgcn_ds_read_tr16_b64_v4i16((s16x4 LAS*)(buf + r0 * 256 + ((chn ^ (r0 & 15)) << 4) + sub));
                const s16x4 vb = __builtin_amdgcn_ds_read_tr16_b64_v4i16((s16x4 LAS*)(buf + r1 * 256 + ((chn ^ (r1 & 15)) << 4) + sub));
                bf16x8 vf; vf[0] = va[0]; vf[1] = va[1]; vf[2] = va[2]; vf[3] = va[3]; vf[4] = vb[0]; vf[5] = vb[1]; vf[6] = vb[2]; vf[7] = vb[3];
                O[ct] = __builtin_amdgcn_mfma_f32_16x16x32_bf16(vf, pfrag, O[ct], 0, 0, 0);
            }
            asm volatile("" ::: "memory");
        }
#undef DSA_ISSUE
        const float inv = 1.f / l;
        if (fr < 8) {
#pragma unroll
            for (int ct = 0; ct < 8; ++ct) {
                uint2 o; o.x = pk2(O[ct][0] * inv, O[ct][1] * inv); o.y = pk2(O[ct][2] * inv, O[ct][3] * inv);
                *(uint2*)(cat + km_off((int)tok, fr * 128 + ct * 16 + 4 * fq, T)) = o;
            }
        }
        asm volatile("s_waitcnt vmcnt(0)" ::: "memory");
    }
}

#define MA_SB() __builtin_amdgcn_sched_barrier(0)
__device__ __forceinline__ void memattn_wave(CParams& p, int b, size_t tok0, int h, int lane) {
    const int fr = lane & 15, fq = lane >> 4;
    unsigned char* ws = p.ws;
    const bf16_t* proj = (const bf16_t*)(ws + WS_PROJ) + (tok0 + fr) * NPROJ + PC_QM + h * 64;
    const bf16_t* km = (const bf16_t*)(ws + WS_KMEM) + (size_t)(b * 4 + h) * (16 * 2 * 64 * 8) + lane * 8;
    const bf16_t* vt = (const bf16_t*)(ws + WS_VTMEM) + (size_t)(b * 4 + h) * (8 * 4 * 64 * 8) + lane * 8;
    const bf16x8 qf0 = ld_frag(proj + fq * 8), qf1 = ld_frag(proj + 32 + fq * 8);
    f32x4 d[16];
    bf16x8 kb[2][8];
#pragma unroll
    for (int j = 0; j < 4; ++j) { kb[0][2 * j] = ld_frag(km + (j * 2) * 512); kb[0][2 * j + 1] = ld_frag(km + (j * 2 + 1) * 512); }
    MA_SB();
#pragma unroll
    for (int g = 0; g < 4; ++g) {
        if (g < 3) {
#pragma unroll
            for (int j = 0; j < 4; ++j) { kb[(g + 1) & 1][2 * j] = ld_frag(km + ((g * 4 + 4 + j) * 2) * 512); kb[(g + 1) & 1][2 * j + 1] = ld_frag(km + ((g * 4 + 4 + j) * 2 + 1) * 512); }
        }
        MA_SB();
#pragma unroll
        for (int j = 0; j < 4; ++j) {
            f32x4 z = (f32x4){0.f, 0.f, 0.f, 0.f};
            z = __builtin_amdgcn_mfma_f32_16x16x32_bf16(kb[g & 1][2 * j], qf0, z, 0, 0, 0);
            z = __builtin_amdgcn_mfma_f32_16x16x32_bf16(kb[g & 1][2 * j + 1], qf1, z, 0, 0, 0);
            d[g * 4 + j] = z * (0.125f * 1.4426950408889634f);
        }
        MA_SB();
    }
    bf16x8 vb[2][8];
#pragma unroll
    for (int i = 0; i < 8; ++i) vb[0][i] = ld_frag(vt + i * 512);
    MA_SB();
    float mx = -INFINITY;
#pragma unroll
    for (int kt = 0; kt < 16; ++kt) mx = fmaxf(mx, fmaxf(fmaxf(d[kt][0], d[kt][1]), fmaxf(d[kt][2], d[kt][3])));
    mx = xrow16_max(mx);
    float s = 0.f;
#pragma unroll
    for (int kt = 0; kt < 16; ++kt)
#pragma unroll
        for (int r = 0; r < 4; ++r) { d[kt][r] = __builtin_amdgcn_exp2f(d[kt][r] - mx); s += d[kt][r]; }
    s = xrow16_sum(s);
    const float inv = 1.f / s;
    f32x4 O[4];
#pragma unroll
    for (int dt = 0; dt < 4; ++dt) O[dt] = (f32x4){0.f, 0.f, 0.f, 0.f};
    MA_SB();
#pragma unroll
    for (int g = 0; g < 4; ++g) {
        if (g < 3) {
#pragma unroll
            for (int i = 0; i < 8; ++i) vb[(g + 1) & 1][i] = ld_frag(vt + ((g + 1) * 8 + i) * 512);
        }
        MA_SB();
#pragma unroll
        for (int cc = 0; cc < 2; ++cc) {
            const int c32 = g * 2 + cc;
            uint4 pf; pf.x = pk2(d[2 * c32][0], d[2 * c32][1]); pf.y = pk2(d[2 * c32][2], d[2 * c32][3]); pf.z = pk2(d[2 * c32 + 1][0], d[2 * c32 + 1][1]); pf.w = pk2(d[2 * c32 + 1][2], d[2 * c32 + 1][3]);
            const bf16x8 pfrag = u4_as_frag(pf);
#pragma unroll
            for (int dt = 0; dt < 4; ++dt) O[dt] = __builtin_amdgcn_mfma_f32_16x16x32_bf16(vb[g & 1][cc * 4 + dt], pfrag, O[dt], 0, 0, 0);
        }
        MA_SB();
    }
    bf16_t* cat = (bf16_t*)(ws + WS_CAT2);
#pragma unroll
    for (int dt = 0; dt < 4; ++dt) {
        uint2 o; o.x = pk2(O[dt][0] * inv, O[dt][1] * inv); o.y = pk2(O[dt][2] * inv, O[dt][3] * inv);
        *(uint2*)(cat + km_off((int)tok0 + fr, 1280 + h * 64 + dt * 16 + 4 * fq, T)) = o;
    }
}

__device__ __forceinline__ void conv_tokens4(CParams& p, int b, int t0, int lane) {
    unsigned char* ws = p.ws;
    const bf16_t* proj = (const bf16_t*)(ws + WS_PROJ) + (size_t)b * SEQ * NPROJ;
    const float* cw = p.in[10];
    const int c = lane * 4;
    uint2 gc[6], hh[6], gb[4];
#pragma unroll
    for (int i = 0; i < 6; ++i) {
        const int tt = t0 - 2 + i, tc = tt < 0 ? 0 : tt;
        gc[i] = *(const uint2*)(proj + (size_t)tc * NPROJ + PC_GC + c); hh[i] = *(const uint2*)(proj + (size_t)tc * NPROJ + PC_H + c);
    }
#pragma unroll
    for (int i = 0; i < 4; ++i) gb[i] = *(const uint2*)(proj + (size_t)(t0 + i) * NPROJ + PC_GB + c);
    const float4 w0 = *(const float4*)(cw + c), w1 = *(const float4*)(cw + 256 + c), w2 = *(const float4*)(cw + 512 + c);
    float u[6][4];
#pragma unroll
    for (int i = 0; i < 6; ++i) {
        const float z = (t0 - 2 + i < 0) ? 0.f : 1.f;
        u[i][0] = bflo(gc[i].x) * bflo(hh[i].x) * z; u[i][1] = bfhi(gc[i].x) * bfhi(hh[i].x) * z;
        u[i][2] = bflo(gc[i].y) * bflo(hh[i].y) * z; u[i][3] = bfhi(gc[i].y) * bfhi(hh[i].y) * z;
    }
    bf16_t* cat = (bf16_t*)(ws + WS_CAT2);
#pragma unroll
    for (int i = 0; i < 4; ++i) {
        const float y0 = fmaf(w0.x, u[i][0], fmaf(w1.x, u[i + 1][0], w2.x * u[i + 2][0]));
        const float y1 = fmaf(w0.y, u[i][1], fmaf(w1.y, u[i + 1][1], w2.y * u[i + 2][1]));
        const float y2 = fmaf(w0.z, u[i][2], fmaf(w1.z, u[i + 1][2], w2.z * u[i + 2][2]));
        const float y3 = fmaf(w0.w, u[i][3], fmaf(w1.w, u[i + 1][3], w2.w * u[i + 2][3]));
        uint2 o; o.x = pk2(bflo(gb[i].x) * y0, bfhi(gb[i].x) * y1); o.y = pk2(bflo(gb[i].y) * y2, bfhi(gb[i].y) * y3);
        *(uint2*)(cat + km_off(b * SEQ + t0 + i, 1024 + c, T)) = o;
    }
}

__device__ __forceinline__ void phase4(CParams& p, char* lds, int wv) {
    const int tid = opaque_tid(wv), lane = tid & 63, wid = tid >> 6;
    if (tid < 256) ((float*)(lds + P4_RB))[tid] = p.in[9][tid] * 1.4426950408889634f;
    const int gw = blockIdx.x * 8 + wid, NW = gridDim.x * 8;
    const int ndsa = (T / 16 - (int)blockIdx.x + (int)gridDim.x - 1) / (int)gridDim.x;
    const int new_ = (EW_ITEMS - gw + NW - 1) / NW;
    const int per = (new_ + ndsa - 1) / (ndsa > 0 ? ndsa : 1);
    int ew = gw;
    for (int i = blockIdx.x; i < T / 16; i += gridDim.x) {
        const int b = i >> 7, tau = i & 127, tile = ((b >> 1) & 1) ? 127 - tau : tau;
        dsa_item(p, b, tile * 16, lds, tid, wv);
        for (int j = 0; j < per && ew < EW_ITEMS; ++j, ew += NW) expert_w_item(p, ew, (float*)(lds + wv * 16384), opaque_i(lane));
    }
    for (; ew < EW_ITEMS; ew += NW) expert_w_item(p, ew, (float*)(lds + wv * 16384), opaque_i(lane));
    for (int i = blockIdx.x; i < T / 32; i += gridDim.x) {
        const int b = i >> 6, t0 = (i & 63) * 32 + (wid >> 2) * 16;
        memattn_wave(p, b, (size_t)b * SEQ + t0, wid & 3, opaque_i(lane));
        conv_tokens4(p, b, t0 + (wid & 3) * 4, opaque_i(lane));
    }
}

#define XB_TMO      128
#define XB_XCNT(j)  (256  + 64 * (j))
#define XB_XSUB(j)  (1280 + 64 * (j))
#define XB_XGEN(j)  (2304 + 64 * (j))
#define XB_TOP      3328
#define XB_TOPGEN   3392
#define XCD_BAR_WORDS 3456
#define XB_SPIN_CAP (1u << 22)
__device__ __forceinline__ unsigned xb_ld(unsigned* p)              { return __hip_atomic_load(p, __ATOMIC_RELAXED, __HIP_MEMORY_SCOPE_AGENT); }
__device__ __forceinline__ unsigned xb_add(unsigned* p, unsigned v) { return __hip_atomic_fetch_add(p, v, __ATOMIC_RELAXED, __HIP_MEMORY_SCOPE_AGENT); }
__device__ __forceinline__ unsigned xb_xcc_id() { return (unsigned)__builtin_amdgcn_s_getreg((3 << 11) | 20) & 0xFu; }
#define XB_SPIN(cond, bar) do { unsigned _sp = 0; while (cond) { __builtin_amdgcn_s_sleep(1); \
    if ((++_sp & 255u) == 0u) { if (xb_ld(&(bar)[XB_TMO])) break; if (_sp > XB_SPIN_CAP) { atomicAdd(&(bar)[XB_TMO], 1u); break; } } } } while (0)
__device__ __forceinline__ void phase5(CParams& p, char* lds, int wv) {
    const int tid = opaque_tid(wv);
    unsigned char* ws = p.ws;
    const float* x = p.in[0];
    constexpr int I1 = (T / 256) * 4;
    unsigned* bar = (unsigned*)(ws + WS_BAR);
    unsigned long long* lnst = (unsigned long long*)(ws + WS_LNST);
    bf16_t* x1h = (bf16_t*)(ws + WS_X1H); bf16_t* x1l = (bf16_t*)(ws + WS_X1L);
    for (int it = vblock(); it < I1; it += gridDim.x) {
        const int pm = it >> 2, pn = it & 3;
        const int brow = pm * 256, bcol = pn * 256;
        g8::Src s; g8::km_src(s, (const bf16_t*)(ws + WS_CAT2), T, brow, (const bf16_t*)(ws + WS_W_OUT2_T), 1024, bcol, tid);
        g8::kloop_issue(s, lds, wv);
        f32x4 acc[2][2][4][2]; g8::acc_zero(acc);
        g8::kloop(acc, s, 48, lds, tid, wv);
        const int te = opaque_i(tid), lane = te & 63, wr = wv >> 2, wc = wv & 3, fr = lane & 15, fq = lane >> 4;
        char* stg = lds + LDS_STG;
        float2* PS = (float2*)(stg + 32 * 1040);
        float2* SR = PS + 256;
        f32x4 vr[2][4][4];
        float4 xn[4];
#pragma unroll
        for (int i = 0; i < 4; ++i) { const int lr = wv + 8 * i; xn[i] = ldnt4(x + (size_t)(brow + (lr >> 4) * 64 + (lr & 15)) * 1024 + bcol + lane * 4); }
#pragma unroll
        for (int ai = 0; ai < 2; ++ai)
#pragma unroll
            for (int m = 0; m < 4; ++m) {
                char* rp = stg + (wr * 16 + fr) * 1040 + (wc * 32 + 4 * fq) * 4;
#pragma unroll
                for (int bj = 0; bj < 2; ++bj)
#pragma unroll
                    for (int n = 0; n < 2; ++n) *(f32x4*)(rp + (bj * 128 + n * 16) * 4) = acc[ai][bj][m][n];
                asm volatile("s_waitcnt lgkmcnt(0)" ::: "memory"); __builtin_amdgcn_s_barrier(); asm volatile("" ::: "memory");
                float4 xc[4];
#pragma unroll
                for (int i = 0; i < 4; ++i) xc[i] = xn[i];
                if (ai * 4 + m < 7) {
                    const int ai2 = (ai * 4 + m + 1) >> 2, m2 = (ai * 4 + m + 1) & 3;
#pragma unroll
                    for (int i = 0; i < 4; ++i) { const int lr = wv + 8 * i; xn[i] = ldnt4(x + (size_t)(brow + ai2 * 128 + (lr >> 4) * 64 + m2 * 16 + (lr & 15)) * 1024 + bcol + lane * 4); }
                }
#pragma unroll
                for (int i = 0; i < 4; ++i) {
                    const int lr = wv + 8 * i;
                    const f32x4 a = *(const f32x4*)(stg + lr * 1040 + lane * 16);
                    f32x4 o; o[0] = fmaf(ALPHA, xc[i].x, a[0]); o[1] = fmaf(ALPHA, xc[i].y, a[1]); o[2] = fmaf(ALPHA, xc[i].z, a[2]); o[3] = fmaf(ALPHA, xc[i].w, a[3]);
                    vr[ai][m][i] = o;
                    const float s1 = wave_sum((o[0] + o[1]) + (o[2] + o[3]));
                    const float s2 = wave_sum((o[0] * o[0] + o[1] * o[1]) + (o[2] * o[2] + o[3] * o[3]));
                    if (lane == 0) PS[ai * 128 + (lr >> 4) * 64 + m * 16 + (lr & 15)] = make_float2(s1, s2);
                }
                asm volatile("s_waitcnt lgkmcnt(0)" ::: "memory"); __builtin_amdgcn_s_barrier(); asm volatile("" ::: "memory");
            }
        if (wv < 4) {
            const float2 ps = PS[te];
            __hip_atomic_store(lnst + (size_t)(pm * 4 + pn) * 256 + te, ((unsigned long long)__float_as_uint(ps.y) << 32) | __float_as_uint(ps.x), __ATOMIC_RELAXED, __HIP_MEMORY_SCOPE_AGENT);
            asm volatile("s_waitcnt vmcnt(0)" ::: "memory");
            if (lane == 0) (void)xb_add(&bar[XCD_BAR_WORDS + 4 * pm], 1u);
            if (wv == 0) {
                XB_SPIN(xb_ld(&bar[XCD_BAR_WORDS + 4 * pm]) < 16u, bar);
                __builtin_amdgcn_fence(__ATOMIC_ACQUIRE, "agent");
            }
        }
        asm volatile("s_waitcnt vmcnt(0) lgkmcnt(0)" ::: "memory"); __builtin_amdgcn_s_barrier(); asm volatile("" ::: "memory");
        if (wv < 4) {
            float s1 = 0.f, s2 = 0.f;
#pragma unroll
            for (int t4 = 0; t4 < 4; ++t4) {
                const unsigned long long w = __hip_atomic_load(lnst + (size_t)(pm * 4 + t4) * 256 + te, __ATOMIC_RELAXED, __HIP_MEMORY_SCOPE_AGENT);
                s1 += __uint_as_float((unsigned)w); s2 += __uint_as_float((unsigned)(w >> 32));
            }
            const float mean = s1 * (1.f / 1024.f);
            const float var = fmaxf(s2 * (1.f / 1024.f) - mean * mean, 0.f);
            SR[te] = make_float2(mean, rsqrtf(var + LN_EPS));
        }
        asm volatile("s_waitcnt lgkmcnt(0)" ::: "memory"); __builtin_amdgcn_s_barrier(); asm volatile("" ::: "memory");
        {
            const float4 gg = *(const float4*)(p.in[14] + bcol + lane * 4), be = *(const float4*)(p.in[15] + bcol + lane * 4);
#pragma unroll
            for (int ai = 0; ai < 2; ++ai)
#pragma unroll
                for (int m = 0; m < 4; ++m)
#pragma unroll
                    for (int i = 0; i < 4; ++i) {
                        const int lr = wv + 8 * i, trow = ai * 128 + (lr >> 4) * 64 + m * 16 + (lr & 15);
                        const float2 sr = SR[trow];
                        const size_t go = (size_t)(brow + trow) * 1024 + bcol + lane * 4;
                        const f32x4 a = vr[ai][m][i];
                        float4 o; o.x = (a[0] - sr.x) * sr.y * gg.x + be.x; o.y = (a[1] - sr.x) * sr.y * gg.y + be.y; o.z = (a[2] - sr.x) * sr.y * gg.z + be.z; o.w = (a[3] - sr.x) * sr.y * gg.w + be.w;
                        stnt4(p.out + go, o);
                        uint2 hi; hi.x = pk2(o.x, o.y); hi.y = pk2(o.z, o.w);
                        uint2 lo; lo.x = pk2(o.x - bflo(hi.x), o.y - bfhi(hi.x)); lo.y = pk2(o.z - bflo(hi.y), o.w - bfhi(hi.y));
                        *(uint2*)(x1h + go) = hi;
                        *(uint2*)(x1l + go) = lo;
                    }
        }
        asm volatile("s_waitcnt lgkmcnt(0)" ::: "memory"); __builtin_amdgcn_s_barrier(); asm volatile("" ::: "memory");
    }
}

__device__ __forceinline__ void phase6(CParams& p, int wv) {
    const int tid = opaque_tid(wv), lane = tid & 63, wid = tid >> 6;
    unsigned char* ws = p.ws;
    const float* g = p.in[14]; const float* bb = p.in[15];
    bf16_t* x1b = (bf16_t*)(ws + WS_X1B); bf16_t* x1lo = (bf16_t*)(ws + WS_X1LO);
    for (int t0 = (blockIdx.x * 8 + wid) * 2; t0 < T; t0 += gridDim.x * 16) {
        float4 v[2][4];
#pragma unroll
        for (int u = 0; u < 2; ++u)
#pragma unroll
            for (int j = 0; j < 4; ++j) v[u][j] = ldnt4(p.out + (size_t)(t0 + u) * 1024 + lane * 4 + 256 * j);
#pragma unroll
        for (int u = 0; u < 2; ++u) {
            const int t = t0 + u;
            float* row = p.out + (size_t)t * 1024;
            float s = 0.f;
#pragma unroll
            for (int j = 0; j < 4; ++j) s += (v[u][j].x + v[u][j].y) + (v[u][j].z + v[u][j].w);
            const float mean = wave_sum(s) * (1.f / 1024.f);
            float q = 0.f;
#pragma unroll
            for (int j = 0; j < 4; ++j) { v[u][j].x -= mean; v[u][j].y -= mean; v[u][j].z -= mean; v[u][j].w -= mean; q += (v[u][j].x * v[u][j].x + v[u][j].y * v[u][j].y) + (v[u][j].z * v[u][j].z + v[u][j].w * v[u][j].w); }
            const float rstd = rsqrtf(wave_sum(q) * (1.f / 1024.f) + LN_EPS);
#pragma unroll
            for (int j = 0; j < 4; ++j) {
                const int cidx = lane * 4 + 256 * j;
                const float4 gg = *(const float4*)(g + cidx), be = *(const float4*)(bb + cidx);
                float4 o; o.x = v[u][j].x * rstd * gg.x + be.x; o.y = v[u][j].y * rstd * gg.y + be.y; o.z = v[u][j].z * rstd * gg.z + be.z; o.w = v[u][j].w * rstd * gg.w + be.w;
                stnt4(row + cidx, o);
                uint2 hi; hi.x = pk2(o.x, o.y); hi.y = pk2(o.z, o.w);
                uint2 lo; lo.x = pk2(o.x - bflo(hi.x), o.y - bfhi(hi.x)); lo.y = pk2(o.z - bflo(hi.y), o.w - bfhi(hi.y));
                *(uint2*)(x1b + (size_t)t * 1024 + cidx) = hi;
                *(uint2*)(x1lo + (size_t)t * 1024 + cidx) = lo;
            }
        }
    }
}

__device__ __forceinline__ float grp8_max(float v) {
    v = fmaxf(v, dpp_f<0xB1>(v)); v = fmaxf(v, dpp_f<0x4E>(v)); v = fmaxf(v, dpp_f<0x141>(v));
    return v;
}
constexpr int NTB = T / 128;
constexpr int TBR = NTB / NROUND;
__device__ __forceinline__ void phase7(CParams& p, char* lds, int wv) {
    const int tid = opaque_tid(wv), lane = tid & 63, wid = tid >> 6, wm = wid >> 2, wn = wid & 3;
    unsigned char* ws = p.ws;
    const int r0 = tid >> 3, c = tid & 7, fr = lane & 15, fq = lane >> 4;
    const bf16_t* Ah = (const bf16_t*)(ws + WS_X1H); const bf16_t* Al = (const bf16_t*)(ws + WS_X1L); const bf16_t* Bt = (const bf16_t*)(ws + WS_W_R_T);
    float* lg = (float*)(lds + LDS_STG);
    const float rbias = p.in[17][lane];
    int* tok_e = (int*)(ws + WS_TOK_E); float* tok_w = (float*)(ws + WS_TOK_W);
    int* tok_pos = (int*)(ws + WS_TOK_POS);
    int* cntb = (int*)(ws + WS_CNTB);
    int* hist = (int*)(lds + LDS_MISC);
    const int grp = lane >> 3;
    for (int tb = blockIdx.x; tb < NTB; tb += gridDim.x) {
        const int m0 = tb * 128;
        f32x4 acc[4][2]; acc_zero(acc);
        const bf16_t* a0 = Ah + (size_t)(m0 + r0) * 1024 + c * 8; const bf16_t* a1 = a0 + (size_t)64 * 1024;
        const bf16_t* a0b = Al + (size_t)(m0 + r0) * 1024 + c * 8; const bf16_t* a1b = a0b + (size_t)64 * 1024;
        const bf16_t* b0 = Bt + (size_t)r0 * 2048 + c * 8; const bf16_t* b1 = b0 + (size_t)64 * 2048;
        pf_kloop<32, true>(acc, a0, a1, a0b, a1b, b0, b1, lds, tid, lane, wm, wn);
        if (wn < 2) {
#pragma unroll
            for (int mi = 0; mi < 4; ++mi)
#pragma unroll
                for (int ni = 0; ni < 2; ++ni) {
                    const int m = wm * 64 + mi * 16 + fr, n = wn * 32 + ni * 16 + 4 * fq;
                    *(f32x4*)(lg + m * 64 + n) = acc[mi][ni];
                }
        }
        if (tid < 64) hist[tid] = 0;
        __syncthreads();
        if (wn >= 2) {
#pragma unroll
            for (int mi = 0; mi < 4; ++mi)
#pragma unroll
                for (int ni = 0; ni < 2; ++ni) {
                    const int m = wm * 64 + mi * 16 + fr, n = (wn - 2) * 32 + ni * 16 + 4 * fq;
                    f32x4 v = *(const f32x4*)(lg + m * 64 + n);
                    v = v + acc[mi][ni];
                    *(f32x4*)(lg + m * 64 + n) = v;
                }
        }
        __syncthreads();
        for (int j = 0; j < 16; ++j) {
            const int tl = wid * 16 + j, t = m0 + tl;
            const float lgt = lg[tl * 64 + lane];
            const float s = 1.f / (1.f + __expf(-lgt));
            const float sc = s + rbias;
            const float m1 = grp8_max(sc);
            const bool ismax = (sc == m1);
            const unsigned long long bm = __ballot(ismax);
            const int nmax = __popcll((bm >> (grp * 8)) & 0xFFull);
            const float m2 = grp8_max(ismax ? -INFINITY : sc);
            const float gscore = m1 + (nmax >= 2 ? m1 : m2);
            int grank = 0;
#pragma unroll
            for (int g2 = 0; g2 < 8; ++g2) {
                const float o = __builtin_bit_cast(float, __builtin_amdgcn_readlane(__builtin_bit_cast(int, gscore), g2 * 8));
                grank += (o > gscore || (o == gscore && g2 < grp)) ? 1 : 0;
            }
            float mv = (grank < 4) ? sc : -INFINITY;
            unsigned long long selm = 0ull;
#pragma unroll
            for (int i8 = 0; i8 < 8; ++i8) {
                const float mx = wave_max(mv);
                const unsigned long long bmx = __ballot(mv == mx);
                const unsigned long long low = bmx & (0ull - bmx);
                selm |= low;
                if ((low >> lane) & 1ull) mv = -INFINITY;
            }
            const bool selq = (selm >> lane) & 1ull;
            const int rank = __popcll(selm & ((1ull << lane) - 1ull));
            const float ssum = wave_sum(selq ? s : 0.f);
            if (selq) {
                tok_e[(size_t)t * 8 + rank] = lane;
                tok_w[(size_t)t * 8 + rank] = s / ssum * 2.5f;
                tok_pos[(size_t)t * 9 + rank] = atomicAdd(&hist[lane], 1);
            }
        }
        __syncthreads();
        if (tid < 64) cntb[tb * 64 + tid] = hist[tid];
        __syncthreads();
    }
}

__device__ __forceinline__ int cntb_partial(const int* cntb, int i0, int i1, int tid) {
    const int e = tid & 63, part = tid >> 6;
    int c = 0;
#pragma unroll 8
    for (int i = i0 + part; i < i1; i += 8) c += cntb[i * 64 + e];
    return c;
}
__device__ __forceinline__ void round_tables(CParams& p, int r, int* misc, int tid) {
    const int* cntb = (const int*)(p.ws + WS_CNTB) + (size_t)r * TBR * 64;
    __syncthreads();
    if (tid < 64) misc[tid] = 0;
    if (tid == 64) misc[64] = TR;
    __syncthreads();
    { const int c = cntb_partial(cntb, 0, TBR, tid); atomicAdd(&misc[tid & 63], c); }
    __syncthreads();
    if (tid < 64) {
        const int nb = (misc[tid] + 255) >> 8;
        int incl = nb;
#pragma unroll
        for (int d = 1; d < 64; d <<= 1) { const int v = __shfl_up(incl, d); if (tid >= d) incl += v; }
        const int excl = incl - nb;
        misc[80 + tid] = excl * 256; misc[160 + tid] = excl;
        if (tid == 63) { misc[80 + 64] = incl * 256; misc[160 + 64] = incl; misc[160 + NE1] = incl + ((TR + 255) >> 8); }
    }
    __syncthreads();
}
__device__ __forceinline__ int find_expert(const int* misc, int blk) {
    int lo = 0, hi = NE1;
#pragma unroll
    for (int i = 0; i < 7; ++i) { const int mid = (lo + hi) >> 1; if (mid < hi && misc[160 + mid] <= blk) lo = mid; else hi = mid; if (hi - lo <= 1) break; }
    while (lo + 1 <= NEXP && misc[160 + lo + 1] <= blk) ++lo;
    return lo;
}

__device__ __forceinline__ void phase9(CParams& p, char* lds, int wv) {
    const int tid = opaque_tid(wv);
    unsigned char* ws = p.ws;
    int* misc = (int*)(lds + LDS_MISC);
    const int* tok_e = (const int*)(ws + WS_TOK_E); const float* tok_w = (const float*)(ws + WS_TOK_W);
    int* tok_pos = (int*)(ws + WS_TOK_POS);
    const int* cntb = (const int*)(ws + WS_CNTB);
    for (int tb = blockIdx.x; tb < NTB; tb += gridDim.x) {
        const int r = tb / TBR;
        round_tables(p, r, misc, tid);
        if (tid < 64) misc[256 + tid] = 0;
        __syncthreads();
        { const int c = cntb_partial(cntb, r * TBR, tb, tid); atomicAdd(&misc[256 + (tid & 63)], c); }
        __syncthreads();
        int* slot_tok = (int*)(ws + WS_SLOT_TOK) + (size_t)r * CAP; float* slot_w = (float*)(ws + WS_SLOT_W) + (size_t)r * CAP;
        for (int i = tid; i < 128 * 8; i += NTHREADS) {
            const int t = tb * 128 + (i >> 3), k = i & 7;
            const int e = tok_e[(size_t)t * 8 + k];
            const int pos = misc[80 + e] + misc[256 + e] + tok_pos[(size_t)t * 9 + k];
            slot_tok[pos] = t; slot_w[pos] = tok_w[(size_t)t * 8 + k];
            tok_pos[(size_t)t * 9 + k] = pos;
        }
        if (tid < 128) {
            const int t = tb * 128 + tid, pos = misc[80 + NEXP] + (t - r * TR);
            slot_tok[pos] = t; slot_w[pos] = 1.f;
            tok_pos[(size_t)t * 9 + 8] = pos;
        }
    }
}

struct GuItem { int r, pos0, e, nt2, nvalid; };
__device__ __forceinline__ GuItem gu_decode(const int* misc0, const int (&nbase)[NROUND + 1], int git) {
    GuItem d;
    int r = 0;
#pragma unroll
    for (int rr = 1; rr < NROUND; ++rr) r += (git >= nbase[rr]) ? 1 : 0;
    int lbase = nbase[0];
#pragma unroll
    for (int rr = 1; rr < NROUND; ++rr) lbase = (r >= rr) ? nbase[rr] : lbase;
    const int it = git - lbase;
    const int* misc = misc0 + r * 256;
    const int blk = it >> 1; d.nt2 = it & 1; d.r = r;
    const int e = find_expert(misc, blk);
    d.e = __builtin_amdgcn_readfirstlane(e);
    const int rb = __builtin_amdgcn_readfirstlane(blk - misc[160 + d.e]);
    d.pos0 = __builtin_amdgcn_readfirstlane(misc[80 + d.e] + rb * 256);
    d.nvalid = __builtin_amdgcn_readfirstlane(min(256, misc[d.e] - rb * 256));
    return d;
}
constexpr int GU_AAUX = 0;
__device__ __forceinline__ void phase_gu(CParams& p, char* lds, int wv) {
    const int tid = opaque_tid(wv);
    unsigned char* ws = p.ws;
    int* misc0 = (int*)(lds + LDS_MISC);
    int nbase[NROUND + 1]; nbase[0] = 0;
#pragma unroll
    for (int r = 0; r < NROUND; ++r) { round_tables(p, r, misc0 + r * 256, tid); nbase[r + 1] = nbase[r] + __builtin_amdgcn_readfirstlane(misc0[r * 256 + 160 + NE1]) * 2; }
    const int nitems = nbase[NROUND];
    int sR, sC; g8::stage_rc(tid * 16, sR, sC);
    const __amdgpu_buffer_rsrc_t rx = g8::make_rsrc(ws + WS_X1H);
    int git = vblock();
    GuItem d; d.r = 0; d.pos0 = 0; d.e = 0; d.nt2 = 0; d.nvalid = 1;
    int tok0 = 0, tok1 = 0;
    g8::Src s;
    if (git < nitems) {
        d = gu_decode(misc0, nbase, git);
        const int* slot_tok = (const int*)(ws + WS_SLOT_TOK) + (size_t)d.r * CAP;
        tok0 = slot_tok[d.pos0 + min(sR, d.nvalid - 1)]; tok1 = slot_tok[d.pos0 + min(128 + sR, d.nvalid - 1)];
        s.ra = rx; s.rb = g8::make_rsrc((const bf16_t*)(ws + WS_W_EGU_T) + (size_t)d.e * 512 * 1024); s.bh = 128u * 64u; s.akt = 64u; s.bkt = 512u * 64u;
        s.ao[0] = (unsigned)(tok0 * 1024 + sC) * 2u; s.ao[1] = (unsigned)(tok1 * 1024 + sC) * 2u;
        s.bo = (unsigned)((d.nt2 * 256 + sR) * 32 + sC) * 2u;
        g8::kloop_issue<GU_AAUX>(s, lds, wv);
    }
    while (git < nitems) {
        const GuItem c = d;
        const int gnext = git + gridDim.x;
        if (gnext < nitems) {
            d = gu_decode(misc0, nbase, gnext);
            const int* slot_tok = (const int*)(ws + WS_SLOT_TOK) + (size_t)d.r * CAP;
            tok0 = slot_tok[d.pos0 + min(sR, d.nvalid - 1)]; tok1 = slot_tok[d.pos0 + min(128 + sR, d.nvalid - 1)];
        }
        f32x4 acc[2][2][4][2]; g8::acc_zero(acc);
        g8::kloop<GU_AAUX>(acc, s, 32, lds, tid, wv);
        git = gnext;
        if (git < nitems) {
            s.rb = g8::make_rsrc((const bf16_t*)(ws + WS_W_EGU_T) + (size_t)d.e * 512 * 1024);
            s.ao[0] = (unsigned)(tok0 * 1024 + sC) * 2u; s.ao[1] = (unsigned)(tok1 * 1024 + sC) * 2u;
            s.bo = (unsigned)((d.nt2 * 256 + sR) * 32 + sC) * 2u;
            g8::kloop_issue<GU_AAUX>(s, lds, wv);
        }
        bf16_t* hslot = (bf16_t*)(ws + WS_HSLOT) + (size_t)c.r * CAP * 256;
        {
            const int te = opaque_i(tid), lane = te & 63, wr = wv >> 2, wc = wv & 3, fr = lane & 15, fq = lane >> 4;
            char* stg = lds + LDS_STG;
#pragma unroll
            for (int ai = 0; ai < 2; ++ai)
#pragma unroll
                for (int m = 0; m < 4; ++m) {
                    char* rp = stg + (ai * 128 + wr * 64 + m * 16 + fr) * 272 + (wc * 16 + 4 * fq) * 2;
#pragma unroll
                    for (int bj = 0; bj < 2; ++bj) {
                        float hv[4];
#pragma unroll
                        for (int j = 0; j < 4; ++j) { const float g = acc[ai][bj][m][0][j], u = acc[ai][bj][m][1][j]; hv[j] = g / (1.f + __expf(-g)) * u; }
                        uint2 o; o.x = pk2(hv[0], hv[1]); o.y = pk2(hv[2], hv[3]);
                        *(uint2*)(rp + bj * 128) = o;
                    }
                }
            asm volatile("s_waitcnt lgkmcnt(0)" ::: "memory"); __builtin_amdgcn_s_barrier(); asm volatile("" ::: "memory");
            uint4 v[8];
#pragma unroll
            for (int i = 0; i < 8; ++i) { const int id = te + i * 512; v[i] = *(const uint4*)(stg + (id >> 4) * 272 + (id & 15) * 16); }
#pragma unroll
            for (int i = 0; i < 8; ++i) { const int id = te + i * 512; typedef unsigned u32x4_t __attribute__((ext_vector_type(4))); const u32x4_t ov = {v[i].x, v[i].y, v[i].z, v[i].w};
                __builtin_nontemporal_store(ov, (u32x4_t*)(hslot + km_off(c.pos0 + (id >> 4), c.nt2 * 128 + (id & 15) * 8, CAP))); }
            asm volatile("s_waitcnt lgkmcnt(0)" ::: "memory"); __builtin_amdgcn_s_barrier(); asm volatile("" ::: "memory");
        }
    }
    asm volatile("s_waitcnt vmcnt(0)" ::: "memory");
}
struct DownItem { int pos0, e, half; };
__device__ __forceinline__ DownItem down_decode(const int* misc, int it, int n2) {
    DownItem d; int blk = it >> 1; d.half = it & 1;
    if (it >= n2) { const int q = (n2 << 1) + (it - n2); blk = q >> 2; d.half = 2 + (q & 3); }
    const int e = find_expert(misc, blk);
    d.e = __builtin_amdgcn_readfirstlane(e);
    const int rb = __builtin_amdgcn_readfirstlane(blk - misc[160 + d.e]);
    d.pos0 = __builtin_amdgcn_readfirstlane(misc[80 + d.e] + rb * 256);
    return d;
}
struct DownFlush {
    bf16_t* yslot; char* lds; int pos0, half, tid, wv; float w[8];
    __device__ __forceinline__ void operator()(f32x4 (&acc)[2][2][4][2], int seg) const {
        g8_store_tile<true>(acc, yslot, 1024, pos0, (half * 2 + seg) * 256, w, lds, tid, wv);
    }
    __device__ __forceinline__ void last(f32x4 (&acc)[2][2][4][2]) const {
        g8_store_tile<false>(acc, yslot, 1024, pos0, (half * 2 + 1) * 256, w, lds, tid, wv);
    }
};
__device__ __forceinline__ void phase_down(CParams& p, int r, char* lds, int wv) {
    const int tid = opaque_tid(wv);
    unsigned char* ws = p.ws;
    int* misc = (int*)(lds + LDS_MISC);
    round_tables(p, r, misc, tid);
    const int nit2 = __builtin_amdgcn_readfirstlane(misc[160 + NE1]) * 2;
    const int n2 = (nit2 / (int)gridDim.x) * (int)gridDim.x;
    const int nitems = n2 + (nit2 - n2) * 2;
    const float* slot_w = (const float*)(ws + WS_SLOT_W) + (size_t)r * CAP;
    const bf16_t* hs = (const bf16_t*)(ws + WS_HSLOT) + (size_t)r * CAP * 256;
    const bf16_t* wed = (const bf16_t*)(ws + WS_W_ED_T);
    const int lane0 = tid & 63, wr0 = wv >> 2, fr0 = lane0 & 15;
    g8::Seg sg; sg.mask = 7; sg.lg = 3; sg.aseg = 0u; sg.bseg = 256u * 64u;
    int it = vblock();
    g8::Src s; DownItem d; float w[8];
    d.pos0 = 0; d.e = 0; d.half = 0;
#pragma unroll
    for (int i = 0; i < 8; ++i) w[i] = 0.f;
    if (it < nitems) {
        d = down_decode(misc, it, n2);
#pragma unroll
        for (int i = 0; i < 8; ++i) w[i] = slot_w[d.pos0 + (i >> 2) * 128 + wr0 * 64 + (i & 3) * 16 + fr0];
        g8::km_src(s, hs, CAP, d.pos0, wed + (size_t)d.e * 1024 * 256, 1024, d.half < 2 ? d.half * 512 : (d.half - 2) * 256, tid);
        g8::kloop_issue(s, lds, wv, sg);
        asm volatile("" :: "v"(w[0]), "v"(w[1]), "v"(w[2]), "v"(w[3]), "v"(w[4]), "v"(w[5]), "v"(w[6]), "v"(w[7]));
    }
    while (it < nitems) {
        const int single = d.half >= 2;
        const int ct_last = single ? d.half - 2 : d.half * 2 + 1;
        DownFlush fl; fl.yslot = (bf16_t*)(ws + WS_YSLOT); fl.lds = lds; fl.pos0 = d.pos0; fl.half = d.half; fl.tid = tid; fl.wv = wv;
#pragma unroll
        for (int i = 0; i < 8; ++i) fl.w[i] = w[i];
        f32x4 acc[2][2][4][2]; g8::acc_zero(acc);
        g8::kloop_ms(acc, s, single ? 8 : 16, lds, tid, wv, sg, fl);
        it += gridDim.x;
        if (it < nitems) {
            d = down_decode(misc, it, n2);
#pragma unroll
            for (int i = 0; i < 8; ++i) w[i] = slot_w[d.pos0 + (i >> 2) * 128 + wr0 * 64 + (i & 3) * 16 + fr0];
            g8::km_src(s, hs, CAP, d.pos0, wed + (size_t)d.e * 1024 * 256, 1024, d.half < 2 ? d.half * 512 : (d.half - 2) * 256, tid);
            g8::kloop_issue(s, lds, wv, sg);
        }
        g8_store_tile<false>(acc, fl.yslot, 1024, fl.pos0, ct_last * 256, fl.w, lds, tid, wv);
        if (it < nitems) asm volatile("" :: "v"(w[0]), "v"(w[1]), "v"(w[2]), "v"(w[3]), "v"(w[4]), "v"(w[5]), "v"(w[6]), "v"(w[7]));
    }
    asm volatile("s_waitcnt vmcnt(0)" ::: "memory");
}

__device__ __forceinline__ void phase_combine(CParams& p, int r, int wv) {
    const int tid = opaque_tid(wv), lane = tid & 63, wid = tid >> 6;
    unsigned char* ws = p.ws;
    const float* g = p.in[24]; const float* bb = p.in[25];
    const int* tok_pos = (const int*)(ws + WS_TOK_POS);
    const bf16_t* yslot = (const bf16_t*)(ws + WS_YSLOT);
    for (int i = blockIdx.x * 8 + wid; i < TR; i += gridDim.x * 8) {
        const int t = r * TR + i;
        float* row = p.out + (size_t)t * 1024;
        float4 v[4];
#pragma unroll
        for (int j = 0; j < 4; ++j) { v[j] = ldnt4(row + lane * 4 + 256 * j); v[j].x *= ALPHA; v[j].y *= ALPHA; v[j].z *= ALPHA; v[j].w *= ALPHA; }
        int pos[9];
#pragma unroll
        for (int k = 0; k < 9; ++k) pos[k] = tok_pos[(size_t)t * 9 + k];
        uint2 y[9][4];
#pragma unroll
        for (int k = 0; k < 9; ++k)
#pragma unroll
            for (int j = 0; j < 4; ++j) { const unsigned long long w64 = __builtin_nontemporal_load((const unsigned long long*)(yslot + (size_t)pos[k] * 1024 + lane * 4 + 256 * j)); y[k][j].x = (uint32_t)w64; y[k][j].y = (uint32_t)(w64 >> 32); }
#pragma unroll
        for (int k = 0; k < 9; ++k)
#pragma unroll
            for (int j = 0; j < 4; ++j) { v[j].x += bflo(y[k][j].x); v[j].y += bfhi(y[k][j].x); v[j].z += bflo(y[k][j].y); v[j].w += bfhi(y[k][j].y); }
        float s = 0.f;
#pragma unroll
        for (int j = 0; j < 4; ++j) s += (v[j].x + v[j].y) + (v[j].z + v[j].w);
        const float mean = wave_sum(s) * (1.f / 1024.f);
        float q = 0.f;
#pragma unroll
        for (int j = 0; j < 4; ++j) { v[j].x -= mean; v[j].y -= mean; v[j].z -= mean; v[j].w -= mean; q += (v[j].x * v[j].x + v[j].y * v[j].y) + (v[j].z * v[j].z + v[j].w * v[j].w); }
        const float rstd = rsqrtf(wave_sum(q) * (1.f / 1024.f) + LN_EPS);
#pragma unroll
        for (int j = 0; j < 4; ++j) {
            const int cidx = lane * 4 + 256 * j;
            const float4 gg = *(const float4*)(g + cidx), be = *(const float4*)(bb + cidx);
            float4 o; o.x = v[j].x * rstd * gg.x + be.x; o.y = v[j].y * rstd * gg.y + be.y; o.z = v[j].z * rstd * gg.z + be.z; o.w = v[j].w * rstd * gg.w + be.w;
            stnt4(row + cidx, o);
        }
    }
}

struct XcdBarrier { unsigned* bar; unsigned x; volatile LAS unsigned* st; };
__device__ __forceinline__ XcdBarrier xcd_barrier_post(unsigned* bar, volatile LAS unsigned* st) {
    XcdBarrier b; b.bar = bar; b.x = xb_xcc_id(); b.st = st;
    if (threadIdx.x == 0) (void)xb_add(&bar[XB_XCNT(b.x)], 1u);
    return b;
}
__device__ __forceinline__ void xcd_barrier_complete(unsigned* bar, unsigned x, unsigned& nloc, unsigned& nx) {
    const unsigned G = gridDim.x * gridDim.y * gridDim.z;
    unsigned sum, cnt, mine, sp = 0u;
    for (;;) {
        sum = 0u; cnt = 0u; mine = 0u;
#pragma unroll
        for (unsigned j = 0; j < 16; ++j) { const unsigned c = xb_ld(&bar[XB_XCNT(j)]); sum += c; cnt += (c > 0u) ? 1u : 0u; mine = (j == x) ? c : mine; }
        if (sum == G) break;
        __builtin_amdgcn_s_sleep(1);
        if ((++sp & 255u) == 0u) { if (xb_ld(&bar[XB_TMO])) break; if (sp > XB_SPIN_CAP) { atomicAdd(&bar[XB_TMO], 1u); break; } }
    }
    nloc = mine > 0u ? mine : 1u; nx = cnt > 0u ? cnt : 1u;
}
__device__ __forceinline__ void xcd_barrier(const XcdBarrier& b, int wv) {
    asm volatile("s_waitcnt vmcnt(0)" ::: "memory");
    __syncthreads();
    if (wv == 0 && lane_id() == 0) {
        unsigned* bar = b.bar;
        __builtin_amdgcn_s_waitcnt(0);
        unsigned nloc = b.st[0], nx = b.st[1];
        if (nloc == 0u) { xcd_barrier_complete(bar, b.x, nloc, nx); b.st[0] = nloc; b.st[1] = nx; }
        const unsigned old = xb_add(&bar[XB_XSUB(b.x)], 1u);
        const unsigned gen = old / nloc;
        if (old + 1u == (gen + 1u) * nloc) {
            __builtin_amdgcn_fence(__ATOMIC_RELEASE, "agent");
            asm volatile("s_waitcnt vmcnt(0)" ::: "memory");
            const unsigned og = xb_add(&bar[XB_TOP], 1u);
            const unsigned tg = og / nx;
            if (og + 1u == (tg + 1u) * nx) xb_add(&bar[XB_TOPGEN], 1u);
            else XB_SPIN(xb_ld(&bar[XB_TOPGEN]) == tg, bar);
            __builtin_amdgcn_fence(__ATOMIC_ACQUIRE, "agent");
            xb_add(&bar[XB_XGEN(b.x)], 1u);
            asm volatile("s_waitcnt vmcnt(0)" ::: "memory");
        } else {
            XB_SPIN(xb_ld(&bar[XB_XGEN(b.x)]) == gen, bar);
            __builtin_amdgcn_fence(__ATOMIC_ACQUIRE, "agent");
            asm volatile("s_waitcnt vmcnt(0)" ::: "memory");
        }
    }
    __syncthreads();
}

__global__ void __launch_bounds__(NTHREADS) fwd_megakernel(Params p_unused) {
    extern __shared__ __attribute__((aligned(16))) char lds[];
    volatile LAS unsigned* st = (volatile LAS unsigned*)(lds + LDS_BARW);
    const int wv = __builtin_amdgcn_readfirstlane((int)(threadIdx.x >> 6));
    if (threadIdx.x == 0) { st[0] = 0u; st[1] = 0u; st[2] = 0u; st[3] = 0u; }
    __syncthreads();
    const XcdBarrier gb = xcd_barrier_post((unsigned*)(kargs()->ws + WS_BAR), st);
    phase0(*kargs(), lds, wv);
    xcd_barrier(gb, wv);
    phase1(*kargs(), lds, wv);
    xcd_barrier(gb, wv);
    phase3(*kargs(), lds, wv);
    xcd_barrier(gb, wv);
    phase4(*kargs(), lds, wv);
    xcd_barrier(gb, wv);
    phase5(*kargs(), lds, wv);
    xcd_barrier(gb, wv);
    phase7(*kargs(), lds, wv);
    xcd_barrier(gb, wv);
    phase9(*kargs(), lds, wv);
    xcd_barrier(gb, wv);
    phase_gu(*kargs(), lds, wv);
    xcd_barrier(gb, wv);
    for (int r = 0; r < NROUND; ++r) {
        phase_down(*kargs(), r, lds, wv);
        xcd_barrier(gb, wv);
        phase_combine(*kargs(), r, wv);
        if (r + 1 < NROUND) xcd_barrier(gb, wv);
    }
}

extern "C" void kernel_launch(void* const* d_in, const int* in_sizes, int n_in, void* d_out, int out_size, void* d_ws, size_t ws_size, hipStream_t stream) {
    static int grid_blocks = 0;
    if (grid_blocks == 0) {
        if (n_in != 26 || out_size != T * DM || ws_size < WS_NEED) {
            fprintf(stderr, "kernel_launch: unexpected shapes (n_in %d out %d ws %zu need %zu)\n", n_in, out_size, ws_size, (size_t)WS_NEED);
            grid_blocks = -1; return;
        }
        int dev = 0, cus = 0, per_cu = 0;
        hipGetDevice(&dev);
        hipDeviceGetAttribute(&cus, hipDeviceAttributeMultiprocessorCount, dev);
        hipFuncSetAttribute((const void*)fwd_megakernel, hipFuncAttributeMaxDynamicSharedMemorySize, LDS_BYTES);
        hipOccupancyMaxActiveBlocksPerMultiprocessor(&per_cu, (const void*)fwd_megakernel, NTHREADS, LDS_BYTES);
        if (per_cu < 1) { fprintf(stderr, "kernel_launch: occupancy query says %d blocks per CU\n", per_cu); grid_blocks = -1; return; }
        grid_blocks = cus * 1;
    }
    if (grid_blocks < 0) return;
    Params p{};
    for (int i = 0; i < 26; ++i) p.in[i] = (const float*)d_in[i];
    p.out = (float*)d_out; p.ws = (unsigned char*)d_ws;
    if (hipMemsetAsync((char*)d_ws + WS_BAR, 0, 16384, stream) != hipSuccess) { fprintf(stderr, "kernel_launch: memset of barrier words failed\n"); return; }
    void* args[] = {&p};
    hipError_t e = hipLaunchCooperativeKernel((const void*)fwd_megakernel, dim3(grid_blocks), dim3(NTHREADS), args, LDS_BYTES, stream);
    if (e != hipSuccess) fprintf(stderr, "cooperative launch failed: %s (grid %d)\n", hipGetErrorString(e), grid_blocks);
}
```

```cpp
#include <hip/hip_runtime.h>
#include <stdint.h>
#include <stdio.h>

typedef unsigned short bf16_t;
typedef short bf16x8 __attribute__((ext_vector_type(8)));
typedef float f32x4 __attribute__((ext_vector_type(4)));
__device__ __forceinline__ float4 ldnt4(const float* p) { const f32x4 v = __builtin_nontemporal_load((const f32x4*)p); return make_float4(v[0], v[1], v[2], v[3]); }
__device__ __forceinline__ void stnt4(float* p, const float4& o) { const f32x4 v = {o.x, o.y, o.z, o.w}; __builtin_nontemporal_store(v, (f32x4*)p); }
#define LAS __attribute__((address_space(3)))

constexpr int DM = 1024, NB = 16, SEQ = 2048, T = NB * SEQ;
constexpr int NPROJ = 1536;
constexpr int NMEM = 256;
constexpr int NEXP = 64, NE1 = 65;
constexpr int DEXP = 256;
constexpr int NROUND = 4, TR = T / NROUND;
constexpr int CAP = 90368;
constexpr float ALPHA = 1.189207115002721f;
constexpr float LN_EPS = 1e-5f, RMS_EPS = 1e-6f;
constexpr float IDXW_SCALE = 0.04419417382415922f;
constexpr int PC_CQ = 0, PC_CKV = 256, PC_KIDX = 384, PC_IDXW = 448, PC_GB = 512, PC_GC = 768, PC_H = 1024, PC_QM = 1280;

constexpr size_t al256(size_t x) { return (x + 255) & ~(size_t)255; }
constexpr size_t WS_W_IN_T = 0;
constexpr size_t WS_W_Q2_T = WS_W_IN_T + (size_t)1536 * 1024 * 2;
constexpr size_t WS_W_MKV_T = WS_W_Q2_T + (size_t)1536 * 256 * 2;
constexpr size_t WS_W_OUT2_T = WS_W_MKV_T + (size_t)512 * 1024 * 2;
constexpr size_t WS_W_R_T = WS_W_OUT2_T + (size_t)1024 * 1536 * 2;
constexpr size_t WS_W_EGU_T = WS_W_R_T + (size_t)128 * 3072 * 2;
constexpr size_t WS_W_ED_T = WS_W_EGU_T + (size_t)NE1 * 512 * 1024 * 2;
constexpr size_t WS_CNT = WS_W_ED_T + (size_t)NE1 * 1024 * 256 * 2;
constexpr size_t WS_CNTB = WS_CNT + 4096;
constexpr size_t WS_BAR = WS_CNTB + (size_t)256 * 64 * 4;
constexpr size_t WS_TOK_E = WS_BAR + 16384;
constexpr size_t WS_TOK_W = WS_TOK_E + (size_t)T * 8 * 4;
constexpr size_t WS_TOK_POS = WS_TOK_W + (size_t)T * 8 * 4;
constexpr size_t WS_SLOT_TOK = al256(WS_TOK_POS + (size_t)T * 9 * 4);
constexpr size_t WS_SLOT_W = WS_SLOT_TOK + (size_t)NROUND * CAP * 4;
constexpr size_t WS_X1B = al256(WS_SLOT_W + (size_t)NROUND * CAP * 4);
constexpr size_t WS_B = al256(WS_X1B + (size_t)T * 1024 * 2);
constexpr size_t WS_XB = WS_B;
constexpr size_t WS_CAT2 = WS_X1B;
constexpr size_t WS_MEMB = WS_XB + (size_t)T * 1024 * 2;
constexpr size_t WS_PROJ = WS_MEMB + (size_t)4096 * 1024 * 2;
constexpr size_t WS_KMEM = WS_PROJ + (size_t)T * NPROJ * 2;
constexpr size_t WS_VTMEM = WS_KMEM + (size_t)4096 * 256 * 2;
constexpr size_t WS_KIDX = WS_VTMEM + (size_t)256 * 4096 * 2;
constexpr size_t WS_CQN = WS_KIDX + (size_t)T * 64 * 2;
constexpr size_t WS_CKVN = WS_CQN + (size_t)T * 256 * 2;
constexpr size_t WS_Q2 = WS_CKVN + (size_t)T * 128 * 2;
constexpr size_t WS_END_EARLY = WS_Q2 + (size_t)T * 1536 * 2;
constexpr size_t WS_X1LO = WS_B;
constexpr size_t WS_LOGITS = WS_X1LO + (size_t)T * 1024 * 2;
constexpr size_t WS_X1F8 = al256(WS_CAT2 + (size_t)T * 1536 * 2);
constexpr size_t WS_X1H = WS_X1F8 + (size_t)T * 1024;
constexpr size_t WS_X1L = WS_X1H + (size_t)T * 1024 * 2;
constexpr size_t WS_LNST = WS_X1L + (size_t)T * 1024 * 2;
constexpr size_t WS_YSLOT = WS_X1B;
constexpr size_t WS_HSLOT = WS_YSLOT + (size_t)CAP * 1024 * 2;
constexpr size_t WS_END_MOE = WS_HSLOT + (size_t)NROUND * CAP * 256 * 2;
static_assert(WS_X1F8 + (size_t)T * 1024 <= WS_HSLOT, "x1 fp8 must end below HSLOT");
static_assert(WS_LNST + (size_t)128 * 4 * 256 * 8 <= WS_END_EARLY, "LN statistics must fit the early region");
constexpr size_t WS_NEED = WS_END_EARLY > WS_END_MOE ? WS_END_EARLY : WS_END_MOE;

constexpr int NTHREADS = 512;
constexpr int LDS_GEMM_H = 65536;
constexpr int LDS_MISC = 139264;
constexpr int LDS_STG = 65536;
constexpr int LDS_BYTES = 155648;
constexpr int LDS_BARW = LDS_BYTES - 16;
constexpr int WAVE_LDS = 15360;

struct Params {
    const float* in[26];
    float* out;
    unsigned char* ws;
};
typedef const __attribute__((address_space(4))) Params CParams;
__device__ __forceinline__ CParams* kargs() {
    CParams* q = (CParams*)__builtin_amdgcn_kernarg_segment_ptr();
    asm volatile("" : "+s"(q));
    return q;
}

typedef __bf16 bf16x2_t __attribute__((ext_vector_type(2)));
typedef float f32x2_t __attribute__((ext_vector_type(2)));
__device__ __forceinline__ uint32_t pk2(float a, float b) {
    const f32x2_t v = {a, b};
    return __builtin_bit_cast(uint32_t, __builtin_convertvector(v, bf16x2_t));
}
__device__ __forceinline__ bf16_t f2bf(float f) { return (bf16_t)(pk2(f, 0.f) & 0xFFFFu); }
__device__ __forceinline__ float bf2f(bf16_t h) { return __uint_as_float(((uint32_t)h) << 16); }
__device__ __forceinline__ float bflo(uint32_t w) { return __uint_as_float(w << 16); }
__device__ __forceinline__ float bfhi(uint32_t w) { return __uint_as_float(w & 0xFFFF0000u); }
__device__ __forceinline__ int lane_id() { return (int)__builtin_amdgcn_mbcnt_hi(~0u, __builtin_amdgcn_mbcnt_lo(~0u, 0u)); }
__device__ __forceinline__ int opaque_tid(int wv) { int t = wv * 64 + lane_id(); asm volatile("" : "+v"(t)); return t; }
__device__ __forceinline__ int opaque_i(int t) { asm volatile("" : "+v"(t)); return t; }
__device__ __forceinline__ size_t km_off(int row, int k, int nrows) { return ((size_t)(k >> 5) * nrows + row) * 32 + (k & 31); }
__device__ __forceinline__ void wave_sync() {
    __builtin_amdgcn_fence(__ATOMIC_RELEASE, "wavefront");
    __builtin_amdgcn_wave_barrier();
    __builtin_amdgcn_fence(__ATOMIC_ACQUIRE, "wavefront");
}
template <int CTRL> __device__ __forceinline__ float dpp_f(float x) {
    return __builtin_bit_cast(float, __builtin_amdgcn_mov_dpp(__builtin_bit_cast(int, x), CTRL, 0xf, 0xf, true));
}
__device__ __forceinline__ float xrow16_max(float x) {
    auto s = __builtin_amdgcn_permlane16_swap(__float_as_uint(x), __float_as_uint(x), false, false);
    x = fmaxf(__uint_as_float(s[0]), __uint_as_float(s[1]));
    auto t = __builtin_amdgcn_permlane32_swap(__float_as_uint(x), __float_as_uint(x), false, false);
    return fmaxf(__uint_as_float(t[0]), __uint_as_float(t[1]));
}
__device__ __forceinline__ float xrow16_sum(float x) {
    auto s = __builtin_amdgcn_permlane16_swap(__float_as_uint(x), __float_as_uint(x), false, false);
    x = __uint_as_float(s[0]) + __uint_as_float(s[1]);
    auto t = __builtin_amdgcn_permlane32_swap(__float_as_uint(x), __float_as_uint(x), false, false);
    return __uint_as_float(t[0]) + __uint_as_float(t[1]);
}
__device__ __forceinline__ float wave_sum(float v) {
    v += dpp_f<0xB1>(v); v += dpp_f<0x4E>(v); v += dpp_f<0x141>(v); v += dpp_f<0x128>(v);
    return xrow16_sum(v);
}
__device__ __forceinline__ float wave_max(float v) {
    v = fmaxf(v, dpp_f<0xB1>(v)); v = fmaxf(v, dpp_f<0x4E>(v)); v = fmaxf(v, dpp_f<0x141>(v)); v = fmaxf(v, dpp_f<0x128>(v));
    return xrow16_max(v);
}
__device__ __forceinline__ uint32_t pk4_f8(float a, float b, float c, float d) {
    int p = __builtin_amdgcn_cvt_pk_fp8_f32(a, b, 0, false);
    p = __builtin_amdgcn_cvt_pk_fp8_f32(c, d, p, true);
    return (uint32_t)p;
}
__device__ __forceinline__ void unpack8(const uint4& v, float* f) {
    f[0] = bflo(v.x); f[1] = bfhi(v.x); f[2] = bflo(v.y); f[3] = bfhi(v.y);
    f[4] = bflo(v.z); f[5] = bfhi(v.z); f[6] = bflo(v.w); f[7] = bfhi(v.w);
}

template <int AMODE>
__device__ __forceinline__ void gemm_loop(f32x4 (&acc)[4][2], const bf16_t* a0, const bf16_t* a1, const bf16_t* a0b, const bf16_t* a1b,
                                          const bf16_t* b0, const bf16_t* b1, int nk, char* lds, const char* ldsH,
                                          int tid, int lane, int wm, int wn) {
    const int fr = lane & 15, fq = lane >> 4;
    const int r0 = tid >> 3, c = tid & 7;
    const int wo = r0 * 128 + ((c ^ ((r0 >> 1) & 7)) << 4);
    uint4 ra0, ra1, rb0, rb1;
    ra0 = ra1 = make_uint4(0, 0, 0, 0);
    if (AMODE != 1) { ra0 = *(const uint4*)a0; ra1 = *(const uint4*)a1; }
    rb0 = *(const uint4*)b0; rb1 = *(const uint4*)b1;
    __syncthreads();
    if (AMODE != 1) { *(uint4*)(lds + wo) = ra0; *(uint4*)(lds + wo + 8192) = ra1; }
    *(uint4*)(lds + 32768 + wo) = rb0; *(uint4*)(lds + 32768 + wo + 8192) = rb1;
    __syncthreads();
    const int swz = (fr >> 1) & 7;
    const int aoff = (wm * 64 + fr) * 128, boff = 32768 + (wn * 32 + fr) * 128;
    for (int kt = 0; kt < nk; ++kt) {
        const int cur = kt & 1;
        if (kt + 1 < nk) {
            const int k1 = kt + 1;
            if (AMODE == 0) { ra0 = *(const uint4*)(a0 + k1 * 64); ra1 = *(const uint4*)(a1 + k1 * 64); }
            if (AMODE == 2) {
                const int seg = k1 >> 4, ko = (k1 & 15) * 64;
                const bf16_t* p0 = (seg == 1) ? a0b : a0; const bf16_t* p1 = (seg == 1) ? a1b : a1;
                ra0 = *(const uint4*)(p0 + ko); ra1 = *(const uint4*)(p1 + ko);
            }
            rb0 = *(const uint4*)(b0 + k1 * 64); rb1 = *(const uint4*)(b1 + k1 * 64);
        }
        const char* pa = (AMODE == 1) ? (ldsH + kt * 16384 + aoff) : (lds + cur * 16384 + aoff);
        const char* pb = lds + cur * 16384 + boff;
#pragma unroll
        for (int kk = 0; kk < 2; ++kk) {
            const int ch = ((kk * 4 + fq) ^ swz) << 4;
            bf16x8 af[4], bfv[2];
#pragma unroll
            for (int mi = 0; mi < 4; ++mi) af[mi] = *(const bf16x8*)(pa + mi * 2048 + ch);
#pragma unroll
            for (int ni = 0; ni < 2; ++ni) bfv[ni] = *(const bf16x8*)(pb + ni * 2048 + ch);
#pragma unroll
            for (int mi = 0; mi < 4; ++mi)
#pragma unroll
                for (int ni = 0; ni < 2; ++ni)
                    acc[mi][ni] = __builtin_amdgcn_mfma_f32_16x16x32_bf16(bfv[ni], af[mi], acc[mi][ni], 0, 0, 0);
        }
        if (kt + 1 < nk) {
            const int nxt = cur ^ 1;
            if (AMODE != 1) { *(uint4*)(lds + nxt * 16384 + wo) = ra0; *(uint4*)(lds + nxt * 16384 + wo + 8192) = ra1; }
            *(uint4*)(lds + 32768 + nxt * 16384 + wo) = rb0; *(uint4*)(lds + 32768 + nxt * 16384 + wo + 8192) = rb1;
        }
        __syncthreads();
    }
}
template <int NK, bool ROUTER>
__device__ __forceinline__ void pf_kloop(f32x4 (&acc)[4][2], const bf16_t* a0, const bf16_t* a1, const bf16_t* a0b, const bf16_t* a1b,
                                             const bf16_t* b0, const bf16_t* b1, char* lds, int tid, int lane, int wm, int wn) {
    static_assert(NK % 4 == 0, "unrolled by 4");
    const int fr = lane & 15, fq = lane >> 4;
    const int r0 = tid >> 3, c = tid & 7;
    const int wo = r0 * 128 + ((c ^ ((r0 >> 1) & 7)) << 4);
    uint4 ra0_0, ra1_0, rb0_0, rb1_0, ra0_1, ra1_1, rb0_1, rb1_1, ra0_2, ra1_2, rb0_2, rb1_2, ra0_3, ra1_3, rb0_3, rb1_3;
#define RT_LOAD(s, k) do { const int k_ = (k); const int seg_ = ROUTER ? (k_ >> 4) : 0, ko_ = ROUTER ? (k_ & 15) * 64 : k_ * 64; const bf16_t* p0_ = (seg_ == 1) ? a0b : a0; const bf16_t* p1_ = (seg_ == 1) ? a1b : a1; \
        ra0_##s = *(const uint4*)(p0_ + ko_); ra1_##s = *(const uint4*)(p1_ + ko_); rb0_##s = *(const uint4*)(b0 + k_ * 64); rb1_##s = *(const uint4*)(b1 + k_ * 64); } while (0)
#define RT_STORE(s, buf) do { *(uint4*)(lds + (buf) * 16384 + wo) = ra0_##s; *(uint4*)(lds + (buf) * 16384 + wo + 8192) = ra1_##s; \
        *(uint4*)(lds + 32768 + (buf) * 16384 + wo) = rb0_##s; *(uint4*)(lds + 32768 + (buf) * 16384 + wo + 8192) = rb1_##s; } while (0)
#define RT_BAR() do { asm volatile("s_waitcnt lgkmcnt(0)" ::: "memory"); __builtin_amdgcn_s_barrier(); asm volatile("" ::: "memory"); } while (0)
    RT_LOAD(0, 0); RT_LOAD(1, 1); RT_LOAD(2, 2); RT_LOAD(3, 3);
    __syncthreads();
    RT_STORE(0, 0);
    RT_BAR();
    const int swz = (fr >> 1) & 7;
    const int aoff = (wm * 64 + fr) * 128, boff = 32768 + (wn * 32 + fr) * 128;
#define RT_STEP(j, jn) do { const int k = kt + (j); \
        RT_LOAD(j, (k + 4 < NK) ? k + 4 : NK - 1);     \
        const char* pa = lds + ((j) & 1) * 16384 + aoff; const char* pb = lds + ((j) & 1) * 16384 + boff; \
        _Pragma("unroll") for (int kk = 0; kk < 2; ++kk) { \
            const int ch = ((kk * 4 + fq) ^ swz) << 4; \
            bf16x8 af[4], bfv[2]; \
            _Pragma("unroll") for (int mi = 0; mi < 4; ++mi) af[mi] = *(const bf16x8*)(pa + mi * 2048 + ch); \
            _Pragma("unroll") for (int ni = 0; ni < 2; ++ni) bfv[ni] = *(const bf16x8*)(pb + ni * 2048 + ch); \
            _Pragma("unroll") for (int mi = 0; mi < 4; ++mi) _Pragma("unroll") for (int ni = 0; ni < 2; ++ni) \
                acc[mi][ni] = __builtin_amdgcn_mfma_f32_16x16x32_bf16(bfv[ni], af[mi], acc[mi][ni], 0, 0, 0); } \
        RT_STORE(jn, ((j) + 1) & 1); \
        RT_BAR(); } while (0)
    for (int kt = 0; kt < NK; kt += 4) {
        RT_STEP(0, 1); RT_STEP(1, 2); RT_STEP(2, 3); RT_STEP(3, 0);
    }
#undef RT_STEP
#undef RT_BAR
#undef RT_LOAD
#undef RT_STORE
}
__device__ __forceinline__ void acc_zero(f32x4 (&acc)[4][2]) {
#pragma unroll
    for (int mi = 0; mi < 4; ++mi)
#pragma unroll
        for (int ni = 0; ni < 2; ++ni) acc[mi][ni] = (f32x4){0.f, 0.f, 0.f, 0.f};
}
template <int OMODE>
__device__ __forceinline__ void gemm_item_bf16(const bf16_t* A, int lda, const bf16_t* Bt, int ldb, int nk, bf16_t* C, int ldc, int m0, int n0,
                                               char* lds, int tid, int lane, int wm, int wn) {
    const int r0 = tid >> 3, c = tid & 7;
    f32x4 acc[4][2]; acc_zero(acc);
    const bf16_t* a0 = A + (size_t)(m0 + r0) * lda + c * 8; const bf16_t* a1 = a0 + (size_t)64 * lda;
    const bf16_t* b0 = Bt + (size_t)(n0 + r0) * ldb + c * 8; const bf16_t* b1 = b0 + (size_t)64 * ldb;
    pf_kloop<16, false>(acc, a0, a1, a0, a1, b0, b1, lds, tid, lane, wm, wn);
    const int fr = lane & 15, fq = lane >> 4;
#pragma unroll
    for (int mi = 0; mi < 4; ++mi)
#pragma unroll
        for (int ni = 0; ni < 2; ++ni) {
            const int m = m0 + wm * 64 + mi * 16 + fr, n = n0 + wn * 32 + ni * 16 + 4 * fq;
            uint2 o; o.x = pk2(acc[mi][ni][0], acc[mi][ni][1]); o.y = pk2(acc[mi][ni][2], acc[mi][ni][3]);
            size_t off;
            if (OMODE == 0) off = (size_t)m * ldc + n;
            else if (OMODE == 1) {
                const int b = m >> 8, key = m & 255, h = n >> 6, d = n & 63;
                off = ((size_t)((((b * 4 + h) * 16 + (key >> 4)) * 2 + (d >> 5)) * 64 + ((d & 31) >> 3) * 16 + (key & 15))) * 8 + (d & 7);
            } else {
                const int h = m >> 6, d = m & 63, b = n >> 8, key = n & 255, k32 = key & 31;
                off = ((size_t)((((b * 4 + h) * 8 + (key >> 5)) * 4 + (d >> 4)) * 64 + ((k32 & 15) >> 2) * 16 + (d & 15))) * 8 + ((k32 >> 4) * 4);
            }
            *(uint2*)(C + off) = o;
        }
}

namespace g8 {
constexpr int HTB = 8192;
__device__ __forceinline__ int lds_byte(int r, int c) { const int ob = (r & 15) * 64 + c * 2; return (r >> 4) * 1024 + (ob ^ (((ob >> 9) & 1) << 5)); }
__device__ __forceinline__ void stage_rc(int b, int& R, int& C) { const int st = b / 1024, sb = b % 1024, swz = sb ^ (((sb >> 9) & 1) << 5); R = st * 16 + swz / 64; C = (swz % 64) / 2; }
struct Src { __amdgpu_buffer_rsrc_t ra, rb; unsigned ao[2]; unsigned bo; unsigned bh; unsigned akt, bkt; };
__device__ __forceinline__ __amdgpu_buffer_rsrc_t make_rsrc(const void* p) {
    const unsigned long long a = (unsigned long long)p;
    const unsigned lo = __builtin_amdgcn_readfirstlane((unsigned)a), hi = __builtin_amdgcn_readfirstlane((unsigned)(a >> 32));
    return __builtin_amdgcn_make_buffer_rsrc((void*)(((unsigned long long)hi << 32) | lo), 0, 0x7FFFFFFF, 0x00020000);
}
#define G8_SA(b,h) (lds + ((b) * 2 + (h)) * g8::HTB)
#define G8_SB(b,h) (lds + (4 + (b) * 2 + (h)) * g8::HTB)
#define G8_KOFF(kt, ktstride, segstride) ((((kt) & sg.mask) * (ktstride)) + (((kt) >> sg.lg) * (segstride)))
#define G8_STAGE_A(b,h,kt) __builtin_amdgcn_raw_ptr_buffer_load_lds(s.ra, (LAS void*)(G8_SA(b,h) + wv * 1024), 16, s.ao[h], G8_KOFF(kt, s.akt, sg.aseg), 0, AAUX)
#define G8_STAGE_B(b,h,kt) __builtin_amdgcn_raw_ptr_buffer_load_lds(s.rb, (LAS void*)(G8_SB(b,h) + wv * 1024), 16, s.bo, G8_KOFF(kt, s.bkt, sg.bseg) + (h) * s.bh, 0, 0)
#define G8_LDA(dst,b,h) do { _Pragma("unroll") for (int m = 0; m < 4; ++m) \
    dst[m] = *(const bf16x8*)(G8_SA(b,h) + g8::lds_byte(wr * 64 + m * 16 + fr, fq * 8)); } while (0)
#define G8_LDB(dst,b,h) do { _Pragma("unroll") for (int n = 0; n < 2; ++n) \
    dst[n] = *(const bf16x8*)(G8_SB(b,h) + g8::lds_byte(wc * 32 + n * 16 + fr, fq * 8)); } while (0)
#define G8_MMA(ai,bj,At,Bt) do { __builtin_amdgcn_s_setprio(1); \
    _Pragma("unroll") for (int m = 0; m < 4; ++m) _Pragma("unroll") for (int n = 0; n < 2; ++n) \
      acc[ai][bj][m][n] = __builtin_amdgcn_mfma_f32_16x16x32_bf16(Bt[n], At[m], acc[ai][bj][m][n], 0, 0, 0); \
    __builtin_amdgcn_s_setprio(0); } while (0)
#define G8_WAIT_V(n) asm volatile("s_waitcnt vmcnt(" #n ")" ::: "memory")
#define G8_WAIT_L(n) asm volatile("s_waitcnt lgkmcnt(" #n ")" ::: "memory")
#define G8_BAR __builtin_amdgcn_s_barrier()
#define G8_SCHED __builtin_amdgcn_sched_barrier(0)

__device__ __forceinline__ void zero_acc(f32x4 (&acc)[2][2][4][2]) {
#pragma unroll
    for (int a = 0; a < 2; ++a)
#pragma unroll
        for (int b = 0; b < 2; ++b)
#pragma unroll
            for (int m = 0; m < 4; ++m)
#pragma unroll
                for (int n = 0; n < 2; ++n) acc[a][b][m][n] = (f32x4){0.f, 0.f, 0.f, 0.f};
}
struct Seg { int mask, lg; unsigned aseg, bseg; };
__device__ __forceinline__ Seg one_seg() { Seg g; g.mask = 0x7FFFFFFF; g.lg = 30; g.aseg = 0u; g.bseg = 0u; return g; }
struct NoFlush { __device__ __forceinline__ void operator()(f32x4 (&)[2][2][4][2], int) const {} };
template <int AAUX = 0>
__device__ __forceinline__ void kloop_issue(const Src& s, char* lds, int wv, const Seg sg = one_seg()) {
    G8_STAGE_B(0, 0, 0); G8_STAGE_A(0, 0, 0);
    G8_STAGE_B(0, 1, 0); G8_STAGE_A(0, 1, 0);
}
template <class Flush, int AAUX = 0>
__device__ __forceinline__ void kloop_ms(f32x4 (&acc)[2][2][4][2], const Src& s, int nt, char* lds, int tid, int wv, const Seg sg, const Flush& flush) {
    const int lane = tid & 63, wr = wv >> 2, wc = wv & 3, fr = lane & 15, fq = lane >> 4;
    bf16x8 At[4], B0[2], B1[2];
    if (wr == 1) G8_BAR;
    G8_WAIT_V(0); G8_BAR;
    G8_STAGE_B(1, 0, 1); G8_STAGE_A(1, 0, 1); G8_STAGE_B(1, 1, 1);
    G8_WAIT_V(3); G8_BAR;
    bool drain = false;
    for (int t = 0; t < nt - 2; t += 2) {
        G8_LDB(B0, 0, 0); G8_SCHED; G8_LDA(At, 0, 0); G8_STAGE_A(1, 1, t + 1);
        G8_WAIT_L(4); G8_BAR; G8_WAIT_L(0); G8_MMA(0, 0, At, B0); G8_BAR; G8_SCHED;
        G8_LDB(B1, 0, 1); G8_STAGE_B(0, 0, t + 2);
        G8_BAR; G8_WAIT_L(0); G8_MMA(0, 1, At, B1); G8_BAR;
        G8_LDA(At, 0, 1); G8_STAGE_A(0, 0, t + 2);
        G8_BAR; G8_WAIT_L(0); G8_MMA(1, 0, At, B0); G8_BAR; G8_SCHED;
        G8_STAGE_B(0, 1, t + 2);
        if (drain) { G8_WAIT_V(0); drain = false; } else { G8_WAIT_V(3); }
        G8_BAR; G8_MMA(1, 1, At, B1); G8_BAR;
        G8_LDB(B0, 1, 0); G8_SCHED; G8_LDA(At, 1, 0); G8_STAGE_A(0, 1, t + 2);
        G8_WAIT_L(4); G8_BAR; G8_WAIT_L(0); G8_MMA(0, 0, At, B0); G8_BAR; G8_SCHED;
        G8_LDB(B1, 1, 1); G8_STAGE_B(1, 0, t + 3);
        G8_BAR; G8_WAIT_L(0); G8_MMA(0, 1, At, B1); G8_BAR;
        G8_LDA(At, 1, 1); G8_STAGE_A(1, 0, t + 3);
        G8_BAR; G8_WAIT_L(0); G8_MMA(1, 0, At, B0); G8_BAR; G8_SCHED;
        G8_STAGE_B(1, 1, t + 3);
        G8_WAIT_V(3); G8_BAR; G8_MMA(1, 1, At, B1); G8_BAR;
        if (((t + 2) & sg.mask) == 0) {
            flush(acc, ((t + 2) >> sg.lg) - 1);
            zero_acc(acc);
            drain = true;
        }
    }
    { G8_LDB(B0, 0, 0); G8_LDA(At, 0, 0); G8_STAGE_A(1, 1, nt - 1);
      G8_BAR; G8_WAIT_L(0); G8_MMA(0, 0, At, B0); G8_BAR;
      G8_LDB(B1, 0, 1); G8_BAR; G8_WAIT_L(0); G8_MMA(0, 1, At, B1); G8_BAR;
      G8_LDA(At, 0, 1); G8_WAIT_V(2); G8_BAR; G8_WAIT_L(0); G8_MMA(1, 0, At, B0); G8_MMA(1, 1, At, B1); G8_BAR; }
    { G8_LDB(B0, 1, 0); G8_LDA(At, 1, 0); G8_WAIT_V(1); G8_BAR; G8_WAIT_L(0); G8_MMA(0, 0, At, B0); G8_BAR;
      G8_LDB(B1, 1, 1); G8_WAIT_V(0); G8_BAR; G8_WAIT_L(0); G8_MMA(0, 1, At, B1); G8_BAR;
      G8_LDA(At, 1, 1); G8_BAR; G8_WAIT_L(0); G8_MMA(1, 0, At, B0); G8_MMA(1, 1, At, B1); G8_BAR; }
    if (wr == 0) G8_BAR;
}
typedef int v8i __attribute__((ext_vector_type(8)));
typedef float f32x16 __attribute__((ext_vector_type(16)));
#define F8_LDFRAG(dst, base) do { const uint4 lo_ = *(const uint4*)(base), hi_ = *(const uint4*)((base) + 512); \
    dst = (v8i){(int)lo_.x, (int)lo_.y, (int)lo_.z, (int)lo_.w, (int)hi_.x, (int)hi_.y, (int)hi_.z, (int)hi_.w}; } while (0)
#define F8_LDA(dst,b,h) do { _Pragma("unroll") for (int m = 0; m < 2; ++m) F8_LDFRAG(dst[m], G8_SA(b,h) + (wr * 2 + m) * 2048 + foff); } while (0)
#define F8_LDB(dst,b,h) do { F8_LDFRAG(dst, G8_SB(b,h) + wc * 2048 + foff); } while (0)
#define F8_MMA(ai,bj,At,Bt) do { __builtin_amdgcn_s_setprio(1); \
    _Pragma("unroll") for (int m = 0; m < 2; ++m) \
      acc[ai][bj][m] = __builtin_amdgcn_mfma_scale_f32_32x32x64_f8f6f4(Bt, At[m], acc[ai][bj][m], 0, 0, 0, 0x7F7F7F7F, 0, 0x7F7F7F7F); \
    __builtin_amdgcn_s_setprio(0); } while (0)
__device__ __forceinline__ void acc_zero_f8(f32x16 (&acc)[2][2][2]) {
#pragma unroll
    for (int a = 0; a < 2; ++a)
#pragma unroll
        for (int b = 0; b < 2; ++b)
#pragma unroll
            for (int m = 0; m < 2; ++m)
#pragma unroll
                for (int i = 0; i < 16; ++i) acc[a][b][m][i] = 0.f;
}
__device__ __forceinline__ void kloop_f8(f32x16 (&acc)[2][2][2], const Src& s, int nt, char* lds, int tid, int wv) {
    constexpr int AAUX = 0;
    const Seg sg = one_seg();
    const int lane = tid & 63, wr = wv >> 2, wc = wv & 3;
    const int foff = (lane >> 5) * 1024 + (lane & 31) * 16;
    v8i At[2], B0, B1;
    if (wr == 1) G8_BAR;
    G8_WAIT_V(0); G8_BAR;
    G8_STAGE_B(1, 0, 1); G8_STAGE_A(1, 0, 1); G8_STAGE_B(1, 1, 1);
    G8_WAIT_V(3); G8_BAR;
    for (int t = 0; t < nt - 2; t += 2) {
        F8_LDB(B0, 0, 0); G8_SCHED; F8_LDA(At, 0, 0); G8_STAGE_A(1, 1, t + 1);
        G8_WAIT_L(4); G8_BAR; G8_WAIT_L(0); F8_MMA(0, 0, At, B0); G8_BAR; G8_SCHED;
        F8_LDB(B1, 0, 1); G8_STAGE_B(0, 0, t + 2);
        G8_BAR; G8_WAIT_L(0); F8_MMA(0, 1, At, B1); G8_BAR;
        F8_LDA(At, 0, 1); G8_STAGE_A(0, 0, t + 2);
        G8_BAR; G8_WAIT_L(0); F8_MMA(1, 0, At, B0); G8_BAR; G8_SCHED;
        G8_STAGE_B(0, 1, t + 2);
        G8_WAIT_V(3);
        G8_BAR; F8_MMA(1, 1, At, B1); G8_BAR;
        F8_LDB(B0, 1, 0); G8_SCHED; F8_LDA(At, 1, 0); G8_STAGE_A(0, 1, t + 2);
        G8_WAIT_L(4); G8_BAR; G8_WAIT_L(0); F8_MMA(0, 0, At, B0); G8_BAR; G8_SCHED;
        F8_LDB(B1, 1, 1); G8_STAGE_B(1, 0, t + 3);
        G8_BAR; G8_WAIT_L(0); F8_MMA(0, 1, At, B1); G8_BAR;
        F8_LDA(At, 1, 1); G8_STAGE_A(1, 0, t + 3);
        G8_BAR; G8_WAIT_L(0); F8_MMA(1, 0, At, B0); G8_BAR; G8_SCHED;
        G8_STAGE_B(1, 1, t + 3);
        G8_WAIT_V(3); G8_BAR; F8_MMA(1, 1, At, B1); G8_BAR;
    }
    { F8_LDB(B0, 0, 0); F8_LDA(At, 0, 0); G8_STAGE_A(1, 1, nt - 1);
      G8_BAR; G8_WAIT_L(0); F8_MMA(0, 0, At, B0); G8_BAR;
      F8_LDB(B1, 0, 1); G8_BAR; G8_WAIT_L(0); F8_MMA(0, 1, At, B1); G8_BAR;
      F8_LDA(At, 0, 1); G8_WAIT_V(2); G8_BAR; G8_WAIT_L(0); F8_MMA(1, 0, At, B0); F8_MMA(1, 1, At, B1); G8_BAR; }
    { F8_LDB(B0, 1, 0); F8_LDA(At, 1, 0); G8_WAIT_V(1); G8_BAR; G8_WAIT_L(0); F8_MMA(0, 0, At, B0); G8_BAR;
      F8_LDB(B1, 1, 1); G8_WAIT_V(0); G8_BAR; G8_WAIT_L(0); F8_MMA(0, 1, At, B1); G8_BAR;
      F8_LDA(At, 1, 1); G8_BAR; G8_WAIT_L(0); F8_MMA(1, 0, At, B0); F8_MMA(1, 1, At, B1); G8_BAR; }
    if (wr == 0) G8_BAR;
}
template <int AAUX = 0>
__device__ __forceinline__ void kloop(f32x4 (&acc)[2][2][4][2], const Src& s, int nt, char* lds, int tid, int wv) {
    kloop_ms<NoFlush, AAUX>(acc, s, nt, lds, tid, wv, one_seg(), NoFlush());
}
__device__ __forceinline__ void acc_zero(f32x4 (&acc)[2][2][4][2]) {
#pragma unroll
    for (int a = 0; a < 2; ++a)
#pragma unroll
        for (int b = 0; b < 2; ++b)
#pragma unroll
            for (int m = 0; m < 4; ++m)
#pragma unroll
                for (int n = 0; n < 2; ++n) acc[a][b][m][n] = (f32x4){0.f, 0.f, 0.f, 0.f};
}
__device__ __forceinline__ void dense_src(Src& s, const bf16_t* A, int lda, int brow, const bf16_t* B, int ldb, int bcol, int tid) {
    s.ra = make_rsrc(A); s.rb = make_rsrc(B); s.bh = (unsigned)(128 * ldb * 2); s.akt = 64u; s.bkt = 64u;
    int R, C; stage_rc(tid * 16, R, C);
    s.bo = (unsigned)((bcol + R) * ldb + C) * 2u;
#pragma unroll
    for (int h = 0; h < 2; ++h) s.ao[h] = (unsigned)((brow + h * 128 + R) * lda + C) * 2u;
}
__device__ __forceinline__ void km_src(Src& s, const bf16_t* A, int anrows, int brow, const bf16_t* B, int bnrows, int bcol, int tid) {
    s.ra = make_rsrc(A); s.rb = make_rsrc(B); s.bh = 128u * 64u; s.akt = (unsigned)anrows * 64u; s.bkt = (unsigned)bnrows * 64u;
    int R, C; stage_rc(tid * 16, R, C);
    s.bo = (unsigned)((bcol + R) * 32 + C) * 2u;
#pragma unroll
    for (int h = 0; h < 2; ++h) s.ao[h] = (unsigned)((brow + h * 128 + R) * 32 + C) * 2u;
}
}

__device__ __forceinline__ void tconv_tile(const float* src, const float* src2, int ld_src, bf16_t* dst, int ld_dst, int k0, int n0, int mode, float* tl, int tid, int kmrows = 0, int kmrow0 = 0, int kmk0 = 0) {
    __syncthreads();
    {
        const int nn = tid & 63, kb = tid >> 6;
        const int np = n0 + nn;
        const float* s = src; int sc = np;
        if (mode == 1) sc = (np < 456) ? np : (np < 512 ? -1 : np - 56);
        if (mode == 2) { s = ((np >> 4) & 1) ? src2 : src; sc = 16 * (np >> 5) + (np & 15); }
#pragma unroll
        for (int i = 0; i < 8; ++i) {
            const int kk = kb + i * 8;
            tl[kk * 65 + nn] = (sc >= 0) ? s[(size_t)(k0 + kk) * ld_src + sc] : 0.f;
        }
    }
    __syncthreads();
    {
        const int n2 = tid >> 3, kc = tid & 7;
        const float* s = tl + (kc * 8) * 65 + n2;
        uint4 o; o.x = pk2(s[0], s[65]); o.y = pk2(s[130], s[195]); o.z = pk2(s[260], s[325]); o.w = pk2(s[390], s[455]);
        if (kmrows) *(uint4*)(dst + km_off(kmrow0 + n0 + n2, kmk0 + k0 + kc * 8, kmrows)) = o;
        else *(uint4*)(dst + (size_t)(n0 + n2) * ld_dst + k0 + kc * 8) = o;
    }
}

__device__ __forceinline__ void tconv_wave(const float* src, const float* src2, int ld_src, bf16_t* dst, int kmrows, int k0, int n0, int mode, float* scr, int lane) {
    const int nn = lane & 31, np = n0 + nn, par = lane >> 5;
    const float* s = src; int sc = np;
    if (mode == 2) { s = ((np >> 4) & 1) ? src2 : src; sc = 16 * (np >> 5) + (np & 15); }
    float v[32];
#pragma unroll
    for (int i = 0; i < 32; ++i) v[i] = __builtin_nontemporal_load(s + (size_t)(k0 + 2 * i + par) * ld_src + sc);
    wave_sync();
#pragma unroll
    for (int i = 0; i < 32; ++i) scr[(2 * i + par) * 33 + nn] = v[i];
    wave_sync();
    const int c = lane & 7;
#pragma unroll
    for (int j = 0; j < 4; ++j) {
        const int n = (lane >> 3) + 8 * j;
        const float* sp = scr + (8 * c) * 33 + n;
        uint4 o; o.x = pk2(sp[0], sp[33]); o.y = pk2(sp[66], sp[99]); o.z = pk2(sp[132], sp[165]); o.w = pk2(sp[198], sp[231]);
        { typedef unsigned u32x4_t __attribute__((ext_vector_type(4))); const u32x4_t ov = {o.x, o.y, o.z, o.w};
          __builtin_nontemporal_store(ov, (u32x4_t*)(dst + km_off(n0 + n, k0 + 8 * c, kmrows))); }
    }
}

constexpr int EW_GU = 16 * 16, EW_DN = 4 * 32, EW_EX = EW_GU + EW_DN, EW_ITEMS = NE1 * EW_EX;
constexpr float W8_SCALE = 32.f;
__device__ __forceinline__ void tconv_wave_f8(const float* src, const float* src2, unsigned char* dst8, int k0, int n0, float* scr, int lane) {
    const int nn = lane & 31, np = n0 + nn, par = lane >> 5;
    const float* s = ((np >> 3) & 1) ? src2 : src; const int sc = 8 * (np >> 4) + (np & 7);
    float v[32];
#pragma unroll
    for (int i = 0; i < 32; ++i) v[i] = __builtin_nontemporal_load(s + (size_t)(k0 + 2 * i + par) * 256 + sc);
    wave_sync();
#pragma unroll
    for (int i = 0; i < 32; ++i) scr[(2 * i + par) * 33 + nn] = v[i];
    wave_sync();
    unsigned char* gb = dst8 + ((size_t)((k0 >> 6) * 16 + (n0 >> 5)) * 4) * 512;
#pragma unroll
    for (int cc = 0; cc < 2; ++cc) {
        const int c = par * 2 + cc;
        const float* sp = scr + (c * 16) * 33 + nn;
        uint4 o;
        o.x = pk4_f8(sp[0] * W8_SCALE, sp[33] * W8_SCALE, sp[66] * W8_SCALE, sp[99] * W8_SCALE);
        o.y = pk4_f8(sp[132] * W8_SCALE, sp[165] * W8_SCALE, sp[198] * W8_SCALE, sp[231] * W8_SCALE);
        o.z = pk4_f8(sp[264] * W8_SCALE, sp[297] * W8_SCALE, sp[330] * W8_SCALE, sp[363] * W8_SCALE);
        o.w = pk4_f8(sp[396] * W8_SCALE, sp[429] * W8_SCALE, sp[462] * W8_SCALE, sp[495] * W8_SCALE);
        { typedef unsigned u32x4_t __attribute__((ext_vector_type(4))); const u32x4_t ov = {o.x, o.y, o.z, o.w};
          __builtin_nontemporal_store(ov, (u32x4_t*)(gb + c * 512 + nn * 16)); }
    }
}
__device__ __forceinline__ void expert_w_item(CParams& p, int it, float* scr, int lane) {
    unsigned char* ws = p.ws;
    const int e = it / EW_EX; int r = it - e * EW_EX;
    const float* wg = (e < NEXP) ? p.in[18] + (size_t)e * 1024 * 256 : p.in[21];
    const float* wu = (e < NEXP) ? p.in[19] + (size_t)e * 1024 * 256 : p.in[22];
    const float* wd = (e < NEXP) ? p.in[20] + (size_t)e * 256 * 1024 : p.in[23];
    if (r < EW_GU) tconv_wave_f8(wg, wu, ws + WS_W_EGU_T + (size_t)e * 524288, (r & 15) * 64, (r >> 4) * 32, scr, lane);
    else { r -= EW_GU; tconv_wave(wd, nullptr, 1024, (bf16_t*)(ws + WS_W_ED_T) + (size_t)e * 1024 * 256, 1024, (r & 3) * 64, (r >> 2) * 32, 0, scr, lane); }
}

__device__ __forceinline__ void phase0(CParams& p, char* lds, int wv) {
    const int tid = opaque_tid(wv), G = gridDim.x, bid = blockIdx.x;
    unsigned char* ws = p.ws;
    float* tl = (float*)lds;
    if (bid == 0) { int* cnt = (int*)(ws + WS_CNT); for (int i = tid; i < 1024; i += NTHREADS) cnt[i] = 0; }
    {
        const int lane = tid & 63, wid = tid >> 6;
        const float* x = p.in[0]; bf16_t* xb = (bf16_t*)(ws + WS_XB);
        const int tl = lane >> 3, c4 = lane & 7;
        for (int it = bid * 8 + wid; it < (T / 8) * 4; it += G * 8) {
            const int tg = it >> 2, kq = it & 3;
            const float* src = x + (size_t)(tg * 8 + tl) * 1024 + kq * 256 + c4 * 4;
            float4 v[8];
#pragma unroll
            for (int j = 0; j < 8; ++j) v[j] = ldnt4(src + j * 32);
#pragma unroll
            for (int j = 0; j < 8; ++j) {
                uint2 o; o.x = pk2(v[j].x, v[j].y); o.y = pk2(v[j].z, v[j].w);
                *(uint2*)(xb + km_off(tg * 8 + tl, (kq * 8 + j) * 32 + c4 * 4, T)) = o;
            }
        }
        const int NM = NB * NMEM * DM / 4096;
        for (int it = bid; it < NM; it += G) {
            const size_t off = (size_t)it * 4096;
            const float4 v0 = ldnt4(p.in[1] + off + tid * 8), v1 = ldnt4(p.in[1] + off + tid * 8 + 4);
            uint4 o; o.x = pk2(v0.x, v0.y); o.y = pk2(v0.z, v0.w); o.z = pk2(v1.x, v1.y); o.w = pk2(v1.z, v1.w);
            *(uint4*)((bf16_t*)(ws + WS_MEMB) + off + tid * 8) = o;
        }
    }
    {
        constexpr int I_IN = 24 * 16, I_QI = 8 * 4, I_MK = 4 * 16, I_MV = 4 * 16, I_OUT = 8 * 16;
        constexpr int NIT = I_IN + I_QI + I_MK + I_MV + I_OUT;
        for (int it = bid; it < NIT; it += G) {
            int r = it;
            if (r < I_IN) { tconv_tile(p.in[2], nullptr, 1480, (bf16_t*)(ws + WS_W_IN_T), 1024, (r % 16) * 64, (r / 16) * 64, 1, tl, tid, 1536, 0, 0); continue; } r -= I_IN;
            if (r < I_QI) { tconv_tile(p.in[8], nullptr, 512, (bf16_t*)(ws + WS_W_Q2_T), 256, (r % 4) * 64, (r / 4) * 64, 0, tl, tid, 1536, 1024, 0); continue; } r -= I_QI;
            if (r < I_MK) { tconv_tile(p.in[11], nullptr, 256, (bf16_t*)(ws + WS_W_MKV_T), 1024, (r % 16) * 64, (r / 16) * 64, 0, tl, tid); continue; } r -= I_MK;
            if (r < I_MV) { tconv_tile(p.in[12], nullptr, 256, (bf16_t*)(ws + WS_W_MKV_T) + (size_t)256 * 1024, 1024, (r % 16) * 64, (r / 16) * 64, 0, tl, tid); continue; } r -= I_MV;
            tconv_tile(p.in[13] + (size_t)512 * 1024, nullptr, 1024, (bf16_t*)(ws + WS_W_OUT2_T), 1536, (r % 8) * 64, (r / 8) * 64, 0, tl, tid, 1024, 0, 1024);
        }
        __syncthreads();
        __syncthreads();
    }
    {
        const float* wuq = p.in[5]; const float* wuk = p.in[6];
        bf16_t* dst = (bf16_t*)(ws + WS_W_Q2_T);
        for (int it = bid; it < 512; it += G) {
            const int o = it * 512 + tid, n = o >> 8, r = o & 255, h = n >> 7, cc = n & 127;
            const float* a = wuq + (size_t)r * 512 + h * 64; const float* b = wuk + (size_t)cc * 512 + h * 64;
            float s = 0.f;
#pragma unroll 4
            for (int d = 0; d < 64; d += 4) { const float4 x = *(const float4*)(a + d), y = *(const float4*)(b + d); s += x.x * y.x + x.y * y.y + x.z * y.z + x.w * y.w; }
            dst[km_off(n, r, 1536)] = f2bf(s * (0.125f * 1.4426950408889634f));
        }
    }
    {
        const float* wuv = p.in[7]; const float* wout = p.in[13];
        bf16_t* dst = (bf16_t*)(ws + WS_W_OUT2_T);
        float* Lu = tl;
        float* Lo = tl + 8192;
        for (int it = bid; it < 128; it += G) {
            const int h = it >> 4, nt = it & 15;
            __syncthreads();
#pragma unroll
            for (int i = 0; i < 16; ++i) { const int idx = tid + i * 512, cc = idx >> 6, d = idx & 63; Lu[idx] = wuv[(size_t)(cc * 8 + h) * 64 + d]; }
#pragma unroll
            for (int i = 0; i < 8; ++i) { const int idx = tid + i * 512, d = idx >> 6, n = idx & 63; Lo[idx] = wout[(size_t)(h * 64 + d) * 1024 + nt * 64 + n]; }
            __syncthreads();
            const int n = tid & 63, cg = tid >> 6;
            float acc[16];
#pragma unroll
            for (int i = 0; i < 16; ++i) acc[i] = 0.f;
            for (int d = 0; d < 64; ++d) {
                const float w = Lo[d * 64 + n];
#pragma unroll
                for (int i = 0; i < 16; ++i) acc[i] = fmaf(Lu[(cg * 16 + i) * 64 + d], w, acc[i]);
            }
            uint4 o0, o1;
            o0.x = pk2(acc[0], acc[1]); o0.y = pk2(acc[2], acc[3]); o0.z = pk2(acc[4], acc[5]); o0.w = pk2(acc[6], acc[7]);
            o1.x = pk2(acc[8], acc[9]); o1.y = pk2(acc[10], acc[11]); o1.z = pk2(acc[12], acc[13]); o1.w = pk2(acc[14], acc[15]);
            bf16_t* dp = dst + km_off(nt * 64 + n, h * 128 + cg * 16, 1024);
            *(uint4*)dp = o0; *(uint4*)(dp + 8) = o1;
        }
        __syncthreads();
    }
    {
        const float* wr = p.in[16]; bf16_t* dst = (bf16_t*)(ws + WS_W_R_T);
        for (int it = bid; it < 128; it += G) {
            const int o = it * 512 + tid, e = o >> 10, k = o & 1023;
            const float w = wr[(size_t)k * 64 + e]; const bf16_t hi = f2bf(w), lo = f2bf(w - bf2f(hi));
            dst[(size_t)e * 2048 + k] = hi; dst[(size_t)e * 2048 + 1024 + k] = hi;
            dst[(size_t)(64 + e) * 2048 + k] = lo; dst[(size_t)(64 + e) * 2048 + 1024 + k] = 0;
        }
    }
}

template <bool RESYNC>
__device__ __forceinline__ void g8_store_tile(const f32x4 (&acc)[2][2][4][2], bf16_t* C, size_t ldc, int row0, int col0, const float* w8, char* lds, int tid_, int wv) {
    const int tid = opaque_i(tid_);
    const int lane = tid & 63, wr = wv >> 2, wc = wv & 3, fr = lane & 15, fq = lane >> 4;
    char* stg = lds + LDS_STG;
    if (RESYNC) { if (wr == 0) __builtin_amdgcn_s_barrier(); }
#pragma unroll
    for (int ai = 0; ai < 2; ++ai) {
#pragma unroll
        for (int m = 0; m < 4; ++m) {
            const float sc = w8 ? w8[ai * 4 + m] : 1.f;
            char* rp = stg + (wr * 64 + m * 16 + fr) * 528 + (wc * 32 + 4 * fq) * 2;
#pragma unroll
            for (int bj = 0; bj < 2; ++bj)
#pragma unroll
                for (int n = 0; n < 2; ++n) {
                    uint2 o; o.x = pk2(acc[ai][bj][m][n][0] * sc, acc[ai][bj][m][n][1] * sc); o.y = pk2(acc[ai][bj][m][n][2] * sc, acc[ai][bj][m][n][3] * sc);
                    *(uint2*)(rp + (bj * 128 + n * 16) * 2) = o;
                }
        }
        asm volatile("s_waitcnt lgkmcnt(0)" ::: "memory"); __builtin_amdgcn_s_barrier(); asm volatile("" ::: "memory");
        uint4 v[8];
#pragma unroll
        for (int i = 0; i < 8; ++i) { const int id = tid + i * 512; v[i] = *(const uint4*)(stg + (id >> 5) * 528 + (id & 31) * 16); }
#pragma unroll
        for (int i = 0; i < 8; ++i) { const int id = tid + i * 512; *(uint4*)(C + (size_t)(row0 + ai * 128 + (id >> 5)) * ldc + col0 + (id & 31) * 8) = v[i]; }
        asm volatile("s_waitcnt lgkmcnt(0)" ::: "memory"); __builtin_amdgcn_s_barrier(); asm volatile("" ::: "memory");
    }
    if (RESYNC) { if (wr == 1) __builtin_amdgcn_s_barrier(); }
}
__device__ __forceinline__ void g8_store_proj(const f32x4 (&acc)[2][2][4][2], CParams& p, int brow, int nt, char* lds, int tid_, int wv) {
    const int tid = opaque_i(tid_);
    const int lane = tid & 63, wr = wv >> 2, wc = wv & 3, fr = lane & 15, fq = lane >> 4;
    unsigned char* ws = p.ws;
    char* stg = lds + LDS_STG;
    float* rs = (float*)(stg + 128 * 528);
    bf16_t* proj = (bf16_t*)(ws + WS_PROJ);
#pragma unroll
    for (int ai = 0; ai < 2; ++ai) {
#pragma unroll
        for (int m = 0; m < 4; ++m) {
            char* rp = stg + (wr * 64 + m * 16 + fr) * 528 + (wc * 32 + 4 * fq) * 2;
#pragma unroll
            for (int bj = 0; bj < 2; ++bj)
#pragma unroll
                for (int n = 0; n < 2; ++n) {
                    uint2 o; o.x = pk2(acc[ai][bj][m][n][0], acc[ai][bj][m][n][1]); o.y = pk2(acc[ai][bj][m][n][2], acc[ai][bj][m][n][3]);
                    *(uint2*)(rp + (bj * 128 + n * 16) * 2) = o;
                }
        }
        asm volatile("s_waitcnt lgkmcnt(0)" ::: "memory"); __builtin_amdgcn_s_barrier(); asm volatile("" ::: "memory");
        const int r0g = brow + ai * 128;
        if (nt != 0) {
            uint4 v[8];
#pragma unroll
            for (int i = 0; i < 8; ++i) { const int id = tid + i * 512; v[i] = *(const uint4*)(stg + (id >> 5) * 528 + (id & 31) * 16); }
#pragma unroll
            for (int i = 0; i < 8; ++i) { const int id = tid + i * 512; *(uint4*)(proj + (size_t)(r0g + (id >> 5)) * NPROJ + nt * 256 + (id & 31) * 8) = v[i]; }
        }
        if (nt <= 1) {
            const int row = tid >> 2, q = tid & 3;
            const int ncol = (nt == 0) ? 256 : 128, per = ncol >> 2;
            float ss = 0.f;
            for (int c = 0; c < per; c += 8) {
                float f[8]; const uint4 u = *(const uint4*)(stg + row * 528 + (q * per + c) * 2); unpack8(u, f);
#pragma unroll
                for (int j = 0; j < 8; ++j) ss = fmaf(f[j], f[j], ss);
            }
            ss += dpp_f<0xB1>(ss); ss += dpp_f<0x4E>(ss);
            if (q == 0) rs[row] = rsqrtf(ss / (float)ncol + RMS_EPS);
            asm volatile("s_waitcnt lgkmcnt(0)" ::: "memory"); __builtin_amdgcn_s_barrier(); asm volatile("" ::: "memory");
            if (nt == 0) {
                const float* gq = p.in[3]; bf16_t* cqn = (bf16_t*)(ws + WS_CQN);
#pragma unroll
                for (int i = 0; i < 8; ++i) {
                    const int id = tid + i * 512, c4 = id & 3, rw = (id >> 2) & 127, kt = id >> 9, col = kt * 32 + c4 * 8;
                    float f[8]; const uint4 u = *(const uint4*)(stg + rw * 528 + col * 2); unpack8(u, f);
                    const float r = rs[rw];
                    const float4 g0 = *(const float4*)(gq + col), g1 = *(const float4*)(gq + col + 4);
                    uint4 o; o.x = pk2(f[0] * r * g0.x, f[1] * r * g0.y); o.y = pk2(f[2] * r * g0.z, f[3] * r * g0.w); o.z = pk2(f[4] * r * g1.x, f[5] * r * g1.y); o.w = pk2(f[6] * r * g1.z, f[7] * r * g1.w);
                    *(uint4*)(cqn + km_off(r0g + rw, col, T)) = o;
                }
            } else {
                const float* gkv = p.in[4]; bf16_t* ckvn = (bf16_t*)(ws + WS_CKVN); bf16_t* kidxf = (bf16_t*)(ws + WS_KIDX);
#pragma unroll
                for (int i = 0; i < 4; ++i) {
                    const int id = tid + i * 512, rw = id >> 4, ch = id & 15, col = ch * 8;
                    float f[8]; const uint4 u = *(const uint4*)(stg + rw * 528 + col * 2); unpack8(u, f);
                    const float r = rs[rw];
                    const float4 g0 = *(const float4*)(gkv + col), g1 = *(const float4*)(gkv + col + 4);
                    uint4 o; o.x = pk2(f[0] * r * g0.x, f[1] * r * g0.y); o.y = pk2(f[2] * r * g0.z, f[3] * r * g0.w); o.z = pk2(f[4] * r * g1.x, f[5] * r * g1.y); o.w = pk2(f[6] * r * g1.z, f[7] * r * g1.w);
                    *(uint4*)(ckvn + (size_t)(r0g + rw) * 128 + col) = o;
                }
#pragma unroll
                for (int i = 0; i < 2; ++i) {
                    const int id = tid + i * 512, f16 = id & 15, fq2 = (id >> 4) & 3, kk = (id >> 6) & 1, t16 = id >> 7;
                    const uint4 u = *(const uint4*)(stg + (t16 * 16 + f16) * 528 + (128 + kk * 32 + fq2 * 8) * 2);
                    *(uint4*)(kidxf + ((size_t)(((r0g >> 4) + t16) * 2 + kk) * 64 + fq2 * 16 + f16) * 8) = u;
                }
            }
        }
        asm volatile("s_waitcnt lgkmcnt(0)" ::: "memory"); __builtin_amdgcn_s_barrier(); asm volatile("" ::: "memory");
    }
}
__device__ __forceinline__ int vblock() { const int G = gridDim.x, b = blockIdx.x; return ((G & 7) == 0) ? (b & 7) * (G >> 3) + (b >> 3) : b; }

__device__ __forceinline__ void phase1(CParams& p, char* lds, int wv) {
    const int tid = opaque_tid(wv), lane = tid & 63, wid = tid >> 6, wm = wid >> 2, wn = wid & 3;
    unsigned char* ws = p.ws;
    constexpr int I1 = (T / 256) * 6, I2 = (4096 / 128) * 2, I3 = 2 * (4096 / 128);
    {
        int it = vblock();
        g8::Src s;
        if (it < I1) { g8::km_src(s, (const bf16_t*)(ws + WS_XB), T, (it / 6) * 256, (const bf16_t*)(ws + WS_W_IN_T), 1536, (it % 6) * 256, tid); g8::kloop_issue(s, lds, wv); }
        while (it < I1) {
            const int brow = (it / 6) * 256, bcol = (it % 6) * 256;
            f32x4 acc[2][2][4][2]; g8::acc_zero(acc);
            g8::kloop(acc, s, 32, lds, tid, wv);
            it += gridDim.x;
            if (it < I1) { g8::km_src(s, (const bf16_t*)(ws + WS_XB), T, (it / 6) * 256, (const bf16_t*)(ws + WS_W_IN_T), 1536, (it % 6) * 256, tid); g8::kloop_issue(s, lds, wv); }
            g8_store_proj(acc, p, brow, bcol >> 8, lds, tid, wv);
        }
    }
    asm volatile("s_waitcnt vmcnt(0)" ::: "memory");
    __syncthreads();
    for (int it = blockIdx.x; it < I2 + I3; it += gridDim.x) {
        if (it < I2) { const int r = it; gemm_item_bf16<1>((const bf16_t*)(ws + WS_MEMB), 1024, (const bf16_t*)(ws + WS_W_MKV_T), 1024, 16, (bf16_t*)(ws + WS_KMEM), 256, (r / 2) * 128, (r % 2) * 128, lds, tid, lane, wm, wn); }
        else { const int r = it - I2;
            gemm_item_bf16<2>((const bf16_t*)(ws + WS_W_MKV_T) + (size_t)256 * 1024, 1024, (const bf16_t*)(ws + WS_MEMB), 1024, 16, (bf16_t*)(ws + WS_VTMEM), 4096, (r / 32) * 128, (r % 32) * 128, lds, tid, lane, wm, wn); }
    }
}

__device__ __forceinline__ void phase2(CParams& p, int wv) {
    const int tid = opaque_tid(wv), lane = tid & 63, wid = tid >> 6;
    unsigned char* ws = p.ws;
    const bf16_t* proj = (const bf16_t*)(ws + WS_PROJ);
    bf16_t* cqn = (bf16_t*)(ws + WS_CQN); bf16_t* ckvn = (bf16_t*)(ws + WS_CKVN);
    const float* gq = p.in[3]; const float* gkv = p.in[4];
    for (int t = blockIdx.x * 8 + wid; t < T; t += gridDim.x * 8) {
        const bf16_t* row = proj + (size_t)t * NPROJ;
        {
            const uint2 v = *(const uint2*)(row + PC_CQ + lane * 4);
            const float a = bflo(v.x), b = bfhi(v.x), c = bflo(v.y), d = bfhi(v.y);
            const float ss = wave_sum(a * a + b * b + c * c + d * d);
            const float r = rsqrtf(ss * (1.f / 256.f) + RMS_EPS);
            const float4 g = *(const float4*)(gq + lane * 4);
            uint2 o; o.x = pk2(a * r * g.x, b * r * g.y); o.y = pk2(c * r * g.z, d * r * g.w);
            *(uint2*)(cqn + km_off(t, lane * 4, T)) = o;
        }
        {
            const uint32_t v = *(const uint32_t*)(row + PC_CKV + lane * 2);
            const float a = bflo(v), b = bfhi(v);
            const float ss = wave_sum(a * a + b * b);
            const float r = rsqrtf(ss * (1.f / 128.f) + RMS_EPS);
            const float2 g = *(const float2*)(gkv + lane * 2);
            *(uint32_t*)(ckvn + (size_t)t * 128 + lane * 2) = pk2(a * r * g.x, b * r * g.y);
        }
        if (lane < 32) {
            const int dd = lane * 2;
            const size_t off = ((size_t)((t >> 4) * 2 + (dd >> 5)) * 64 + ((dd & 31) >> 3) * 16 + (t & 15)) * 8 + (dd & 7);
            *(uint32_t*)((bf16_t*)(ws + WS_KIDX) + off) = *(const uint32_t*)(row + PC_KIDX + dd);
        }
    }
}

__device__ __forceinline__ void phase3(CParams& p, char* lds, int wv) {
    const int tid = opaque_tid(wv);
    unsigned char* ws = p.ws;
    constexpr int I1 = (T / 256) * 6;
    int it = vblock();
    g8::Src s;
    if (it < I1) { g8::km_src(s, (const bf16_t*)(ws + WS_CQN), T, (it / 6) * 256, (const bf16_t*)(ws + WS_W_Q2_T), 1536, (it % 6) * 256, tid); g8::kloop_issue(s, lds, wv); }
    while (it < I1) {
        const int brow = (it / 6) * 256, bcol = (it % 6) * 256;
        f32x4 acc[2][2][4][2]; g8::acc_zero(acc);
        g8::kloop(acc, s, 8, lds, tid, wv);
        it += gridDim.x;
        if (it < I1) { g8::km_src(s, (const bf16_t*)(ws + WS_CQN), T, (it / 6) * 256, (const bf16_t*)(ws + WS_W_Q2_T), 1536, (it % 6) * 256, tid); g8::kloop_issue(s, lds, wv); }
        g8_store_tile<false>(acc, (bf16_t*)(ws + WS_Q2), 1536, brow, bcol, nullptr, lds, tid, wv);
    }
}

typedef short s16x4 __attribute__((ext_vector_type(4)));
__device__ __forceinline__ int t5_bucket(int n) {
    if (n < 16) return n;
    if (n >= 128) return 31;
    const int l = 16 + (int)(__log2f((float)n * 0.0625f) * (16.0f / 3.0f));
    return l < 31 ? l : 31;
}
__device__ __forceinline__ bf16x8 ld_frag(const bf16_t* p) { return *(const bf16x8*)p; }
__device__ __forceinline__ bf16x8 u4_as_frag(const uint4& v) { union { uint4 u; bf16x8 f; } c; c.u = v; return c.f; }

constexpr int SK_STRIDE = 2052;
constexpr int P4_SEL = 16 * SK_STRIDE * 4;
constexpr int P4_RB = P4_SEL + 16 * 256 * 2;
constexpr int P4_SELB = P4_RB + 1024;

constexpr int P4_CSCR = P4_SELB + 4096;
constexpr int P4_HIST = P4_CSCR + 2048;
template <int NREG>
__device__ __forceinline__ void select_query(const uint32_t* skrow, unsigned short* sel, unsigned char* selb, uint32_t* cscr, uint32_t* hist, int t, int lane) {
    const unsigned long long ltmask = (1ull << lane) - 1ull;
    uint32_t key[NREG];
#pragma unroll
    for (int i = 0; i < NREG; ++i) { const int s = i * 64 + lane; const uint32_t kv = skrow[s]; key[i] = (s <= t) ? kv : 0u; }
    uint32_t prefix = 0; bool exact = false;
    int nS = 0, nU = t + 1, bit = 31;
    {
        const uint32_t cand = 0x80000000u;
        int cnt = 0;
#pragma unroll
        for (int i = 0; i < NREG; ++i) cnt += __popcll(__ballot(key[i] >= cand));
        if (cnt >= 256) { prefix = cand; nU = cnt; exact = (cnt == 256); } else { nU -= cnt; nS = cnt; }
        bit = 30;
        if (!exact && nU > 64) {
            uint32_t a = 0xFFFFFFFFu, o = 0u;
#pragma unroll
            for (int i = 0; i < NREG; ++i) { const bool inU = ((key[i] ^ prefix) >> 31) == 0u && key[i] != 0u; a &= inU ? key[i] : 0xFFFFFFFFu; o |= inU ? key[i] : 0u; }
#pragma unroll
            for (int d = 1; d < 64; d <<= 1) { a &= (uint32_t)__shfl_xor((int)a, d); o |= (uint32_t)__shfl_xor((int)o, d); }
            const uint32_t diff = (a ^ o) & 0x7FFFFFFFu;
            if (diff == 0u) { prefix = a; bit = -1; }
            else {
                const int top = 31 - __clz(diff);
                const uint32_t keep = (top >= 30) ? 0u : (0x7FFFFFFFu & ~((2u << top) - 1u));
                prefix |= a & keep;
                const int nb = (top + 1 < 8) ? top + 1 : 8, shift = top + 1 - nb;
                *(uint4*)(hist + lane * 4) = make_uint4(0u, 0u, 0u, 0u);
                wave_sync();
#pragma unroll
                for (int i = 0; i < NREG; ++i) {
                    const bool inU = ((key[i] ^ prefix) >> (top + 1)) == 0u && key[i] != 0u;
                    if (inU) atomicAdd(&hist[(key[i] >> shift) & 255u], 1u);
                }
                wave_sync();
                const uint4 h4 = *(const uint4*)(hist + lane * 4);
                int suf = (int)(h4.x + h4.y + h4.z + h4.w);
#pragma unroll
                for (int d = 1; d < 64; d <<= 1) { const int v = __shfl_down(suf, d); if (lane + d < 64) suf += v; }
                const int need = 256 - nS;
                const int L = __popcll(__ballot(suf >= need)) - 1;
                const int above = (L < 63) ? __builtin_amdgcn_readlane(suf, (L + 1) & 63) : 0;
                const int hb[4] = {__builtin_amdgcn_readlane((int)h4.x, L), __builtin_amdgcn_readlane((int)h4.y, L), __builtin_amdgcn_readlane((int)h4.z, L), __builtin_amdgcn_readlane((int)h4.w, L)};
                int c = above, dig = 4 * L, inbin = 0, aboved = above;
                bool found = false;
#pragma unroll
                for (int j = 3; j >= 0; --j) { if (!found) { const int c2 = c + hb[j]; if (c2 >= need) { dig = 4 * L + j; inbin = hb[j]; aboved = c; found = true; } c = c2; } }
                prefix |= (uint32_t)dig << shift;
                nS += aboved; nU = inbin;
                exact = (nS + nU == 256);
                bit = shift - 1;
            }
        }
    }
    for (; !exact && bit >= 0 && nU > 64; --bit) {
        const uint32_t cand = prefix | (1u << bit);
        int cnt = 0;
#pragma unroll
        for (int i = 0; i < NREG; ++i) cnt += __popcll(__ballot(key[i] >= cand));
        if (cnt >= 256) { prefix = cand; nU = cnt - nS; if (cnt == 256) { exact = true; break; } }
        else { nU -= cnt - nS; nS = cnt; }
    }
    int quota = 0; bool have_quota = false;
    if (!exact && bit >= 0) {
        const int sh = bit + 1;
        int pos = 0;
        wave_sync();
#pragma unroll
        for (int i = 0; i < NREG; ++i) {
            const bool inU = (key[i] >> sh) == (prefix >> sh) && key[i] != 0u;
            const unsigned long long bu = __ballot(inU);
            if (inU) { const int d = pos + __popcll(bu & ltmask); if (d < 64) cscr[d] = key[i]; }
            pos += __popcll(bu);
        }
        wave_sync();
        const uint32_t u = (lane < pos) ? cscr[lane] : 0u;
        for (; bit >= 0; --bit) {
            const uint32_t cand = prefix | (1u << bit);
            const int cnt = nS + __popcll(__ballot(u >= cand));
            if (cnt >= 256) { prefix = cand; if (cnt == 256) { exact = true; break; } }
        }
        if (!exact) {
            if (nS + __popcll(__ballot(u >= prefix)) == 256) exact = true;
            else { quota = 256 - (nS + __popcll(__ballot(u > prefix))); have_quota = true; }
        }
    }
    if (!exact && !have_quota) {
        int cgt = 0;
#pragma unroll
        for (int i = 0; i < NREG; ++i) cgt += __popcll(__ballot(key[i] > prefix));
        quota = 256 - cgt;
    }
    int pos = 0, eqc = 0;
#pragma unroll
    for (int i = 0; i < NREG; ++i) {
        const uint32_t u = key[i];
        bool take;
        if (exact) take = (u >= prefix);
        else {
            const bool eq = (u == prefix);
            const unsigned long long beq = __ballot(eq);
            const int myeq = eqc + __popcll(beq & ltmask);
            take = (u > prefix) || (eq && myeq < quota);
            eqc += __popcll(beq);
        }
        const unsigned long long bt = __ballot(take);
        if (take) {
            const int dst = pos + __popcll(bt & ltmask); sel[dst] = (unsigned short)(i * 64 + lane);
            if (t - (i * 64 + 63) >= 128) selb[dst] = (unsigned char)31;
            else selb[dst] = (unsigned char)t5_bucket(t - (i * 64 + lane));
        }
        pos += __popcll(bt);
    }
}

__device__ __forceinline__ void dsa_item(CParams& p, int b, int t0, char* lds, int tid_in, int wv) {
    const int tid = opaque_i(tid_in);
    const int lane = tid & 63, wid = tid >> 6, fr = lane & 15, fq = lane >> 4;
    unsigned char* ws = p.ws;
    uint32_t* SK = (uint32_t*)lds;
    unsigned short* SEL = (unsigned short*)(lds + P4_SEL);
    const float* RB = (const float*)(lds + P4_RB);
    unsigned char* SELB = (unsigned char*)(lds + P4_SELB);
    const bf16_t* q2 = (const bf16_t*)(ws + WS_Q2) + ((size_t)b * SEQ + t0) * 1536;
    const bf16_t* kidx = (const bf16_t*)(ws + WS_KIDX) + (size_t)b * SEQ * 64;
    const bf16_t* ckvn = (const bf16_t*)(ws + WS_CKVN) + (size_t)b * SEQ * 128;
    __syncthreads();
    if (t0 >= 256) {
        bf16x8 qf[8][2];
#pragma unroll
        for (int h = 0; h < 8; ++h)
#pragma unroll
            for (int kk = 0; kk < 2; ++kk) qf[h][kk] = ld_frag(q2 + (size_t)fr * 1536 + 1024 + h * 64 + kk * 32 + fq * 8);
        float wv[8];
        { const uint4 v = *(const uint4*)((const bf16_t*)(ws + WS_PROJ) + ((size_t)b * SEQ + t0 + fr) * NPROJ + PC_IDXW); unpack8(v, wv); }
#pragma unroll
        for (int i = 0; i < 8; ++i) wv[i] *= IDXW_SCALE;
        const int ntile = (t0 + 16) >> 4;
        const int tq = t0 + fr;
        bf16x8 kn0 = ld_frag(kidx + (size_t)(wid * 2) * 512 + lane * 8), kn1 = ld_frag(kidx + (size_t)(wid * 2 + 1) * 512 + lane * 8);
        for (int kt = wid; kt < ntile; kt += 8) {
            const int key0 = kt * 16;
            const bf16x8 kf0 = kn0, kf1 = kn1;
            { const int kx = (kt + 8 < ntile) ? kt + 8 : kt;
              kn0 = ld_frag(kidx + (size_t)(kx * 2) * 512 + lane * 8); kn1 = ld_frag(kidx + (size_t)(kx * 2 + 1) * 512 + lane * 8); }
            float sacc[4] = {0.f, 0.f, 0.f, 0.f};
#pragma unroll
            for (int h = 0; h < 8; ++h) {
                f32x4 d = (f32x4){0.f, 0.f, 0.f, 0.f};
                d = __builtin_amdgcn_mfma_f32_16x16x32_bf16(kf0, qf[h][0], d, 0, 0, 0);
                d = __builtin_amdgcn_mfma_f32_16x16x32_bf16(kf1, qf[h][1], d, 0, 0, 0);
#pragma unroll
                for (int r = 0; r < 4; ++r) sacc[r] = fmaf(wv[h], fmaxf(d[r], 0.f), sacc[r]);
            }
            uint4 ko;
            uint32_t kk4[4];
#pragma unroll
            for (int r = 0; r < 4; ++r) {
                const int s = key0 + 4 * fq + r;
                float sc = sacc[r]; if (sc == 0.f) sc = 0.f;
                const uint32_t u = __float_as_uint(sc);
                const uint32_t key = (u & 0x80000000u) ? ~u : (u | 0x80000000u);
                kk4[r] = (s <= tq) ? key : 0u;
            }
            ko.x = kk4[0]; ko.y = kk4[1]; ko.z = kk4[2]; ko.w = kk4[3];
            *(uint4*)(SK + fr * SK_STRIDE + key0 + 4 * fq) = ko;
        }
        __syncthreads();
#pragma nounroll
        for (int qq = 0; qq < 2; ++qq) {
            const int q = wid * 2 + qq, t = t0 + q;
            uint32_t* cscr = (uint32_t*)(lds + P4_CSCR) + wid * 64;
#define DSA_SEL(N) select_query<N>(SK + q * SK_STRIDE, SEL + q * 256, SELB + q * 256, cscr, (uint32_t*)(lds + P4_HIST) + wid * 256, t, lane)
            switch (__builtin_amdgcn_readfirstlane(t0 >> 8)) {
                case 1: DSA_SEL(8); break;
                case 2: DSA_SEL(12); break;
                case 3: DSA_SEL(16); break;
                case 4: DSA_SEL(20); break;
                case 5: DSA_SEL(24); break;
                case 6: DSA_SEL(28); break;
                default: DSA_SEL(32); break;
            }
#undef DSA_SEL
        }
    } else {
        for (int qq = 0; qq < 2; ++qq) {
            const int q = wid * 2 + qq, t = t0 + q;
            for (int k = lane; k <= t; k += 64) { SEL[q * 256 + k] = (unsigned short)k; SELB[q * 256 + k] = (unsigned char)t5_bucket(t - k); }
        }
    }
    __syncthreads();
    char* vst = lds + wv * 16384;
    bf16_t* cat = (bf16_t*)(ws + WS_CAT2);
    const __amdgpu_buffer_rsrc_t rkv = g8::make_rsrc(ckvn);
#pragma nounroll
    for (int qq = 0; qq < 2; ++qq) {
        const int q = wid * 2 + qq, t = t0 + q;
        const int nsel = (t + 1 < 256) ? t + 1 : 256;
        const size_t tok = (size_t)b * SEQ + t;
        const unsigned short* selq = SEL + q * 256;
        bf16x8 qf[4];
#pragma unroll
        for (int kk = 0; kk < 4; ++kk) {
            uint4 v = make_uint4(0, 0, 0, 0);
            if (fr < 8) v = *(const uint4*)(q2 + (size_t)q * 1536 + fr * 128 + kk * 32 + fq * 8);
            qf[kk] = u4_as_frag(v);
        }
        asm volatile("" :: "v"(qf[0]), "v"(qf[1]), "v"(qf[2]), "v"(qf[3]));
        float m = -INFINITY, l = 0.f;
        f32x4 O[8];
#pragma unroll
        for (int ct = 0; ct < 8; ++ct) O[ct] = (f32x4){0.f, 0.f, 0.f, 0.f};
        const int nck = (nsel + 31) >> 5;
#define DSA_ISSUE(c) do { int sv_[8]; \
            _Pragma("unroll") for (int pc = 0; pc < 8; ++pc) sv_[pc] = (int)selq[(c) * 32 + pc * 4 + fq];     \
            _Pragma("unroll") for (int pc = 0; pc < 8; ++pc) { \
            const int row_ = pc * 4 + fq; const int k_ = (c) * 32 + row_; \
            const int s_ = (k_ < nsel) ? sv_[pc] : 0; \
            __builtin_amdgcn_raw_ptr_buffer_load_lds(rkv, (LAS void*)(vst + ((c) & 1) * 8192 + pc * 1024), 16, (unsigned)(s_ * 256 + ((fr ^ (row_ & 15)) << 4)), 0, 0, 0); } } while (0)
        DSA_ISSUE(0);
#pragma nounroll
        for (int ck = 0; ck < nck; ++ck) {
            if (ck + 1 < nck) { DSA_ISSUE(ck + 1); asm volatile("s_waitcnt vmcnt(8)" ::: "memory"); }
            else asm volatile("s_waitcnt vmcnt(0)" ::: "memory");
            const char* buf = vst + (ck & 1) * 8192;
            bf16x8 a0[4], a1[4];
#pragma unroll
            for (int kk = 0; kk < 4; ++kk) {
                const int ch = ((kk * 4 + fq) ^ fr) << 4;
                a0[kk] = *(const bf16x8*)(buf + fr * 256 + ch);
                a1[kk] = *(const bf16x8*)(buf + (16 + fr) * 256 + ch);
            }
            f32x4 d0 = (f32x4){0.f, 0.f, 0.f, 0.f}, d1 = (f32x4){0.f, 0.f, 0.f, 0.f};
#pragma unroll
            for (int kk = 0; kk < 4; ++kk) {
                d0 = __builtin_amdgcn_mfma_f32_16x16x32_bf16(a0[kk], qf[kk], d0, 0, 0, 0);
                d1 = __builtin_amdgcn_mfma_f32_16x16x32_bf16(a1[kk], qf[kk], d1, 0, 0, 0);
            }
            float lg0[4], lg1[4];
            {
                const int kb = ck * 32 + 4 * fq;
                const uint32_t bw0 = *(const uint32_t*)(SELB + q * 256 + kb), bw1 = *(const uint32_t*)(SELB + q * 256 + kb + 16);
#pragma unroll
                for (int r = 0; r < 4; ++r) {
                    const bool v0 = (kb + r) < nsel, v1 = (kb + 16 + r) < nsel;
                    const int b0 = (int)((bw0 >> (8 * r)) & 31u), b1 = (int)((bw1 >> (8 * r)) & 31u);
                    const float rb0 = RB[b0 * 8 + (fr & 7)], rb1 = RB[b1 * 8 + (fr & 7)];
                    lg0[r] = (d0[r] + rb0) + (v0 ? 0.f : -INFINITY);
                    lg1[r] = (d1[r] + rb1) + (v1 ? 0.f : -INFINITY);
                }
            }
            float cm = fmaxf(fmaxf(fmaxf(lg0[0], lg0[1]), fmaxf(lg0[2], lg0[3])), fmaxf(fmaxf(lg1[0], lg1[1]), fmaxf(lg1[2], lg1[3])));
            cm = xrow16_max(cm);
            const float mn = fmaxf(m, cm);
            const float scl = __builtin_amdgcn_exp2f(m - mn);
            float p0[4], p1[4], ls = 0.f;
#pragma unroll
            for (int r = 0; r < 4; ++r) { p0[r] = __builtin_amdgcn_exp2f(lg0[r] - mn); p1[r] = __builtin_amdgcn_exp2f(lg1[r] - mn); ls += p0[r] + p1[r]; }
            ls = xrow16_sum(ls);
            l = l * scl + ls; m = mn;
            if (__any(scl != 1.f)) {
#pragma unroll
                for (int ct = 0; ct < 8; ++ct) O[ct] = O[ct] * scl;
            }
            uint4 pf; pf.x = pk2(p0[0], p0[1]); pf.y = pk2(p0[2], p0[3]); pf.z = pk2(p1[0], p1[1]); pf.w = pk2(p1[2], p1[3]);
            const bf16x8 pfrag = u4_as_frag(pf);
#pragma unroll
            for (int ct = 0; ct < 8; ++ct) {
                const int r0 = 4 * fq + (fr >> 2), r1 = r0 + 16;
                const int chn = ct * 2 + ((fr & 3) >> 1), sub = 8 * (fr & 1);
                const s16x4 va = __builtin_amdgcn_ds_read_tr16_b64_v4i16((s16x4 LAS*)(buf + r0 * 256 + ((chn ^ (r0 & 15)) << 4) + sub));
                const s16x4 vb = __builtin_amdgcn_ds_read_tr16_b64_v4i16((s16x4 LAS*)(buf + r1 * 256 + ((chn ^ (r1 & 15)) << 4) + sub));
                bf16x8 vf; vf[0] = va[0]; vf[1] = va[1]; vf[2] = va[2]; vf[3] = va[3]; vf[4] = vb[0]; vf[5] = vb[1]; vf[6] = vb[2]; vf[7] = vb[3];
                O[ct] = __builtin_amdgcn_mfma_f32_16x16x32_bf16(vf, pfrag, O[ct], 0, 0, 0);
            }
            asm volatile("" ::: "memory");
        }
#undef DSA_ISSUE
        const float inv = 1.f / l;
        if (fr < 8) {
#pragma unroll
            for (int ct = 0; ct < 8; ++ct) {
                uint2 o; o.x = pk2(O[ct][0] * inv, O[ct][1] * inv); o.y = pk2(O[ct][2] * inv, O[ct][3] * inv);
                *(uint2*)(cat + km_off((int)tok, fr * 128 + ct * 16 + 4 * fq, T)) = o;
            }
        }
        asm volatile("s_waitcnt vmcnt(0)" ::: "memory");
    }
}

#define MA_SB() __builtin_amdgcn_sched_barrier(0)
__device__ __forceinline__ void memattn_wave(CParams& p, int b, size_t tok0, int h, int lane) {
    const int fr = lane & 15, fq = lane >> 4;
    unsigned char* ws = p.ws;
    const bf16_t* proj = (const bf16_t*)(ws + WS_PROJ) + (tok0 + fr) * NPROJ + PC_QM + h * 64;
    const bf16_t* km = (const bf16_t*)(ws + WS_KMEM) + (size_t)(b * 4 + h) * (16 * 2 * 64 * 8) + lane * 8;
    const bf16_t* vt = (const bf16_t*)(ws + WS_VTMEM) + (size_t)(b * 4 + h) * (8 * 4 * 64 * 8) + lane * 8;
    const bf16x8 qf0 = ld_frag(proj + fq * 8), qf1 = ld_frag(proj + 32 + fq * 8);
    f32x4 d[16];
    bf16x8 kb[2][8];
#pragma unroll
    for (int j = 0; j < 4; ++j) { kb[0][2 * j] = ld_frag(km + (j * 2) * 512); kb[0][2 * j + 1] = ld_frag(km + (j * 2 + 1) * 512); }
    MA_SB();
#pragma unroll
    for (int g = 0; g < 4; ++g) {
        if (g < 3) {
#pragma unroll
            for (int j = 0; j < 4; ++j) { kb[(g + 1) & 1][2 * j] = ld_frag(km + ((g * 4 + 4 + j) * 2) * 512); kb[(g + 1) & 1][2 * j + 1] = ld_frag(km + ((g * 4 + 4 + j) * 2 + 1) * 512); }
        }
        MA_SB();
#pragma unroll
        for (int j = 0; j < 4; ++j) {
            f32x4 z = (f32x4){0.f, 0.f, 0.f, 0.f};
            z = __builtin_amdgcn_mfma_f32_16x16x32_bf16(kb[g & 1][2 * j], qf0, z, 0, 0, 0);
            z = __builtin_amdgcn_mfma_f32_16x16x32_bf16(kb[g & 1][2 * j + 1], qf1, z, 0, 0, 0);
            d[g * 4 + j] = z * (0.125f * 1.4426950408889634f);
        }
        MA_SB();
    }
    bf16x8 vb[2][8];
#pragma unroll
    for (int i = 0; i < 8; ++i) vb[0][i] = ld_frag(vt + i * 512);
    MA_SB();
    float mx = -INFINITY;
#pragma unroll
    for (int kt = 0; kt < 16; ++kt) mx = fmaxf(mx, fmaxf(fmaxf(d[kt][0], d[kt][1]), fmaxf(d[kt][2], d[kt][3])));
    mx = xrow16_max(mx);
    float s = 0.f;
#pragma unroll
    for (int kt = 0; kt < 16; ++kt)
#pragma unroll
        for (int r = 0; r < 4; ++r) { d[kt][r] = __builtin_amdgcn_exp2f(d[kt][r] - mx); s += d[kt][r]; }
    s = xrow16_sum(s);
    const float inv = 1.f / s;
    f32x4 O[4];
#pragma unroll
    for (int dt = 0; dt < 4; ++dt) O[dt] = (f32x4){0.f, 0.f, 0.f, 0.f};
    MA_SB();
#pragma unroll
    for (int g = 0; g < 4; ++g) {
        if (g < 3) {
#pragma unroll
            for (int i = 0; i < 8; ++i) vb[(g + 1) & 1][i] = ld_frag(vt + ((g + 1) * 8 + i) * 512);
        }
        MA_SB();
#pragma unroll
        for (int cc = 0; cc < 2; ++cc) {
            const int c32 = g * 2 + cc;
            uint4 pf; pf.x = pk2(d[2 * c32][0], d[2 * c32][1]); pf.y = pk2(d[2 * c32][2], d[2 * c32][3]); pf.z = pk2(d[2 * c32 + 1][0], d[2 * c32 + 1][1]); pf.w = pk2(d[2 * c32 + 1][2], d[2 * c32 + 1][3]);
            const bf16x8 pfrag = u4_as_frag(pf);
#pragma unroll
            for (int dt = 0; dt < 4; ++dt) O[dt] = __builtin_amdgcn_mfma_f32_16x16x32_bf16(vb[g & 1][cc * 4 + dt], pfrag, O[dt], 0, 0, 0);
        }
        MA_SB();
    }
    bf16_t* cat = (bf16_t*)(ws + WS_CAT2);
#pragma unroll
    for (int dt = 0; dt < 4; ++dt) {
        uint2 o; o.x = pk2(O[dt][0] * inv, O[dt][1] * inv); o.y = pk2(O[dt][2] * inv, O[dt][3] * inv);
        *(uint2*)(cat + km_off((int)tok0 + fr, 1280 + h * 64 + dt * 16 + 4 * fq, T)) = o;
    }
}

__device__ __forceinline__ void conv_tokens4(CParams& p, int b, int t0, int lane) {
    unsigned char* ws = p.ws;
    const bf16_t* proj = (const bf16_t*)(ws + WS_PROJ) + (size_t)b * SEQ * NPROJ;
    const float* cw = p.in[10];
    const int c = lane * 4;
    uint2 gc[6], hh[6], gb[4];
#pragma unroll
    for (int i = 0; i < 6; ++i) {
        const int tt = t0 - 2 + i, tc = tt < 0 ? 0 : tt;
        gc[i] = *(const uint2*)(proj + (size_t)tc * NPROJ + PC_GC + c); hh[i] = *(const uint2*)(proj + (size_t)tc * NPROJ + PC_H + c);
    }
#pragma unroll
    for (int i = 0; i < 4; ++i) gb[i] = *(const uint2*)(proj + (size_t)(t0 + i) * NPROJ + PC_GB + c);
    const float4 w0 = *(const float4*)(cw + c), w1 = *(const float4*)(cw + 256 + c), w2 = *(const float4*)(cw + 512 + c);
    float u[6][4];
#pragma unroll
    for (int i = 0; i < 6; ++i) {
        const float z = (t0 - 2 + i < 0) ? 0.f : 1.f;
        u[i][0] = bflo(gc[i].x) * bflo(hh[i].x) * z; u[i][1] = bfhi(gc[i].x) * bfhi(hh[i].x) * z;
        u[i][2] = bflo(gc[i].y) * bflo(hh[i].y) * z; u[i][3] = bfhi(gc[i].y) * bfhi(hh[i].y) * z;
    }
    bf16_t* cat = (bf16_t*)(ws + WS_CAT2);
#pragma unroll
    for (int i = 0; i < 4; ++i) {
        const float y0 = fmaf(w0.x, u[i][0], fmaf(w1.x, u[i + 1][0], w2.x * u[i + 2][0]));
        const float y1 = fmaf(w0.y, u[i][1], fmaf(w1.y, u[i + 1][1], w2.y * u[i + 2][1]));
        const float y2 = fmaf(w0.z, u[i][2], fmaf(w1.z, u[i + 1][2], w2.z * u[i + 2][2]));
        const float y3 = fmaf(w0.w, u[i][3], fmaf(w1.w, u[i + 1][3], w2.w * u[i + 2][3]));
        uint2 o; o.x = pk2(bflo(gb[i].x) * y0, bfhi(gb[i].x) * y1); o.y = pk2(bflo(gb[i].y) * y2, bfhi(gb[i].y) * y3);
        *(uint2*)(cat + km_off(b * SEQ + t0 + i, 1024 + c, T)) = o;
    }
}

__device__ __forceinline__ void phase4(CParams& p, char* lds, int wv) {
    const int tid = opaque_tid(wv), lane = tid & 63, wid = tid >> 6;
    if (tid < 256) ((float*)(lds + P4_RB))[tid] = p.in[9][tid] * 1.4426950408889634f;
    const int gw = blockIdx.x * 8 + wid, NW = gridDim.x * 8;
    const int ndsa = (T / 16 - (int)blockIdx.x + (int)gridDim.x - 1) / (int)gridDim.x;
    const int new_ = (EW_ITEMS - gw + NW - 1) / NW;
    const int per = (new_ + ndsa - 1) / (ndsa > 0 ? ndsa : 1);
    int ew = gw;
    for (int i = blockIdx.x; i < T / 16; i += gridDim.x) {
        const int b = i >> 7, tau = i & 127, tile = ((b >> 1) & 1) ? 127 - tau : tau;
        dsa_item(p, b, tile * 16, lds, tid, wv);
        for (int j = 0; j < per && ew < EW_ITEMS; ++j, ew += NW) expert_w_item(p, ew, (float*)(lds + wv * 16384), opaque_i(lane));
    }
    for (; ew < EW_ITEMS; ew += NW) expert_w_item(p, ew, (float*)(lds + wv * 16384), opaque_i(lane));
    for (int i = blockIdx.x; i < T / 32; i += gridDim.x) {
        const int b = i >> 6, t0 = (i & 63) * 32 + (wid >> 2) * 16;
        memattn_wave(p, b, (size_t)b * SEQ + t0, wid & 3, opaque_i(lane));
        conv_tokens4(p, b, t0 + (wid & 3) * 4, opaque_i(lane));
    }
}

#define XB_TMO      128
#define XB_XCNT(j)  (256  + 64 * (j))
#define XB_XSUB(j)  (1280 + 64 * (j))
#define XB_XGEN(j)  (2304 + 64 * (j))
#define XB_TOP      3328
#define XB_TOPGEN   3392
#define XCD_BAR_WORDS 3456
#define XB_SPIN_CAP (1u << 22)
__device__ __forceinline__ unsigned xb_ld(unsigned* p)              { return __hip_atomic_load(p, __ATOMIC_RELAXED, __HIP_MEMORY_SCOPE_AGENT); }
__device__ __forceinline__ unsigned xb_add(unsigned* p, unsigned v) { return __hip_atomic_fetch_add(p, v, __ATOMIC_RELAXED, __HIP_MEMORY_SCOPE_AGENT); }
__device__ __forceinline__ unsigned xb_xcc_id() { return (unsigned)__builtin_amdgcn_s_getreg((3 << 11) | 20) & 0xFu; }
#define XB_SPIN(cond, bar) do { unsigned _sp = 0; while (cond) { __builtin_amdgcn_s_sleep(1); \
    if ((++_sp & 255u) == 0u) { if (xb_ld(&(bar)[XB_TMO])) break; if (_sp > XB_SPIN_CAP) { atomicAdd(&(bar)[XB_TMO], 1u); break; } } } } while (0)
__device__ __forceinline__ void phase5(CParams& p, char* lds, int wv) {
    const int tid = opaque_tid(wv);
    unsigned char* ws = p.ws;
    const float* x = p.in[0];
    constexpr int I1 = (T / 256) * 4;
    unsigned* bar = (unsigned*)(ws + WS_BAR);
    unsigned long long* lnst = (unsigned long long*)(ws + WS_LNST);
    bf16_t* x1h = (bf16_t*)(ws + WS_X1H); bf16_t* x1l = (bf16_t*)(ws + WS_X1L); unsigned char* x1f8 = ws + WS_X1F8;
    for (int it = vblock(); it < I1; it += gridDim.x) {
        const int pm = it >> 2, pn = it & 3;
        const int brow = pm * 256, bcol = pn * 256;
        g8::Src s; g8::km_src(s, (const bf16_t*)(ws + WS_CAT2), T, brow, (const bf16_t*)(ws + WS_W_OUT2_T), 1024, bcol, tid);
        g8::kloop_issue(s, lds, wv);
        f32x4 acc[2][2][4][2]; g8::acc_zero(acc);
        g8::kloop(acc, s, 48, lds, tid, wv);
        const int te = opaque_i(tid), lane = te & 63, wr = wv >> 2, wc = wv & 3, fr = lane & 15, fq = lane >> 4;
        char* stg = lds + LDS_STG;
        float2* PS = (float2*)(stg + 32 * 1040);
        float2* SR = PS + 256;
        f32x4 vr[2][4][4];
        float4 xn[4];
#pragma unroll
        for (int i = 0; i < 4; ++i) { const int lr = wv + 8 * i; xn[i] = ldnt4(x + (size_t)(brow + (lr >> 4) * 64 + (lr & 15)) * 1024 + bcol + lane * 4); }
#pragma unroll
        for (int ai = 0; ai < 2; ++ai)
#pragma unroll
            for (int m = 0; m < 4; ++m) {
                char* rp = stg + (wr * 16 + fr) * 1040 + (wc * 32 + 4 * fq) * 4;
#pragma unroll
                for (int bj = 0; bj < 2; ++bj)
#pragma unroll
                    for (int n = 0; n < 2; ++n) *(f32x4*)(rp + (bj * 128 + n * 16) * 4) = acc[ai][bj][m][n];
                asm volatile("s_waitcnt lgkmcnt(0)" ::: "memory"); __builtin_amdgcn_s_barrier(); asm volatile("" ::: "memory");
                float4 xc[4];
#pragma unroll
                for (int i = 0; i < 4; ++i) xc[i] = xn[i];
                if (ai * 4 + m < 7) {
                    const int ai2 = (ai * 4 + m + 1) >> 2, m2 = (ai * 4 + m + 1) & 3;
#pragma unroll
                    for (int i = 0; i < 4; ++i) { const int lr = wv + 8 * i; xn[i] = ldnt4(x + (size_t)(brow + ai2 * 128 + (lr >> 4) * 64 + m2 * 16 + (lr & 15)) * 1024 + bcol + lane * 4); }
                }
#pragma unroll
                for (int i = 0; i < 4; ++i) {
                    const int lr = wv + 8 * i;
                    const f32x4 a = *(const f32x4*)(stg + lr * 1040 + lane * 16);
                    f32x4 o; o[0] = fmaf(ALPHA, xc[i].x, a[0]); o[1] = fmaf(ALPHA, xc[i].y, a[1]); o[2] = fmaf(ALPHA, xc[i].z, a[2]); o[3] = fmaf(ALPHA, xc[i].w, a[3]);
                    vr[ai][m][i] = o;
                    const float s1 = wave_sum((o[0] + o[1]) + (o[2] + o[3]));
                    const float s2 = wave_sum((o[0] * o[0] + o[1] * o[1]) + (o[2] * o[2] + o[3] * o[3]));
                    if (lane == 0) PS[ai * 128 + (lr >> 4) * 64 + m * 16 + (lr & 15)] = make_float2(s1, s2);
                }
                asm volatile("s_waitcnt lgkmcnt(0)" ::: "memory"); __builtin_amdgcn_s_barrier(); asm volatile("" ::: "memory");
            }
        if (wv < 4) {
            const float2 ps = PS[te];
            __hip_atomic_store(lnst + (size_t)(pm * 4 + pn) * 256 + te, ((unsigned long long)__float_as_uint(ps.y) << 32) | __float_as_uint(ps.x), __ATOMIC_RELAXED, __HIP_MEMORY_SCOPE_AGENT);
            asm volatile("s_waitcnt vmcnt(0)" ::: "memory");
            if (lane == 0) (void)xb_add(&bar[XCD_BAR_WORDS + 4 * pm], 1u);
            if (wv == 0) {
                XB_SPIN(xb_ld(&bar[XCD_BAR_WORDS + 4 * pm]) < 16u, bar);
                __builtin_amdgcn_fence(__ATOMIC_ACQUIRE, "agent");
            }
        }
        asm volatile("s_waitcnt vmcnt(0) lgkmcnt(0)" ::: "memory"); __builtin_amdgcn_s_barrier(); asm volatile("" ::: "memory");
        if (wv < 4) {
            float s1 = 0.f, s2 = 0.f;
#pragma unroll
            for (int t4 = 0; t4 < 4; ++t4) {
                const unsigned long long w = __hip_atomic_load(lnst + (size_t)(pm * 4 + t4) * 256 + te, __ATOMIC_RELAXED, __HIP_MEMORY_SCOPE_AGENT);
                s1 += __uint_as_float((unsigned)w); s2 += __uint_as_float((unsigned)(w >> 32));
            }
            const float mean = s1 * (1.f / 1024.f);
            const float var = fmaxf(s2 * (1.f / 1024.f) - mean * mean, 0.f);
            SR[te] = make_float2(mean, rsqrtf(var + LN_EPS));
        }
        asm volatile("s_waitcnt lgkmcnt(0)" ::: "memory"); __builtin_amdgcn_s_barrier(); asm volatile("" ::: "memory");
        {
            const float4 gg = *(const float4*)(p.in[14] + bcol + lane * 4), be = *(const float4*)(p.in[15] + bcol + lane * 4);
#pragma unroll
            for (int ai = 0; ai < 2; ++ai)
#pragma unroll
                for (int m = 0; m < 4; ++m)
#pragma unroll
                    for (int i = 0; i < 4; ++i) {
                        const int lr = wv + 8 * i, trow = ai * 128 + (lr >> 4) * 64 + m * 16 + (lr & 15);
                        const float2 sr = SR[trow];
                        const size_t go = (size_t)(brow + trow) * 1024 + bcol + lane * 4;
                        const f32x4 a = vr[ai][m][i];
                        float4 o; o.x = (a[0] - sr.x) * sr.y * gg.x + be.x; o.y = (a[1] - sr.x) * sr.y * gg.y + be.y; o.z = (a[2] - sr.x) * sr.y * gg.z + be.z; o.w = (a[3] - sr.x) * sr.y * gg.w + be.w;
                        stnt4(p.out + go, o);
                        uint2 hi; hi.x = pk2(o.x, o.y); hi.y = pk2(o.z, o.w);
                        uint2 lo; lo.x = pk2(o.x - bflo(hi.x), o.y - bfhi(hi.x)); lo.y = pk2(o.z - bflo(hi.y), o.w - bfhi(hi.y));
                        *(uint2*)(x1h + go) = hi;
                        *(uint2*)(x1l + go) = lo;
                        *(uint32_t*)(x1f8 + go) = pk4_f8(o.x, o.y, o.z, o.w);
                    }
        }
        asm volatile("s_waitcnt lgkmcnt(0)" ::: "memory"); __builtin_amdgcn_s_barrier(); asm volatile("" ::: "memory");
    }
}

__device__ __forceinline__ void phase6(CParams& p, int wv) {
    const int tid = opaque_tid(wv), lane = tid & 63, wid = tid >> 6;
    unsigned char* ws = p.ws;
    const float* g = p.in[14]; const float* bb = p.in[15];
    bf16_t* x1b = (bf16_t*)(ws + WS_X1B); bf16_t* x1lo = (bf16_t*)(ws + WS_X1LO);
    for (int t0 = (blockIdx.x * 8 + wid) * 2; t0 < T; t0 += gridDim.x * 16) {
        float4 v[2][4];
#pragma unroll
        for (int u = 0; u < 2; ++u)
#pragma unroll
            for (int j = 0; j < 4; ++j) v[u][j] = ldnt4(p.out + (size_t)(t0 + u) * 1024 + lane * 4 + 256 * j);
#pragma unroll
        for (int u = 0; u < 2; ++u) {
            const int t = t0 + u;
            float* row = p.out + (size_t)t * 1024;
            float s = 0.f;
#pragma unroll
            for (int j = 0; j < 4; ++j) s += (v[u][j].x + v[u][j].y) + (v[u][j].z + v[u][j].w);
            const float mean = wave_sum(s) * (1.f / 1024.f);
            float q = 0.f;
#pragma unroll
            for (int j = 0; j < 4; ++j) { v[u][j].x -= mean; v[u][j].y -= mean; v[u][j].z -= mean; v[u][j].w -= mean; q += (v[u][j].x * v[u][j].x + v[u][j].y * v[u][j].y) + (v[u][j].z * v[u][j].z + v[u][j].w * v[u][j].w); }
            const float rstd = rsqrtf(wave_sum(q) * (1.f / 1024.f) + LN_EPS);
#pragma unroll
            for (int j = 0; j < 4; ++j) {
                const int cidx = lane * 4 + 256 * j;
                const float4 gg = *(const float4*)(g + cidx), be = *(const float4*)(bb + cidx);
                float4 o; o.x = v[u][j].x * rstd * gg.x + be.x; o.y = v[u][j].y * rstd * gg.y + be.y; o.z = v[u][j].z * rstd * gg.z + be.z; o.w = v[u][j].w * rstd * gg.w + be.w;
                stnt4(row + cidx, o);
                uint2 hi; hi.x = pk2(o.x, o.y); hi.y = pk2(o.z, o.w);
                uint2 lo; lo.x = pk2(o.x - bflo(hi.x), o.y - bfhi(hi.x)); lo.y = pk2(o.z - bflo(hi.y), o.w - bfhi(hi.y));
                *(uint2*)(x1b + (size_t)t * 1024 + cidx) = hi;
                *(uint2*)(x1lo + (size_t)t * 1024 + cidx) = lo;
            }
        }
    }
}

__device__ __forceinline__ float grp8_max(float v) {
    v = fmaxf(v, dpp_f<0xB1>(v)); v = fmaxf(v, dpp_f<0x4E>(v)); v = fmaxf(v, dpp_f<0x141>(v));
    return v;
}
constexpr int NTB = T / 128;
constexpr int TBR = NTB / NROUND;
__device__ __forceinline__ void phase7(CParams& p, char* lds, int wv) {
    const int tid = opaque_tid(wv), lane = tid & 63, wid = tid >> 6, wm = wid >> 2, wn = wid & 3;
    unsigned char* ws = p.ws;
    const int r0 = tid >> 3, c = tid & 7, fr = lane & 15, fq = lane >> 4;
    const bf16_t* Ah = (const bf16_t*)(ws + WS_X1H); const bf16_t* Al = (const bf16_t*)(ws + WS_X1L); const bf16_t* Bt = (const bf16_t*)(ws + WS_W_R_T);
    float* lg = (float*)(lds + LDS_STG);
    const float rbias = p.in[17][lane];
    int* tok_e = (int*)(ws + WS_TOK_E); float* tok_w = (float*)(ws + WS_TOK_W);
    int* tok_pos = (int*)(ws + WS_TOK_POS);
    int* cntb = (int*)(ws + WS_CNTB);
    int* hist = (int*)(lds + LDS_MISC);
    const int grp = lane >> 3;
    for (int tb = blockIdx.x; tb < NTB; tb += gridDim.x) {
        const int m0 = tb * 128;
        f32x4 acc[4][2]; acc_zero(acc);
        const bf16_t* a0 = Ah + (size_t)(m0 + r0) * 1024 + c * 8; const bf16_t* a1 = a0 + (size_t)64 * 1024;
        const bf16_t* a0b = Al + (size_t)(m0 + r0) * 1024 + c * 8; const bf16_t* a1b = a0b + (size_t)64 * 1024;
        const bf16_t* b0 = Bt + (size_t)r0 * 2048 + c * 8; const bf16_t* b1 = b0 + (size_t)64 * 2048;
        pf_kloop<32, true>(acc, a0, a1, a0b, a1b, b0, b1, lds, tid, lane, wm, wn);
        if (wn < 2) {
#pragma unroll
            for (int mi = 0; mi < 4; ++mi)
#pragma unroll
                for (int ni = 0; ni < 2; ++ni) {
                    const int m = wm * 64 + mi * 16 + fr, n = wn * 32 + ni * 16 + 4 * fq;
                    *(f32x4*)(lg + m * 64 + n) = acc[mi][ni];
                }
        }
        if (tid < 64) hist[tid] = 0;
        __syncthreads();
        if (wn >= 2) {
#pragma unroll
            for (int mi = 0; mi < 4; ++mi)
#pragma unroll
                for (int ni = 0; ni < 2; ++ni) {
                    const int m = wm * 64 + mi * 16 + fr, n = (wn - 2) * 32 + ni * 16 + 4 * fq;
                    f32x4 v = *(const f32x4*)(lg + m * 64 + n);
                    v = v + acc[mi][ni];
                    *(f32x4*)(lg + m * 64 + n) = v;
                }
        }
        __syncthreads();
        for (int j = 0; j < 16; ++j) {
            const int tl = wid * 16 + j, t = m0 + tl;
            const float lgt = lg[tl * 64 + lane];
            const float s = 1.f / (1.f + __expf(-lgt));
            const float sc = s + rbias;
            const float m1 = grp8_max(sc);
            const bool ismax = (sc == m1);
            const unsigned long long bm = __ballot(ismax);
            const int nmax = __popcll((bm >> (grp * 8)) & 0xFFull);
            const float m2 = grp8_max(ismax ? -INFINITY : sc);
            const float gscore = m1 + (nmax >= 2 ? m1 : m2);
            int grank = 0;
#pragma unroll
            for (int g2 = 0; g2 < 8; ++g2) {
                const float o = __builtin_bit_cast(float, __builtin_amdgcn_readlane(__builtin_bit_cast(int, gscore), g2 * 8));
                grank += (o > gscore || (o == gscore && g2 < grp)) ? 1 : 0;
            }
            float mv = (grank < 4) ? sc : -INFINITY;
            unsigned long long selm = 0ull;
#pragma unroll
            for (int i8 = 0; i8 < 8; ++i8) {
                const float mx = wave_max(mv);
                const unsigned long long bmx = __ballot(mv == mx);
                const unsigned long long low = bmx & (0ull - bmx);
                selm |= low;
                if ((low >> lane) & 1ull) mv = -INFINITY;
            }
            const bool selq = (selm >> lane) & 1ull;
            const int rank = __popcll(selm & ((1ull << lane) - 1ull));
            const float ssum = wave_sum(selq ? s : 0.f);
            if (selq) {
                tok_e[(size_t)t * 8 + rank] = lane;
                tok_w[(size_t)t * 8 + rank] = s / ssum * 2.5f;
                tok_pos[(size_t)t * 9 + rank] = atomicAdd(&hist[lane], 1);
            }
        }
        __syncthreads();
        if (tid < 64) cntb[tb * 64 + tid] = hist[tid];
        __syncthreads();
    }
}

__device__ __forceinline__ int cntb_partial(const int* cntb, int i0, int i1, int tid) {
    const int e = tid & 63, part = tid >> 6;
    int c = 0;
#pragma unroll 8
    for (int i = i0 + part; i < i1; i += 8) c += cntb[i * 64 + e];
    return c;
}
__device__ __forceinline__ void round_tables(CParams& p, int r, int* misc, int tid) {
    const int* cntb = (const int*)(p.ws + WS_CNTB) + (size_t)r * TBR * 64;
    __syncthreads();
    if (tid < 64) misc[tid] = 0;
    if (tid == 64) misc[64] = TR;
    __syncthreads();
    { const int c = cntb_partial(cntb, 0, TBR, tid); atomicAdd(&misc[tid & 63], c); }
    __syncthreads();
    if (tid < 64) {
        const int nb = (misc[tid] + 255) >> 8;
        int incl = nb;
#pragma unroll
        for (int d = 1; d < 64; d <<= 1) { const int v = __shfl_up(incl, d); if (tid >= d) incl += v; }
        const int excl = incl - nb;
        misc[80 + tid] = excl * 256; misc[160 + tid] = excl;
        if (tid == 63) { misc[80 + 64] = incl * 256; misc[160 + 64] = incl; misc[160 + NE1] = incl + ((TR + 255) >> 8); }
    }
    __syncthreads();
}
__device__ __forceinline__ int find_expert(const int* misc, int blk) {
    int lo = 0, hi = NE1;
#pragma unroll
    for (int i = 0; i < 7; ++i) { const int mid = (lo + hi) >> 1; if (mid < hi && misc[160 + mid] <= blk) lo = mid; else hi = mid; if (hi - lo <= 1) break; }
    while (lo + 1 <= NEXP && misc[160 + lo + 1] <= blk) ++lo;
    return lo;
}

__device__ __forceinline__ void phase9(CParams& p, char* lds, int wv) {
    const int tid = opaque_tid(wv);
    unsigned char* ws = p.ws;
    int* misc = (int*)(lds + LDS_MISC);
    const int* tok_e = (const int*)(ws + WS_TOK_E); const float* tok_w = (const float*)(ws + WS_TOK_W);
    int* tok_pos = (int*)(ws + WS_TOK_POS);
    const int* cntb = (const int*)(ws + WS_CNTB);
    for (int tb = blockIdx.x; tb < NTB; tb += gridDim.x) {
        const int r = tb / TBR;
        round_tables(p, r, misc, tid);
        if (tid < 64) misc[256 + tid] = 0;
        __syncthreads();
        { const int c = cntb_partial(cntb, r * TBR, tb, tid); atomicAdd(&misc[256 + (tid & 63)], c); }
        __syncthreads();
        int* slot_tok = (int*)(ws + WS_SLOT_TOK) + (size_t)r * CAP; float* slot_w = (float*)(ws + WS_SLOT_W) + (size_t)r * CAP;
        for (int i = tid; i < 128 * 8; i += NTHREADS) {
            const int t = tb * 128 + (i >> 3), k = i & 7;
            const int e = tok_e[(size_t)t * 8 + k];
            const int pos = misc[80 + e] + misc[256 + e] + tok_pos[(size_t)t * 9 + k];
            slot_tok[pos] = t; slot_w[pos] = tok_w[(size_t)t * 8 + k];
            tok_pos[(size_t)t * 9 + k] = pos;
        }
        if (tid < 128) {
            const int t = tb * 128 + tid, pos = misc[80 + NEXP] + (t - r * TR);
            slot_tok[pos] = t; slot_w[pos] = 1.f;
            tok_pos[(size_t)t * 9 + 8] = pos;
        }
    }
}

struct GuItem { int r, pos0, e, nt2, nvalid; };
__device__ __forceinline__ GuItem gu_decode(const int* misc0, const int (&nbase)[NROUND + 1], int git) {
    GuItem d;
    int r = 0;
#pragma unroll
    for (int rr = 1; rr < NROUND; ++rr) r += (git >= nbase[rr]) ? 1 : 0;
    int lbase = nbase[0];
#pragma unroll
    for (int rr = 1; rr < NROUND; ++rr) lbase = (r >= rr) ? nbase[rr] : lbase;
    const int it = git - lbase;
    const int* misc = misc0 + r * 256;
    const int blk = it >> 1; d.nt2 = it & 1; d.r = r;
    const int e = find_expert(misc, blk);
    d.e = __builtin_amdgcn_readfirstlane(e);
    const int rb = __builtin_amdgcn_readfirstlane(blk - misc[160 + d.e]);
    d.pos0 = __builtin_amdgcn_readfirstlane(misc[80 + d.e] + rb * 256);
    d.nvalid = __builtin_amdgcn_readfirstlane(min(256, misc[d.e] - rb * 256));
    return d;
}
__device__ __forceinline__ void phase_gu(CParams& p, char* lds, int wv) {
    const int tid = opaque_tid(wv);
    unsigned char* ws = p.ws;
    int* misc0 = (int*)(lds + LDS_MISC);
    int nbase[NROUND + 1]; nbase[0] = 0;
#pragma unroll
    for (int r = 0; r < NROUND; ++r) { round_tables(p, r, misc0 + r * 256, tid); nbase[r + 1] = nbase[r] + __builtin_amdgcn_readfirstlane(misc0[r * 256 + 160 + NE1]) * 2; }
    const int nitems = nbase[NROUND];
    const int lane_ = tid & 63;
    const int sR = (wv >> 1) * 32 + (lane_ & 31), sCb = (2 * (wv & 1) + (lane_ >> 5)) * 16;
    const __amdgpu_buffer_rsrc_t rx = g8::make_rsrc(ws + WS_X1F8);
    int git = vblock();
    GuItem d; d.r = 0; d.pos0 = 0; d.e = 0; d.nt2 = 0; d.nvalid = 1;
    int tok0 = 0, tok1 = 0;
    g8::Src s;
    if (git < nitems) {
        d = gu_decode(misc0, nbase, git);
        const int* slot_tok = (const int*)(ws + WS_SLOT_TOK) + (size_t)d.r * CAP;
        tok0 = slot_tok[d.pos0 + min(sR, d.nvalid - 1)]; tok1 = slot_tok[d.pos0 + min(128 + sR, d.nvalid - 1)];
        s.ra = rx; s.rb = g8::make_rsrc(ws + WS_W_EGU_T + (size_t)d.e * 524288); s.bh = 8192u; s.akt = 64u; s.bkt = 32768u;
        s.ao[0] = (unsigned)(tok0 * 1024 + sCb); s.ao[1] = (unsigned)(tok1 * 1024 + sCb);
        s.bo = (unsigned)(d.nt2 * 16384 + tid * 16);
        g8::kloop_issue<0>(s, lds, wv);
    }
    while (git < nitems) {
        const GuItem c = d;
        const int gnext = git + gridDim.x;
        if (gnext < nitems) {
            d = gu_decode(misc0, nbase, gnext);
            const int* slot_tok = (const int*)(ws + WS_SLOT_TOK) + (size_t)d.r * CAP;
            tok0 = slot_tok[d.pos0 + min(sR, d.nvalid - 1)]; tok1 = slot_tok[d.pos0 + min(128 + sR, d.nvalid - 1)];
        }
        g8::f32x16 acc[2][2][2]; g8::acc_zero_f8(acc);
        g8::kloop_f8(acc, s, 16, lds, tid, wv);
        git = gnext;
        if (git < nitems) {
            s.rb = g8::make_rsrc(ws + WS_W_EGU_T + (size_t)d.e * 524288);
            s.ao[0] = (unsigned)(tok0 * 1024 + sCb); s.ao[1] = (unsigned)(tok1 * 1024 + sCb);
            s.bo = (unsigned)(d.nt2 * 16384 + tid * 16);
            g8::kloop_issue<0>(s, lds, wv);
        }
        bf16_t* hslot = (bf16_t*)(ws + WS_HSLOT) + (size_t)c.r * CAP * 256;
        {
            const int te = opaque_i(tid), lane = te & 63, wr = wv >> 2, wc = wv & 3, tc = lane & 31, hh = lane >> 5;
            char* stg = lds + LDS_STG;
            constexpr float ws8 = 1.f / W8_SCALE;
#pragma unroll
            for (int ai = 0; ai < 2; ++ai)
#pragma unroll
                for (int m = 0; m < 2; ++m) {
                    char* rp = stg + (ai * 128 + wr * 64 + m * 32 + tc) * 272 + (wc * 16 + 4 * hh) * 2;
#pragma unroll
                    for (int bj = 0; bj < 2; ++bj)
#pragma unroll
                        for (int pq = 0; pq < 2; ++pq) {
                            float hv[4];
#pragma unroll
                            for (int j = 0; j < 4; ++j) { const float g = acc[ai][bj][m][(2 * pq) * 4 + j] * ws8, u = acc[ai][bj][m][(2 * pq + 1) * 4 + j] * ws8; hv[j] = g / (1.f + __expf(-g)) * u; }
                            uint2 o; o.x = pk2(hv[0], hv[1]); o.y = pk2(hv[2], hv[3]);
                            *(uint2*)(rp + bj * 128 + pq * 16) = o;
                        }
                }
            asm volatile("s_waitcnt lgkmcnt(0)" ::: "memory"); __builtin_amdgcn_s_barrier(); asm volatile("" ::: "memory");
            uint4 v[8];
#pragma unroll
            for (int i = 0; i < 8; ++i) { const int id = te + i * 512; v[i] = *(const uint4*)(stg + (id >> 4) * 272 + (id & 15) * 16); }
#pragma unroll
            for (int i = 0; i < 8; ++i) { const int id = te + i * 512; typedef unsigned u32x4_t __attribute__((ext_vector_type(4))); const u32x4_t ov = {v[i].x, v[i].y, v[i].z, v[i].w};
                __builtin_nontemporal_store(ov, (u32x4_t*)(hslot + km_off(c.pos0 + (id >> 4), c.nt2 * 128 + (id & 15) * 8, CAP))); }
            asm volatile("s_waitcnt lgkmcnt(0)" ::: "memory"); __builtin_amdgcn_s_barrier(); asm volatile("" ::: "memory");
        }
    }
    asm volatile("s_waitcnt vmcnt(0)" ::: "memory");
}
struct DownItem { int pos0, e, half; };
__device__ __forceinline__ DownItem down_decode(const int* misc, int it, int n2) {
    DownItem d; int blk = it >> 1; d.half = it & 1;
    if (it >= n2) { const int q = (n2 << 1) + (it - n2); blk = q >> 2; d.half = 2 + (q & 3); }
    const int e = find_expert(misc, blk);
    d.e = __builtin_amdgcn_readfirstlane(e);
    const int rb = __builtin_amdgcn_readfirstlane(blk - misc[160 + d.e]);
    d.pos0 = __builtin_amdgcn_readfirstlane(misc[80 + d.e] + rb * 256);
    return d;
}
struct DownFlush {
    bf16_t* yslot; char* lds; int pos0, half, tid, wv; float w[8];
    __device__ __forceinline__ void operator()(f32x4 (&acc)[2][2][4][2], int seg) const {
        g8_store_tile<true>(acc, yslot, 1024, pos0, (half * 2 + seg) * 256, w, lds, tid, wv);
    }
    __device__ __forceinline__ void last(f32x4 (&acc)[2][2][4][2]) const {
        g8_store_tile<false>(acc, yslot, 1024, pos0, (half * 2 + 1) * 256, w, lds, tid, wv);
    }
};
__device__ __forceinline__ void phase_down(CParams& p, int r, char* lds, int wv) {
    const int tid = opaque_tid(wv);
    unsigned char* ws = p.ws;
    int* misc = (int*)(lds + LDS_MISC);
    round_tables(p, r, misc, tid);
    const int nit2 = __builtin_amdgcn_readfirstlane(misc[160 + NE1]) * 2;
    const int n2 = (nit2 / (int)gridDim.x) * (int)gridDim.x;
    const int nitems = n2 + (nit2 - n2) * 2;
    const float* slot_w = (const float*)(ws + WS_SLOT_W) + (size_t)r * CAP;
    const bf16_t* hs = (const bf16_t*)(ws + WS_HSLOT) + (size_t)r * CAP * 256;
    const bf16_t* wed = (const bf16_t*)(ws + WS_W_ED_T);
    const int lane0 = tid & 63, wr0 = wv >> 2, fr0 = lane0 & 15;
    g8::Seg sg; sg.mask = 7; sg.lg = 3; sg.aseg = 0u; sg.bseg = 256u * 64u;
    int it = vblock();
    g8::Src s; DownItem d; float w[8];
    d.pos0 = 0; d.e = 0; d.half = 0;
#pragma unroll
    for (int i = 0; i < 8; ++i) w[i] = 0.f;
    if (it < nitems) {
        d = down_decode(misc, it, n2);
#pragma unroll
        for (int i = 0; i < 8; ++i) w[i] = slot_w[d.pos0 + (i >> 2) * 128 + wr0 * 64 + (i & 3) * 16 + fr0];
        g8::km_src(s, hs, CAP, d.pos0, wed + (size_t)d.e * 1024 * 256, 1024, d.half < 2 ? d.half * 512 : (d.half - 2) * 256, tid);
        g8::kloop_issue(s, lds, wv, sg);
        asm volatile("" :: "v"(w[0]), "v"(w[1]), "v"(w[2]), "v"(w[3]), "v"(w[4]), "v"(w[5]), "v"(w[6]), "v"(w[7]));
    }
    while (it < nitems) {
        const int single = d.half >= 2;
        const int ct_last = single ? d.half - 2 : d.half * 2 + 1;
        DownFlush fl; fl.yslot = (bf16_t*)(ws + WS_YSLOT); fl.lds = lds; fl.pos0 = d.pos0; fl.half = d.half; fl.tid = tid; fl.wv = wv;
#pragma unroll
        for (int i = 0; i < 8; ++i) fl.w[i] = w[i];
        f32x4 acc[2][2][4][2]; g8::acc_zero(acc);
        g8::kloop_ms(acc, s, single ? 8 : 16, lds, tid, wv, sg, fl);
        it += gridDim.x;
        if (it < nitems) {
            d = down_decode(misc, it, n2);
#pragma unroll
            for (int i = 0; i < 8; ++i) w[i] = slot_w[d.pos0 + (i >> 2) * 128 + wr0 * 64 + (i & 3) * 16 + fr0];
            g8::km_src(s, hs, CAP, d.pos0, wed + (size_t)d.e * 1024 * 256, 1024, d.half < 2 ? d.half * 512 : (d.half - 2) * 256, tid);
            g8::kloop_issue(s, lds, wv, sg);
        }
        g8_store_tile<false>(acc, fl.yslot, 1024, fl.pos0, ct_last * 256, fl.w, lds, tid, wv);
        if (it < nitems) asm volatile("" :: "v"(w[0]), "v"(w[1]), "v"(w[2]), "v"(w[3]), "v"(w[4]), "v"(w[5]), "v"(w[6]), "v"(w[7]));
    }
    asm volatile("s_waitcnt vmcnt(0)" ::: "memory");
}

__device__ __forceinline__ void phase_combine(CParams& p, int r, int wv) {
    const int tid = opaque_tid(wv), lane = tid & 63, wid = tid >> 6;
    unsigned char* ws = p.ws;
    const float* g = p.in[24]; const float* bb = p.in[25];
    const int* tok_pos = (const int*)(ws + WS_TOK_POS);
    const bf16_t* yslot = (const bf16_t*)(ws + WS_YSLOT);
    for (int i = blockIdx.x * 8 + wid; i < TR; i += gridDim.x * 8) {
        const int t = r * TR + i;
        float* row = p.out + (size_t)t * 1024;
        float4 v[4];
#pragma unroll
        for (int j = 0; j < 4; ++j) { v[j] = ldnt4(row + lane * 4 + 256 * j); v[j].x *= ALPHA; v[j].y *= ALPHA; v[j].z *= ALPHA; v[j].w *= ALPHA; }
        int pos[9];
#pragma unroll
        for (int k = 0; k < 9; ++k) pos[k] = tok_pos[(size_t)t * 9 + k];
        uint2 y[9][4];
#pragma unroll
        for (int k = 0; k < 9; ++k)
#pragma unroll
            for (int j = 0; j < 4; ++j) { const unsigned long long w64 = __builtin_nontemporal_load((const unsigned long long*)(yslot + (size_t)pos[k] * 1024 + lane * 4 + 256 * j)); y[k][j].x = (uint32_t)w64; y[k][j].y = (uint32_t)(w64 >> 32); }
#pragma unroll
        for (int k = 0; k < 9; ++k)
#pragma unroll
            for (int j = 0; j < 4; ++j) { v[j].x += bflo(y[k][j].x); v[j].y += bfhi(y[k][j].x); v[j].z += bflo(y[k][j].y); v[j].w += bfhi(y[k][j].y); }
        float s = 0.f;
#pragma unroll
        for (int j = 0; j < 4; ++j) s += (v[j].x + v[j].y) + (v[j].z + v[j].w);
        const float mean = wave_sum(s) * (1.f / 1024.f);
        float q = 0.f;
#pragma unroll
        for (int j = 0; j < 4; ++j) { v[j].x -= mean; v[j].y -= mean; v[j].z -= mean; v[j].w -= mean; q += (v[j].x * v[j].x + v[j].y * v[j].y) + (v[j].z * v[j].z + v[j].w * v[j].w); }
        const float rstd = rsqrtf(wave_sum(q) * (1.f / 1024.f) + LN_EPS);
#pragma unroll
        for (int j = 0; j < 4; ++j) {
            const int cidx = lane * 4 + 256 * j;
            const float4 gg = *(const float4*)(g + cidx), be = *(const float4*)(bb + cidx);
            float4 o; o.x = v[j].x * rstd * gg.x + be.x; o.y = v[j].y * rstd * gg.y + be.y; o.z = v[j].z * rstd * gg.z + be.z; o.w = v[j].w * rstd * gg.w + be.w;
            stnt4(row + cidx, o);
        }
    }
}

struct XcdBarrier { unsigned* bar; unsigned x; volatile LAS unsigned* st; };
__device__ __forceinline__ XcdBarrier xcd_barrier_post(unsigned* bar, volatile LAS unsigned* st) {
    XcdBarrier b; b.bar = bar; b.x = xb_xcc_id(); b.st = st;
    if (threadIdx.x == 0) (void)xb_add(&bar[XB_XCNT(b.x)], 1u);
    return b;
}
__device__ __forceinline__ void xcd_barrier_complete(unsigned* bar, unsigned x, unsigned& nloc, unsigned& nx) {
    const unsigned G = gridDim.x * gridDim.y * gridDim.z;
    unsigned sum, cnt, mine, sp = 0u;
    for (;;) {
        sum = 0u; cnt = 0u; mine = 0u;
#pragma unroll
        for (unsigned j = 0; j < 16; ++j) { const unsigned c = xb_ld(&bar[XB_XCNT(j)]); sum += c; cnt += (c > 0u) ? 1u : 0u; mine = (j == x) ? c : mine; }
        if (sum == G) break;
        __builtin_amdgcn_s_sleep(1);
        if ((++sp & 255u) == 0u) { if (xb_ld(&bar[XB_TMO])) break; if (sp > XB_SPIN_CAP) { atomicAdd(&bar[XB_TMO], 1u); break; } }
    }
    nloc = mine > 0u ? mine : 1u; nx = cnt > 0u ? cnt : 1u;
}
__device__ __forceinline__ void xcd_barrier(const XcdBarrier& b, int wv) {
    asm volatile("s_waitcnt vmcnt(0)" ::: "memory");
    __syncthreads();
    if (wv == 0 && lane_id() == 0) {
        unsigned* bar = b.bar;
        __builtin_amdgcn_s_waitcnt(0);
        unsigned nloc = b.st[0], nx = b.st[1];
        if (nloc == 0u) { xcd_barrier_complete(bar, b.x, nloc, nx); b.st[0] = nloc; b.st[1] = nx; }
        const unsigned old = xb_add(&bar[XB_XSUB(b.x)], 1u);
        const unsigned gen = old / nloc;
        if (old + 1u == (gen + 1u) * nloc) {
            __builtin_amdgcn_fence(__ATOMIC_RELEASE, "agent");
            asm volatile("s_waitcnt vmcnt(0)" ::: "memory");
            const unsigned og = xb_add(&bar[XB_TOP], 1u);
            const unsigned tg = og / nx;
            if (og + 1u == (tg + 1u) * nx) xb_add(&bar[XB_TOPGEN], 1u);
            else XB_SPIN(xb_ld(&bar[XB_TOPGEN]) == tg, bar);
            __builtin_amdgcn_fence(__ATOMIC_ACQUIRE, "agent");
            xb_add(&bar[XB_XGEN(b.x)], 1u);
            asm volatile("s_waitcnt vmcnt(0)" ::: "memory");
        } else {
            XB_SPIN(xb_ld(&bar[XB_XGEN(b.x)]) == gen, bar);
            __builtin_amdgcn_fence(__ATOMIC_ACQUIRE, "agent");
            asm volatile("s_waitcnt vmcnt(0)" ::: "memory");
        }
    }
    __syncthreads();
}

__global__ void __launch_bounds__(NTHREADS) fwd_megakernel(Params p_unused) {
    extern __shared__ __attribute__((aligned(16))) char lds[];
    volatile LAS unsigned* st = (volatile LAS unsigned*)(lds + LDS_BARW);
    const int wv = __builtin_amdgcn_readfirstlane((int)(threadIdx.x >> 6));
    if (threadIdx.x == 0) { st[0] = 0u; st[1] = 0u; st[2] = 0u; st[3] = 0u; }
    __syncthreads();
    const XcdBarrier gb = xcd_barrier_post((unsigned*)(kargs()->ws + WS_BAR), st);
    phase0(*kargs(), lds, wv);
    xcd_barrier(gb, wv);
    phase1(*kargs(), lds, wv);
    xcd_barrier(gb, wv);
    phase3(*kargs(), lds, wv);
    xcd_barrier(gb, wv);
    phase4(*kargs(), lds, wv);
    xcd_barrier(gb, wv);
    phase5(*kargs(), lds, wv);
    xcd_barrier(gb, wv);
    phase7(*kargs(), lds, wv);
    xcd_barrier(gb, wv);
    phase9(*kargs(), lds, wv);
    xcd_barrier(gb, wv);
    phase_gu(*kargs(), lds, wv);
    xcd_barrier(gb, wv);
    for (int r = 0; r < NROUND; ++r) {
        phase_down(*kargs(), r, lds, wv);
        xcd_barrier(gb, wv);
        phase_combine(*kargs(), r, wv);
        if (r + 1 < NROUND) xcd_barrier(gb, wv);
    }
}

extern "C" void kernel_launch(void* const* d_in, const int* in_sizes, int n_in, void* d_out, int out_size, void* d_ws, size_t ws_size, hipStream_t stream) {
    static int grid_blocks = 0;
    if (grid_blocks == 0) {
        if (n_in != 26 || out_size != T * DM || ws_size < WS_NEED) {
            fprintf(stderr, "kernel_launch: unexpected shapes (n_in %d out %d ws %zu need %zu)\n", n_in, out_size, ws_size, (size_t)WS_NEED);
            grid_blocks = -1; return;
        }
        int dev = 0, cus = 0, per_cu = 0;
        hipGetDevice(&dev);
        hipDeviceGetAttribute(&cus, hipDeviceAttributeMultiprocessorCount, dev);
        hipFuncSetAttribute((const void*)fwd_megakernel, hipFuncAttributeMaxDynamicSharedMemorySize, LDS_BYTES);
        hipOccupancyMaxActiveBlocksPerMultiprocessor(&per_cu, (const void*)fwd_megakernel, NTHREADS, LDS_BYTES);
        if (per_cu < 1) { fprintf(stderr, "kernel_launch: occupancy query says %d blocks per CU\n", per_cu); grid_blocks = -1; return; }
        grid_blocks = cus * 1;
    }
    if (grid_blocks < 0) return;
    Params p{};
    for (int i = 0; i < 26; ++i) p.in[i] = (const float*)d_in[i];
    p.out = (float*)d_out; p.ws = (unsigned char*)d_ws;
    if (hipMemsetAsync((char*)d_ws + WS_BAR, 0, 16384, stream) != hipSuccess) { fprintf(stderr, "kernel_launch: memset of barrier words failed\n"); return; }
    void* args[] = {&p};
    hipError_t e = hipLaunchCooperativeKernel((const void*)fwd_megakernel, dim3(grid_blocks), dim3(NTHREADS), args, LDS_BYTES, stream);
    if (e != hipSuccess) fprintf(stderr, "cooperative launch failed: %s (grid %d)\n", hipGetErrorString(e), grid_blocks);
}
```

```cpp
#include <hip/hip_runtime.h>
#include <stdint.h>
#include <stdio.h>

typedef unsigned short bf16_t;
typedef short bf16x8 __attribute__((ext_vector_type(8)));
typedef float f32x4 __attribute__((ext_vector_type(4)));
__device__ __forceinline__ float4 ldnt4(const float* p) { const f32x4 v = __builtin_nontemporal_load((const f32x4*)p); return make_float4(v[0], v[1], v[2], v[3]); }
__device__ __forceinline__ void stnt4(float* p, const float4& o) { const f32x4 v = {o.x, o.y, o.z, o.w}; __builtin_nontemporal_store(v, (f32x4*)p); }
#define LAS __attribute__((address_space(3)))

constexpr int DM = 1024, NB = 16, SEQ = 2048, T = NB * SEQ;
constexpr int NPROJ = 1536;
constexpr int NMEM = 256;
constexpr int NEXP = 64, NE1 = 65;
constexpr int DEXP = 256;
constexpr int NROUND = 4, TR = T / NROUND;
constexpr int CAP = 90368;
constexpr float ALPHA = 1.189207115002721f;
constexpr float LN_EPS = 1e-5f, RMS_EPS = 1e-6f;
constexpr float IDXW_SCALE = 0.04419417382415922f;
constexpr int PC_CQ = 0, PC_CKV = 256, PC_KIDX = 384, PC_IDXW = 448, PC_GB = 512, PC_GC = 768, PC_H = 1024, PC_QM = 1280;

constexpr size_t al256(size_t x) { return (x + 255) & ~(size_t)255; }
constexpr size_t WS_W_IN_T = 0;
constexpr size_t WS_W_Q2_T = WS_W_IN_T + (size_t)1536 * 1024 * 2;
constexpr size_t WS_W_MKV_T = WS_W_Q2_T + (size_t)1536 * 256 * 2;
constexpr size_t WS_W_OUT2_T = WS_W_MKV_T + (size_t)512 * 1024 * 2;
constexpr size_t WS_W_R_T = WS_W_OUT2_T + (size_t)1024 * 1536 * 2;
constexpr size_t WS_W_EGU_T = WS_W_R_T + (size_t)128 * 3072 * 2;
constexpr size_t WS_W_ED_T = WS_W_EGU_T + (size_t)NE1 * 512 * 1024 * 2;
constexpr size_t WS_CNT = WS_W_ED_T + (size_t)NE1 * 1024 * 256 * 2;
constexpr size_t WS_CNTB = WS_CNT + 4096;
constexpr size_t WS_BAR = WS_CNTB + (size_t)256 * 64 * 4;
constexpr size_t WS_TOK_E = WS_BAR + 16384;
constexpr size_t WS_TOK_W = WS_TOK_E + (size_t)T * 8 * 4;
constexpr size_t WS_TOK_POS = WS_TOK_W + (size_t)T * 8 * 4;
constexpr size_t WS_SLOT_TOK = al256(WS_TOK_POS + (size_t)T * 9 * 4);
constexpr size_t WS_SLOT_W = WS_SLOT_TOK + (size_t)NROUND * CAP * 4;
constexpr size_t WS_X1B = al256(WS_SLOT_W + (size_t)NROUND * CAP * 4);
constexpr size_t WS_B = al256(WS_X1B + (size_t)T * 1024 * 2);
constexpr size_t WS_XB = WS_B;
constexpr size_t WS_CAT2 = WS_X1B;
constexpr size_t WS_MEMB = WS_XB + (size_t)T * 1024 * 2;
constexpr size_t WS_PROJ = WS_MEMB + (size_t)4096 * 1024 * 2;
constexpr size_t WS_KMEM = WS_PROJ + (size_t)T * NPROJ * 2;
constexpr size_t WS_VTMEM = WS_KMEM + (size_t)4096 * 256 * 2;
constexpr size_t WS_KIDX = WS_VTMEM + (size_t)256 * 4096 * 2;
constexpr size_t WS_CQN = WS_KIDX + (size_t)T * 64 * 2;
constexpr size_t WS_CKVN = WS_CQN + (size_t)T * 256 * 2;
constexpr size_t WS_Q2 = WS_CKVN + (size_t)T * 128 * 2;
constexpr size_t WS_END_EARLY = WS_Q2 + (size_t)T * 1536 * 2;
constexpr size_t WS_X1LO = WS_B;
constexpr size_t WS_LOGITS = WS_X1LO + (size_t)T * 1024 * 2;
constexpr size_t WS_X1F8 = al256(WS_CAT2 + (size_t)T * 1536 * 2);
constexpr size_t WS_X1H = WS_X1F8 + (size_t)T * 1024;
constexpr size_t WS_X1L = WS_X1H + (size_t)T * 1024 * 2;
constexpr size_t WS_LNST = WS_X1L + (size_t)T * 1024 * 2;
constexpr size_t WS_YSLOT = WS_X1B;
constexpr size_t WS_HSLOT = WS_YSLOT + (size_t)CAP * 1024 * 2;
constexpr size_t WS_END_MOE = WS_HSLOT + (size_t)NROUND * CAP * 256 * 2;
static_assert(WS_X1F8 + (size_t)T * 1024 <= WS_HSLOT, "x1 fp8 must end below HSLOT");
static_assert(WS_LNST + (size_t)128 * 4 * 256 * 8 <= WS_END_EARLY, "LN statistics must fit the early region");
constexpr size_t WS_NEED = WS_END_EARLY > WS_END_MOE ? WS_END_EARLY : WS_END_MOE;

constexpr int NTHREADS = 512;
constexpr int LDS_GEMM_H = 65536;
constexpr int LDS_MISC = 139264;
constexpr int LDS_STG = 65536;
constexpr int LDS_BYTES = 155648;
constexpr int LDS_BARW = LDS_BYTES - 16;
constexpr int WAVE_LDS = 15360;

struct Params {
    const float* in[26];
    float* out;
    unsigned char* ws;
};
typedef const __attribute__((address_space(4))) Params CParams;
__device__ __forceinline__ CParams* kargs() {
    CParams* q = (CParams*)__builtin_amdgcn_kernarg_segment_ptr();
    asm volatile("" : "+s"(q));
    return q;
}

typedef __bf16 bf16x2_t __attribute__((ext_vector_type(2)));
typedef float f32x2_t __attribute__((ext_vector_type(2)));
__device__ __forceinline__ uint32_t pk2(float a, float b) {
    const f32x2_t v = {a, b};
    return __builtin_bit_cast(uint32_t, __builtin_convertvector(v, bf16x2_t));
}
__device__ __forceinline__ bf16_t f2bf(float f) { return (bf16_t)(pk2(f, 0.f) & 0xFFFFu); }
__device__ __forceinline__ float bf2f(bf16_t h) { return __uint_as_float(((uint32_t)h) << 16); }
__device__ __forceinline__ float bflo(uint32_t w) { return __uint_as_float(w << 16); }
__device__ __forceinline__ float bfhi(uint32_t w) { return __uint_as_float(w & 0xFFFF0000u); }
__device__ __forceinline__ int lane_id() { return (int)__builtin_amdgcn_mbcnt_hi(~0u, __builtin_amdgcn_mbcnt_lo(~0u, 0u)); }
__device__ __forceinline__ int opaque_tid(int wv) { int t = wv * 64 + lane_id(); asm volatile("" : "+v"(t)); return t; }
__device__ __forceinline__ int opaque_i(int t) { asm volatile("" : "+v"(t)); return t; }
__device__ __forceinline__ size_t km_off(int row, int k, int nrows) { return ((size_t)(k >> 5) * nrows + row) * 32 + (k & 31); }
__device__ __forceinline__ void wave_sync() {
    __builtin_amdgcn_fence(__ATOMIC_RELEASE, "wavefront");
    __builtin_amdgcn_wave_barrier();
    __builtin_amdgcn_fence(__ATOMIC_ACQUIRE, "wavefront");
}
template <int CTRL> __device__ __forceinline__ float dpp_f(float x) {
    return __builtin_bit_cast(float, __builtin_amdgcn_mov_dpp(__builtin_bit_cast(int, x), CTRL, 0xf, 0xf, true));
}
__device__ __forceinline__ float xrow16_max(float x) {
    auto s = __builtin_amdgcn_permlane16_swap(__float_as_uint(x), __float_as_uint(x), false, false);
    x = fmaxf(__uint_as_float(s[0]), __uint_as_float(s[1]));
    auto t = __builtin_amdgcn_permlane32_swap(__float_as_uint(x), __float_as_uint(x), false, false);
    return fmaxf(__uint_as_float(t[0]), __uint_as_float(t[1]));
}
__device__ __forceinline__ float xrow16_sum(float x) {
    auto s = __builtin_amdgcn_permlane16_swap(__float_as_uint(x), __float_as_uint(x), false, false);
    x = __uint_as_float(s[0]) + __uint_as_float(s[1]);
    auto t = __builtin_amdgcn_permlane32_swap(__float_as_uint(x), __float_as_uint(x), false, false);
    return __uint_as_float(t[0]) + __uint_as_float(t[1]);
}
__device__ __forceinline__ float wave_sum(float v) {
    v += dpp_f<0xB1>(v); v += dpp_f<0x4E>(v); v += dpp_f<0x141>(v); v += dpp_f<0x128>(v);
    return xrow16_sum(v);
}
__device__ __forceinline__ float wave_max(float v) {
    v = fmaxf(v, dpp_f<0xB1>(v)); v = fmaxf(v, dpp_f<0x4E>(v)); v = fmaxf(v, dpp_f<0x141>(v)); v = fmaxf(v, dpp_f<0x128>(v));
    return xrow16_max(v);
}
__device__ __forceinline__ uint32_t pk4_f8(float a, float b, float c, float d) {
    int p = __builtin_amdgcn_cvt_pk_fp8_f32(a, b, 0, false);
    p = __builtin_amdgcn_cvt_pk_fp8_f32(c, d, p, true);
    return (uint32_t)p;
}
__device__ __forceinline__ void unpack8(const uint4& v, float* f) {
    f[0] = bflo(v.x); f[1] = bfhi(v.x); f[2] = bflo(v.y); f[3] = bfhi(v.y);
    f[4] = bflo(v.z); f[5] = bfhi(v.z); f[6] = bflo(v.w); f[7] = bfhi(v.w);
}

template <int AMODE>
__device__ __forceinline__ void gemm_loop(f32x4 (&acc)[4][2], const bf16_t* a0, const bf16_t* a1, const bf16_t* a0b, const bf16_t* a1b,
                                          const bf16_t* b0, const bf16_t* b1, int nk, char* lds, const char* ldsH,
                                          int tid, int lane, int wm, int wn) {
    const int fr = lane & 15, fq = lane >> 4;
    const int r0 = tid >> 3, c = tid & 7;
    const int wo = r0 * 128 + ((c ^ ((r0 >> 1) & 7)) << 4);
    uint4 ra0, ra1, rb0, rb1;
    ra0 = ra1 = make_uint4(0, 0, 0, 0);
    if (AMODE != 1) { ra0 = *(const uint4*)a0; ra1 = *(const uint4*)a1; }
    rb0 = *(const uint4*)b0; rb1 = *(const uint4*)b1;
    __syncthreads();
    if (AMODE != 1) { *(uint4*)(lds + wo) = ra0; *(uint4*)(lds + wo + 8192) = ra1; }
    *(uint4*)(lds + 32768 + wo) = rb0; *(uint4*)(lds + 32768 + wo + 8192) = rb1;
    __syncthreads();
    const int swz = (fr >> 1) & 7;
    const int aoff = (wm * 64 + fr) * 128, boff = 32768 + (wn * 32 + fr) * 128;
    for (int kt = 0; kt < nk; ++kt) {
        const int cur = kt & 1;
        if (kt + 1 < nk) {
            const int k1 = kt + 1;
            if (AMODE == 0) { ra0 = *(const uint4*)(a0 + k1 * 64); ra1 = *(const uint4*)(a1 + k1 * 64); }
            if (AMODE == 2) {
                const int seg = k1 >> 4, ko = (k1 & 15) * 64;
                const bf16_t* p0 = (seg == 1) ? a0b : a0; const bf16_t* p1 = (seg == 1) ? a1b : a1;
                ra0 = *(const uint4*)(p0 + ko); ra1 = *(const uint4*)(p1 + ko);
            }
            rb0 = *(const uint4*)(b0 + k1 * 64); rb1 = *(const uint4*)(b1 + k1 * 64);
        }
        const char* pa = (AMODE == 1) ? (ldsH + kt * 16384 + aoff) : (lds + cur * 16384 + aoff);
        const char* pb = lds + cur * 16384 + boff;
#pragma unroll
        for (int kk = 0; kk < 2; ++kk) {
            const int ch = ((kk * 4 + fq) ^ swz) << 4;
            bf16x8 af[4], bfv[2];
#pragma unroll
            for (int mi = 0; mi < 4; ++mi) af[mi] = *(const bf16x8*)(pa + mi * 2048 + ch);
#pragma unroll
            for (int ni = 0; ni < 2; ++ni) bfv[ni] = *(const bf16x8*)(pb + ni * 2048 + ch);
#pragma unroll
            for (int mi = 0; mi < 4; ++mi)
#pragma unroll
                for (int ni = 0; ni < 2; ++ni)
                    acc[mi][ni] = __builtin_amdgcn_mfma_f32_16x16x32_bf16(bfv[ni], af[mi], acc[mi][ni], 0, 0, 0);
        }
        if (kt + 1 < nk) {
            const int nxt = cur ^ 1;
            if (AMODE != 1) { *(uint4*)(lds + nxt * 16384 + wo) = ra0; *(uint4*)(lds + nxt * 16384 + wo + 8192) = ra1; }
            *(uint4*)(lds + 32768 + nxt * 16384 + wo) = rb0; *(uint4*)(lds + 32768 + nxt * 16384 + wo + 8192) = rb1;
        }
        __syncthreads();
    }
}
template <int NK, bool ROUTER>
__device__ __forceinline__ void pf_kloop(f32x4 (&acc)[4][2], const bf16_t* a0, const bf16_t* a1, const bf16_t* a0b, const bf16_t* a1b,
                                             const bf16_t* b0, const bf16_t* b1, char* lds, int tid, int lane, int wm, int wn) {
    static_assert(NK % 4 == 0, "unrolled by 4");
    const int fr = lane & 15, fq = lane >> 4;
    const int r0 = tid >> 3, c = tid & 7;
    const int wo = r0 * 128 + ((c ^ ((r0 >> 1) & 7)) << 4);
    uint4 ra0_0, ra1_0, rb0_0, rb1_0, ra0_1, ra1_1, rb0_1, rb1_1, ra0_2, ra1_2, rb0_2, rb1_2, ra0_3, ra1_3, rb0_3, rb1_3;
#define RT_LOAD(s, k) do { const int k_ = (k); const int seg_ = ROUTER ? (k_ >> 4) : 0, ko_ = ROUTER ? (k_ & 15) * 64 : k_ * 64; const bf16_t* p0_ = (seg_ == 1) ? a0b : a0; const bf16_t* p1_ = (seg_ == 1) ? a1b : a1; \
        ra0_##s = *(const uint4*)(p0_ + ko_); ra1_##s = *(const uint4*)(p1_ + ko_); rb0_##s = *(const uint4*)(b0 + k_ * 64); rb1_##s = *(const uint4*)(b1 + k_ * 64); } while (0)
#define RT_STORE(s, buf) do { *(uint4*)(lds + (buf) * 16384 + wo) = ra0_##s; *(uint4*)(lds + (buf) * 16384 + wo + 8192) = ra1_##s; \
        *(uint4*)(lds + 32768 + (buf) * 16384 + wo) = rb0_##s; *(uint4*)(lds + 32768 + (buf) * 16384 + wo + 8192) = rb1_##s; } while (0)
#define RT_BAR() do { asm volatile("s_waitcnt lgkmcnt(0)" ::: "memory"); __builtin_amdgcn_s_barrier(); asm volatile("" ::: "memory"); } while (0)
    RT_LOAD(0, 0); RT_LOAD(1, 1); RT_LOAD(2, 2); RT_LOAD(3, 3);
    __syncthreads();
    RT_STORE(0, 0);
    RT_BAR();
    const int swz = (fr >> 1) & 7;
    const int aoff = (wm * 64 + fr) * 128, boff = 32768 + (wn * 32 + fr) * 128;
#define RT_STEP(j, jn) do { const int k = kt + (j); \
        RT_LOAD(j, (k + 4 < NK) ? k + 4 : NK - 1);     \
        const char* pa = lds + ((j) & 1) * 16384 + aoff; const char* pb = lds + ((j) & 1) * 16384 + boff; \
        _Pragma("unroll") for (int kk = 0; kk < 2; ++kk) { \
            const int ch = ((kk * 4 + fq) ^ swz) << 4; \
            bf16x8 af[4], bfv[2]; \
            _Pragma("unroll") for (int mi = 0; mi < 4; ++mi) af[mi] = *(const bf16x8*)(pa + mi * 2048 + ch); \
            _Pragma("unroll") for (int ni = 0; ni < 2; ++ni) bfv[ni] = *(const bf16x8*)(pb + ni * 2048 + ch); \
            _Pragma("unroll") for (int mi = 0; mi < 4; ++mi) _Pragma("unroll") for (int ni = 0; ni < 2; ++ni) \
                acc[mi][ni] = __builtin_amdgcn_mfma_f32_16x16x32_bf16(bfv[ni], af[mi], acc[mi][ni], 0, 0, 0); } \
        RT_STORE(jn, ((j) + 1) & 1); \
        RT_BAR(); } while (0)
    for (int kt = 0; kt < NK; kt += 4) {
        RT_STEP(0, 1); RT_STEP(1, 2); RT_STEP(2, 3); RT_STEP(3, 0);
    }
#undef RT_STEP
#undef RT_BAR
#undef RT_LOAD
#undef RT_STORE
}
__device__ __forceinline__ void acc_zero(f32x4 (&acc)[4][2]) {
#pragma unroll
    for (int mi = 0; mi < 4; ++mi)
#pragma unroll
        for (int ni = 0; ni < 2; ++ni) acc[mi][ni] = (f32x4){0.f, 0.f, 0.f, 0.f};
}
template <int OMODE>
__device__ __forceinline__ void gemm_item_bf16(const bf16_t* A, int lda, const bf16_t* Bt, int ldb, int nk, bf16_t* C, int ldc, int m0, int n0,
                                               char* lds, int tid, int lane, int wm, int wn) {
    const int r0 = tid >> 3, c = tid & 7;
    f32x4 acc[4][2]; acc_zero(acc);
    const bf16_t* a0 = A + (size_t)(m0 + r0) * lda + c * 8; const bf16_t* a1 = a0 + (size_t)64 * lda;
    const bf16_t* b0 = Bt + (size_t)(n0 + r0) * ldb + c * 8; const bf16_t* b1 = b0 + (size_t)64 * ldb;
    pf_kloop<16, false>(acc, a0, a1, a0, a1, b0, b1, lds, tid, lane, wm, wn);
    const int fr = lane & 15, fq = lane >> 4;
#pragma unroll
    for (int mi = 0; mi < 4; ++mi)
#pragma unroll
        for (int ni = 0; ni < 2; ++ni) {
            const int m = m0 + wm * 64 + mi * 16 + fr, n = n0 + wn * 32 + ni * 16 + 4 * fq;
            uint2 o; o.x = pk2(acc[mi][ni][0], acc[mi][ni][1]); o.y = pk2(acc[mi][ni][2], acc[mi][ni][3]);
            size_t off;
            if (OMODE == 0) off = (size_t)m * ldc + n;
            else if (OMODE == 1) {
                const int b = m >> 8, key = m & 255, h = n >> 6, d = n & 63;
                off = ((size_t)((((b * 4 + h) * 16 + (key >> 4)) * 2 + (d >> 5)) * 64 + ((d & 31) >> 3) * 16 + (key & 15))) * 8 + (d & 7);
            } else {
                const int h = m >> 6, d = m & 63, b = n >> 8, key = n & 255, k32 = key & 31;
                off = ((size_t)((((b * 4 + h) * 8 + (key >> 5)) * 4 + (d >> 4)) * 64 + ((k32 & 15) >> 2) * 16 + (d & 15))) * 8 + ((k32 >> 4) * 4);
            }
            *(uint2*)(C + off) = o;
        }
}

namespace g8 {
constexpr int HTB = 8192;
__device__ __forceinline__ int lds_byte(int r, int c) { const int ob = (r & 15) * 64 + c * 2; return (r >> 4) * 1024 + (ob ^ (((ob >> 9) & 1) << 5)); }
__device__ __forceinline__ void stage_rc(int b, int& R, int& C) { const int st = b / 1024, sb = b % 1024, swz = sb ^ (((sb >> 9) & 1) << 5); R = st * 16 + swz / 64; C = (swz % 64) / 2; }
struct Src { __amdgpu_buffer_rsrc_t ra, rb; unsigned ao[2]; unsigned bo; unsigned bh; unsigned akt, bkt; };
__device__ __forceinline__ __amdgpu_buffer_rsrc_t make_rsrc(const void* p) {
    const unsigned long long a = (unsigned long long)p;
    const unsigned lo = __builtin_amdgcn_readfirstlane((unsigned)a), hi = __builtin_amdgcn_readfirstlane((unsigned)(a >> 32));
    return __builtin_amdgcn_make_buffer_rsrc((void*)(((unsigned long long)hi << 32) | lo), 0, 0x7FFFFFFF, 0x00020000);
}
#define G8_SA(b,h) (lds + ((b) * 2 + (h)) * g8::HTB)
#define G8_SB(b,h) (lds + (4 + (b) * 2 + (h)) * g8::HTB)
#define G8_KOFF(kt, ktstride, segstride) ((((kt) & sg.mask) * (ktstride)) + (((kt) >> sg.lg) * (segstride)))
#define G8_STAGE_A(b,h,kt) __builtin_amdgcn_raw_ptr_buffer_load_lds(s.ra, (LAS void*)(G8_SA(b,h) + wv * 1024), 16, s.ao[h], G8_KOFF(kt, s.akt, sg.aseg), 0, AAUX)
#define G8_STAGE_B(b,h,kt) __builtin_amdgcn_raw_ptr_buffer_load_lds(s.rb, (LAS void*)(G8_SB(b,h) + wv * 1024), 16, s.bo, G8_KOFF(kt, s.bkt, sg.bseg) + (h) * s.bh, 0, 0)
#define G8_LDA(dst,b,h) do { _Pragma("unroll") for (int m = 0; m < 4; ++m) \
    dst[m] = *(const bf16x8*)(G8_SA(b,h) + g8::lds_byte(wr * 64 + m * 16 + fr, fq * 8)); } while (0)
#define G8_LDB(dst,b,h) do { _Pragma("unroll") for (int n = 0; n < 2; ++n) \
    dst[n] = *(const bf16x8*)(G8_SB(b,h) + g8::lds_byte(wc * 32 + n * 16 + fr, fq * 8)); } while (0)
#define G8_MMA(ai,bj,At,Bt) do { __builtin_amdgcn_s_setprio(1); \
    _Pragma("unroll") for (int m = 0; m < 4; ++m) _Pragma("unroll") for (int n = 0; n < 2; ++n) \
      acc[ai][bj][m][n] = __builtin_amdgcn_mfma_f32_16x16x32_bf16(Bt[n], At[m], acc[ai][bj][m][n], 0, 0, 0); \
    __builtin_amdgcn_s_setprio(0); } while (0)
#define G8_WAIT_V(n) asm volatile("s_waitcnt vmcnt(" #n ")" ::: "memory")
#define G8_WAIT_L(n) asm volatile("s_waitcnt lgkmcnt(" #n ")" ::: "memory")
#define G8_BAR __builtin_amdgcn_s_barrier()
#define G8_SCHED __builtin_amdgcn_sched_barrier(0)

__device__ __forceinline__ void zero_acc(f32x4 (&acc)[2][2][4][2]) {
#pragma unroll
    for (int a = 0; a < 2; ++a)
#pragma unroll
        for (int b = 0; b < 2; ++b)
#pragma unroll
            for (int m = 0; m < 4; ++m)
#pragma unroll
                for (int n = 0; n < 2; ++n) acc[a][b][m][n] = (f32x4){0.f, 0.f, 0.f, 0.f};
}
struct Seg { int mask, lg; unsigned aseg, bseg; };
__device__ __forceinline__ Seg one_seg() { Seg g; g.mask = 0x7FFFFFFF; g.lg = 30; g.aseg = 0u; g.bseg = 0u; return g; }
struct NoFlush { __device__ __forceinline__ void operator()(f32x4 (&)[2][2][4][2], int) const {} };
template <int AAUX = 0>
__device__ __forceinline__ void kloop_issue(const Src& s, char* lds, int wv, const Seg sg = one_seg()) {
    G8_STAGE_B(0, 0, 0); G8_STAGE_A(0, 0, 0);
    G8_STAGE_B(0, 1, 0); G8_STAGE_A(0, 1, 0);
}
template <class Flush, int AAUX = 0>
__device__ __forceinline__ void kloop_ms(f32x4 (&acc)[2][2][4][2], const Src& s, int nt, char* lds, int tid, int wv, const Seg sg, const Flush& flush) {
    const int lane = tid & 63, wr = wv >> 2, wc = wv & 3, fr = lane & 15, fq = lane >> 4;
    bf16x8 At[4], B0[2], B1[2];
    if (wr == 1) G8_BAR;
    G8_WAIT_V(0); G8_BAR;
    G8_STAGE_B(1, 0, 1); G8_STAGE_A(1, 0, 1); G8_STAGE_B(1, 1, 1);
    G8_WAIT_V(3); G8_BAR;
    bool drain = false;
    for (int t = 0; t < nt - 2; t += 2) {
        G8_LDB(B0, 0, 0); G8_SCHED; G8_LDA(At, 0, 0); G8_STAGE_A(1, 1, t + 1);
        G8_WAIT_L(4); G8_BAR; G8_WAIT_L(0); G8_MMA(0, 0, At, B0); G8_BAR; G8_SCHED;
        G8_LDB(B1, 0, 1); G8_STAGE_B(0, 0, t + 2);
        G8_BAR; G8_WAIT_L(0); G8_MMA(0, 1, At, B1); G8_BAR;
        G8_LDA(At, 0, 1); G8_STAGE_A(0, 0, t + 2);
        G8_BAR; G8_WAIT_L(0); G8_MMA(1, 0, At, B0); G8_BAR; G8_SCHED;
        G8_STAGE_B(0, 1, t + 2);
        if (drain) { G8_WAIT_V(0); drain = false; } else { G8_WAIT_V(3); }
        G8_BAR; G8_MMA(1, 1, At, B1); G8_BAR;
        G8_LDB(B0, 1, 0); G8_SCHED; G8_LDA(At, 1, 0); G8_STAGE_A(0, 1, t + 2);
        G8_WAIT_L(4); G8_BAR; G8_WAIT_L(0); G8_MMA(0, 0, At, B0); G8_BAR; G8_SCHED;
        G8_LDB(B1, 1, 1); G8_STAGE_B(1, 0, t + 3);
        G8_BAR; G8_WAIT_L(0); G8_MMA(0, 1, At, B1); G8_BAR;
        G8_LDA(At, 1, 1); G8_STAGE_A(1, 0, t + 3);
        G8_BAR; G8_WAIT_L(0); G8_MMA(1, 0, At, B0); G8_BAR; G8_SCHED;
        G8_STAGE_B(1, 1, t + 3);
        G8_WAIT_V(3); G8_BAR; G8_MMA(1, 1, At, B1); G8_BAR;
        if (((t + 2) & sg.mask) == 0) {
            flush(acc, ((t + 2) >> sg.lg) - 1);
            zero_acc(acc);
            drain = true;
        }
    }
    { G8_LDB(B0, 0, 0); G8_LDA(At, 0, 0); G8_STAGE_A(1, 1, nt - 1);
      G8_BAR; G8_WAIT_L(0); G8_MMA(0, 0, At, B0); G8_BAR;
      G8_LDB(B1, 0, 1); G8_BAR; G8_WAIT_L(0); G8_MMA(0, 1, At, B1); G8_BAR;
      G8_LDA(At, 0, 1); G8_WAIT_V(2); G8_BAR; G8_WAIT_L(0); G8_MMA(1, 0, At, B0); G8_MMA(1, 1, At, B1); G8_BAR; }
    { G8_LDB(B0, 1, 0); G8_LDA(At, 1, 0); G8_WAIT_V(1); G8_BAR; G8_WAIT_L(0); G8_MMA(0, 0, At, B0); G8_BAR;
      G8_LDB(B1, 1, 1); G8_WAIT_V(0); G8_BAR; G8_WAIT_L(0); G8_MMA(0, 1, At, B1); G8_BAR;
      G8_LDA(At, 1, 1); G8_BAR; G8_WAIT_L(0); G8_MMA(1, 0, At, B0); G8_MMA(1, 1, At, B1); G8_BAR; }
    if (wr == 0) G8_BAR;
}
typedef int v8i __attribute__((ext_vector_type(8)));
typedef float f32x16 __attribute__((ext_vector_type(16)));
typedef short s16x16 __attribute__((ext_vector_type(16)));
#define F8_LDFRAG(dst, base) do { const bf16x8 lo_ = *(const bf16x8*)(base), hi_ = *(const bf16x8*)((base) + 512); \
    dst = __builtin_bit_cast(v8i, __builtin_shufflevector(lo_, hi_, 0, 1, 2, 3, 4, 5, 6, 7, 8, 9, 10, 11, 12, 13, 14, 15)); } while (0)
#define F8_LDA(dst,b,h) do { _Pragma("unroll") for (int m = 0; m < 2; ++m) F8_LDFRAG(dst[m], G8_SA(b,h) + (wr * 2 + m) * 2048 + foff); } while (0)
#define F8_LDB(dst,b,h) do { F8_LDFRAG(dst, G8_SB(b,h) + wc * 2048 + foff); } while (0)
#define F8_MMA(ai,bj,At,Bt) do { __builtin_amdgcn_s_setprio(1); \
    _Pragma("unroll") for (int m = 0; m < 2; ++m) \
      acc[ai][bj][m] = __builtin_amdgcn_mfma_scale_f32_32x32x64_f8f6f4(Bt, At[m], acc[ai][bj][m], 0, 0, 0, 0x7F7F7F7F, 0, 0x7F7F7F7F); \
    __builtin_amdgcn_s_setprio(0); } while (0)
__device__ __forceinline__ void acc_zero_f8(f32x16 (&acc)[2][2][2]) {
#pragma unroll
    for (int a = 0; a < 2; ++a)
#pragma unroll
        for (int b = 0; b < 2; ++b)
#pragma unroll
            for (int m = 0; m < 2; ++m)
#pragma unroll
                for (int i = 0; i < 16; ++i) acc[a][b][m][i] = 0.f;
}
__device__ __forceinline__ void kloop_f8(f32x16 (&acc)[2][2][2], const Src& s, int nt, char* lds, int tid, int wv) {
    constexpr int AAUX = 0;
    const Seg sg = one_seg();
    const int lane = tid & 63, wr = wv >> 2, wc = wv & 3;
    const int foff = (lane >> 5) * 1024 + (lane & 31) * 16;
    v8i At[2], B0, B1;
    if (wr == 1) G8_BAR;
    G8_WAIT_V(0); G8_BAR;
    G8_STAGE_B(1, 0, 1); G8_STAGE_A(1, 0, 1); G8_STAGE_B(1, 1, 1);
    G8_WAIT_V(3); G8_BAR;
    for (int t = 0; t < nt - 2; t += 2) {
        F8_LDB(B0, 0, 0); G8_SCHED; F8_LDA(At, 0, 0); G8_STAGE_A(1, 1, t + 1);
        G8_WAIT_L(4); G8_BAR; G8_WAIT_L(0); F8_MMA(0, 0, At, B0); G8_BAR; G8_SCHED;
        F8_LDB(B1, 0, 1); G8_STAGE_B(0, 0, t + 2);
        G8_BAR; G8_WAIT_L(0); F8_MMA(0, 1, At, B1); G8_BAR;
        F8_LDA(At, 0, 1); G8_STAGE_A(0, 0, t + 2);
        G8_BAR; G8_WAIT_L(0); F8_MMA(1, 0, At, B0); G8_BAR; G8_SCHED;
        G8_STAGE_B(0, 1, t + 2);
        G8_WAIT_V(3);
        G8_BAR; F8_MMA(1, 1, At, B1); G8_BAR;
        F8_LDB(B0, 1, 0); G8_SCHED; F8_LDA(At, 1, 0); G8_STAGE_A(0, 1, t + 2);
        G8_WAIT_L(4); G8_BAR; G8_WAIT_L(0); F8_MMA(0, 0, At, B0); G8_BAR; G8_SCHED;
        F8_LDB(B1, 1, 1); G8_STAGE_B(1, 0, t + 3);
        G8_BAR; G8_WAIT_L(0); F8_MMA(0, 1, At, B1); G8_BAR;
        F8_LDA(At, 1, 1); G8_STAGE_A(1, 0, t + 3);
        G8_BAR; G8_WAIT_L(0); F8_MMA(1, 0, At, B0); G8_BAR; G8_SCHED;
        G8_STAGE_B(1, 1, t + 3);
        G8_WAIT_V(3); G8_BAR; F8_MMA(1, 1, At, B1); G8_BAR;
    }
    { F8_LDB(B0, 0, 0); F8_LDA(At, 0, 0); G8_STAGE_A(1, 1, nt - 1);
      G8_BAR; G8_WAIT_L(0); F8_MMA(0, 0, At, B0); G8_BAR;
      F8_LDB(B1, 0, 1); G8_BAR; G8_WAIT_L(0); F8_MMA(0, 1, At, B1); G8_BAR;
      F8_LDA(At, 0, 1); G8_WAIT_V(2); G8_BAR; G8_WAIT_L(0); F8_MMA(1, 0, At, B0); F8_MMA(1, 1, At, B1); G8_BAR; }
    { F8_LDB(B0, 1, 0); F8_LDA(At, 1, 0); G8_WAIT_V(1); G8_BAR; G8_WAIT_L(0); F8_MMA(0, 0, At, B0); G8_BAR;
      F8_LDB(B1, 1, 1); G8_WAIT_V(0); G8_BAR; G8_WAIT_L(0); F8_MMA(0, 1, At, B1); G8_BAR;
      F8_LDA(At, 1, 1); G8_BAR; G8_WAIT_L(0); F8_MMA(1, 0, At, B0); F8_MMA(1, 1, At, B1); G8_BAR; }
    if (wr == 0) G8_BAR;
}
template <int AAUX = 0>
__device__ __forceinline__ void kloop(f32x4 (&acc)[2][2][4][2], const Src& s, int nt, char* lds, int tid, int wv) {
    kloop_ms<NoFlush, AAUX>(acc, s, nt, lds, tid, wv, one_seg(), NoFlush());
}
__device__ __forceinline__ void acc_zero(f32x4 (&acc)[2][2][4][2]) {
#pragma unroll
    for (int a = 0; a < 2; ++a)
#pragma unroll
        for (int b = 0; b < 2; ++b)
#pragma unroll
            for (int m = 0; m < 4; ++m)
#pragma unroll
                for (int n = 0; n < 2; ++n) acc[a][b][m][n] = (f32x4){0.f, 0.f, 0.f, 0.f};
}
__device__ __forceinline__ void dense_src(Src& s, const bf16_t* A, int lda, int brow, const bf16_t* B, int ldb, int bcol, int tid) {
    s.ra = make_rsrc(A); s.rb = make_rsrc(B); s.bh = (unsigned)(128 * ldb * 2); s.akt = 64u; s.bkt = 64u;
    int R, C; stage_rc(tid * 16, R, C);
    s.bo = (unsigned)((bcol + R) * ldb + C) * 2u;
#pragma unroll
    for (int h = 0; h < 2; ++h) s.ao[h] = (unsigned)((brow + h * 128 + R) * lda + C) * 2u;
}
__device__ __forceinline__ void km_src(Src& s, const bf16_t* A, int anrows, int brow, const bf16_t* B, int bnrows, int bcol, int tid) {
    s.ra = make_rsrc(A); s.rb = make_rsrc(B); s.bh = 128u * 64u; s.akt = (unsigned)anrows * 64u; s.bkt = (unsigned)bnrows * 64u;
    int R, C; stage_rc(tid * 16, R, C);
    s.bo = (unsigned)((bcol + R) * 32 + C) * 2u;
#pragma unroll
    for (int h = 0; h < 2; ++h) s.ao[h] = (unsigned)((brow + h * 128 + R) * 32 + C) * 2u;
}
}

__device__ __forceinline__ void tconv_tile(const float* src, const float* src2, int ld_src, bf16_t* dst, int ld_dst, int k0, int n0, int mode, float* tl, int tid, int kmrows = 0, int kmrow0 = 0, int kmk0 = 0) {
    __syncthreads();
    {
        const int nn = tid & 63, kb = tid >> 6;
        const int np = n0 + nn;
        const float* s = src; int sc = np;
        if (mode == 1) sc = (np < 456) ? np : (np < 512 ? -1 : np - 56);
        if (mode == 2) { s = ((np >> 4) & 1) ? src2 : src; sc = 16 * (np >> 5) + (np & 15); }
#pragma unroll
        for (int i = 0; i < 8; ++i) {
            const int kk = kb + i * 8;
            tl[kk * 65 + nn] = (sc >= 0) ? s[(size_t)(k0 + kk) * ld_src + sc] : 0.f;
        }
    }
    __syncthreads();
    {
        const int n2 = tid >> 3, kc = tid & 7;
        const float* s = tl + (kc * 8) * 65 + n2;
        uint4 o; o.x = pk2(s[0], s[65]); o.y = pk2(s[130], s[195]); o.z = pk2(s[260], s[325]); o.w = pk2(s[390], s[455]);
        if (kmrows) *(uint4*)(dst + km_off(kmrow0 + n0 + n2, kmk0 + k0 + kc * 8, kmrows)) = o;
        else *(uint4*)(dst + (size_t)(n0 + n2) * ld_dst + k0 + kc * 8) = o;
    }
}

__device__ __forceinline__ void tconv_wave(const float* src, const float* src2, int ld_src, bf16_t* dst, int kmrows, int k0, int n0, int mode, float* scr, int lane) {
    const int nn = lane & 31, np = n0 + nn, par = lane >> 5;
    const float* s = src; int sc = np;
    if (mode == 2) { s = ((np >> 4) & 1) ? src2 : src; sc = 16 * (np >> 5) + (np & 15); }
    float v[32];
#pragma unroll
    for (int i = 0; i < 32; ++i) v[i] = __builtin_nontemporal_load(s + (size_t)(k0 + 2 * i + par) * ld_src + sc);
    wave_sync();
#pragma unroll
    for (int i = 0; i < 32; ++i) scr[(2 * i + par) * 33 + nn] = v[i];
    wave_sync();
    const int c = lane & 7;
#pragma unroll
    for (int j = 0; j < 4; ++j) {
        const int n = (lane >> 3) + 8 * j;
        const float* sp = scr + (8 * c) * 33 + n;
        uint4 o; o.x = pk2(sp[0], sp[33]); o.y = pk2(sp[66], sp[99]); o.z = pk2(sp[132], sp[165]); o.w = pk2(sp[198], sp[231]);
        { typedef unsigned u32x4_t __attribute__((ext_vector_type(4))); const u32x4_t ov = {o.x, o.y, o.z, o.w};
          __builtin_nontemporal_store(ov, (u32x4_t*)(dst + km_off(n0 + n, k0 + 8 * c, kmrows))); }
    }
}

constexpr int EW_GU = 16 * 16, EW_DN = 4 * 32, EW_EX = EW_GU + EW_DN, EW_ITEMS = NE1 * EW_EX;
constexpr float W8_SCALE = 32.f;
__device__ __forceinline__ void tconv_wave_f8(const float* src, const float* src2, unsigned char* dst8, int k0, int n0, float* scr, int lane) {
    const int nn = lane & 31, np = n0 + nn, par = lane >> 5;
    const float* s = ((np >> 3) & 1) ? src2 : src; const int sc = 8 * (np >> 4) + (np & 7);
    float v[32];
#pragma unroll
    for (int i = 0; i < 32; ++i) v[i] = __builtin_nontemporal_load(s + (size_t)(k0 + 2 * i + par) * 256 + sc);
    wave_sync();
#pragma unroll
    for (int i = 0; i < 32; ++i) scr[(2 * i + par) * 33 + nn] = v[i];
    wave_sync();
    unsigned char* gb = dst8 + ((size_t)((k0 >> 6) * 16 + (n0 >> 5)) * 4) * 512;
#pragma unroll
    for (int cc = 0; cc < 2; ++cc) {
        const int c = par * 2 + cc;
        const float* sp = scr + (c * 16) * 33 + nn;
        uint4 o;
        o.x = pk4_f8(sp[0] * W8_SCALE, sp[33] * W8_SCALE, sp[66] * W8_SCALE, sp[99] * W8_SCALE);
        o.y = pk4_f8(sp[132] * W8_SCALE, sp[165] * W8_SCALE, sp[198] * W8_SCALE, sp[231] * W8_SCALE);
        o.z = pk4_f8(sp[264] * W8_SCALE, sp[297] * W8_SCALE, sp[330] * W8_SCALE, sp[363] * W8_SCALE);
        o.w = pk4_f8(sp[396] * W8_SCALE, sp[429] * W8_SCALE, sp[462] * W8_SCALE, sp[495] * W8_SCALE);
        { typedef unsigned u32x4_t __attribute__((ext_vector_type(4))); const u32x4_t ov = {o.x, o.y, o.z, o.w};
          __builtin_nontemporal_store(ov, (u32x4_t*)(gb + c * 512 + nn * 16)); }
    }
}
__device__ __forceinline__ void expert_w_item(CParams& p, int it, float* scr, int lane) {
    unsigned char* ws = p.ws;
    const int e = it / EW_EX; int r = it - e * EW_EX;
    const float* wg = (e < NEXP) ? p.in[18] + (size_t)e * 1024 * 256 : p.in[21];
    const float* wu = (e < NEXP) ? p.in[19] + (size_t)e * 1024 * 256 : p.in[22];
    const float* wd = (e < NEXP) ? p.in[20] + (size_t)e * 256 * 1024 : p.in[23];
    if (r < EW_GU) tconv_wave_f8(wg, wu, ws + WS_W_EGU_T + (size_t)e * 524288, (r & 15) * 64, (r >> 4) * 32, scr, lane);
    else { r -= EW_GU; tconv_wave(wd, nullptr, 1024, (bf16_t*)(ws + WS_W_ED_T) + (size_t)e * 1024 * 256, 1024, (r & 3) * 64, (r >> 2) * 32, 0, scr, lane); }
}

__device__ __forceinline__ void phase0(CParams& p, char* lds, int wv) {
    const int tid = opaque_tid(wv), G = gridDim.x, bid = blockIdx.x;
    unsigned char* ws = p.ws;
    float* tl = (float*)lds;
    if (bid == 0) { int* cnt = (int*)(ws + WS_CNT); for (int i = tid; i < 1024; i += NTHREADS) cnt[i] = 0; }
    {
        const int lane = tid & 63, wid = tid >> 6;
        const float* x = p.in[0]; bf16_t* xb = (bf16_t*)(ws + WS_XB);
        const int tl = lane >> 3, c4 = lane & 7;
        for (int it = bid * 8 + wid; it < (T / 8) * 4; it += G * 8) {
            const int tg = it >> 2, kq = it & 3;
            const float* src = x + (size_t)(tg * 8 + tl) * 1024 + kq * 256 + c4 * 4;
            float4 v[8];
#pragma unroll
            for (int j = 0; j < 8; ++j) v[j] = ldnt4(src + j * 32);
#pragma unroll
            for (int j = 0; j < 8; ++j) {
                uint2 o; o.x = pk2(v[j].x, v[j].y); o.y = pk2(v[j].z, v[j].w);
                *(uint2*)(xb + km_off(tg * 8 + tl, (kq * 8 + j) * 32 + c4 * 4, T)) = o;
            }
        }
        const int NM = NB * NMEM * DM / 4096;
        for (int it = bid; it < NM; it += G) {
            const size_t off = (size_t)it * 4096;
            const float4 v0 = ldnt4(p.in[1] + off + tid * 8), v1 = ldnt4(p.in[1] + off + tid * 8 + 4);
            uint4 o; o.x = pk2(v0.x, v0.y); o.y = pk2(v0.z, v0.w); o.z = pk2(v1.x, v1.y); o.w = pk2(v1.z, v1.w);
            *(uint4*)((bf16_t*)(ws + WS_MEMB) + off + tid * 8) = o;
        }
    }
    {
        constexpr int I_IN = 24 * 16, I_QI = 8 * 4, I_MK = 4 * 16, I_MV = 4 * 16, I_OUT = 8 * 16;
        constexpr int NIT = I_IN + I_QI + I_MK + I_MV + I_OUT;
        for (int it = bid; it < NIT; it += G) {
            int r = it;
            if (r < I_IN) { tconv_tile(p.in[2], nullptr, 1480, (bf16_t*)(ws + WS_W_IN_T), 1024, (r % 16) * 64, (r / 16) * 64, 1, tl, tid, 1536, 0, 0); continue; } r -= I_IN;
            if (r < I_QI) { tconv_tile(p.in[8], nullptr, 512, (bf16_t*)(ws + WS_W_Q2_T), 256, (r % 4) * 64, (r / 4) * 64, 0, tl, tid, 1536, 1024, 0); continue; } r -= I_QI;
            if (r < I_MK) { tconv_tile(p.in[11], nullptr, 256, (bf16_t*)(ws + WS_W_MKV_T), 1024, (r % 16) * 64, (r / 16) * 64, 0, tl, tid); continue; } r -= I_MK;
            if (r < I_MV) { tconv_tile(p.in[12], nullptr, 256, (bf16_t*)(ws + WS_W_MKV_T) + (size_t)256 * 1024, 1024, (r % 16) * 64, (r / 16) * 64, 0, tl, tid); continue; } r -= I_MV;
            tconv_tile(p.in[13] + (size_t)512 * 1024, nullptr, 1024, (bf16_t*)(ws + WS_W_OUT2_T), 1536, (r % 8) * 64, (r / 8) * 64, 0, tl, tid, 1024, 0, 1024);
        }
        __syncthreads();
        __syncthreads();
    }
    {
        const float* wuq = p.in[5]; const float* wuk = p.in[6];
        bf16_t* dst = (bf16_t*)(ws + WS_W_Q2_T);
        for (int it = bid; it < 512; it += G) {
            const int o = it * 512 + tid, n = o >> 8, r = o & 255, h = n >> 7, cc = n & 127;
            const float* a = wuq + (size_t)r * 512 + h * 64; const float* b = wuk + (size_t)cc * 512 + h * 64;
            float s = 0.f;
#pragma unroll 4
            for (int d = 0; d < 64; d += 4) { const float4 x = *(const float4*)(a + d), y = *(const float4*)(b + d); s += x.x * y.x + x.y * y.y + x.z * y.z + x.w * y.w; }
            dst[km_off(n, r, 1536)] = f2bf(s * (0.125f * 1.4426950408889634f));
        }
    }
    {
        const float* wuv = p.in[7]; const float* wout = p.in[13];
        bf16_t* dst = (bf16_t*)(ws + WS_W_OUT2_T);
        float* Lu = tl;
        float* Lo = tl + 8192;
        for (int it = bid; it < 128; it += G) {
            const int h = it >> 4, nt = it & 15;
            __syncthreads();
#pragma unroll
            for (int i = 0; i < 16; ++i) { const int idx = tid + i * 512, cc = idx >> 6, d = idx & 63; Lu[idx] = wuv[(size_t)(cc * 8 + h) * 64 + d]; }
#pragma unroll
            for (int i = 0; i < 8; ++i) { const int idx = tid + i * 512, d = idx >> 6, n = idx & 63; Lo[idx] = wout[(size_t)(h * 64 + d) * 1024 + nt * 64 + n]; }
            __syncthreads();
            const int n = tid & 63, cg = tid >> 6;
            float acc[16];
#pragma unroll
            for (int i = 0; i < 16; ++i) acc[i] = 0.f;
            for (int d = 0; d < 64; ++d) {
                const float w = Lo[d * 64 + n];
#pragma unroll
                for (int i = 0; i < 16; ++i) acc[i] = fmaf(Lu[(cg * 16 + i) * 64 + d], w, acc[i]);
            }
            uint4 o0, o1;
            o0.x = pk2(acc[0], acc[1]); o0.y = pk2(acc[2], acc[3]); o0.z = pk2(acc[4], acc[5]); o0.w = pk2(acc[6], acc[7]);
            o1.x = pk2(acc[8], acc[9]); o1.y = pk2(acc[10], acc[11]); o1.z = pk2(acc[12], acc[13]); o1.w = pk2(acc[14], acc[15]);
            bf16_t* dp = dst + km_off(nt * 64 + n, h * 128 + cg * 16, 1024);
            *(uint4*)dp = o0; *(uint4*)(dp + 8) = o1;
        }
        __syncthreads();
    }
    {
        const float* wr = p.in[16]; bf16_t* dst = (bf16_t*)(ws + WS_W_R_T);
        for (int it = bid; it < 128; it += G) {
            const int o = it * 512 + tid, e = o >> 10, k = o & 1023;
            const float w = wr[(size_t)k * 64 + e]; const bf16_t hi = f2bf(w), lo = f2bf(w - bf2f(hi));
            dst[(size_t)e * 2048 + k] = hi; dst[(size_t)e * 2048 + 1024 + k] = hi;
            dst[(size_t)(64 + e) * 2048 + k] = lo; dst[(size_t)(64 + e) * 2048 + 1024 + k] = 0;
        }
    }
}

template <bool RESYNC>
__device__ __forceinline__ void g8_store_tile(const f32x4 (&acc)[2][2][4][2], bf16_t* C, size_t ldc, int row0, int col0, const float* w8, char* lds, int tid_, int wv) {
    const int tid = opaque_i(tid_);
    const int lane = tid & 63, wr = wv >> 2, wc = wv & 3, fr = lane & 15, fq = lane >> 4;
    char* stg = lds + LDS_STG;
    if (RESYNC) { if (wr == 0) __builtin_amdgcn_s_barrier(); }
#pragma unroll
    for (int ai = 0; ai < 2; ++ai) {
#pragma unroll
        for (int m = 0; m < 4; ++m) {
            const float sc = w8 ? w8[ai * 4 + m] : 1.f;
            char* rp = stg + (wr * 64 + m * 16 + fr) * 528 + (wc * 32 + 4 * fq) * 2;
#pragma unroll
            for (int bj = 0; bj < 2; ++bj)
#pragma unroll
                for (int n = 0; n < 2; ++n) {
                    uint2 o; o.x = pk2(acc[ai][bj][m][n][0] * sc, acc[ai][bj][m][n][1] * sc); o.y = pk2(acc[ai][bj][m][n][2] * sc, acc[ai][bj][m][n][3] * sc);
                    *(uint2*)(rp + (bj * 128 + n * 16) * 2) = o;
                }
        }
        asm volatile("s_waitcnt lgkmcnt(0)" ::: "memory"); __builtin_amdgcn_s_barrier(); asm volatile("" ::: "memory");
        uint4 v[8];
#pragma unroll
        for (int i = 0; i < 8; ++i) { const int id = tid + i * 512; v[i] = *(const uint4*)(stg + (id >> 5) * 528 + (id & 31) * 16); }
#pragma unroll
        for (int i = 0; i < 8; ++i) { const int id = tid + i * 512; *(uint4*)(C + (size_t)(row0 + ai * 128 + (id >> 5)) * ldc + col0 + (id & 31) * 8) = v[i]; }
        asm volatile("s_waitcnt lgkmcnt(0)" ::: "memory"); __builtin_amdgcn_s_barrier(); asm volatile("" ::: "memory");
    }
    if (RESYNC) { if (wr == 1) __builtin_amdgcn_s_barrier(); }
}
__device__ __forceinline__ void g8_store_proj(const f32x4 (&acc)[2][2][4][2], CParams& p, int brow, int nt, char* lds, int tid_, int wv) {
    const int tid = opaque_i(tid_);
    const int lane = tid & 63, wr = wv >> 2, wc = wv & 3, fr = lane & 15, fq = lane >> 4;
    unsigned char* ws = p.ws;
    char* stg = lds + LDS_STG;
    float* rs = (float*)(stg + 128 * 528);
    bf16_t* proj = (bf16_t*)(ws + WS_PROJ);
#pragma unroll
    for (int ai = 0; ai < 2; ++ai) {
#pragma unroll
        for (int m = 0; m < 4; ++m) {
            char* rp = stg + (wr * 64 + m * 16 + fr) * 528 + (wc * 32 + 4 * fq) * 2;
#pragma unroll
            for (int bj = 0; bj < 2; ++bj)
#pragma unroll
                for (int n = 0; n < 2; ++n) {
                    uint2 o; o.x = pk2(acc[ai][bj][m][n][0], acc[ai][bj][m][n][1]); o.y = pk2(acc[ai][bj][m][n][2], acc[ai][bj][m][n][3]);
                    *(uint2*)(rp + (bj * 128 + n * 16) * 2) = o;
                }
        }
        asm volatile("s_waitcnt lgkmcnt(0)" ::: "memory"); __builtin_amdgcn_s_barrier(); asm volatile("" ::: "memory");
        const int r0g = brow + ai * 128;
        if (nt != 0) {
            uint4 v[8];
#pragma unroll
            for (int i = 0; i < 8; ++i) { const int id = tid + i * 512; v[i] = *(const uint4*)(stg + (id >> 5) * 528 + (id & 31) * 16); }
#pragma unroll
            for (int i = 0; i < 8; ++i) { const int id = tid + i * 512; *(uint4*)(proj + (size_t)(r0g + (id >> 5)) * NPROJ + nt * 256 + (id & 31) * 8) = v[i]; }
        }
        if (nt <= 1) {
            const int row = tid >> 2, q = tid & 3;
            const int ncol = (nt == 0) ? 256 : 128, per = ncol >> 2;
            float ss = 0.f;
            for (int c = 0; c < per; c += 8) {
                float f[8]; const uint4 u = *(const uint4*)(stg + row * 528 + (q * per + c) * 2); unpack8(u, f);
#pragma unroll
                for (int j = 0; j < 8; ++j) ss = fmaf(f[j], f[j], ss);
            }
            ss += dpp_f<0xB1>(ss); ss += dpp_f<0x4E>(ss);
            if (q == 0) rs[row] = rsqrtf(ss / (float)ncol + RMS_EPS);
            asm volatile("s_waitcnt lgkmcnt(0)" ::: "memory"); __builtin_amdgcn_s_barrier(); asm volatile("" ::: "memory");
            if (nt == 0) {
                const float* gq = p.in[3]; bf16_t* cqn = (bf16_t*)(ws + WS_CQN);
#pragma unroll
                for (int i = 0; i < 8; ++i) {
                    const int id = tid + i * 512, c4 = id & 3, rw = (id >> 2) & 127, kt = id >> 9, col = kt * 32 + c4 * 8;
                    float f[8]; const uint4 u = *(const uint4*)(stg + rw * 528 + col * 2); unpack8(u, f);
                    const float r = rs[rw];
                    const float4 g0 = *(const float4*)(gq + col), g1 = *(const float4*)(gq + col + 4);
                    uint4 o; o.x = pk2(f[0] * r * g0.x, f[1] * r * g0.y); o.y = pk2(f[2] * r * g0.z, f[3] * r * g0.w); o.z = pk2(f[4] * r * g1.x, f[5] * r * g1.y); o.w = pk2(f[6] * r * g1.z, f[7] * r * g1.w);
                    *(uint4*)(cqn + km_off(r0g + rw, col, T)) = o;
                }
            } else {
                const float* gkv = p.in[4]; bf16_t* ckvn = (bf16_t*)(ws + WS_CKVN); bf16_t* kidxf = (bf16_t*)(ws + WS_KIDX);
#pragma unroll
                for (int i = 0; i < 4; ++i) {
                    const int id = tid + i * 512, rw = id >> 4, ch = id & 15, col = ch * 8;
                    float f[8]; const uint4 u = *(const uint4*)(stg + rw * 528 + col * 2); unpack8(u, f);
                    const float r = rs[rw];
                    const float4 g0 = *(const float4*)(gkv + col), g1 = *(const float4*)(gkv + col + 4);
                    uint4 o; o.x = pk2(f[0] * r * g0.x, f[1] * r * g0.y); o.y = pk2(f[2] * r * g0.z, f[3] * r * g0.w); o.z = pk2(f[4] * r * g1.x, f[5] * r * g1.y); o.w = pk2(f[6] * r * g1.z, f[7] * r * g1.w);
                    *(uint4*)(ckvn + (size_t)(r0g + rw) * 128 + col) = o;
                }
#pragma unroll
                for (int i = 0; i < 2; ++i) {
                    const int id = tid + i * 512, f16 = id & 15, fq2 = (id >> 4) & 3, kk = (id >> 6) & 1, t16 = id >> 7;
                    const uint4 u = *(const uint4*)(stg + (t16 * 16 + f16) * 528 + (128 + kk * 32 + fq2 * 8) * 2);
                    *(uint4*)(kidxf + ((size_t)(((r0g >> 4) + t16) * 2 + kk) * 64 + fq2 * 16 + f16) * 8) = u;
                }
            }
        }
        asm volatile("s_waitcnt lgkmcnt(0)" ::: "memory"); __builtin_amdgcn_s_barrier(); asm volatile("" ::: "memory");
    }
}
__device__ __forceinline__ int vblock() { const int G = gridDim.x, b = blockIdx.x; return ((G & 7) == 0) ? (b & 7) * (G >> 3) + (b >> 3) : b; }

__device__ __forceinline__ void phase1(CParams& p, char* lds, int wv) {
    const int tid = opaque_tid(wv), lane = tid & 63, wid = tid >> 6, wm = wid >> 2, wn = wid & 3;
    unsigned char* ws = p.ws;
    constexpr int I1 = (T / 256) * 6, I2 = (4096 / 128) * 2, I3 = 2 * (4096 / 128);
    {
        int it = vblock();
        g8::Src s;
        if (it < I1) { g8::km_src(s, (const bf16_t*)(ws + WS_XB), T, (it / 6) * 256, (const bf16_t*)(ws + WS_W_IN_T), 1536, (it % 6) * 256, tid); g8::kloop_issue(s, lds, wv); }
        while (it < I1) {
            const int brow = (it / 6) * 256, bcol = (it % 6) * 256;
            f32x4 acc[2][2][4][2]; g8::acc_zero(acc);
            g8::kloop(acc, s, 32, lds, tid, wv);
            it += gridDim.x;
            if (it < I1) { g8::km_src(s, (const bf16_t*)(ws + WS_XB), T, (it / 6) * 256, (const bf16_t*)(ws + WS_W_IN_T), 1536, (it % 6) * 256, tid); g8::kloop_issue(s, lds, wv); }
            g8_store_proj(acc, p, brow, bcol >> 8, lds, tid, wv);
        }
    }
    asm volatile("s_waitcnt vmcnt(0)" ::: "memory");
    __syncthreads();
    for (int it = blockIdx.x; it < I2 + I3; it += gridDim.x) {
        if (it < I2) { const int r = it; gemm_item_bf16<1>((const bf16_t*)(ws + WS_MEMB), 1024, (const bf16_t*)(ws + WS_W_MKV_T), 1024, 16, (bf16_t*)(ws + WS_KMEM), 256, (r / 2) * 128, (r % 2) * 128, lds, tid, lane, wm, wn); }
        else { const int r = it - I2;
            gemm_item_bf16<2>((const bf16_t*)(ws + WS_W_MKV_T) + (size_t)256 * 1024, 1024, (const bf16_t*)(ws + WS_MEMB), 1024, 16, (bf16_t*)(ws + WS_VTMEM), 4096, (r / 32) * 128, (r % 32) * 128, lds, tid, lane, wm, wn); }
    }
}

__device__ __forceinline__ void phase2(CParams& p, int wv) {
    const int tid = opaque_tid(wv), lane = tid & 63, wid = tid >> 6;
    unsigned char* ws = p.ws;
    const bf16_t* proj = (const bf16_t*)(ws + WS_PROJ);
    bf16_t* cqn = (bf16_t*)(ws + WS_CQN); bf16_t* ckvn = (bf16_t*)(ws + WS_CKVN);
    const float* gq = p.in[3]; const float* gkv = p.in[4];
    for (int t = blockIdx.x * 8 + wid; t < T; t += gridDim.x * 8) {
        const bf16_t* row = proj + (size_t)t * NPROJ;
        {
            const uint2 v = *(const uint2*)(row + PC_CQ + lane * 4);
            const float a = bflo(v.x), b = bfhi(v.x), c = bflo(v.y), d = bfhi(v.y);
            const float ss = wave_sum(a * a + b * b + c * c + d * d);
            const float r = rsqrtf(ss * (1.f / 256.f) + RMS_EPS);
            const float4 g = *(const float4*)(gq + lane * 4);
            uint2 o; o.x = pk2(a * r * g.x, b * r * g.y); o.y = pk2(c * r * g.z, d * r * g.w);
            *(uint2*)(cqn + km_off(t, lane * 4, T)) = o;
        }
        {
            const uint32_t v = *(const uint32_t*)(row + PC_CKV + lane * 2);
            const float a = bflo(v), b = bfhi(v);
            const float ss = wave_sum(a * a + b * b);
            const float r = rsqrtf(ss * (1.f / 128.f) + RMS_EPS);
            const float2 g = *(const float2*)(gkv + lane * 2);
            *(uint32_t*)(ckvn + (size_t)t * 128 + lane * 2) = pk2(a * r * g.x, b * r * g.y);
        }
        if (lane < 32) {
            const int dd = lane * 2;
            const size_t off = ((size_t)((t >> 4) * 2 + (dd >> 5)) * 64 + ((dd & 31) >> 3) * 16 + (t & 15)) * 8 + (dd & 7);
            *(uint32_t*)((bf16_t*)(ws + WS_KIDX) + off) = *(const uint32_t*)(row + PC_KIDX + dd);
        }
    }
}

__device__ __forceinline__ void phase3(CParams& p, char* lds, int wv) {
    const int tid = opaque_tid(wv);
    unsigned char* ws = p.ws;
    constexpr int I1 = (T / 256) * 6;
    int it = vblock();
    g8::Src s;
    if (it < I1) { g8::km_src(s, (const bf16_t*)(ws + WS_CQN), T, (it / 6) * 256, (const bf16_t*)(ws + WS_W_Q2_T), 1536, (it % 6) * 256, tid); g8::kloop_issue(s, lds, wv); }
    while (it < I1) {
        const int brow = (it / 6) * 256, bcol = (it % 6) * 256;
        f32x4 acc[2][2][4][2]; g8::acc_zero(acc);
        g8::kloop(acc, s, 8, lds, tid, wv);
        it += gridDim.x;
        if (it < I1) { g8::km_src(s, (const bf16_t*)(ws + WS_CQN), T, (it / 6) * 256, (const bf16_t*)(ws + WS_W_Q2_T), 1536, (it % 6) * 256, tid); g8::kloop_issue(s, lds, wv); }
        g8_store_tile<false>(acc, (bf16_t*)(ws + WS_Q2), 1536, brow, bcol, nullptr, lds, tid, wv);
    }
}

typedef short s16x4 __attribute__((ext_vector_type(4)));
__device__ __forceinline__ int t5_bucket(int n) {
    if (n < 16) return n;
    if (n >= 128) return 31;
    const int l = 16 + (int)(__log2f((float)n * 0.0625f) * (16.0f / 3.0f));
    return l < 31 ? l : 31;
}
__device__ __forceinline__ bf16x8 ld_frag(const bf16_t* p) { return *(const bf16x8*)p; }
__device__ __forceinline__ bf16x8 u4_as_frag(const uint4& v) { union { uint4 u; bf16x8 f; } c; c.u = v; return c.f; }

constexpr int SK_STRIDE = 2052;
constexpr int P4_SEL = 16 * SK_STRIDE * 4;
constexpr int P4_RB = P4_SEL + 16 * 256 * 2;
constexpr int P4_SELB = P4_RB + 1024;

constexpr int P4_CSCR = P4_SELB + 4096;
constexpr int P4_HIST = P4_CSCR + 2048;
template <int NREG>
__device__ __forceinline__ void select_query(const uint32_t* skrow, unsigned short* sel, unsigned char* selb, uint32_t* cscr, uint32_t* hist, int t, int lane) {
    const unsigned long long ltmask = (1ull << lane) - 1ull;
    uint32_t key[NREG];
#pragma unroll
    for (int i = 0; i < NREG; ++i) { const int s = i * 64 + lane; const uint32_t kv = skrow[s]; key[i] = (s <= t) ? kv : 0u; }
    uint32_t prefix = 0; bool exact = false;
    int nS = 0, nU = t + 1, bit = 31;
    {
        const uint32_t cand = 0x80000000u;
        int cnt = 0;
#pragma unroll
        for (int i = 0; i < NREG; ++i) cnt += __popcll(__ballot(key[i] >= cand));
        if (cnt >= 256) { prefix = cand; nU = cnt; exact = (cnt == 256); } else { nU -= cnt; nS = cnt; }
        bit = 30;
        if (!exact && nU > 64) {
            uint32_t a = 0xFFFFFFFFu, o = 0u;
#pragma unroll
            for (int i = 0; i < NREG; ++i) { const bool inU = ((key[i] ^ prefix) >> 31) == 0u && key[i] != 0u; a &= inU ? key[i] : 0xFFFFFFFFu; o |= inU ? key[i] : 0u; }
#pragma unroll
            for (int d = 1; d < 64; d <<= 1) { a &= (uint32_t)__shfl_xor((int)a, d); o |= (uint32_t)__shfl_xor((int)o, d); }
            const uint32_t diff = (a ^ o) & 0x7FFFFFFFu;
            if (diff == 0u) { prefix = a; bit = -1; }
            else {
                const int top = 31 - __clz(diff);
                const uint32_t keep = (top >= 30) ? 0u : (0x7FFFFFFFu & ~((2u << top) - 1u));
                prefix |= a & keep;
                const int nb = (top + 1 < 8) ? top + 1 : 8, shift = top + 1 - nb;
                *(uint4*)(hist + lane * 4) = make_uint4(0u, 0u, 0u, 0u);
                wave_sync();
#pragma unroll
                for (int i = 0; i < NREG; ++i) {
                    const bool inU = ((key[i] ^ prefix) >> (top + 1)) == 0u && key[i] != 0u;
                    if (inU) atomicAdd(&hist[(key[i] >> shift) & 255u], 1u);
                }
                wave_sync();
                const uint4 h4 = *(const uint4*)(hist + lane * 4);
                int suf = (int)(h4.x + h4.y + h4.z + h4.w);
#pragma unroll
                for (int d = 1; d < 64; d <<= 1) { const int v = __shfl_down(suf, d); if (lane + d < 64) suf += v; }
                const int need = 256 - nS;
                const int L = __popcll(__ballot(suf >= need)) - 1;
                const int above = (L < 63) ? __builtin_amdgcn_readlane(suf, (L + 1) & 63) : 0;
                const int hb[4] = {__builtin_amdgcn_readlane((int)h4.x, L), __builtin_amdgcn_readlane((int)h4.y, L), __builtin_amdgcn_readlane((int)h4.z, L), __builtin_amdgcn_readlane((int)h4.w, L)};
                int c = above, dig = 4 * L, inbin = 0, aboved = above;
                bool found = false;
#pragma unroll
                for (int j = 3; j >= 0; --j) { if (!found) { const int c2 = c + hb[j]; if (c2 >= need) { dig = 4 * L + j; inbin = hb[j]; aboved = c; found = true; } c = c2; } }
                prefix |= (uint32_t)dig << shift;
                nS += aboved; nU = inbin;
                exact = (nS + nU == 256);
                bit = shift - 1;
            }
        }
    }
    for (; !exact && bit >= 0 && nU > 64; --bit) {
        const uint32_t cand = prefix | (1u << bit);
        int cnt = 0;
#pragma unroll
        for (int i = 0; i < NREG; ++i) cnt += __popcll(__ballot(key[i] >= cand));
        if (cnt >= 256) { prefix = cand; nU = cnt - nS; if (cnt == 256) { exact = true; break; } }
        else { nU -= cnt - nS; nS = cnt; }
    }
    int quota = 0; bool have_quota = false;
    if (!exact && bit >= 0) {
        const int sh = bit + 1;
        int pos = 0;
        wave_sync();
#pragma unroll
        for (int i = 0; i < NREG; ++i) {
            const bool inU = (key[i] >> sh) == (prefix >> sh) && key[i] != 0u;
            const unsigned long long bu = __ballot(inU);
            if (inU) { const int d = pos + __popcll(bu & ltmask); if (d < 64) cscr[d] = key[i]; }
            pos += __popcll(bu);
        }
        wave_sync();
        const uint32_t u = (lane < pos) ? cscr[lane] : 0u;
        for (; bit >= 0; --bit) {
            const uint32_t cand = prefix | (1u << bit);
            const int cnt = nS + __popcll(__ballot(u >= cand));
            if (cnt >= 256) { prefix = cand; if (cnt == 256) { exact = true; break; } }
        }
        if (!exact) {
            if (nS + __popcll(__ballot(u >= prefix)) == 256) exact = true;
            else { quota = 256 - (nS + __popcll(__ballot(u > prefix))); have_quota = true; }
        }
    }
    if (!exact && !have_quota) {
        int cgt = 0;
#pragma unroll
        for (int i = 0; i < NREG; ++i) cgt += __popcll(__ballot(key[i] > prefix));
        quota = 256 - cgt;
    }
    int pos = 0, eqc = 0;
#pragma unroll
    for (int i = 0; i < NREG; ++i) {
        const uint32_t u = key[i];
        bool take;
        if (exact) take = (u >= prefix);
        else {
            const bool eq = (u == prefix);
            const unsigned long long beq = __ballot(eq);
            const int myeq = eqc + __popcll(beq & ltmask);
            take = (u > prefix) || (eq && myeq < quota);
            eqc += __popcll(beq);
        }
        const unsigned long long bt = __ballot(take);
        if (take) {
            const int dst = pos + __popcll(bt & ltmask); sel[dst] = (unsigned short)(i * 64 + lane);
            if (t - (i * 64 + 63) >= 128) selb[dst] = (unsigned char)31;
            else selb[dst] = (unsigned char)t5_bucket(t - (i * 64 + lane));
        }
        pos += __popcll(bt);
    }
}

__device__ __forceinline__ void dsa_item(CParams& p, int b, int t0, char* lds, int tid_in, int wv) {
    const int tid = opaque_i(tid_in);
    const int lane = tid & 63, wid = tid >> 6, fr = lane & 15, fq = lane >> 4;
    unsigned char* ws = p.ws;
    uint32_t* SK = (uint32_t*)lds;
    unsigned short* SEL = (unsigned short*)(lds + P4_SEL);
    const float* RB = (const float*)(lds + P4_RB);
    unsigned char* SELB = (unsigned char*)(lds + P4_SELB);
    const bf16_t* q2 = (const bf16_t*)(ws + WS_Q2) + ((size_t)b * SEQ + t0) * 1536;
    const bf16_t* kidx = (const bf16_t*)(ws + WS_KIDX) + (size_t)b * SEQ * 64;
    const bf16_t* ckvn = (const bf16_t*)(ws + WS_CKVN) + (size_t)b * SEQ * 128;
    __syncthreads();
    if (t0 >= 256) {
        bf16x8 qf[8][2];
#pragma unroll
        for (int h = 0; h < 8; ++h)
#pragma unroll
            for (int kk = 0; kk < 2; ++kk) qf[h][kk] = ld_frag(q2 + (size_t)fr * 1536 + 1024 + h * 64 + kk * 32 + fq * 8);
        float wv[8];
        { const uint4 v = *(const uint4*)((const bf16_t*)(ws + WS_PROJ) + ((size_t)b * SEQ + t0 + fr) * NPROJ + PC_IDXW); unpack8(v, wv); }
#pragma unroll
        for (int i = 0; i < 8; ++i) wv[i] *= IDXW_SCALE;
        const int ntile = (t0 + 16) >> 4;
        const int tq = t0 + fr;
        bf16x8 kn0 = ld_frag(kidx + (size_t)(wid * 2) * 512 + lane * 8), kn1 = ld_frag(kidx + (size_t)(wid * 2 + 1) * 512 + lane * 8);
        for (int kt = wid; kt < ntile; kt += 8) {
            const int key0 = kt * 16;
            const bf16x8 kf0 = kn0, kf1 = kn1;
            { const int kx = (kt + 8 < ntile) ? kt + 8 : kt;
              kn0 = ld_frag(kidx + (size_t)(kx * 2) * 512 + lane * 8); kn1 = ld_frag(kidx + (size_t)(kx * 2 + 1) * 512 + lane * 8); }
            float sacc[4] = {0.f, 0.f, 0.f, 0.f};
#pragma unroll
            for (int h = 0; h < 8; ++h) {
                f32x4 d = (f32x4){0.f, 0.f, 0.f, 0.f};
                d = __builtin_amdgcn_mfma_f32_16x16x32_bf16(kf0, qf[h][0], d, 0, 0, 0);
                d = __builtin_amdgcn_mfma_f32_16x16x32_bf16(kf1, qf[h][1], d, 0, 0, 0);
#pragma unroll
                for (int r = 0; r < 4; ++r) sacc[r] = fmaf(wv[h], fmaxf(d[r], 0.f), sacc[r]);
            }
            uint4 ko;
            uint32_t kk4[4];
#pragma unroll
            for (int r = 0; r < 4; ++r) {
                const int s = key0 + 4 * fq + r;
                float sc = sacc[r]; if (sc == 0.f) sc = 0.f;
                const uint32_t u = __float_as_uint(sc);
                const uint32_t key = (u & 0x80000000u) ? ~u : (u | 0x80000000u);
                kk4[r] = (s <= tq) ? key : 0u;
            }
            ko.x = kk4[0]; ko.y = kk4[1]; ko.z = kk4[2]; ko.w = kk4[3];
            *(uint4*)(SK + fr * SK_STRIDE + key0 + 4 * fq) = ko;
        }
        __syncthreads();
#pragma nounroll
        for (int qq = 0; qq < 2; ++qq) {
            const int q = wid * 2 + qq, t = t0 + q;
            uint32_t* cscr = (uint32_t*)(lds + P4_CSCR) + wid * 64;
#define DSA_SEL(N) select_query<N>(SK + q * SK_STRIDE, SEL + q * 256, SELB + q * 256, cscr, (uint32_t*)(lds + P4_HIST) + wid * 256, t, lane)
            switch (__builtin_amdgcn_readfirstlane(t0 >> 8)) {
                case 1: DSA_SEL(8); break;
                case 2: DSA_SEL(12); break;
                case 3: DSA_SEL(16); break;
                case 4: DSA_SEL(20); break;
                case 5: DSA_SEL(24); break;
                case 6: DSA_SEL(28); break;
                default: DSA_SEL(32); break;
            }
#undef DSA_SEL
        }
    } else {
        for (int qq = 0; qq < 2; ++qq) {
            const int q = wid * 2 + qq, t = t0 + q;
            for (int k = lane; k <= t; k += 64) { SEL[q * 256 + k] = (unsigned short)k; SELB[q * 256 + k] = (unsigned char)t5_bucket(t - k); }
        }
    }
    __syncthreads();
    char* vst = lds + wv * 16384;
    bf16_t* cat = (bf16_t*)(ws + WS_CAT2);
    const __amdgpu_buffer_rsrc_t rkv = g8::make_rsrc(ckvn);
#pragma nounroll
    for (int qq = 0; qq < 2; ++qq) {
        const int q = wid * 2 + qq, t = t0 + q;
        const int nsel = (t + 1 < 256) ? t + 1 : 256;
        const size_t tok = (size_t)b * SEQ + t;
        const unsigned short* selq = SEL + q * 256;
        bf16x8 qf[4];
#pragma unroll
        for (int kk = 0; kk < 4; ++kk) {
            uint4 v = make_uint4(0, 0, 0, 0);
            if (fr < 8) v = *(const uint4*)(q2 + (size_t)q * 1536 + fr * 128 + kk * 32 + fq * 8);
            qf[kk] = u4_as_frag(v);
        }
        asm volatile("" :: "v"(qf[0]), "v"(qf[1]), "v"(qf[2]), "v"(qf[3]));
        float m = -INFINITY, l = 0.f;
        f32x4 O[8];
#pragma unroll
        for (int ct = 0; ct < 8; ++ct) O[ct] = (f32x4){0.f, 0.f, 0.f, 0.f};
        const int nck = (nsel + 31) >> 5;
#define DSA_ISSUE(c) do { int sv_[8]; \
            _Pragma("unroll") for (int pc = 0; pc < 8; ++pc) sv_[pc] = (int)selq[(c) * 32 + pc * 4 + fq];     \
            _Pragma("unroll") for (int pc = 0; pc < 8; ++pc) { \
            const int row_ = pc * 4 + fq; const int k_ = (c) * 32 + row_; \
            const int s_ = (k_ < nsel) ? sv_[pc] : 0; \
            __builtin_amdgcn_raw_ptr_buffer_load_lds(rkv, (LAS void*)(vst + ((c) & 1) * 8192 + pc * 1024), 16, (unsigned)(s_ * 256 + ((fr ^ (row_ & 15)) << 4)), 0, 0, 0); } } while (0)
        DSA_ISSUE(0);
#pragma nounroll
        for (int ck = 0; ck < nck; ++ck) {
            if (ck + 1 < nck) { DSA_ISSUE(ck + 1); asm volatile("s_waitcnt vmcnt(8)" ::: "memory"); }
            else asm volatile("s_waitcnt vmcnt(0)" ::: "memory");
            const char* buf = vst + (ck & 1) * 8192;
            bf16x8 a0[4], a1[4];
#pragma unroll
            for (int kk = 0; kk < 4; ++kk) {
                const int ch = ((kk * 4 + fq) ^ fr) << 4;
                a0[kk] = *(const bf16x8*)(buf + fr * 256 + ch);
                a1[kk] = *(const bf16x8*)(buf + (16 + fr) * 256 + ch);
            }
            f32x4 d0 = (f32x4){0.f, 0.f, 0.f, 0.f}, d1 = (f32x4){0.f, 0.f, 0.f, 0.f};
#pragma unroll
            for (int kk = 0; kk < 4; ++kk) {
                d0 = __builtin_amdgcn_mfma_f32_16x16x32_bf16(a0[kk], qf[kk], d0, 0, 0, 0);
                d1 = __builtin_amdgcn_mfma_f32_16x16x32_bf16(a1[kk], qf[kk], d1, 0, 0, 0);
            }
            float lg0[4], lg1[4];
            {
                const int kb = ck * 32 + 4 * fq;
                const uint32_t bw0 = *(const uint32_t*)(SELB + q * 256 + kb), bw1 = *(const uint32_t*)(SELB + q * 256 + kb + 16);
#pragma unroll
                for (int r = 0; r < 4; ++r) {
                    const bool v0 = (kb + r) < nsel, v1 = (kb + 16 + r) < nsel;
                    const int b0 = (int)((bw0 >> (8 * r)) & 31u), b1 = (int)((bw1 >> (8 * r)) & 31u);
                    const float rb0 = RB[b0 * 8 + (fr & 7)], rb1 = RB[b1 * 8 + (fr & 7)];
                    lg0[r] = (d0[r] + rb0) + (v0 ? 0.f : -INFINITY);
                    lg1[r] = (d1[r] + rb1) + (v1 ? 0.f : -INFINITY);
                }
            }
            float cm = fmaxf(fmaxf(fmaxf(lg0[0], lg0[1]), fmaxf(lg0[2], lg0[3])), fmaxf(fmaxf(lg1[0], lg1[1]), fmaxf(lg1[2], lg1[3])));
            cm = xrow16_max(cm);
            const float mn = fmaxf(m, cm);
            const float scl = __builtin_amdgcn_exp2f(m - mn);
            float p0[4], p1[4], ls = 0.f;
#pragma unroll
            for (int r = 0; r < 4; ++r) { p0[r] = __builtin_amdgcn_exp2f(lg0[r] - mn); p1[r] = __builtin_amdgcn_exp2f(lg1[r] - mn); ls += p0[r] + p1[r]; }
            ls = xrow16_sum(ls);
            l = l * scl + ls; m = mn;
            if (__any(scl != 1.f)) {
#pragma unroll
                for (int ct = 0; ct < 8; ++ct) O[ct] = O[ct] * scl;
            }
            uint4 pf; pf.x = pk2(p0[0], p0[1]); pf.y = pk2(p0[2], p0[3]); pf.z = pk2(p1[0], p1[1]); pf.w = pk2(p1[2], p1[3]);
            const bf16x8 pfrag = u4_as_frag(pf);
#pragma unroll
            for (int ct = 0; ct < 8; ++ct) {
                const int r0 = 4 * fq + (fr >> 2), r1 = r0 + 16;
                const int chn = ct * 2 + ((fr & 3) >> 1), sub = 8 * (fr & 1);
                const s16x4 va = __builtin_amdgcn_ds_read_tr16_b64_v4i16((s16x4 LAS*)(buf + r0 * 256 + ((chn ^ (r0 & 15)) << 4) + sub));
                const s16x4 vb = __builtin_amdgcn_ds_read_tr16_b64_v4i16((s16x4 LAS*)(buf + r1 * 256 + ((chn ^ (r1 & 15)) << 4) + sub));
                bf16x8 vf; vf[0] = va[0]; vf[1] = va[1]; vf[2] = va[2]; vf[3] = va[3]; vf[4] = vb[0]; vf[5] = vb[1]; vf[6] = vb[2]; vf[7] = vb[3];
                O[ct] = __builtin_amdgcn_mfma_f32_16x16x32_bf16(vf, pfrag, O[ct], 0, 0, 0);
            }
            asm volatile("" ::: "memory");
        }
#undef DSA_ISSUE
        const float inv = 1.f / l;
        if (fr < 8) {
#pragma unroll
            for (int ct = 0; ct < 8; ++ct) {
                uint2 o; o.x = pk2(O[ct][0] * inv, O[ct][1] * inv); o.y = pk2(O[ct][2] * inv, O[ct][3] * inv);
                *(uint2*)(cat + km_off((int)tok, fr * 128 + ct * 16 + 4 * fq, T)) = o;
            }
        }
        asm volatile("s_waitcnt vmcnt(0)" ::: "memory");
    }
}

#define MA_SB() __builtin_amdgcn_sched_barrier(0)
__device__ __forceinline__ void memattn_wave(CParams& p, int b, size_t tok0, int h, int lane) {
    const int fr = lane & 15, fq = lane >> 4;
    unsigned char* ws = p.ws;
    const bf16_t* proj = (const bf16_t*)(ws + WS_PROJ) + (tok0 + fr) * NPROJ + PC_QM + h * 64;
    const bf16_t* km = (const bf16_t*)(ws + WS_KMEM) + (size_t)(b * 4 + h) * (16 * 2 * 64 * 8) + lane * 8;
    const bf16_t* vt = (const bf16_t*)(ws + WS_VTMEM) + (size_t)(b * 4 + h) * (8 * 4 * 64 * 8) + lane * 8;
    const bf16x8 qf0 = ld_frag(proj + fq * 8), qf1 = ld_frag(proj + 32 + fq * 8);
    f32x4 d[16];
    bf16x8 kb[2][8];
#pragma unroll
    for (int j = 0; j < 4; ++j) { kb[0][2 * j] = ld_frag(km + (j * 2) * 512); kb[0][2 * j + 1] = ld_frag(km + (j * 2 + 1) * 512); }
    MA_SB();
#pragma unroll
    for (int g = 0; g < 4; ++g) {
        if (g < 3) {
#pragma unroll
            for (int j = 0; j < 4; ++j) { kb[(g + 1) & 1][2 * j] = ld_frag(km + ((g * 4 + 4 + j) * 2) * 512); kb[(g + 1) & 1][2 * j + 1] = ld_frag(km + ((g * 4 + 4 + j) * 2 + 1) * 512); }
        }
        MA_SB();
#pragma unroll
        for (int j = 0; j < 4; ++j) {
            f32x4 z = (f32x4){0.f, 0.f, 0.f, 0.f};
            z = __builtin_amdgcn_mfma_f32_16x16x32_bf16(kb[g & 1][2 * j], qf0, z, 0, 0, 0);
            z = __builtin_amdgcn_mfma_f32_16x16x32_bf16(kb[g & 1][2 * j + 1], qf1, z, 0, 0, 0);
            d[g * 4 + j] = z * (0.125f * 1.4426950408889634f);
        }
        MA_SB();
    }
    bf16x8 vb[2][8];
#pragma unroll
    for (int i = 0; i < 8; ++i) vb[0][i] = ld_frag(vt + i * 512);
    MA_SB();
    float mx = -INFINITY;
#pragma unroll
    for (int kt = 0; kt < 16; ++kt) mx = fmaxf(mx, fmaxf(fmaxf(d[kt][0], d[kt][1]), fmaxf(d[kt][2], d[kt][3])));
    mx = xrow16_max(mx);
    float s = 0.f;
#pragma unroll
    for (int kt = 0; kt < 16; ++kt)
#pragma unroll
        for (int r = 0; r < 4; ++r) { d[kt][r] = __builtin_amdgcn_exp2f(d[kt][r] - mx); s += d[kt][r]; }
    s = xrow16_sum(s);
    const float inv = 1.f / s;
    f32x4 O[4];
#pragma unroll
    for (int dt = 0; dt < 4; ++dt) O[dt] = (f32x4){0.f, 0.f, 0.f, 0.f};
    MA_SB();
#pragma unroll
    for (int g = 0; g < 4; ++g) {
        if (g < 3) {
#pragma unroll
            for (int i = 0; i < 8; ++i) vb[(g + 1) & 1][i] = ld_frag(vt + ((g + 1) * 8 + i) * 512);
        }
        MA_SB();
#pragma unroll
        for (int cc = 0; cc < 2; ++cc) {
            const int c32 = g * 2 + cc;
            uint4 pf; pf.x = pk2(d[2 * c32][0], d[2 * c32][1]); pf.y = pk2(d[2 * c32][2], d[2 * c32][3]); pf.z = pk2(d[2 * c32 + 1][0], d[2 * c32 + 1][1]); pf.w = pk2(d[2 * c32 + 1][2], d[2 * c32 + 1][3]);
            const bf16x8 pfrag = u4_as_frag(pf);
#pragma unroll
            for (int dt = 0; dt < 4; ++dt) O[dt] = __builtin_amdgcn_mfma_f32_16x16x32_bf16(vb[g & 1][cc * 4 + dt], pfrag, O[dt], 0, 0, 0);
        }
        MA_SB();
    }
    bf16_t* cat = (bf16_t*)(ws + WS_CAT2);
#pragma unroll
    for (int dt = 0; dt < 4; ++dt) {
        uint2 o; o.x = pk2(O[dt][0] * inv, O[dt][1] * inv); o.y = pk2(O[dt][2] * inv, O[dt][3] * inv);
        *(uint2*)(cat + km_off((int)tok0 + fr, 1280 + h * 64 + dt * 16 + 4 * fq, T)) = o;
    }
}

__device__ __forceinline__ void conv_tokens4(CParams& p, int b, int t0, int lane) {
    unsigned char* ws = p.ws;
    const bf16_t* proj = (const bf16_t*)(ws + WS_PROJ) + (size_t)b * SEQ * NPROJ;
    const float* cw = p.in[10];
    const int c = lane * 4;
    uint2 gc[6], hh[6], gb[4];
#pragma unroll
    for (int i = 0; i < 6; ++i) {
        const int tt = t0 - 2 + i, tc = tt < 0 ? 0 : tt;
        gc[i] = *(const uint2*)(proj + (size_t)tc * NPROJ + PC_GC + c); hh[i] = *(const uint2*)(proj + (size_t)tc * NPROJ + PC_H + c);
    }
#pragma unroll
    for (int i = 0; i < 4; ++i) gb[i] = *(const uint2*)(proj + (size_t)(t0 + i) * NPROJ + PC_GB + c);
    const float4 w0 = *(const float4*)(cw + c), w1 = *(const float4*)(cw + 256 + c), w2 = *(const float4*)(cw + 512 + c);
    float u[6][4];
#pragma unroll
    for (int i = 0; i < 6; ++i) {
        const float z = (t0 - 2 + i < 0) ? 0.f : 1.f;
        u[i][0] = bflo(gc[i].x) * bflo(hh[i].x) * z; u[i][1] = bfhi(gc[i].x) * bfhi(hh[i].x) * z;
        u[i][2] = bflo(gc[i].y) * bflo(hh[i].y) * z; u[i][3] = bfhi(gc[i].y) * bfhi(hh[i].y) * z;
    }
    bf16_t* cat = (bf16_t*)(ws + WS_CAT2);
#pragma unroll
    for (int i = 0; i < 4; ++i) {
        const float y0 = fmaf(w0.x, u[i][0], fmaf(w1.x, u[i + 1][0], w2.x * u[i + 2][0]));
        const float y1 = fmaf(w0.y, u[i][1], fmaf(w1.y, u[i + 1][1], w2.y * u[i + 2][1]));
        const float y2 = fmaf(w0.z, u[i][2], fmaf(w1.z, u[i + 1][2], w2.z * u[i + 2][2]));
        const float y3 = fmaf(w0.w, u[i][3], fmaf(w1.w, u[i + 1][3], w2.w * u[i + 2][3]));
        uint2 o; o.x = pk2(bflo(gb[i].x) * y0, bfhi(gb[i].x) * y1); o.y = pk2(bflo(gb[i].y) * y2, bfhi(gb[i].y) * y3);
        *(uint2*)(cat + km_off(b * SEQ + t0 + i, 1024 + c, T)) = o;
    }
}

__device__ __forceinline__ void phase4(CParams& p, char* lds, int wv) {
    const int tid = opaque_tid(wv), lane = tid & 63, wid = tid >> 6;
    if (tid < 256) ((float*)(lds + P4_RB))[tid] = p.in[9][tid] * 1.4426950408889634f;
    const int gw = blockIdx.x * 8 + wid, NW = gridDim.x * 8;
    const int ndsa = (T / 16 - (int)blockIdx.x + (int)gridDim.x - 1) / (int)gridDim.x;
    const int new_ = (EW_ITEMS - gw + NW - 1) / NW;
    const int per = (new_ + ndsa - 1) / (ndsa > 0 ? ndsa : 1);
    int ew = gw;
    for (int i = blockIdx.x; i < T / 16; i += gridDim.x) {
        const int b = i >> 7, tau = i & 127, tile = ((b >> 1) & 1) ? 127 - tau : tau;
        dsa_item(p, b, tile * 16, lds, tid, wv);
        for (int j = 0; j < per && ew < EW_ITEMS; ++j, ew += NW) expert_w_item(p, ew, (float*)(lds + wv * 16384), opaque_i(lane));
    }
    for (; ew < EW_ITEMS; ew += NW) expert_w_item(p, ew, (float*)(lds + wv * 16384), opaque_i(lane));
    for (int i = blockIdx.x; i < T / 32; i += gridDim.x) {
        const int b = i >> 6, t0 = (i & 63) * 32 + (wid >> 2) * 16;
        memattn_wave(p, b, (size_t)b * SEQ + t0, wid & 3, opaque_i(lane));
        conv_tokens4(p, b, t0 + (wid & 3) * 4, opaque_i(lane));
    }
}

#define XB_TMO      128
#define XB_XCNT(j)  (256  + 64 * (j))
#define XB_XSUB(j)  (1280 + 64 * (j))
#define XB_XGEN(j)  (2304 + 64 * (j))
#define XB_TOP      3328
#define XB_TOPGEN   3392
#define XCD_BAR_WORDS 3456
#define XB_SPIN_CAP (1u << 22)
__device__ __forceinline__ unsigned xb_ld(unsigned* p)              { return __hip_atomic_load(p, __ATOMIC_RELAXED, __HIP_MEMORY_SCOPE_AGENT); }
__device__ __forceinline__ unsigned xb_add(unsigned* p, unsigned v) { return __hip_atomic_fetch_add(p, v, __ATOMIC_RELAXED, __HIP_MEMORY_SCOPE_AGENT); }
__device__ __forceinline__ unsigned xb_xcc_id() { return (unsigned)__builtin_amdgcn_s_getreg((3 << 11) | 20) & 0xFu; }
#define XB_SPIN(cond, bar) do { unsigned _sp = 0; while (cond) { __builtin_amdgcn_s_sleep(1); \
    if ((++_sp & 255u) == 0u) { if (xb_ld(&(bar)[XB_TMO])) break; if (_sp > XB_SPIN_CAP) { atomicAdd(&(bar)[XB_TMO], 1u); break; } } } } while (0)
__device__ __forceinline__ void phase5(CParams& p, char* lds, int wv) {
    const int tid = opaque_tid(wv);
    unsigned char* ws = p.ws;
    const float* x = p.in[0];
    constexpr int I1 = (T / 256) * 4;
    unsigned* bar = (unsigned*)(ws + WS_BAR);
    unsigned long long* lnst = (unsigned long long*)(ws + WS_LNST);
    bf16_t* x1h = (bf16_t*)(ws + WS_X1H); bf16_t* x1l = (bf16_t*)(ws + WS_X1L); unsigned char* x1f8 = ws + WS_X1F8;
    for (int it = vblock(); it < I1; it += gridDim.x) {
        const int pm = it >> 2, pn = it & 3;
        const int brow = pm * 256, bcol = pn * 256;
        g8::Src s; g8::km_src(s, (const bf16_t*)(ws + WS_CAT2), T, brow, (const bf16_t*)(ws + WS_W_OUT2_T), 1024, bcol, tid);
        g8::kloop_issue(s, lds, wv);
        f32x4 acc[2][2][4][2]; g8::acc_zero(acc);
        g8::kloop(acc, s, 48, lds, tid, wv);
        const int te = opaque_i(tid), lane = te & 63, wr = wv >> 2, wc = wv & 3, fr = lane & 15, fq = lane >> 4;
        char* stg = lds + LDS_STG;
        float2* PS = (float2*)(stg + 32 * 1040);
        float2* SR = PS + 256;
        f32x4 vr[2][4][4];
        float4 xn[4];
#pragma unroll
        for (int i = 0; i < 4; ++i) { const int lr = wv + 8 * i; xn[i] = ldnt4(x + (size_t)(brow + (lr >> 4) * 64 + (lr & 15)) * 1024 + bcol + lane * 4); }
#pragma unroll
        for (int ai = 0; ai < 2; ++ai)
#pragma unroll
            for (int m = 0; m < 4; ++m) {
                char* rp = stg + (wr * 16 + fr) * 1040 + (wc * 32 + 4 * fq) * 4;
#pragma unroll
                for (int bj = 0; bj < 2; ++bj)
#pragma unroll
                    for (int n = 0; n < 2; ++n) *(f32x4*)(rp + (bj * 128 + n * 16) * 4) = acc[ai][bj][m][n];
                asm volatile("s_waitcnt lgkmcnt(0)" ::: "memory"); __builtin_amdgcn_s_barrier(); asm volatile("" ::: "memory");
                float4 xc[4];
#pragma unroll
                for (int i = 0; i < 4; ++i) xc[i] = xn[i];
                if (ai * 4 + m < 7) {
                    const int ai2 = (ai * 4 + m + 1) >> 2, m2 = (ai * 4 + m + 1) & 3;
#pragma unroll
                    for (int i = 0; i < 4; ++i) { const int lr = wv + 8 * i; xn[i] = ldnt4(x + (size_t)(brow + ai2 * 128 + (lr >> 4) * 64 + m2 * 16 + (lr & 15)) * 1024 + bcol + lane * 4); }
                }
#pragma unroll
                for (int i = 0; i < 4; ++i) {
                    const int lr = wv + 8 * i;
                    const f32x4 a = *(const f32x4*)(stg + lr * 1040 + lane * 16);
                    f32x4 o; o[0] = fmaf(ALPHA, xc[i].x, a[0]); o[1] = fmaf(ALPHA, xc[i].y, a[1]); o[2] = fmaf(ALPHA, xc[i].z, a[2]); o[3] = fmaf(ALPHA, xc[i].w, a[3]);
                    vr[ai][m][i] = o;
                    const float s1 = wave_sum((o[0] + o[1]) + (o[2] + o[3]));
                    const float s2 = wave_sum((o[0] * o[0] + o[1] * o[1]) + (o[2] * o[2] + o[3] * o[3]));
                    if (lane == 0) PS[ai * 128 + (lr >> 4) * 64 + m * 16 + (lr & 15)] = make_float2(s1, s2);
                }
                asm volatile("s_waitcnt lgkmcnt(0)" ::: "memory"); __builtin_amdgcn_s_barrier(); asm volatile("" ::: "memory");
            }
        if (wv < 4) {
            const float2 ps = PS[te];
            __hip_atomic_store(lnst + (size_t)(pm * 4 + pn) * 256 + te, ((unsigned long long)__float_as_uint(ps.y) << 32) | __float_as_uint(ps.x), __ATOMIC_RELAXED, __HIP_MEMORY_SCOPE_AGENT);
            asm volatile("s_waitcnt vmcnt(0)" ::: "memory");
            if (lane == 0) (void)xb_add(&bar[XCD_BAR_WORDS + 4 * pm], 1u);
            if (wv == 0) {
                XB_SPIN(xb_ld(&bar[XCD_BAR_WORDS + 4 * pm]) < 16u, bar);
                __builtin_amdgcn_fence(__ATOMIC_ACQUIRE, "agent");
            }
        }
        asm volatile("s_waitcnt vmcnt(0) lgkmcnt(0)" ::: "memory"); __builtin_amdgcn_s_barrier(); asm volatile("" ::: "memory");
        if (wv < 4) {
            float s1 = 0.f, s2 = 0.f;
#pragma unroll
            for (int t4 = 0; t4 < 4; ++t4) {
                const unsigned long long w = __hip_atomic_load(lnst + (size_t)(pm * 4 + t4) * 256 + te, __ATOMIC_RELAXED, __HIP_MEMORY_SCOPE_AGENT);
                s1 += __uint_as_float((unsigned)w); s2 += __uint_as_float((unsigned)(w >> 32));
            }
            const float mean = s1 * (1.f / 1024.f);
            const float var = fmaxf(s2 * (1.f / 1024.f) - mean * mean, 0.f);
            SR[te] = make_float2(mean, rsqrtf(var + LN_EPS));
        }
        asm volatile("s_waitcnt lgkmcnt(0)" ::: "memory"); __builtin_amdgcn_s_barrier(); asm volatile("" ::: "memory");
        {
            const float4 gg = *(const float4*)(p.in[14] + bcol + lane * 4), be = *(const float4*)(p.in[15] + bcol + lane * 4);
#pragma unroll
            for (int ai = 0; ai < 2; ++ai)
#pragma unroll
                for (int m = 0; m < 4; ++m)
#pragma unroll
                    for (int i = 0; i < 4; ++i) {
                        const int lr = wv + 8 * i, trow = ai * 128 + (lr >> 4) * 64 + m * 16 + (lr & 15);
                        const float2 sr = SR[trow];
                        const size_t go = (size_t)(brow + trow) * 1024 + bcol + lane * 4;
                        const f32x4 a = vr[ai][m][i];
                        float4 o; o.x = (a[0] - sr.x) * sr.y * gg.x + be.x; o.y = (a[1] - sr.x) * sr.y * gg.y + be.y; o.z = (a[2] - sr.x) * sr.y * gg.z + be.z; o.w = (a[3] - sr.x) * sr.y * gg.w + be.w;
                        stnt4(p.out + go, o);
                        uint2 hi; hi.x = pk2(o.x, o.y); hi.y = pk2(o.z, o.w);
                        uint2 lo; lo.x = pk2(o.x - bflo(hi.x), o.y - bfhi(hi.x)); lo.y = pk2(o.z - bflo(hi.y), o.w - bfhi(hi.y));
                        *(uint2*)(x1h + go) = hi;
                        *(uint2*)(x1l + go) = lo;
                        *(uint32_t*)(x1f8 + go) = pk4_f8(o.x, o.y, o.z, o.w);
                    }
        }
        asm volatile("s_waitcnt lgkmcnt(0)" ::: "memory"); __builtin_amdgcn_s_barrier(); asm volatile("" ::: "memory");
    }
}

__device__ __forceinline__ void phase6(CParams& p, int wv) {
    const int tid = opaque_tid(wv), lane = tid & 63, wid = tid >> 6;
    unsigned char* ws = p.ws;
    const float* g = p.in[14]; const float* bb = p.in[15];
    bf16_t* x1b = (bf16_t*)(ws + WS_X1B); bf16_t* x1lo = (bf16_t*)(ws + WS_X1LO);
    for (int t0 = (blockIdx.x * 8 + wid) * 2; t0 < T; t0 += gridDim.x * 16) {
        float4 v[2][4];
#pragma unroll
        for (int u = 0; u < 2; ++u)
#pragma unroll
            for (int j = 0; j < 4; ++j) v[u][j] = ldnt4(p.out + (size_t)(t0 + u) * 1024 + lane * 4 + 256 * j);
#pragma unroll
        for (int u = 0; u < 2; ++u) {
            const int t = t0 + u;
            float* row = p.out + (size_t)t * 1024;
            float s = 0.f;
#pragma unroll
            for (int j = 0; j < 4; ++j) s += (v[u][j].x + v[u][j].y) + (v[u][j].z + v[u][j].w);
            const float mean = wave_sum(s) * (1.f / 1024.f);
            float q = 0.f;
#pragma unroll
            for (int j = 0; j < 4; ++j) { v[u][j].x -= mean; v[u][j].y -= mean; v[u][j].z -= mean; v[u][j].w -= mean; q += (v[u][j].x * v[u][j].x + v[u][j].y * v[u][j].y) + (v[u][j].z * v[u][j].z + v[u][j].w * v[u][j].w); }
            const float rstd = rsqrtf(wave_sum(q) * (1.f / 1024.f) + LN_EPS);
#pragma unroll
            for (int j = 0; j < 4; ++j) {
                const int cidx = lane * 4 + 256 * j;
                const float4 gg = *(const float4*)(g + cidx), be = *(const float4*)(bb + cidx);
                float4 o; o.x = v[u][j].x * rstd * gg.x + be.x; o.y = v[u][j].y * rstd * gg.y + be.y; o.z = v[u][j].z * rstd * gg.z + be.z; o.w = v[u][j].w * rstd * gg.w + be.w;
                stnt4(row + cidx, o);
                uint2 hi; hi.x = pk2(o.x, o.y); hi.y = pk2(o.z, o.w);
                uint2 lo; lo.x = pk2(o.x - bflo(hi.x), o.y - bfhi(hi.x)); lo.y = pk2(o.z - bflo(hi.y), o.w - bfhi(hi.y));
                *(uint2*)(x1b + (size_t)t * 1024 + cidx) = hi;
                *(uint2*)(x1lo + (size_t)t * 1024 + cidx) = lo;
            }
        }
    }
}

__device__ __forceinline__ float grp8_max(float v) {
    v = fmaxf(v, dpp_f<0xB1>(v)); v = fmaxf(v, dpp_f<0x4E>(v)); v = fmaxf(v, dpp_f<0x141>(v));
    return v;
}
constexpr int NTB = T / 128;
constexpr int TBR = NTB / NROUND;
__device__ __forceinline__ void phase7(CParams& p, char* lds, int wv) {
    const int tid = opaque_tid(wv), lane = tid & 63, wid = tid >> 6, wm = wid >> 2, wn = wid & 3;
    unsigned char* ws = p.ws;
    const int r0 = tid >> 3, c = tid & 7, fr = lane & 15, fq = lane >> 4;
    const bf16_t* Ah = (const bf16_t*)(ws + WS_X1H); const bf16_t* Al = (const bf16_t*)(ws + WS_X1L); const bf16_t* Bt = (const bf16_t*)(ws + WS_W_R_T);
    float* lg = (float*)(lds + LDS_STG);
    const float rbias = p.in[17][lane];
    int* tok_e = (int*)(ws + WS_TOK_E); float* tok_w = (float*)(ws + WS_TOK_W);
    int* tok_pos = (int*)(ws + WS_TOK_POS);
    int* cntb = (int*)(ws + WS_CNTB);
    int* hist = (int*)(lds + LDS_MISC);
    const int grp = lane >> 3;
    for (int tb = blockIdx.x; tb < NTB; tb += gridDim.x) {
        const int m0 = tb * 128;
        f32x4 acc[4][2]; acc_zero(acc);
        const bf16_t* a0 = Ah + (size_t)(m0 + r0) * 1024 + c * 8; const bf16_t* a1 = a0 + (size_t)64 * 1024;
        const bf16_t* a0b = Al + (size_t)(m0 + r0) * 1024 + c * 8; const bf16_t* a1b = a0b + (size_t)64 * 1024;
        const bf16_t* b0 = Bt + (size_t)r0 * 2048 + c * 8; const bf16_t* b1 = b0 + (size_t)64 * 2048;
        pf_kloop<32, true>(acc, a0, a1, a0b, a1b, b0, b1, lds, tid, lane, wm, wn);
        if (wn < 2) {
#pragma unroll
            for (int mi = 0; mi < 4; ++mi)
#pragma unroll
                for (int ni = 0; ni < 2; ++ni) {
                    const int m = wm * 64 + mi * 16 + fr, n = wn * 32 + ni * 16 + 4 * fq;
                    *(f32x4*)(lg + m * 64 + n) = acc[mi][ni];
                }
        }
        if (tid < 64) hist[tid] = 0;
        __syncthreads();
        if (wn >= 2) {
#pragma unroll
            for (int mi = 0; mi < 4; ++mi)
#pragma unroll
                for (int ni = 0; ni < 2; ++ni) {
                    const int m = wm * 64 + mi * 16 + fr, n = (wn - 2) * 32 + ni * 16 + 4 * fq;
                    f32x4 v = *(const f32x4*)(lg + m * 64 + n);
                    v = v + acc[mi][ni];
                    *(f32x4*)(lg + m * 64 + n) = v;
                }
        }
        __syncthreads();
        for (int j = 0; j < 16; ++j) {
            const int tl = wid * 16 + j, t = m0 + tl;
            const float lgt = lg[tl * 64 + lane];
            const float s = 1.f / (1.f + __expf(-lgt));
            const float sc = s + rbias;
            const float m1 = grp8_max(sc);
            const bool ismax = (sc == m1);
            const unsigned long long bm = __ballot(ismax);
            const int nmax = __popcll((bm >> (grp * 8)) & 0xFFull);
            const float m2 = grp8_max(ismax ? -INFINITY : sc);
            const float gscore = m1 + (nmax >= 2 ? m1 : m2);
            int grank = 0;
#pragma unroll
            for (int g2 = 0; g2 < 8; ++g2) {
                const float o = __builtin_bit_cast(float, __builtin_amdgcn_readlane(__builtin_bit_cast(int, gscore), g2 * 8));
                grank += (o > gscore || (o == gscore && g2 < grp)) ? 1 : 0;
            }
            float mv = (grank < 4) ? sc : -INFINITY;
            unsigned long long selm = 0ull;
#pragma unroll
            for (int i8 = 0; i8 < 8; ++i8) {
                const float mx = wave_max(mv);
                const unsigned long long bmx = __ballot(mv == mx);
                const unsigned long long low = bmx & (0ull - bmx);
                selm |= low;
                if ((low >> lane) & 1ull) mv = -INFINITY;
            }
            const bool selq = (selm >> lane) & 1ull;
            const int rank = __popcll(selm & ((1ull << lane) - 1ull));
            const float ssum = wave_sum(selq ? s : 0.f);
            if (selq) {
                tok_e[(size_t)t * 8 + rank] = lane;
                tok_w[(size_t)t * 8 + rank] = s / ssum * 2.5f;
                tok_pos[(size_t)t * 9 + rank] = atomicAdd(&hist[lane], 1);
            }
        }
        __syncthreads();
        if (tid < 64) cntb[tb * 64 + tid] = hist[tid];
        __syncthreads();
    }
}

__device__ __forceinline__ int cntb_partial(const int* cntb, int i0, int i1, int tid) {
    const int e = tid & 63, part = tid >> 6;
    int c = 0;
#pragma unroll 8
    for (int i = i0 + part; i < i1; i += 8) c += cntb[i * 64 + e];
    return c;
}
__device__ __forceinline__ void round_tables(CParams& p, int r, int* misc, int tid) {
    const int* cntb = (const int*)(p.ws + WS_CNTB) + (size_t)r * TBR * 64;
    __syncthreads();
    if (tid < 64) misc[tid] = 0;
    if (tid == 64) misc[64] = TR;
    __syncthreads();
    { const int c = cntb_partial(cntb, 0, TBR, tid); atomicAdd(&misc[tid & 63], c); }
    __syncthreads();
    if (tid < 64) {
        const int nb = (misc[tid] + 255) >> 8;
        int incl = nb;
#pragma unroll
        for (int d = 1; d < 64; d <<= 1) { const int v = __shfl_up(incl, d); if (tid >= d) incl += v; }
        const int excl = incl - nb;
        misc[80 + tid] = excl * 256; misc[160 + tid] = excl;
        if (tid == 63) { misc[80 + 64] = incl * 256; misc[160 + 64] = incl; misc[160 + NE1] = incl + ((TR + 255) >> 8); }
    }
    __syncthreads();
}
__device__ __forceinline__ int find_expert(const int* misc, int blk) {
    int lo = 0, hi = NE1;
#pragma unroll
    for (int i = 0; i < 7; ++i) { const int mid = (lo + hi) >> 1; if (mid < hi && misc[160 + mid] <= blk) lo = mid; else hi = mid; if (hi - lo <= 1) break; }
    while (lo + 1 <= NEXP && misc[160 + lo + 1] <= blk) ++lo;
    return lo;
}

__device__ __forceinline__ void phase9(CParams& p, char* lds, int wv) {
    const int tid = opaque_tid(wv);
    unsigned char* ws = p.ws;
    int* misc = (int*)(lds + LDS_MISC);
    const int* tok_e = (const int*)(ws + WS_TOK_E); const float* tok_w = (const float*)(ws + WS_TOK_W);
    int* tok_pos = (int*)(ws + WS_TOK_POS);
    const int* cntb = (const int*)(ws + WS_CNTB);
    for (int tb = blockIdx.x; tb < NTB; tb += gridDim.x) {
        const int r = tb / TBR;
        round_tables(p, r, misc, tid);
        if (tid < 64) misc[256 + tid] = 0;
        __syncthreads();
        { const int c = cntb_partial(cntb, r * TBR, tb, tid); atomicAdd(&misc[256 + (tid & 63)], c); }
        __syncthreads();
        int* slot_tok = (int*)(ws + WS_SLOT_TOK) + (size_t)r * CAP; float* slot_w = (float*)(ws + WS_SLOT_W) + (size_t)r * CAP;
        for (int i = tid; i < 128 * 8; i += NTHREADS) {
            const int t = tb * 128 + (i >> 3), k = i & 7;
            const int e = tok_e[(size_t)t * 8 + k];
            const int pos = misc[80 + e] + misc[256 + e] + tok_pos[(size_t)t * 9 + k];
            slot_tok[pos] = t; slot_w[pos] = tok_w[(size_t)t * 8 + k];
            tok_pos[(size_t)t * 9 + k] = pos;
        }
        if (tid < 128) {
            const int t = tb * 128 + tid, pos = misc[80 + NEXP] + (t - r * TR);
            slot_tok[pos] = t; slot_w[pos] = 1.f;
            tok_pos[(size_t)t * 9 + 8] = pos;
        }
    }
}

struct GuItem { int r, pos0, e, nt2, nvalid; };
__device__ __forceinline__ GuItem gu_decode(const int* misc0, const int (&nbase)[NROUND + 1], int git) {
    GuItem d;
    int r = 0;
#pragma unroll
    for (int rr = 1; rr < NROUND; ++rr) r += (git >= nbase[rr]) ? 1 : 0;
    int lbase = nbase[0];
#pragma unroll
    for (int rr = 1; rr < NROUND; ++rr) lbase = (r >= rr) ? nbase[rr] : lbase;
    const int it = git - lbase;
    const int* misc = misc0 + r * 256;
    const int blk = it >> 1; d.nt2 = it & 1; d.r = r;
    const int e = find_expert(misc, blk);
    d.e = __builtin_amdgcn_readfirstlane(e);
    const int rb = __builtin_amdgcn_readfirstlane(blk - misc[160 + d.e]);
    d.pos0 = __builtin_amdgcn_readfirstlane(misc[80 + d.e] + rb * 256);
    d.nvalid = __builtin_amdgcn_readfirstlane(min(256, misc[d.e] - rb * 256));
    return d;
}
__device__ __forceinline__ void phase_gu(CParams& p, char* lds, int wv) {
    const int tid = opaque_tid(wv);
    unsigned char* ws = p.ws;
    int* misc0 = (int*)(lds + LDS_MISC);
    int nbase[NROUND + 1]; nbase[0] = 0;
#pragma unroll
    for (int r = 0; r < NROUND; ++r) { round_tables(p, r, misc0 + r * 256, tid); nbase[r + 1] = nbase[r] + __builtin_amdgcn_readfirstlane(misc0[r * 256 + 160 + NE1]) * 2; }
    const int nitems = nbase[NROUND];
    const int lane_ = tid & 63;
    const int sR = (wv >> 1) * 32 + (lane_ & 31), sCb = (2 * (wv & 1) + (lane_ >> 5)) * 16;
    const __amdgpu_buffer_rsrc_t rx = g8::make_rsrc(ws + WS_X1F8);
    int git = vblock();
    GuItem d; d.r = 0; d.pos0 = 0; d.e = 0; d.nt2 = 0; d.nvalid = 1;
    int tok0 = 0, tok1 = 0;
    g8::Src s;
    if (git < nitems) {
        d = gu_decode(misc0, nbase, git);
        const int* slot_tok = (const int*)(ws + WS_SLOT_TOK) + (size_t)d.r * CAP;
        tok0 = slot_tok[d.pos0 + min(sR, d.nvalid - 1)]; tok1 = slot_tok[d.pos0 + min(128 + sR, d.nvalid - 1)];
        s.ra = rx; s.rb = g8::make_rsrc(ws + WS_W_EGU_T + (size_t)d.e * 524288); s.bh = 8192u; s.akt = 64u; s.bkt = 32768u;
        s.ao[0] = (unsigned)(tok0 * 1024 + sCb); s.ao[1] = (unsigned)(tok1 * 1024 + sCb);
        s.bo = (unsigned)(d.nt2 * 16384 + tid * 16);
        g8::kloop_issue<0>(s, lds, wv);
    }
    while (git < nitems) {
        const GuItem c = d;
        const int gnext = git + gridDim.x;
        if (gnext < nitems) {
            d = gu_decode(misc0, nbase, gnext);
            const int* slot_tok = (const int*)(ws + WS_SLOT_TOK) + (size_t)d.r * CAP;
            tok0 = slot_tok[d.pos0 + min(sR, d.nvalid - 1)]; tok1 = slot_tok[d.pos0 + min(128 + sR, d.nvalid - 1)];
        }
        g8::f32x16 acc[2][2][2]; g8::acc_zero_f8(acc);
        g8::kloop_f8(acc, s, 16, lds, tid, wv);
        git = gnext;
        if (git < nitems) {
            s.rb = g8::make_rsrc(ws + WS_W_EGU_T + (size_t)d.e * 524288);
            s.ao[0] = (unsigned)(tok0 * 1024 + sCb); s.ao[1] = (unsigned)(tok1 * 1024 + sCb);
            s.bo = (unsigned)(d.nt2 * 16384 + tid * 16);
            g8::kloop_issue<0>(s, lds, wv);
        }
        bf16_t* hslot = (bf16_t*)(ws + WS_HSLOT) + (size_t)c.r * CAP * 256;
        {
            const int te = opaque_i(tid), lane = te & 63, wr = wv >> 2, wc = wv & 3, tc = lane & 31, hh = lane >> 5;
            char* stg = lds + LDS_STG;
            constexpr float ws8 = 1.f / W8_SCALE;
#pragma unroll
            for (int ai = 0; ai < 2; ++ai)
#pragma unroll
                for (int m = 0; m < 2; ++m) {
                    char* rp = stg + (ai * 128 + wr * 64 + m * 32 + tc) * 272 + (wc * 16 + 4 * hh) * 2;
#pragma unroll
                    for (int bj = 0; bj < 2; ++bj)
#pragma unroll
                        for (int pq = 0; pq < 2; ++pq) {
                            float hv[4];
#pragma unroll
                            for (int j = 0; j < 4; ++j) { const float g = acc[ai][bj][m][(2 * pq) * 4 + j] * ws8, u = acc[ai][bj][m][(2 * pq + 1) * 4 + j] * ws8; hv[j] = g * __builtin_amdgcn_rcpf(1.f + __expf(-g)) * u; }
                            uint2 o; o.x = pk2(hv[0], hv[1]); o.y = pk2(hv[2], hv[3]);
                            *(uint2*)(rp + bj * 128 + pq * 16) = o;
                        }
                }
            asm volatile("s_waitcnt lgkmcnt(0)" ::: "memory"); __builtin_amdgcn_s_barrier(); asm volatile("" ::: "memory");
            uint4 v[8];
#pragma unroll
            for (int i = 0; i < 8; ++i) { const int id = te + i * 512; v[i] = *(const uint4*)(stg + (id >> 4) * 272 + (id & 15) * 16); }
#pragma unroll
            for (int i = 0; i < 8; ++i) { const int id = te + i * 512; typedef unsigned u32x4_t __attribute__((ext_vector_type(4))); const u32x4_t ov = {v[i].x, v[i].y, v[i].z, v[i].w};
                __builtin_nontemporal_store(ov, (u32x4_t*)(hslot + km_off(c.pos0 + (id >> 4), c.nt2 * 128 + (id & 15) * 8, CAP))); }
            asm volatile("s_waitcnt lgkmcnt(0)" ::: "memory"); __builtin_amdgcn_s_barrier(); asm volatile("" ::: "memory");
        }
    }
    asm volatile("s_waitcnt vmcnt(0)" ::: "memory");
}
struct DownItem { int pos0, e, half; };
__device__ __forceinline__ DownItem down_decode(const int* misc, int it, int n2) {
    DownItem d; int blk = it >> 1; d.half = it & 1;
    if (it >= n2) { const int q = (n2 << 1) + (it - n2); blk = q >> 2; d.half = 2 + (q & 3); }
    const int e = find_expert(misc, blk);
    d.e = __builtin_amdgcn_readfirstlane(e);
    const int rb = __builtin_amdgcn_readfirstlane(blk - misc[160 + d.e]);
    d.pos0 = __builtin_amdgcn_readfirstlane(misc[80 + d.e] + rb * 256);
    return d;
}
struct DownFlush {
    bf16_t* yslot; char* lds; int pos0, half, tid, wv; float w[8];
    __device__ __forceinline__ void operator()(f32x4 (&acc)[2][2][4][2], int seg) const {
        g8_store_tile<true>(acc, yslot, 1024, pos0, (half * 2 + seg) * 256, w, lds, tid, wv);
    }
    __device__ __forceinline__ void last(f32x4 (&acc)[2][2][4][2]) const {
        g8_store_tile<false>(acc, yslot, 1024, pos0, (half * 2 + 1) * 256, w, lds, tid, wv);
    }
};
__device__ __forceinline__ void phase_down(CParams& p, int r, char* lds, int wv) {
    const int tid = opaque_tid(wv);
    unsigned char* ws = p.ws;
    int* misc = (int*)(lds + LDS_MISC);
    round_tables(p, r, misc, tid);
    const int nit2 = __builtin_amdgcn_readfirstlane(misc[160 + NE1]) * 2;
    const int n2 = (nit2 / (int)gridDim.x) * (int)gridDim.x;
    const int nitems = n2 + (nit2 - n2) * 2;
    const float* slot_w = (const float*)(ws + WS_SLOT_W) + (size_t)r * CAP;
    const bf16_t* hs = (const bf16_t*)(ws + WS_HSLOT) + (size_t)r * CAP * 256;
    const bf16_t* wed = (const bf16_t*)(ws + WS_W_ED_T);
    const int lane0 = tid & 63, wr0 = wv >> 2, fr0 = lane0 & 15;
    g8::Seg sg; sg.mask = 7; sg.lg = 3; sg.aseg = 0u; sg.bseg = 256u * 64u;
    int it = vblock();
    g8::Src s; DownItem d; float w[8];
    d.pos0 = 0; d.e = 0; d.half = 0;
#pragma unroll
    for (int i = 0; i < 8; ++i) w[i] = 0.f;
    if (it < nitems) {
        d = down_decode(misc, it, n2);
#pragma unroll
        for (int i = 0; i < 8; ++i) w[i] = slot_w[d.pos0 + (i >> 2) * 128 + wr0 * 64 + (i & 3) * 16 + fr0];
        g8::km_src(s, hs, CAP, d.pos0, wed + (size_t)d.e * 1024 * 256, 1024, d.half < 2 ? d.half * 512 : (d.half - 2) * 256, tid);
        g8::kloop_issue(s, lds, wv, sg);
        asm volatile("" :: "v"(w[0]), "v"(w[1]), "v"(w[2]), "v"(w[3]), "v"(w[4]), "v"(w[5]), "v"(w[6]), "v"(w[7]));
    }
    while (it < nitems) {
        const int single = d.half >= 2;
        const int ct_last = single ? d.half - 2 : d.half * 2 + 1;
        DownFlush fl; fl.yslot = (bf16_t*)(ws + WS_YSLOT); fl.lds = lds; fl.pos0 = d.pos0; fl.half = d.half; fl.tid = tid; fl.wv = wv;
#pragma unroll
        for (int i = 0; i < 8; ++i) fl.w[i] = w[i];
        f32x4 acc[2][2][4][2]; g8::acc_zero(acc);
        g8::kloop_ms(acc, s, single ? 8 : 16, lds, tid, wv, sg, fl);
        it += gridDim.x;
        if (it < nitems) {
            d = down_decode(misc, it, n2);
#pragma unroll
            for (int i = 0; i < 8; ++i) w[i] = slot_w[d.pos0 + (i >> 2) * 128 + wr0 * 64 + (i & 3) * 16 + fr0];
            g8::km_src(s, hs, CAP, d.pos0, wed + (size_t)d.e * 1024 * 256, 1024, d.half < 2 ? d.half * 512 : (d.half - 2) * 256, tid);
            g8::kloop_issue(s, lds, wv, sg);
        }
        g8_store_tile<false>(acc, fl.yslot, 1024, fl.pos0, ct_last * 256, fl.w, lds, tid, wv);
        if (it < nitems) asm volatile("" :: "v"(w[0]), "v"(w[1]), "v"(w[2]), "v"(w[3]), "v"(w[4]), "v"(w[5]), "v"(w[6]), "v"(w[7]));
    }
    asm volatile("s_waitcnt vmcnt(0)" ::: "memory");
}

__device__ __forceinline__ void phase_combine(CParams& p, int r, int wv) {
    const int tid = opaque_tid(wv), lane = tid & 63, wid = tid >> 6;
    unsigned char* ws = p.ws;
    const float* g = p.in[24]; const float* bb = p.in[25];
    const int* tok_pos = (const int*)(ws + WS_TOK_POS);
    const bf16_t* yslot = (const bf16_t*)(ws + WS_YSLOT);
    for (int i = blockIdx.x * 8 + wid; i < TR; i += gridDim.x * 8) {
        const int t = r * TR + i;
        float* row = p.out + (size_t)t * 1024;
        float4 v[4];
#pragma unroll
        for (int j = 0; j < 4; ++j) { v[j] = ldnt4(row + lane * 4 + 256 * j); v[j].x *= ALPHA; v[j].y *= ALPHA; v[j].z *= ALPHA; v[j].w *= ALPHA; }
        int pos[9];
#pragma unroll
        for (int k = 0; k < 9; ++k) pos[k] = tok_pos[(size_t)t * 9 + k];
        uint2 y[9][4];
#pragma unroll
        for (int k = 0; k < 9; ++k)
#pragma unroll
            for (int j = 0; j < 4; ++j) { const unsigned long long w64 = __builtin_nontemporal_load((const unsigned long long*)(yslot + (size_t)pos[k] * 1024 + lane * 4 + 256 * j)); y[k][j].x = (uint32_t)w64; y[k][j].y = (uint32_t)(w64 >> 32); }
#pragma unroll
        for (int k = 0; k < 9; ++k)
#pragma unroll
            for (int j = 0; j < 4; ++j) { v[j].x += bflo(y[k][j].x); v[j].y += bfhi(y[k][j].x); v[j].z += bflo(y[k][j].y); v[j].w += bfhi(y[k][j].y); }
        float s = 0.f;
#pragma unroll
        for (int j = 0; j < 4; ++j) s += (v[j].x + v[j].y) + (v[j].z + v[j].w);
        const float mean = wave_sum(s) * (1.f / 1024.f);
        float q = 0.f;
#pragma unroll
        for (int j = 0; j < 4; ++j) { v[j].x -= mean; v[j].y -= mean; v[j].z -= mean; v[j].w -= mean; q += (v[j].x * v[j].x + v[j].y * v[j].y) + (v[j].z * v[j].z + v[j].w * v[j].w); }
        const float rstd = rsqrtf(wave_sum(q) * (1.f / 1024.f) + LN_EPS);
#pragma unroll
        for (int j = 0; j < 4; ++j) {
            const int cidx = lane * 4 + 256 * j;
            const float4 gg = *(const float4*)(g + cidx), be = *(const float4*)(bb + cidx);
            float4 o; o.x = v[j].x * rstd * gg.x + be.x; o.y = v[j].y * rstd * gg.y + be.y; o.z = v[j].z * rstd * gg.z + be.z; o.w = v[j].w * rstd * gg.w + be.w;
            stnt4(row + cidx, o);
        }
    }
}

struct XcdBarrier { unsigned* bar; unsigned x; volatile LAS unsigned* st; };
__device__ __forceinline__ XcdBarrier xcd_barrier_post(unsigned* bar, volatile LAS unsigned* st) {
    XcdBarrier b; b.bar = bar; b.x = xb_xcc_id(); b.st = st;
    if (threadIdx.x == 0) (void)xb_add(&bar[XB_XCNT(b.x)], 1u);
    return b;
}
__device__ __forceinline__ void xcd_barrier_complete(unsigned* bar, unsigned x, unsigned& nloc, unsigned& nx) {
    const unsigned G = gridDim.x * gridDim.y * gridDim.z;
    unsigned sum, cnt, mine, sp = 0u;
    for (;;) {
        sum = 0u; cnt = 0u; mine = 0u;
#pragma unroll
        for (unsigned j = 0; j < 16; ++j) { const unsigned c = xb_ld(&bar[XB_XCNT(j)]); sum += c; cnt += (c > 0u) ? 1u : 0u; mine = (j == x) ? c : mine; }
        if (sum == G) break;
        __builtin_amdgcn_s_sleep(1);
        if ((++sp & 255u) == 0u) { if (xb_ld(&bar[XB_TMO])) break; if (sp > XB_SPIN_CAP) { atomicAdd(&bar[XB_TMO], 1u); break; } }
    }
    nloc = mine > 0u ? mine : 1u; nx = cnt > 0u ? cnt : 1u;
}
__device__ __forceinline__ void xcd_barrier(const XcdBarrier& b, int wv) {
    asm volatile("s_waitcnt vmcnt(0)" ::: "memory");
    __syncthreads();
    if (wv == 0 && lane_id() == 0) {
        unsigned* bar = b.bar;
        __builtin_amdgcn_s_waitcnt(0);
        unsigned nloc = b.st[0], nx = b.st[1];
        if (nloc == 0u) { xcd_barrier_complete(bar, b.x, nloc, nx); b.st[0] = nloc; b.st[1] = nx; }
        const unsigned old = xb_add(&bar[XB_XSUB(b.x)], 1u);
        const unsigned gen = old / nloc;
        if (old + 1u == (gen + 1u) * nloc) {
            __builtin_amdgcn_fence(__ATOMIC_RELEASE, "agent");
            asm volatile("s_waitcnt vmcnt(0)" ::: "memory");
            const unsigned og = xb_add(&bar[XB_TOP], 1u);
            const unsigned tg = og / nx;
            if (og + 1u == (tg + 1u) * nx) xb_add(&bar[XB_TOPGEN], 1u);
            else XB_SPIN(xb_ld(&bar[XB_TOPGEN]) == tg, bar);
            __builtin_amdgcn_fence(__ATOMIC_ACQUIRE, "agent");
            xb_add(&bar[XB_XGEN(b.x)], 1u);
            asm volatile("s_waitcnt vmcnt(0)" ::: "memory");
        } else {
            XB_SPIN(xb_ld(&bar[XB_XGEN(b.x)]) == gen, bar);
            __builtin_amdgcn_fence(__ATOMIC_ACQUIRE, "agent");
            asm volatile("s_waitcnt vmcnt(0)" ::: "memory");
        }
    }
    __syncthreads();
}

__global__ void __launch_bounds__(NTHREADS) fwd_megakernel(Params p_unused) {
    extern __shared__ __attribute__((aligned(16))) char lds[];
    volatile LAS unsigned* st = (volatile LAS unsigned*)(lds + LDS_BARW);
    const int wv = __builtin_amdgcn_readfirstlane((int)(threadIdx.x >> 6));
    if (threadIdx.x == 0) { st[0] = 0u; st[1] = 0u; st[2] = 0u; st[3] = 0u; }
    __syncthreads();
    const XcdBarrier gb = xcd_barrier_post((unsigned*)(kargs()->ws + WS_BAR), st);
    phase0(*kargs(), lds, wv);
    xcd_barrier(gb, wv);
    phase1(*kargs(), lds, wv);
    xcd_barrier(gb, wv);
    phase3(*kargs(), lds, wv);
    xcd_barrier(gb, wv);
    phase4(*kargs(), lds, wv);
    xcd_barrier(gb, wv);
    phase5(*kargs(), lds, wv);
    xcd_barrier(gb, wv);
    phase7(*kargs(), lds, wv);
    xcd_barrier(gb, wv);
    phase9(*kargs(), lds, wv);
    xcd_barrier(gb, wv);
    phase_gu(*kargs(), lds, wv);
    xcd_barrier(gb, wv);
    for (int r = 0; r < NROUND; ++r) {
        phase_down(*kargs(), r, lds, wv);
        xcd_barrier(gb, wv);
        phase_combine(*kargs(), r, wv);
        if (r + 1 < NROUND) xcd_barrier(gb, wv);
    }
}

extern "C" void kernel_launch(void* const* d_in, const int* in_sizes, int n_in, void* d_out, int out_size, void* d_ws, size_t ws_size, hipStream_t stream) {
    static int grid_blocks = 0;
    if (grid_blocks == 0) {
        if (n_in != 26 || out_size != T * DM || ws_size < WS_NEED) {
            fprintf(stderr, "kernel_launch: unexpected shapes (n_in %d out %d ws %zu need %zu)\n", n_in, out_size, ws_size, (size_t)WS_NEED);
            grid_blocks = -1; return;
        }
        int dev = 0, cus = 0, per_cu = 0;
        hipGetDevice(&dev);
        hipDeviceGetAttribute(&cus, hipDeviceAttributeMultiprocessorCount, dev);
        hipFuncSetAttribute((const void*)fwd_megakernel, hipFuncAttributeMaxDynamicSharedMemorySize, LDS_BYTES);
        hipOccupancyMaxActiveBlocksPerMultiprocessor(&per_cu, (const void*)fwd_megakernel, NTHREADS, LDS_BYTES);
        if (per_cu < 1) { fprintf(stderr, "kernel_launch: occupancy query says %d blocks per CU\n", per_cu); grid_blocks = -1; return; }
        grid_blocks = cus * 1;
    }
    if (grid_blocks < 0) return;
    Params p{};
    for (int i = 0; i < 26; ++i) p.in[i] = (const float*)d_in[i];
    p.out = (float*)d_out; p.ws = (unsigned char*)d_ws;
    if (hipMemsetAsync((char*)d_ws + WS_BAR, 0, 16384, stream) != hipSuccess) { fprintf(stderr, "kernel_launch: memset of barrier words failed\n"); return; }
    void* args[] = {&p};
    hipError_t e = hipLaunchCooperativeKernel((const void*)fwd_megakernel, dim3(grid_blocks), dim3(NTHREADS), args, LDS_BYTES, stream);
    if (e != hipSuccess) fprintf(stderr, "cooperative launch failed: %s (grid %d)\n", hipGetErrorString(e), grid_blocks);
}
```

```cpp
#include <hip/hip_runtime.h>
#include <stdint.h>
#include <stdio.h>

typedef unsigned short bf16_t;
typedef short bf16x8 __attribute__((ext_vector_type(8)));
typedef float f32x4 __attribute__((ext_vector_type(4)));
__device__ __forceinline__ float4 ldnt4(const float* p) { const f32x4 v = __builtin_nontemporal_load((const f32x4*)p); return make_float4(v[0], v[1], v[2], v[3]); }
__device__ __forceinline__ void stnt4(float* p, const float4& o) { const f32x4 v = {o.x, o.y, o.z, o.w}; __builtin_nontemporal_store(v, (f32x4*)p); }
#define LAS __attribute__((address_space(3)))

constexpr int DM = 1024, NB = 16, SEQ = 2048, T = NB * SEQ;
constexpr int NPROJ = 1536;
constexpr int NMEM = 256;
constexpr int NEXP = 64, NE1 = 65;
constexpr int DEXP = 256;
constexpr int NROUND = 4, TR = T / NROUND;
constexpr int CAP = 90368;
constexpr float ALPHA = 1.189207115002721f;
constexpr float LN_EPS = 1e-5f, RMS_EPS = 1e-6f;
constexpr float IDXW_SCALE = 0.04419417382415922f;
constexpr int PC_CQ = 0, PC_CKV = 256, PC_KIDX = 384, PC_IDXW = 448, PC_GB = 512, PC_GC = 768, PC_H = 1024, PC_QM = 1280;

constexpr size_t al256(size_t x) { return (x + 255) & ~(size_t)255; }
constexpr size_t WS_W_IN_T = 0;
constexpr size_t WS_W_Q2_T = WS_W_IN_T + (size_t)1536 * 1024 * 2;
constexpr size_t WS_W_MKV_T = WS_W_Q2_T + (size_t)1536 * 256 * 2;
constexpr size_t WS_W_OUT2_T = WS_W_MKV_T + (size_t)512 * 1024 * 2;
constexpr size_t WS_W_R_T = WS_W_OUT2_T + (size_t)1024 * 1536 * 2;
constexpr size_t WS_W_EGU_T = WS_W_R_T + (size_t)128 * 3072 * 2;
constexpr size_t WS_W_ED_T = WS_W_EGU_T + (size_t)NE1 * 512 * 1024 * 2;
constexpr size_t WS_CNT = WS_W_ED_T + (size_t)NE1 * 1024 * 256 * 2;
constexpr size_t WS_CNTB = WS_CNT + 4096;
constexpr size_t WS_BAR = WS_CNTB + (size_t)256 * 64 * 4;
constexpr size_t WS_TOK_E = WS_BAR + 16384;
constexpr size_t WS_TOK_W = WS_TOK_E + (size_t)T * 8 * 4;
constexpr size_t WS_TOK_POS = WS_TOK_W + (size_t)T * 8 * 4;
constexpr size_t WS_SLOT_TOK = al256(WS_TOK_POS + (size_t)T * 9 * 4);
constexpr size_t WS_SLOT_W = WS_SLOT_TOK + (size_t)NROUND * CAP * 4;
constexpr size_t WS_X1B = al256(WS_SLOT_W + (size_t)NROUND * CAP * 4);
constexpr size_t WS_B = al256(WS_X1B + (size_t)T * 1024 * 2);
constexpr size_t WS_XB = WS_B;
constexpr size_t WS_CAT2 = WS_X1B;
constexpr size_t WS_MEMB = WS_XB + (size_t)T * 1024 * 2;
constexpr size_t WS_PROJ = WS_MEMB + (size_t)4096 * 1024 * 2;
constexpr size_t WS_KMEM = WS_PROJ + (size_t)T * NPROJ * 2;
constexpr size_t WS_VTMEM = WS_KMEM + (size_t)4096 * 256 * 2;
constexpr size_t WS_KIDX = WS_VTMEM + (size_t)256 * 4096 * 2;
constexpr size_t WS_CQN = WS_KIDX + (size_t)T * 64 * 2;
constexpr size_t WS_CKVN = WS_CQN + (size_t)T * 256 * 2;
constexpr size_t WS_Q2 = WS_CKVN + (size_t)T * 128 * 2;
constexpr size_t WS_END_EARLY = WS_Q2 + (size_t)T * 1536 * 2;
constexpr size_t WS_X1LO = WS_B;
constexpr size_t WS_LOGITS = WS_X1LO + (size_t)T * 1024 * 2;
constexpr size_t WS_X1F8 = al256(WS_CAT2 + (size_t)T * 1536 * 2);
constexpr size_t WS_X1H = WS_X1F8 + (size_t)T * 1024;
constexpr size_t WS_X1L = WS_X1H + (size_t)T * 1024 * 2;
constexpr size_t WS_LNST = WS_X1L + (size_t)T * 1024 * 2;
constexpr size_t WS_YSLOT = WS_X1B;
constexpr size_t WS_HSLOT = WS_YSLOT + (size_t)CAP * 1024 * 2;
constexpr size_t WS_END_MOE = WS_HSLOT + (size_t)NROUND * CAP * 256 * 2;
static_assert(WS_X1F8 + (size_t)T * 1024 <= WS_HSLOT, "x1 fp8 must end below HSLOT");
static_assert(WS_LNST + (size_t)128 * 4 * 256 * 8 <= WS_END_EARLY, "LN statistics must fit the early region");
constexpr size_t WS_NEED = WS_END_EARLY > WS_END_MOE ? WS_END_EARLY : WS_END_MOE;

constexpr int NTHREADS = 512;
constexpr int LDS_GEMM_H = 65536;
constexpr int LDS_MISC = 139264;
constexpr int LDS_STG = 65536;
constexpr int LDS_BYTES = 155648;
constexpr int LDS_BARW = LDS_BYTES - 16;
constexpr int WAVE_LDS = 15360;

struct Params {
    const float* in[26];
    float* out;
    unsigned char* ws;
};
typedef const __attribute__((address_space(4))) Params CParams;
__device__ __forceinline__ CParams* kargs() {
    CParams* q = (CParams*)__builtin_amdgcn_kernarg_segment_ptr();
    asm volatile("" : "+s"(q));
    return q;
}

typedef __bf16 bf16x2_t __attribute__((ext_vector_type(2)));
typedef float f32x2_t __attribute__((ext_vector_type(2)));
__device__ __forceinline__ uint32_t pk2(float a, float b) {
    const f32x2_t v = {a, b};
    return __builtin_bit_cast(uint32_t, __builtin_convertvector(v, bf16x2_t));
}
__device__ __forceinline__ bf16_t f2bf(float f) { return (bf16_t)(pk2(f, 0.f) & 0xFFFFu); }
__device__ __forceinline__ float bf2f(bf16_t h) { return __uint_as_float(((uint32_t)h) << 16); }
__device__ __forceinline__ float bflo(uint32_t w) { return __uint_as_float(w << 16); }
__device__ __forceinline__ float bfhi(uint32_t w) { return __uint_as_float(w & 0xFFFF0000u); }
__device__ __forceinline__ int lane_id() { return (int)__builtin_amdgcn_mbcnt_hi(~0u, __builtin_amdgcn_mbcnt_lo(~0u, 0u)); }
__device__ __forceinline__ int opaque_tid(int wv) { int t = wv * 64 + lane_id(); asm volatile("" : "+v"(t)); return t; }
__device__ __forceinline__ int opaque_i(int t) { asm volatile("" : "+v"(t)); return t; }
__device__ __forceinline__ size_t km_off(int row, int k, int nrows) { return ((size_t)(k >> 5) * nrows + row) * 32 + (k & 31); }
__device__ __forceinline__ void wave_sync() {
    __builtin_amdgcn_fence(__ATOMIC_RELEASE, "wavefront");
    __builtin_amdgcn_wave_barrier();
    __builtin_amdgcn_fence(__ATOMIC_ACQUIRE, "wavefront");
}
template <int CTRL> __device__ __forceinline__ float dpp_f(float x) {
    return __builtin_bit_cast(float, __builtin_amdgcn_mov_dpp(__builtin_bit_cast(int, x), CTRL, 0xf, 0xf, true));
}
__device__ __forceinline__ float xrow16_max(float x) {
    auto s = __builtin_amdgcn_permlane16_swap(__float_as_uint(x), __float_as_uint(x), false, false);
    x = fmaxf(__uint_as_float(s[0]), __uint_as_float(s[1]));
    auto t = __builtin_amdgcn_permlane32_swap(__float_as_uint(x), __float_as_uint(x), false, false);
    return fmaxf(__uint_as_float(t[0]), __uint_as_float(t[1]));
}
__device__ __forceinline__ float xrow16_sum(float x) {
    auto s = __builtin_amdgcn_permlane16_swap(__float_as_uint(x), __float_as_uint(x), false, false);
    x = __uint_as_float(s[0]) + __uint_as_float(s[1]);
    auto t = __builtin_amdgcn_permlane32_swap(__float_as_uint(x), __float_as_uint(x), false, false);
    return __uint_as_float(t[0]) + __uint_as_float(t[1]);
}
__device__ __forceinline__ float wave_sum(float v) {
    v += dpp_f<0xB1>(v); v += dpp_f<0x4E>(v); v += dpp_f<0x141>(v); v += dpp_f<0x128>(v);
    return xrow16_sum(v);
}
__device__ __forceinline__ float wave_max(float v) {
    v = fmaxf(v, dpp_f<0xB1>(v)); v = fmaxf(v, dpp_f<0x4E>(v)); v = fmaxf(v, dpp_f<0x141>(v)); v = fmaxf(v, dpp_f<0x128>(v));
    return xrow16_max(v);
}
__device__ __forceinline__ uint32_t pk4_f8(float a, float b, float c, float d) {
    int p = __builtin_amdgcn_cvt_pk_fp8_f32(a, b, 0, false);
    p = __builtin_amdgcn_cvt_pk_fp8_f32(c, d, p, true);
    return (uint32_t)p;
}
__device__ __forceinline__ void unpack8(const uint4& v, float* f) {
    f[0] = bflo(v.x); f[1] = bfhi(v.x); f[2] = bflo(v.y); f[3] = bfhi(v.y);
    f[4] = bflo(v.z); f[5] = bfhi(v.z); f[6] = bflo(v.w); f[7] = bfhi(v.w);
}

template <int AMODE>
__device__ __forceinline__ void gemm_loop(f32x4 (&acc)[4][2], const bf16_t* a0, const bf16_t* a1, const bf16_t* a0b, const bf16_t* a1b,
                                          const bf16_t* b0, const bf16_t* b1, int nk, char* lds, const char* ldsH,
                                          int tid, int lane, int wm, int wn) {
    const int fr = lane & 15, fq = lane >> 4;
    const int r0 = tid >> 3, c = tid & 7;
    const int wo = r0 * 128 + ((c ^ ((r0 >> 1) & 7)) << 4);
    uint4 ra0, ra1, rb0, rb1;
    ra0 = ra1 = make_uint4(0, 0, 0, 0);
    if (AMODE != 1) { ra0 = *(const uint4*)a0; ra1 = *(const uint4*)a1; }
    rb0 = *(const uint4*)b0; rb1 = *(const uint4*)b1;
    __syncthreads();
    if (AMODE != 1) { *(uint4*)(lds + wo) = ra0; *(uint4*)(lds + wo + 8192) = ra1; }
    *(uint4*)(lds + 32768 + wo) = rb0; *(uint4*)(lds + 32768 + wo + 8192) = rb1;
    __syncthreads();
    const int swz = (fr >> 1) & 7;
    const int aoff = (wm * 64 + fr) * 128, boff = 32768 + (wn * 32 + fr) * 128;
    for (int kt = 0; kt < nk; ++kt) {
        const int cur = kt & 1;
        if (kt + 1 < nk) {
            const int k1 = kt + 1;
            if (AMODE == 0) { ra0 = *(const uint4*)(a0 + k1 * 64); ra1 = *(const uint4*)(a1 + k1 * 64); }
            if (AMODE == 2) {
                const int seg = k1 >> 4, ko = (k1 & 15) * 64;
                const bf16_t* p0 = (seg == 1) ? a0b : a0; const bf16_t* p1 = (seg == 1) ? a1b : a1;
                ra0 = *(const uint4*)(p0 + ko); ra1 = *(const uint4*)(p1 + ko);
            }
            rb0 = *(const uint4*)(b0 + k1 * 64); rb1 = *(const uint4*)(b1 + k1 * 64);
        }
        const char* pa = (AMODE == 1) ? (ldsH + kt * 16384 + aoff) : (lds + cur * 16384 + aoff);
        const char* pb = lds + cur * 16384 + boff;
#pragma unroll
        for (int kk = 0; kk < 2; ++kk) {
            const int ch = ((kk * 4 + fq) ^ swz) << 4;
            bf16x8 af[4], bfv[2];
#pragma unroll
            for (int mi = 0; mi < 4; ++mi) af[mi] = *(const bf16x8*)(pa + mi * 2048 + ch);
#pragma unroll
            for (int ni = 0; ni < 2; ++ni) bfv[ni] = *(const bf16x8*)(pb + ni * 2048 + ch);
#pragma unroll
            for (int mi = 0; mi < 4; ++mi)
#pragma unroll
                for (int ni = 0; ni < 2; ++ni)
                    acc[mi][ni] = __builtin_amdgcn_mfma_f32_16x16x32_bf16(bfv[ni], af[mi], acc[mi][ni], 0, 0, 0);
        }
        if (kt + 1 < nk) {
            const int nxt = cur ^ 1;
            if (AMODE != 1) { *(uint4*)(lds + nxt * 16384 + wo) = ra0; *(uint4*)(lds + nxt * 16384 + wo + 8192) = ra1; }
            *(uint4*)(lds + 32768 + nxt * 16384 + wo) = rb0; *(uint4*)(lds + 32768 + nxt * 16384 + wo + 8192) = rb1;
        }
        __syncthreads();
    }
}
template <int NK, bool ROUTER>
__device__ __forceinline__ void pf_kloop(f32x4 (&acc)[4][2], const bf16_t* a0, const bf16_t* a1, const bf16_t* a0b, const bf16_t* a1b,
                                             const bf16_t* b0, const bf16_t* b1, char* lds, int tid, int lane, int wm, int wn) {
    static_assert(NK % 4 == 0, "unrolled by 4");
    const int fr = lane & 15, fq = lane >> 4;
    const int r0 = tid >> 3, c = tid & 7;
    const int wo = r0 * 128 + ((c ^ ((r0 >> 1) & 7)) << 4);
    uint4 ra0_0, ra1_0, rb0_0, rb1_0, ra0_1, ra1_1, rb0_1, rb1_1, ra0_2, ra1_2, rb0_2, rb1_2, ra0_3, ra1_3, rb0_3, rb1_3;
#define RT_LOAD(s, k) do { const int k_ = (k); const int seg_ = ROUTER ? (k_ >> 4) : 0, ko_ = ROUTER ? (k_ & 15) * 64 : k_ * 64; const bf16_t* p0_ = (seg_ == 1) ? a0b : a0; const bf16_t* p1_ = (seg_ == 1) ? a1b : a1; \
        ra0_##s = *(const uint4*)(p0_ + ko_); ra1_##s = *(const uint4*)(p1_ + ko_); rb0_##s = *(const uint4*)(b0 + k_ * 64); rb1_##s = *(const uint4*)(b1 + k_ * 64); } while (0)
#define RT_STORE(s, buf) do { *(uint4*)(lds + (buf) * 16384 + wo) = ra0_##s; *(uint4*)(lds + (buf) * 16384 + wo + 8192) = ra1_##s; \
        *(uint4*)(lds + 32768 + (buf) * 16384 + wo) = rb0_##s; *(uint4*)(lds + 32768 + (buf) * 16384 + wo + 8192) = rb1_##s; } while (0)
#define RT_BAR() do { asm volatile("s_waitcnt lgkmcnt(0)" ::: "memory"); __builtin_amdgcn_s_barrier(); asm volatile("" ::: "memory"); } while (0)
    RT_LOAD(0, 0); RT_LOAD(1, 1); RT_LOAD(2, 2); RT_LOAD(3, 3);
    __syncthreads();
    RT_STORE(0, 0);
    RT_BAR();
    const int swz = (fr >> 1) & 7;
    const int aoff = (wm * 64 + fr) * 128, boff = 32768 + (wn * 32 + fr) * 128;
#define RT_STEP(j, jn) do { const int k = kt + (j); \
        RT_LOAD(j, (k + 4 < NK) ? k + 4 : NK - 1);     \
        const char* pa = lds + ((j) & 1) * 16384 + aoff; const char* pb = lds + ((j) & 1) * 16384 + boff; \
        _Pragma("unroll") for (int kk = 0; kk < 2; ++kk) { \
            const int ch = ((kk * 4 + fq) ^ swz) << 4; \
            bf16x8 af[4], bfv[2]; \
            _Pragma("unroll") for (int mi = 0; mi < 4; ++mi) af[mi] = *(const bf16x8*)(pa + mi * 2048 + ch); \
            _Pragma("unroll") for (int ni = 0; ni < 2; ++ni) bfv[ni] = *(const bf16x8*)(pb + ni * 2048 + ch); \
            _Pragma("unroll") for (int mi = 0; mi < 4; ++mi) _Pragma("unroll") for (int ni = 0; ni < 2; ++ni) \
                acc[mi][ni] = __builtin_amdgcn_mfma_f32_16x16x32_bf16(bfv[ni], af[mi], acc[mi][ni], 0, 0, 0); } \
        RT_STORE(jn, ((j) + 1) & 1); \
        RT_BAR(); } while (0)
    for (int kt = 0; kt < NK; kt += 4) {
        RT_STEP(0, 1); RT_STEP(1, 2); RT_STEP(2, 3); RT_STEP(3, 0);
    }
#undef RT_STEP
#undef RT_BAR
#undef RT_LOAD
#undef RT_STORE
}
__device__ __forceinline__ void acc_zero(f32x4 (&acc)[4][2]) {
#pragma unroll
    for (int mi = 0; mi < 4; ++mi)
#pragma unroll
        for (int ni = 0; ni < 2; ++ni) acc[mi][ni] = (f32x4){0.f, 0.f, 0.f, 0.f};
}
template <int OMODE>
__device__ __forceinline__ void gemm_item_bf16(const bf16_t* A, int lda, const bf16_t* Bt, int ldb, int nk, bf16_t* C, int ldc, int m0, int n0,
                                               char* lds, int tid, int lane, int wm, int wn) {
    const int r0 = tid >> 3, c = tid & 7;
    f32x4 acc[4][2]; acc_zero(acc);
    const bf16_t* a0 = A + (size_t)(m0 + r0) * lda + c * 8; const bf16_t* a1 = a0 + (size_t)64 * lda;
    const bf16_t* b0 = Bt + (size_t)(n0 + r0) * ldb + c * 8; const bf16_t* b1 = b0 + (size_t)64 * ldb;
    pf_kloop<16, false>(acc, a0, a1, a0, a1, b0, b1, lds, tid, lane, wm, wn);
    const int fr = lane & 15, fq = lane >> 4;
#pragma unroll
    for (int mi = 0; mi < 4; ++mi)
#pragma unroll
        for (int ni = 0; ni < 2; ++ni) {
            const int m = m0 + wm * 64 + mi * 16 + fr, n = n0 + wn * 32 + ni * 16 + 4 * fq;
            uint2 o; o.x = pk2(acc[mi][ni][0], acc[mi][ni][1]); o.y = pk2(acc[mi][ni][2], acc[mi][ni][3]);
            size_t off;
            if (OMODE == 0) off = (size_t)m * ldc + n;
            else if (OMODE == 1) {
                const int b = m >> 8, key = m & 255, h = n >> 6, d = n & 63;
                off = ((size_t)((((b * 4 + h) * 16 + (key >> 4)) * 2 + (d >> 5)) * 64 + ((d & 31) >> 3) * 16 + (key & 15))) * 8 + (d & 7);
            } else {
                const int h = m >> 6, d = m & 63, b = n >> 8, key = n & 255, k32 = key & 31;
                off = ((size_t)((((b * 4 + h) * 8 + (key >> 5)) * 4 + (d >> 4)) * 64 + ((k32 & 15) >> 2) * 16 + (d & 15))) * 8 + ((k32 >> 4) * 4);
            }
            *(uint2*)(C + off) = o;
        }
}

namespace g8 {
constexpr int HTB = 8192;
__device__ __forceinline__ int lds_byte(int r, int c) { const int ob = (r & 15) * 64 + c * 2; return (r >> 4) * 1024 + (ob ^ (((ob >> 9) & 1) << 5)); }
__device__ __forceinline__ void stage_rc(int b, int& R, int& C) { const int st = b / 1024, sb = b % 1024, swz = sb ^ (((sb >> 9) & 1) << 5); R = st * 16 + swz / 64; C = (swz % 64) / 2; }
struct Src { __amdgpu_buffer_rsrc_t ra, rb; unsigned ao[2]; unsigned bo; unsigned bh; unsigned akt, bkt; };
__device__ __forceinline__ __amdgpu_buffer_rsrc_t make_rsrc(const void* p) {
    const unsigned long long a = (unsigned long long)p;
    const unsigned lo = __builtin_amdgcn_readfirstlane((unsigned)a), hi = __builtin_amdgcn_readfirstlane((unsigned)(a >> 32));
    return __builtin_amdgcn_make_buffer_rsrc((void*)(((unsigned long long)hi << 32) | lo), 0, 0x7FFFFFFF, 0x00020000);
}
#define G8_SA(b,h) (lds + ((b) * 2 + (h)) * g8::HTB)
#define G8_SB(b,h) (lds + (4 + (b) * 2 + (h)) * g8::HTB)
#define G8_KOFF(kt, ktstride, segstride) ((((kt) & sg.mask) * (ktstride)) + (((kt) >> sg.lg) * (segstride)))
#define G8_STAGE_A(b,h,kt) __builtin_amdgcn_raw_ptr_buffer_load_lds(s.ra, (LAS void*)(G8_SA(b,h) + wv * 1024), 16, s.ao[h], G8_KOFF(kt, s.akt, sg.aseg), 0, AAUX)
#define G8_STAGE_B(b,h,kt) __builtin_amdgcn_raw_ptr_buffer_load_lds(s.rb, (LAS void*)(G8_SB(b,h) + wv * 1024), 16, s.bo, G8_KOFF(kt, s.bkt, sg.bseg) + (h) * s.bh, 0, 0)
#define G8_LDA(dst,b,h) do { _Pragma("unroll") for (int m = 0; m < 4; ++m) \
    dst[m] = *(const bf16x8*)(G8_SA(b,h) + g8::lds_byte(wr * 64 + m * 16 + fr, fq * 8)); } while (0)
#define G8_LDB(dst,b,h) do { _Pragma("unroll") for (int n = 0; n < 2; ++n) \
    dst[n] = *(const bf16x8*)(G8_SB(b,h) + g8::lds_byte(wc * 32 + n * 16 + fr, fq * 8)); } while (0)
#define G8_MMA(ai,bj,At,Bt) do { __builtin_amdgcn_s_setprio(1); \
    _Pragma("unroll") for (int m = 0; m < 4; ++m) _Pragma("unroll") for (int n = 0; n < 2; ++n) \
      acc[ai][bj][m][n] = __builtin_amdgcn_mfma_f32_16x16x32_bf16(Bt[n], At[m], acc[ai][bj][m][n], 0, 0, 0); \
    __builtin_amdgcn_s_setprio(0); } while (0)
#define G8_WAIT_V(n) asm volatile("s_waitcnt vmcnt(" #n ")" ::: "memory")
#define G8_WAIT_L(n) asm volatile("s_waitcnt lgkmcnt(" #n ")" ::: "memory")
#define G8_BAR __builtin_amdgcn_s_barrier()
#define G8_SCHED __builtin_amdgcn_sched_barrier(0)

__device__ __forceinline__ void zero_acc(f32x4 (&acc)[2][2][4][2]) {
#pragma unroll
    for (int a = 0; a < 2; ++a)
#pragma unroll
        for (int b = 0; b < 2; ++b)
#pragma unroll
            for (int m = 0; m < 4; ++m)
#pragma unroll
                for (int n = 0; n < 2; ++n) acc[a][b][m][n] = (f32x4){0.f, 0.f, 0.f, 0.f};
}
struct Seg { int mask, lg; unsigned aseg, bseg; };
__device__ __forceinline__ Seg one_seg() { Seg g; g.mask = 0x7FFFFFFF; g.lg = 30; g.aseg = 0u; g.bseg = 0u; return g; }
struct NoFlush { __device__ __forceinline__ void operator()(f32x4 (&)[2][2][4][2], int) const {} };
template <int AAUX = 0>
__device__ __forceinline__ void kloop_issue(const Src& s, char* lds, int wv, const Seg sg = one_seg()) {
    G8_STAGE_B(0, 0, 0); G8_STAGE_A(0, 0, 0);
    G8_STAGE_B(0, 1, 0); G8_STAGE_A(0, 1, 0);
}
template <class Flush, int AAUX = 0>
__device__ __forceinline__ void kloop_ms(f32x4 (&acc)[2][2][4][2], const Src& s, int nt, char* lds, int tid, int wv, const Seg sg, const Flush& flush) {
    const int lane = tid & 63, wr = wv >> 2, wc = wv & 3, fr = lane & 15, fq = lane >> 4;
    bf16x8 At[4], B0[2], B1[2];
    if (wr == 1) G8_BAR;
    G8_WAIT_V(0); G8_BAR;
    G8_STAGE_B(1, 0, 1); G8_STAGE_A(1, 0, 1); G8_STAGE_B(1, 1, 1);
    G8_WAIT_V(3); G8_BAR;
    bool drain = false;
    for (int t = 0; t < nt - 2; t += 2) {
        G8_LDB(B0, 0, 0); G8_SCHED; G8_LDA(At, 0, 0); G8_STAGE_A(1, 1, t + 1);
        G8_WAIT_L(4); G8_BAR; G8_WAIT_L(0); G8_MMA(0, 0, At, B0); G8_BAR; G8_SCHED;
        G8_LDB(B1, 0, 1); G8_STAGE_B(0, 0, t + 2);
        G8_BAR; G8_WAIT_L(0); G8_MMA(0, 1, At, B1); G8_BAR;
        G8_LDA(At, 0, 1); G8_STAGE_A(0, 0, t + 2);
        G8_BAR; G8_WAIT_L(0); G8_MMA(1, 0, At, B0); G8_BAR; G8_SCHED;
        G8_STAGE_B(0, 1, t + 2);
        if (drain) { G8_WAIT_V(0); drain = false; } else { G8_WAIT_V(3); }
        G8_BAR; G8_MMA(1, 1, At, B1); G8_BAR;
        G8_LDB(B0, 1, 0); G8_SCHED; G8_LDA(At, 1, 0); G8_STAGE_A(0, 1, t + 2);
        G8_WAIT_L(4); G8_BAR; G8_WAIT_L(0); G8_MMA(0, 0, At, B0); G8_BAR; G8_SCHED;
        G8_LDB(B1, 1, 1); G8_STAGE_B(1, 0, t + 3);
        G8_BAR; G8_WAIT_L(0); G8_MMA(0, 1, At, B1); G8_BAR;
        G8_LDA(At, 1, 1); G8_STAGE_A(1, 0, t + 3);
        G8_BAR; G8_WAIT_L(0); G8_MMA(1, 0, At, B0); G8_BAR; G8_SCHED;
        G8_STAGE_B(1, 1, t + 3);
        G8_WAIT_V(3); G8_BAR; G8_MMA(1, 1, At, B1); G8_BAR;
        if (((t + 2) & sg.mask) == 0) {
            flush(acc, ((t + 2) >> sg.lg) - 1);
            zero_acc(acc);
            drain = true;
        }
    }
    { G8_LDB(B0, 0, 0); G8_LDA(At, 0, 0); G8_STAGE_A(1, 1, nt - 1);
      G8_BAR; G8_WAIT_L(0); G8_MMA(0, 0, At, B0); G8_BAR;
      G8_LDB(B1, 0, 1); G8_BAR; G8_WAIT_L(0); G8_MMA(0, 1, At, B1); G8_BAR;
      G8_LDA(At, 0, 1); G8_WAIT_V(2); G8_BAR; G8_WAIT_L(0); G8_MMA(1, 0, At, B0); G8_MMA(1, 1, At, B1); G8_BAR; }
    { G8_LDB(B0, 1, 0); G8_LDA(At, 1, 0); G8_WAIT_V(1); G8_BAR; G8_WAIT_L(0); G8_MMA(0, 0, At, B0); G8_BAR;
      G8_LDB(B1, 1, 1); G8_WAIT_V(0); G8_BAR; G8_WAIT_L(0); G8_MMA(0, 1, At, B1); G8_BAR;
      G8_LDA(At, 1, 1); G8_BAR; G8_WAIT_L(0); G8_MMA(1, 0, At, B0); G8_MMA(1, 1, At, B1); G8_BAR; }
    if (wr == 0) G8_BAR;
}
typedef int v8i __attribute__((ext_vector_type(8)));
typedef float f32x16 __attribute__((ext_vector_type(16)));
typedef short s16x16 __attribute__((ext_vector_type(16)));
#define F8_LDFRAG(dst, base) do { const bf16x8 lo_ = *(const bf16x8*)(base), hi_ = *(const bf16x8*)((base) + 512); \
    dst = __builtin_bit_cast(v8i, __builtin_shufflevector(lo_, hi_, 0, 1, 2, 3, 4, 5, 6, 7, 8, 9, 10, 11, 12, 13, 14, 15)); } while (0)
#define F8_LDA(dst,b,h) do { _Pragma("unroll") for (int m = 0; m < 2; ++m) F8_LDFRAG(dst[m], G8_SA(b,h) + (wr * 2 + m) * 2048 + foff); } while (0)
#define F8_LDB(dst,b,h) do { F8_LDFRAG(dst, G8_SB(b,h) + wc * 2048 + foff); } while (0)
#define F8_MMA(ai,bj,At,Bt) do { __builtin_amdgcn_s_setprio(1); \
    _Pragma("unroll") for (int m = 0; m < 2; ++m) \
      acc[ai][bj][m] = __builtin_amdgcn_mfma_scale_f32_32x32x64_f8f6f4(Bt, At[m], acc[ai][bj][m], 0, 0, 0, 0x7F7F7F7F, 0, 0x7F7F7F7F); \
    __builtin_amdgcn_s_setprio(0); } while (0)
__device__ __forceinline__ void acc_zero_f8(f32x16 (&acc)[2][2][2]) {
#pragma unroll
    for (int a = 0; a < 2; ++a)
#pragma unroll
        for (int b = 0; b < 2; ++b)
#pragma unroll
            for (int m = 0; m < 2; ++m)
#pragma unroll
                for (int i = 0; i < 16; ++i) acc[a][b][m][i] = 0.f;
}
__device__ __forceinline__ void kloop_f8(f32x16 (&acc)[2][2][2], const Src& s, int nt, char* lds, int tid, int wv) {
    constexpr int AAUX = 0;
    const Seg sg = one_seg();
    const int lane = tid & 63, wr = wv >> 2, wc = wv & 3;
    const int foff = (lane >> 5) * 1024 + (lane & 31) * 16;
    v8i At[2], B0, B1;
    if (wr == 1) G8_BAR;
    G8_WAIT_V(0); G8_BAR;
    G8_STAGE_B(1, 0, 1); G8_STAGE_A(1, 0, 1); G8_STAGE_B(1, 1, 1);
    G8_WAIT_V(3); G8_BAR;
    for (int t = 0; t < nt - 2; t += 2) {
        F8_LDB(B0, 0, 0); G8_SCHED; F8_LDA(At, 0, 0); G8_STAGE_A(1, 1, t + 1);
        G8_WAIT_L(4); G8_BAR; G8_WAIT_L(0); F8_MMA(0, 0, At, B0); G8_BAR; G8_SCHED;
        F8_LDB(B1, 0, 1); G8_STAGE_B(0, 0, t + 2);
        G8_BAR; G8_WAIT_L(0); F8_MMA(0, 1, At, B1); G8_BAR;
        F8_LDA(At, 0, 1); G8_STAGE_A(0, 0, t + 2);
        G8_BAR; G8_WAIT_L(0); F8_MMA(1, 0, At, B0); G8_BAR; G8_SCHED;
        G8_STAGE_B(0, 1, t + 2);
        G8_WAIT_V(3);
        G8_BAR; F8_MMA(1, 1, At, B1); G8_BAR;
        F8_LDB(B0, 1, 0); G8_SCHED; F8_LDA(At, 1, 0); G8_STAGE_A(0, 1, t + 2);
        G8_WAIT_L(4); G8_BAR; G8_WAIT_L(0); F8_MMA(0, 0, At, B0); G8_BAR; G8_SCHED;
        F8_LDB(B1, 1, 1); G8_STAGE_B(1, 0, t + 3);
        G8_BAR; G8_WAIT_L(0); F8_MMA(0, 1, At, B1); G8_BAR;
        F8_LDA(At, 1, 1); G8_STAGE_A(1, 0, t + 3);
        G8_BAR; G8_WAIT_L(0); F8_MMA(1, 0, At, B0); G8_BAR; G8_SCHED;
        G8_STAGE_B(1, 1, t + 3);
        G8_WAIT_V(3); G8_BAR; F8_MMA(1, 1, At, B1); G8_BAR;
    }
    { F8_LDB(B0, 0, 0); F8_LDA(At, 0, 0); G8_STAGE_A(1, 1, nt - 1);
      G8_BAR; G8_WAIT_L(0); F8_MMA(0, 0, At, B0); G8_BAR;
      F8_LDB(B1, 0, 1); G8_BAR; G8_WAIT_L(0); F8_MMA(0, 1, At, B1); G8_BAR;
      F8_LDA(At, 0, 1); G8_WAIT_V(2); G8_BAR; G8_WAIT_L(0); F8_MMA(1, 0, At, B0); F8_MMA(1, 1, At, B1); G8_BAR; }
    { F8_LDB(B0, 1, 0); F8_LDA(At, 1, 0); G8_WAIT_V(1); G8_BAR; G8_WAIT_L(0); F8_MMA(0, 0, At, B0); G8_BAR;
      F8_LDB(B1, 1, 1); G8_WAIT_V(0); G8_BAR; G8_WAIT_L(0); F8_MMA(0, 1, At, B1); G8_BAR;
      F8_LDA(At, 1, 1); G8_BAR; G8_WAIT_L(0); F8_MMA(1, 0, At, B0); F8_MMA(1, 1, At, B1); G8_BAR; }
    if (wr == 0) G8_BAR;
}
template <int AAUX = 0>
__device__ __forceinline__ void kloop(f32x4 (&acc)[2][2][4][2], const Src& s, int nt, char* lds, int tid, int wv) {
    kloop_ms<NoFlush, AAUX>(acc, s, nt, lds, tid, wv, one_seg(), NoFlush());
}
__device__ __forceinline__ void acc_zero(f32x4 (&acc)[2][2][4][2]) {
#pragma unroll
    for (int a = 0; a < 2; ++a)
#pragma unroll
        for (int b = 0; b < 2; ++b)
#pragma unroll
            for (int m = 0; m < 4; ++m)
#pragma unroll
                for (int n = 0; n < 2; ++n) acc[a][b][m][n] = (f32x4){0.f, 0.f, 0.f, 0.f};
}
__device__ __forceinline__ void dense_src(Src& s, const bf16_t* A, int lda, int brow, const bf16_t* B, int ldb, int bcol, int tid) {
    s.ra = make_rsrc(A); s.rb = make_rsrc(B); s.bh = (unsigned)(128 * ldb * 2); s.akt = 64u; s.bkt = 64u;
    int R, C; stage_rc(tid * 16, R, C);
    s.bo = (unsigned)((bcol + R) * ldb + C) * 2u;
#pragma unroll
    for (int h = 0; h < 2; ++h) s.ao[h] = (unsigned)((brow + h * 128 + R) * lda + C) * 2u;
}
__device__ __forceinline__ void km_src(Src& s, const bf16_t* A, int anrows, int brow, const bf16_t* B, int bnrows, int bcol, int tid) {
    s.ra = make_rsrc(A); s.rb = make_rsrc(B); s.bh = 128u * 64u; s.akt = (unsigned)anrows * 64u; s.bkt = (unsigned)bnrows * 64u;
    int R, C; stage_rc(tid * 16, R, C);
    s.bo = (unsigned)((bcol + R) * 32 + C) * 2u;
#pragma unroll
    for (int h = 0; h < 2; ++h) s.ao[h] = (unsigned)((brow + h * 128 + R) * 32 + C) * 2u;
}
}

__device__ __forceinline__ void tconv_tile(const float* src, const float* src2, int ld_src, bf16_t* dst, int ld_dst, int k0, int n0, int mode, float* tl, int tid, int kmrows = 0, int kmrow0 = 0, int kmk0 = 0) {
    __syncthreads();
    {
        const int nn = tid & 63, kb = tid >> 6;
        const int np = n0 + nn;
        const float* s = src; int sc = np;
        if (mode == 1) sc = (np < 456) ? np : (np < 512 ? -1 : np - 56);
        if (mode == 2) { s = ((np >> 4) & 1) ? src2 : src; sc = 16 * (np >> 5) + (np & 15); }
#pragma unroll
        for (int i = 0; i < 8; ++i) {
            const int kk = kb + i * 8;
            tl[kk * 65 + nn] = (sc >= 0) ? s[(size_t)(k0 + kk) * ld_src + sc] : 0.f;
        }
    }
    __syncthreads();
    {
        const int n2 = tid >> 3, kc = tid & 7;
        const float* s = tl + (kc * 8) * 65 + n2;
        uint4 o; o.x = pk2(s[0], s[65]); o.y = pk2(s[130], s[195]); o.z = pk2(s[260], s[325]); o.w = pk2(s[390], s[455]);
        if (kmrows) *(uint4*)(dst + km_off(kmrow0 + n0 + n2, kmk0 + k0 + kc * 8, kmrows)) = o;
        else *(uint4*)(dst + (size_t)(n0 + n2) * ld_dst + k0 + kc * 8) = o;
    }
}

__device__ __forceinline__ void tconv_wave(const float* src, const float* src2, int ld_src, bf16_t* dst, int kmrows, int k0, int n0, int mode, float* scr, int lane) {
    const int nn = lane & 31, np = n0 + nn, par = lane >> 5;
    const float* s = src; int sc = np;
    if (mode == 2) { s = ((np >> 4) & 1) ? src2 : src; sc = 16 * (np >> 5) + (np & 15); }
    float v[32];
#pragma unroll
    for (int i = 0; i < 32; ++i) v[i] = __builtin_nontemporal_load(s + (size_t)(k0 + 2 * i + par) * ld_src + sc);
    wave_sync();
#pragma unroll
    for (int i = 0; i < 32; ++i) scr[(2 * i + par) * 33 + nn] = v[i];
    wave_sync();
    const int c = lane & 7;
#pragma unroll
    for (int j = 0; j < 4; ++j) {
        const int n = (lane >> 3) + 8 * j;
        const float* sp = scr + (8 * c) * 33 + n;
        uint4 o; o.x = pk2(sp[0], sp[33]); o.y = pk2(sp[66], sp[99]); o.z = pk2(sp[132], sp[165]); o.w = pk2(sp[198], sp[231]);
        { typedef unsigned u32x4_t __attribute__((ext_vector_type(4))); const u32x4_t ov = {o.x, o.y, o.z, o.w};
          __builtin_nontemporal_store(ov, (u32x4_t*)(dst + km_off(n0 + n, k0 + 8 * c, kmrows))); }
    }
}

constexpr int EW_GU = 16 * 16, EW_DN = 4 * 32, EW_EX = EW_GU + EW_DN, EW_ITEMS = NE1 * EW_EX;
constexpr float W8_SCALE = 32.f;
__device__ __forceinline__ void tconv_wave_f8(const float* src, const float* src2, unsigned char* dst8, int k0, int n0, float* scr, int lane) {
    const int nn = lane & 31, np = n0 + nn, par = lane >> 5;
    const float* s = ((np >> 3) & 1) ? src2 : src; const int sc = 8 * (np >> 4) + (np & 7);
    float v[32];
#pragma unroll
    for (int i = 0; i < 32; ++i) v[i] = __builtin_nontemporal_load(s + (size_t)(k0 + 2 * i + par) * 256 + sc);
    wave_sync();
#pragma unroll
    for (int i = 0; i < 32; ++i) scr[(2 * i + par) * 33 + nn] = v[i];
    wave_sync();
    unsigned char* gb = dst8 + ((size_t)((k0 >> 6) * 16 + (n0 >> 5)) * 4) * 512;
#pragma unroll
    for (int cc = 0; cc < 2; ++cc) {
        const int c = par * 2 + cc;
        const float* sp = scr + (c * 16) * 33 + nn;
        uint4 o;
        o.x = pk4_f8(sp[0] * W8_SCALE, sp[33] * W8_SCALE, sp[66] * W8_SCALE, sp[99] * W8_SCALE);
        o.y = pk4_f8(sp[132] * W8_SCALE, sp[165] * W8_SCALE, sp[198] * W8_SCALE, sp[231] * W8_SCALE);
        o.z = pk4_f8(sp[264] * W8_SCALE, sp[297] * W8_SCALE, sp[330] * W8_SCALE, sp[363] * W8_SCALE);
        o.w = pk4_f8(sp[396] * W8_SCALE, sp[429] * W8_SCALE, sp[462] * W8_SCALE, sp[495] * W8_SCALE);
        { typedef unsigned u32x4_t __attribute__((ext_vector_type(4))); const u32x4_t ov = {o.x, o.y, o.z, o.w};
          __builtin_nontemporal_store(ov, (u32x4_t*)(gb + c * 512 + nn * 16)); }
    }
}
__device__ __forceinline__ void expert_w_item(CParams& p, int it, float* scr, int lane) {
    unsigned char* ws = p.ws;
    const int e = it / EW_EX; int r = it - e * EW_EX;
    const float* wg = (e < NEXP) ? p.in[18] + (size_t)e * 1024 * 256 : p.in[21];
    const float* wu = (e < NEXP) ? p.in[19] + (size_t)e * 1024 * 256 : p.in[22];
    const float* wd = (e < NEXP) ? p.in[20] + (size_t)e * 256 * 1024 : p.in[23];
    if (r < EW_GU) tconv_wave_f8(wg, wu, ws + WS_W_EGU_T + (size_t)e * 524288, (r & 15) * 64, (r >> 4) * 32, scr, lane);
    else { r -= EW_GU; tconv_wave(wd, nullptr, 1024, (bf16_t*)(ws + WS_W_ED_T) + (size_t)e * 1024 * 256, 1024, (r & 3) * 64, (r >> 2) * 32, 0, scr, lane); }
}

__device__ __forceinline__ void phase0(CParams& p, char* lds, int wv) {
    const int tid = opaque_tid(wv), G = gridDim.x, bid = blockIdx.x;
    unsigned char* ws = p.ws;
    float* tl = (float*)lds;
    if (bid == 0) { int* cnt = (int*)(ws + WS_CNT); for (int i = tid; i < 1024; i += NTHREADS) cnt[i] = 0; }
    {
        const int lane = tid & 63, wid = tid >> 6;
        const float* x = p.in[0]; bf16_t* xb = (bf16_t*)(ws + WS_XB);
        const int tl = lane >> 3, c4 = lane & 7;
        for (int it = bid * 8 + wid; it < (T / 8) * 4; it += G * 8) {
            const int tg = it >> 2, kq = it & 3;
            const float* src = x + (size_t)(tg * 8 + tl) * 1024 + kq * 256 + c4 * 4;
            float4 v[8];
#pragma unroll
            for (int j = 0; j < 8; ++j) v[j] = ldnt4(src + j * 32);
#pragma unroll
            for (int j = 0; j < 8; ++j) {
                uint2 o; o.x = pk2(v[j].x, v[j].y); o.y = pk2(v[j].z, v[j].w);
                *(uint2*)(xb + km_off(tg * 8 + tl, (kq * 8 + j) * 32 + c4 * 4, T)) = o;
            }
        }
        const int NM = NB * NMEM * DM / 4096;
        for (int it = bid; it < NM; it += G) {
            const size_t off = (size_t)it * 4096;
            const float4 v0 = ldnt4(p.in[1] + off + tid * 8), v1 = ldnt4(p.in[1] + off + tid * 8 + 4);
            uint4 o; o.x = pk2(v0.x, v0.y); o.y = pk2(v0.z, v0.w); o.z = pk2(v1.x, v1.y); o.w = pk2(v1.z, v1.w);
            *(uint4*)((bf16_t*)(ws + WS_MEMB) + off + tid * 8) = o;
        }
    }
    {
        constexpr int I_IN = 24 * 16, I_QI = 8 * 4, I_MK = 4 * 16, I_MV = 4 * 16, I_OUT = 8 * 16;
        constexpr int NIT = I_IN + I_QI + I_MK + I_MV + I_OUT;
        for (int it = bid; it < NIT; it += G) {
            int r = it;
            if (r < I_IN) { tconv_tile(p.in[2], nullptr, 1480, (bf16_t*)(ws + WS_W_IN_T), 1024, (r % 16) * 64, (r / 16) * 64, 1, tl, tid, 1536, 0, 0); continue; } r -= I_IN;
            if (r < I_QI) { tconv_tile(p.in[8], nullptr, 512, (bf16_t*)(ws + WS_W_Q2_T), 256, (r % 4) * 64, (r / 4) * 64, 0, tl, tid, 1536, 1024, 0); continue; } r -= I_QI;
            if (r < I_MK) { tconv_tile(p.in[11], nullptr, 256, (bf16_t*)(ws + WS_W_MKV_T), 1024, (r % 16) * 64, (r / 16) * 64, 0, tl, tid); continue; } r -= I_MK;
            if (r < I_MV) { tconv_tile(p.in[12], nullptr, 256, (bf16_t*)(ws + WS_W_MKV_T) + (size_t)256 * 1024, 1024, (r % 16) * 64, (r / 16) * 64, 0, tl, tid); continue; } r -= I_MV;
            tconv_tile(p.in[13] + (size_t)512 * 1024, nullptr, 1024, (bf16_t*)(ws + WS_W_OUT2_T), 1536, (r % 8) * 64, (r / 8) * 64, 0, tl, tid, 1024, 0, 1024);
        }
        __syncthreads();
        __syncthreads();
    }
    {
        const float* wuq = p.in[5]; const float* wuk = p.in[6];
        bf16_t* dst = (bf16_t*)(ws + WS_W_Q2_T);
        for (int it = bid; it < 512; it += G) {
            const int o = it * 512 + tid, n = o >> 8, r = o & 255, h = n >> 7, cc = n & 127;
            const float* a = wuq + (size_t)r * 512 + h * 64; const float* b = wuk + (size_t)cc * 512 + h * 64;
            float s = 0.f;
#pragma unroll 4
            for (int d = 0; d < 64; d += 4) { const float4 x = *(const float4*)(a + d), y = *(const float4*)(b + d); s += x.x * y.x + x.y * y.y + x.z * y.z + x.w * y.w; }
            dst[km_off(n, r, 1536)] = f2bf(s * (0.125f * 1.4426950408889634f));
        }
    }
    {
        const float* wuv = p.in[7]; const float* wout = p.in[13];
        bf16_t* dst = (bf16_t*)(ws + WS_W_OUT2_T);
        float* Lu = tl;
        float* Lo = tl + 8192;
        for (int it = bid; it < 128; it += G) {
            const int h = it >> 4, nt = it & 15;
            __syncthreads();
#pragma unroll
            for (int i = 0; i < 16; ++i) { const int idx = tid + i * 512, cc = idx >> 6, d = idx & 63; Lu[idx] = wuv[(size_t)(cc * 8 + h) * 64 + d]; }
#pragma unroll
            for (int i = 0; i < 8; ++i) { const int idx = tid + i * 512, d = idx >> 6, n = idx & 63; Lo[idx] = wout[(size_t)(h * 64 + d) * 1024 + nt * 64 + n]; }
            __syncthreads();
            const int n = tid & 63, cg = tid >> 6;
            float acc[16];
#pragma unroll
            for (int i = 0; i < 16; ++i) acc[i] = 0.f;
            for (int d = 0; d < 64; ++d) {
                const float w = Lo[d * 64 + n];
#pragma unroll
                for (int i = 0; i < 16; ++i) acc[i] = fmaf(Lu[(cg * 16 + i) * 64 + d], w, acc[i]);
            }
            uint4 o0, o1;
            o0.x = pk2(acc[0], acc[1]); o0.y = pk2(acc[2], acc[3]); o0.z = pk2(acc[4], acc[5]); o0.w = pk2(acc[6], acc[7]);
            o1.x = pk2(acc[8], acc[9]); o1.y = pk2(acc[10], acc[11]); o1.z = pk2(acc[12], acc[13]); o1.w = pk2(acc[14], acc[15]);
            bf16_t* dp = dst + km_off(nt * 64 + n, h * 128 + cg * 16, 1024);
            *(uint4*)dp = o0; *(uint4*)(dp + 8) = o1;
        }
        __syncthreads();
    }
    {
        const float* wr = p.in[16]; bf16_t* dst = (bf16_t*)(ws + WS_W_R_T);
        for (int it = bid; it < 128; it += G) {
            const int o = it * 512 + tid, e = o >> 10, k = o & 1023;
            const float w = wr[(size_t)k * 64 + e]; const bf16_t hi = f2bf(w), lo = f2bf(w - bf2f(hi));
            dst[(size_t)e * 2048 + k] = hi; dst[(size_t)e * 2048 + 1024 + k] = hi;
            dst[(size_t)(64 + e) * 2048 + k] = lo; dst[(size_t)(64 + e) * 2048 + 1024 + k] = 0;
        }
    }
}

template <bool RESYNC>
__device__ __forceinline__ void g8_store_tile(const f32x4 (&acc)[2][2][4][2], bf16_t* C, size_t ldc, int row0, int col0, const float* w8, char* lds, int tid_, int wv) {
    const int tid = opaque_i(tid_);
    const int lane = tid & 63, wr = wv >> 2, wc = wv & 3, fr = lane & 15, fq = lane >> 4;
    char* stg = lds + LDS_STG;
    if (RESYNC) { if (wr == 0) __builtin_amdgcn_s_barrier(); }
#pragma unroll
    for (int ai = 0; ai < 2; ++ai) {
#pragma unroll
        for (int m = 0; m < 4; ++m) {
            const float sc = w8 ? w8[ai * 4 + m] : 1.f;
            char* rp = stg + (wr * 64 + m * 16 + fr) * 528 + (wc * 32 + 4 * fq) * 2;
#pragma unroll
            for (int bj = 0; bj < 2; ++bj)
#pragma unroll
                for (int n = 0; n < 2; ++n) {
                    uint2 o; o.x = pk2(acc[ai][bj][m][n][0] * sc, acc[ai][bj][m][n][1] * sc); o.y = pk2(acc[ai][bj][m][n][2] * sc, acc[ai][bj][m][n][3] * sc);
                    *(uint2*)(rp + (bj * 128 + n * 16) * 2) = o;
                }
        }
        asm volatile("s_waitcnt lgkmcnt(0)" ::: "memory"); __builtin_amdgcn_s_barrier(); asm volatile("" ::: "memory");
        uint4 v[8];
#pragma unroll
        for (int i = 0; i < 8; ++i) { const int id = tid + i * 512; v[i] = *(const uint4*)(stg + (id >> 5) * 528 + (id & 31) * 16); }
#pragma unroll
        for (int i = 0; i < 8; ++i) { const int id = tid + i * 512; *(uint4*)(C + (size_t)(row0 + ai * 128 + (id >> 5)) * ldc + col0 + (id & 31) * 8) = v[i]; }
        asm volatile("s_waitcnt lgkmcnt(0)" ::: "memory"); __builtin_amdgcn_s_barrier(); asm volatile("" ::: "memory");
    }
    if (RESYNC) { if (wr == 1) __builtin_amdgcn_s_barrier(); }
}
__device__ __forceinline__ void g8_store_proj(const f32x4 (&acc)[2][2][4][2], CParams& p, int brow, int nt, char* lds, int tid_, int wv) {
    const int tid = opaque_i(tid_);
    const int lane = tid & 63, wr = wv >> 2, wc = wv & 3, fr = lane & 15, fq = lane >> 4;
    unsigned char* ws = p.ws;
    char* stg = lds + LDS_STG;
    float* rs = (float*)(stg + 128 * 528);
    bf16_t* proj = (bf16_t*)(ws + WS_PROJ);
#pragma unroll
    for (int ai = 0; ai < 2; ++ai) {
#pragma unroll
        for (int m = 0; m < 4; ++m) {
            char* rp = stg + (wr * 64 + m * 16 + fr) * 528 + (wc * 32 + 4 * fq) * 2;
#pragma unroll
            for (int bj = 0; bj < 2; ++bj)
#pragma unroll
                for (int n = 0; n < 2; ++n) {
                    uint2 o; o.x = pk2(acc[ai][bj][m][n][0], acc[ai][bj][m][n][1]); o.y = pk2(acc[ai][bj][m][n][2], acc[ai][bj][m][n][3]);
                    *(uint2*)(rp + (bj * 128 + n * 16) * 2) = o;
                }
        }
        asm volatile("s_waitcnt lgkmcnt(0)" ::: "memory"); __builtin_amdgcn_s_barrier(); asm volatile("" ::: "memory");
        const int r0g = brow + ai * 128;
        if (nt != 0) {
            uint4 v[8];
#pragma unroll
            for (int i = 0; i < 8; ++i) { const int id = tid + i * 512; v[i] = *(const uint4*)(stg + (id >> 5) * 528 + (id & 31) * 16); }
#pragma unroll
            for (int i = 0; i < 8; ++i) { const int id = tid + i * 512; *(uint4*)(proj + (size_t)(r0g + (id >> 5)) * NPROJ + nt * 256 + (id & 31) * 8) = v[i]; }
        }
        if (nt <= 1) {
            const int row = tid >> 2, q = tid & 3;
            const int ncol = (nt == 0) ? 256 : 128, per = ncol >> 2;
            float ss = 0.f;
            for (int c = 0; c < per; c += 8) {
                float f[8]; const uint4 u = *(const uint4*)(stg + row * 528 + (q * per + c) * 2); unpack8(u, f);
#pragma unroll
                for (int j = 0; j < 8; ++j) ss = fmaf(f[j], f[j], ss);
            }
            ss += dpp_f<0xB1>(ss); ss += dpp_f<0x4E>(ss);
            if (q == 0) rs[row] = rsqrtf(ss / (float)ncol + RMS_EPS);
            asm volatile("s_waitcnt lgkmcnt(0)" ::: "memory"); __builtin_amdgcn_s_barrier(); asm volatile("" ::: "memory");
            if (nt == 0) {
                const float* gq = p.in[3]; bf16_t* cqn = (bf16_t*)(ws + WS_CQN);
#pragma unroll
                for (int i = 0; i < 8; ++i) {
                    const int id = tid + i * 512, c4 = id & 3, rw = (id >> 2) & 127, kt = id >> 9, col = kt * 32 + c4 * 8;
                    float f[8]; const uint4 u = *(const uint4*)(stg + rw * 528 + col * 2); unpack8(u, f);
                    const float r = rs[rw];
                    const float4 g0 = *(const float4*)(gq + col), g1 = *(const float4*)(gq + col + 4);
                    uint4 o; o.x = pk2(f[0] * r * g0.x, f[1] * r * g0.y); o.y = pk2(f[2] * r * g0.z, f[3] * r * g0.w); o.z = pk2(f[4] * r * g1.x, f[5] * r * g1.y); o.w = pk2(f[6] * r * g1.z, f[7] * r * g1.w);
                    *(uint4*)(cqn + km_off(r0g + rw, col, T)) = o;
                }
            } else {
                const float* gkv = p.in[4]; bf16_t* ckvn = (bf16_t*)(ws + WS_CKVN); bf16_t* kidxf = (bf16_t*)(ws + WS_KIDX);
#pragma unroll
                for (int i = 0; i < 4; ++i) {
                    const int id = tid + i * 512, rw = id >> 4, ch = id & 15, col = ch * 8;
                    float f[8]; const uint4 u = *(const uint4*)(stg + rw * 528 + col * 2); unpack8(u, f);
                    const float r = rs[rw];
                    const float4 g0 = *(const float4*)(gkv + col), g1 = *(const float4*)(gkv + col + 4);
                    uint4 o; o.x = pk2(f[0] * r * g0.x, f[1] * r * g0.y); o.y = pk2(f[2] * r * g0.z, f[3] * r * g0.w); o.z = pk2(f[4] * r * g1.x, f[5] * r * g1.y); o.w = pk2(f[6] * r * g1.z, f[7] * r * g1.w);
                    *(uint4*)(ckvn + (size_t)(r0g + rw) * 128 + col) = o;
                }
#pragma unroll
                for (int i = 0; i < 2; ++i) {
                    const int id = tid + i * 512, f16 = id & 15, fq2 = (id >> 4) & 3, kk = (id >> 6) & 1, t16 = id >> 7;
                    const uint4 u = *(const uint4*)(stg + (t16 * 16 + f16) * 528 + (128 + kk * 32 + fq2 * 8) * 2);
                    *(uint4*)(kidxf + ((size_t)(((r0g >> 4) + t16) * 2 + kk) * 64 + fq2 * 16 + f16) * 8) = u;
                }
            }
        }
        asm volatile("s_waitcnt lgkmcnt(0)" ::: "memory"); __builtin_amdgcn_s_barrier(); asm volatile("" ::: "memory");
    }
}
__device__ __forceinline__ int vblock() { const int G = gridDim.x, b = blockIdx.x; return ((G & 7) == 0) ? (b & 7) * (G >> 3) + (b >> 3) : b; }

__device__ __forceinline__ void phase1(CParams& p, char* lds, int wv) {
    const int tid = opaque_tid(wv), lane = tid & 63, wid = tid >> 6, wm = wid >> 2, wn = wid & 3;
    unsigned char* ws = p.ws;
    constexpr int I1 = (T / 256) * 6, I2 = (4096 / 128) * 2, I3 = 2 * (4096 / 128);
    {
        int it = vblock();
        g8::Src s;
        if (it < I1) { g8::km_src(s, (const bf16_t*)(ws + WS_XB), T, (it / 6) * 256, (const bf16_t*)(ws + WS_W_IN_T), 1536, (it % 6) * 256, tid); g8::kloop_issue(s, lds, wv); }
        while (it < I1) {
            const int brow = (it / 6) * 256, bcol = (it % 6) * 256;
            f32x4 acc[2][2][4][2]; g8::acc_zero(acc);
            g8::kloop(acc, s, 32, lds, tid, wv);
            it += gridDim.x;
            if (it < I1) { g8::km_src(s, (const bf16_t*)(ws + WS_XB), T, (it / 6) * 256, (const bf16_t*)(ws + WS_W_IN_T), 1536, (it % 6) * 256, tid); g8::kloop_issue(s, lds, wv); }
            g8_store_proj(acc, p, brow, bcol >> 8, lds, tid, wv);
        }
    }
    asm volatile("s_waitcnt vmcnt(0)" ::: "memory");
    __syncthreads();
    for (int it = blockIdx.x; it < I2 + I3; it += gridDim.x) {
        if (it < I2) { const int r = it; gemm_item_bf16<1>((const bf16_t*)(ws + WS_MEMB), 1024, (const bf16_t*)(ws + WS_W_MKV_T), 1024, 16, (bf16_t*)(ws + WS_KMEM), 256, (r / 2) * 128, (r % 2) * 128, lds, tid, lane, wm, wn); }
        else { const int r = it - I2;
            gemm_item_bf16<2>((const bf16_t*)(ws + WS_W_MKV_T) + (size_t)256 * 1024, 1024, (const bf16_t*)(ws + WS_MEMB), 1024, 16, (bf16_t*)(ws + WS_VTMEM), 4096, (r / 32) * 128, (r % 32) * 128, lds, tid, lane, wm, wn); }
    }
}

__device__ __forceinline__ void phase2(CParams& p, int wv) {
    const int tid = opaque_tid(wv), lane = tid & 63, wid = tid >> 6;
    unsigned char* ws = p.ws;
    const bf16_t* proj = (const bf16_t*)(ws + WS_PROJ);
    bf16_t* cqn = (bf16_t*)(ws + WS_CQN); bf16_t* ckvn = (bf16_t*)(ws + WS_CKVN);
    const float* gq = p.in[3]; const float* gkv = p.in[4];
    for (int t = blockIdx.x * 8 + wid; t < T; t += gridDim.x * 8) {
        const bf16_t* row = proj + (size_t)t * NPROJ;
        {
            const uint2 v = *(const uint2*)(row + PC_CQ + lane * 4);
            const float a = bflo(v.x), b = bfhi(v.x), c = bflo(v.y), d = bfhi(v.y);
            const float ss = wave_sum(a * a + b * b + c * c + d * d);
            const float r = rsqrtf(ss * (1.f / 256.f) + RMS_EPS);
            const float4 g = *(const float4*)(gq + lane * 4);
            uint2 o; o.x = pk2(a * r * g.x, b * r * g.y); o.y = pk2(c * r * g.z, d * r * g.w);
            *(uint2*)(cqn + km_off(t, lane * 4, T)) = o;
        }
        {
            const uint32_t v = *(const uint32_t*)(row + PC_CKV + lane * 2);
            const float a = bflo(v), b = bfhi(v);
            const float ss = wave_sum(a * a + b * b);
            const float r = rsqrtf(ss * (1.f / 128.f) + RMS_EPS);
            const float2 g = *(const float2*)(gkv + lane * 2);
            *(uint32_t*)(ckvn + (size_t)t * 128 + lane * 2) = pk2(a * r * g.x, b * r * g.y);
        }
        if (lane < 32) {
            const int dd = lane * 2;
            const size_t off = ((size_t)((t >> 4) * 2 + (dd >> 5)) * 64 + ((dd & 31) >> 3) * 16 + (t & 15)) * 8 + (dd & 7);
            *(uint32_t*)((bf16_t*)(ws + WS_KIDX) + off) = *(const uint32_t*)(row + PC_KIDX + dd);
        }
    }
}

__device__ __forceinline__ void phase3(CParams& p, char* lds, int wv) {
    const int tid = opaque_tid(wv);
    unsigned char* ws = p.ws;
    constexpr int I1 = (T / 256) * 6;
    int it = vblock();
    g8::Src s;
    if (it < I1) { g8::km_src(s, (const bf16_t*)(ws + WS_CQN), T, (it / 6) * 256, (const bf16_t*)(ws + WS_W_Q2_T), 1536, (it % 6) * 256, tid); g8::kloop_issue(s, lds, wv); }
    while (it < I1) {
        const int brow = (it / 6) * 256, bcol = (it % 6) * 256;
        f32x4 acc[2][2][4][2]; g8::acc_zero(acc);
        g8::kloop(acc, s, 8, lds, tid, wv);
        it += gridDim.x;
        if (it < I1) { g8::km_src(s, (const bf16_t*)(ws + WS_CQN), T, (it / 6) * 256, (const bf16_t*)(ws + WS_W_Q2_T), 1536, (it % 6) * 256, tid); g8::kloop_issue(s, lds, wv); }
        g8_store_tile<false>(acc, (bf16_t*)(ws + WS_Q2), 1536, brow, bcol, nullptr, lds, tid, wv);
    }
}

typedef short s16x4 __attribute__((ext_vector_type(4)));
__device__ __forceinline__ int t5_bucket(int n) {
    if (n < 16) return n;
    if (n >= 128) return 31;
    const int l = 16 + (int)(__log2f((float)n * 0.0625f) * (16.0f / 3.0f));
    return l < 31 ? l : 31;
}
__device__ __forceinline__ bf16x8 ld_frag(const bf16_t* p) { return *(const bf16x8*)p; }
__device__ __forceinline__ bf16x8 u4_as_frag(const uint4& v) { union { uint4 u; bf16x8 f; } c; c.u = v; return c.f; }

constexpr int SK_STRIDE = 2052;
constexpr int P4_SEL = 16 * SK_STRIDE * 4;
constexpr int P4_RB = P4_SEL + 16 * 256 * 2;
constexpr int P4_SELB = P4_RB + 1024;

constexpr int P4_CSCR = P4_SELB + 4096;
constexpr int P4_HIST = P4_CSCR + 2048;
template <int NREG>
__device__ __forceinline__ void select_query(const uint32_t* skrow, unsigned short* sel, unsigned char* selb, uint32_t* cscr, uint32_t* hist, int t, int lane) {
    const unsigned long long ltmask = (1ull << lane) - 1ull;
    uint32_t key[NREG];
#pragma unroll
    for (int i = 0; i < NREG; ++i) { const int s = i * 64 + lane; const uint32_t kv = skrow[s]; key[i] = (s <= t) ? kv : 0u; }
    uint32_t prefix = 0; bool exact = false;
    int nS = 0, nU = t + 1, bit = 31;
    {
        const uint32_t cand = 0x80000000u;
        int cnt = 0;
#pragma unroll
        for (int i = 0; i < NREG; ++i) cnt += __popcll(__ballot(key[i] >= cand));
        if (cnt >= 256) { prefix = cand; nU = cnt; exact = (cnt == 256); } else { nU -= cnt; nS = cnt; }
        bit = 30;
        if (!exact && nU > 64) {
            uint32_t a = 0xFFFFFFFFu, o = 0u;
#pragma unroll
            for (int i = 0; i < NREG; ++i) { const bool inU = ((key[i] ^ prefix) >> 31) == 0u && key[i] != 0u; a &= inU ? key[i] : 0xFFFFFFFFu; o |= inU ? key[i] : 0u; }
#pragma unroll
            for (int d = 1; d < 64; d <<= 1) { a &= (uint32_t)__shfl_xor((int)a, d); o |= (uint32_t)__shfl_xor((int)o, d); }
            const uint32_t diff = (a ^ o) & 0x7FFFFFFFu;
            if (diff == 0u) { prefix = a; bit = -1; }
            else {
                const int top = 31 - __clz(diff);
                const uint32_t keep = (top >= 30) ? 0u : (0x7FFFFFFFu & ~((2u << top) - 1u));
                prefix |= a & keep;
                const int nb = (top + 1 < 8) ? top + 1 : 8, shift = top + 1 - nb;
                *(uint4*)(hist + lane * 4) = make_uint4(0u, 0u, 0u, 0u);
                wave_sync();
#pragma unroll
                for (int i = 0; i < NREG; ++i) {
                    const bool inU = ((key[i] ^ prefix) >> (top + 1)) == 0u && key[i] != 0u;
                    if (inU) atomicAdd(&hist[(key[i] >> shift) & 255u], 1u);
                }
                wave_sync();
                const uint4 h4 = *(const uint4*)(hist + lane * 4);
                int suf = (int)(h4.x + h4.y + h4.z + h4.w);
#pragma unroll
                for (int d = 1; d < 64; d <<= 1) { const int v = __shfl_down(suf, d); if (lane + d < 64) suf += v; }
                const int need = 256 - nS;
                const int L = __popcll(__ballot(suf >= need)) - 1;
                const int above = (L < 63) ? __builtin_amdgcn_readlane(suf, (L + 1) & 63) : 0;
                const int hb[4] = {__builtin_amdgcn_readlane((int)h4.x, L), __builtin_amdgcn_readlane((int)h4.y, L), __builtin_amdgcn_readlane((int)h4.z, L), __builtin_amdgcn_readlane((int)h4.w, L)};
                int c = above, dig = 4 * L, inbin = 0, aboved = above;
                bool found = false;
#pragma unroll
                for (int j = 3; j >= 0; --j) { if (!found) { const int c2 = c + hb[j]; if (c2 >= need) { dig = 4 * L + j; inbin = hb[j]; aboved = c; found = true; } c = c2; } }
                prefix |= (uint32_t)dig << shift;
                nS += aboved; nU = inbin;
                exact = (nS + nU == 256);
                bit = shift - 1;
            }
        }
    }
    for (; !exact && bit >= 0 && nU > 64; --bit) {
        const uint32_t cand = prefix | (1u << bit);
        int cnt = 0;
#pragma unroll
        for (int i = 0; i < NREG; ++i) cnt += __popcll(__ballot(key[i] >= cand));
        if (cnt >= 256) { prefix = cand; nU = cnt - nS; if (cnt == 256) { exact = true; break; } }
        else { nU -= cnt - nS; nS = cnt; }
    }
    int quota = 0; bool have_quota = false;
    if (!exact && bit >= 0) {
        const int sh = bit + 1;
        int pos = 0;
        wave_sync();
#pragma unroll
        for (int i = 0; i < NREG; ++i) {
            const bool inU = (key[i] >> sh) == (prefix >> sh) && key[i] != 0u;
            const unsigned long long bu = __ballot(inU);
            if (inU) { const int d = pos + __popcll(bu & ltmask); if (d < 64) cscr[d] = key[i]; }
            pos += __popcll(bu);
        }
        wave_sync();
        const uint32_t u = (lane < pos) ? cscr[lane] : 0u;
        for (; bit >= 0; --bit) {
            const uint32_t cand = prefix | (1u << bit);
            const int cnt = nS + __popcll(__ballot(u >= cand));
            if (cnt >= 256) { prefix = cand; if (cnt == 256) { exact = true; break; } }
        }
        if (!exact) {
            if (nS + __popcll(__ballot(u >= prefix)) == 256) exact = true;
            else { quota = 256 - (nS + __popcll(__ballot(u > prefix))); have_quota = true; }
        }
    }
    if (!exact && !have_quota) {
        int cgt = 0;
#pragma unroll
        for (int i = 0; i < NREG; ++i) cgt += __popcll(__ballot(key[i] > prefix));
        quota = 256 - cgt;
    }
    int pos = 0, eqc = 0;
#pragma unroll
    for (int i = 0; i < NREG; ++i) {
        const uint32_t u = key[i];
        bool take;
        if (exact) take = (u >= prefix);
        else {
            const bool eq = (u == prefix);
            const unsigned long long beq = __ballot(eq);
            const int myeq = eqc + __popcll(beq & ltmask);
            take = (u > prefix) || (eq && myeq < quota);
            eqc += __popcll(beq);
        }
        const unsigned long long bt = __ballot(take);
        if (take) {
            const int dst = pos + __popcll(bt & ltmask); sel[dst] = (unsigned short)(i * 64 + lane);
            if (t - (i * 64 + 63) >= 128) selb[dst] = (unsigned char)31;
            else selb[dst] = (unsigned char)t5_bucket(t - (i * 64 + lane));
        }
        pos += __popcll(bt);
    }
}

__device__ __forceinline__ void dsa_item(CParams& p, int b, int t0, char* lds, int tid_in, int wv) {
    const int tid = opaque_i(tid_in);
    const int lane = tid & 63, wid = tid >> 6, fr = lane & 15, fq = lane >> 4;
    unsigned char* ws = p.ws;
    uint32_t* SK = (uint32_t*)lds;
    unsigned short* SEL = (unsigned short*)(lds + P4_SEL);
    const float* RB = (const float*)(lds + P4_RB);
    unsigned char* SELB = (unsigned char*)(lds + P4_SELB);
    const bf16_t* q2 = (const bf16_t*)(ws + WS_Q2) + ((size_t)b * SEQ + t0) * 1536;
    const bf16_t* kidx = (const bf16_t*)(ws + WS_KIDX) + (size_t)b * SEQ * 64;
    const bf16_t* ckvn = (const bf16_t*)(ws + WS_CKVN) + (size_t)b * SEQ * 128;
    __syncthreads();
    if (t0 >= 256) {
        bf16x8 qf[8][2];
#pragma unroll
        for (int h = 0; h < 8; ++h)
#pragma unroll
            for (int kk = 0; kk < 2; ++kk) qf[h][kk] = ld_frag(q2 + (size_t)fr * 1536 + 1024 + h * 64 + kk * 32 + fq * 8);
        float wv[8];
        { const uint4 v = *(const uint4*)((const bf16_t*)(ws + WS_PROJ) + ((size_t)b * SEQ + t0 + fr) * NPROJ + PC_IDXW); unpack8(v, wv); }
#pragma unroll
        for (int i = 0; i < 8; ++i) wv[i] *= IDXW_SCALE;
        const int ntile = (t0 + 16) >> 4;
        const int tq = t0 + fr;
        bf16x8 kn0 = ld_frag(kidx + (size_t)(wid * 2) * 512 + lane * 8), kn1 = ld_frag(kidx + (size_t)(wid * 2 + 1) * 512 + lane * 8);
        for (int kt = wid; kt < ntile; kt += 8) {
            const int key0 = kt * 16;
            const bf16x8 kf0 = kn0, kf1 = kn1;
            { const int kx = (kt + 8 < ntile) ? kt + 8 : kt;
              kn0 = ld_frag(kidx + (size_t)(kx * 2) * 512 + lane * 8); kn1 = ld_frag(kidx + (size_t)(kx * 2 + 1) * 512 + lane * 8); }
            float sacc[4] = {0.f, 0.f, 0.f, 0.f};
#pragma unroll
            for (int h = 0; h < 8; ++h) {
                f32x4 d = (f32x4){0.f, 0.f, 0.f, 0.f};
                d = __builtin_amdgcn_mfma_f32_16x16x32_bf16(kf0, qf[h][0], d, 0, 0, 0);
                d = __builtin_amdgcn_mfma_f32_16x16x32_bf16(kf1, qf[h][1], d, 0, 0, 0);
#pragma unroll
                for (int r = 0; r < 4; ++r) sacc[r] = fmaf(wv[h], fmaxf(d[r], 0.f), sacc[r]);
            }
            uint4 ko;
            uint32_t kk4[4];
#pragma unroll
            for (int r = 0; r < 4; ++r) {
                const int s = key0 + 4 * fq + r;
                float sc = sacc[r]; if (sc == 0.f) sc = 0.f;
                const uint32_t u = __float_as_uint(sc);
                const uint32_t key = (u & 0x80000000u) ? ~u : (u | 0x80000000u);
                kk4[r] = (s <= tq) ? key : 0u;
            }
            ko.x = kk4[0]; ko.y = kk4[1]; ko.z = kk4[2]; ko.w = kk4[3];
            *(uint4*)(SK + fr * SK_STRIDE + key0 + 4 * fq) = ko;
        }
        __syncthreads();
#pragma nounroll
        for (int qq = 0; qq < 2; ++qq) {
            const int q = wid * 2 + qq, t = t0 + q;
            uint32_t* cscr = (uint32_t*)(lds + P4_CSCR) + wid * 64;
#define DSA_SEL(N) select_query<N>(SK + q * SK_STRIDE, SEL + q * 256, SELB + q * 256, cscr, (uint32_t*)(lds + P4_HIST) + wid * 256, t, lane)
            switch (__builtin_amdgcn_readfirstlane(t0 >> 8)) {
                case 1: DSA_SEL(8); break;
                case 2: DSA_SEL(12); break;
                case 3: DSA_SEL(16); break;
                case 4: DSA_SEL(20); break;
                case 5: DSA_SEL(24); break;
                case 6: DSA_SEL(28); break;
                default: DSA_SEL(32); break;
            }
#undef DSA_SEL
        }
    } else {
        for (int qq = 0; qq < 2; ++qq) {
            const int q = wid * 2 + qq, t = t0 + q;
            for (int k = lane; k <= t; k += 64) { SEL[q * 256 + k] = (unsigned short)k; SELB[q * 256 + k] = (unsigned char)t5_bucket(t - k); }
        }
    }
    __syncthreads();
    char* vst = lds + wv * 16384;
    bf16_t* cat = (bf16_t*)(ws + WS_CAT2);
    const __amdgpu_buffer_rsrc_t rkv = g8::make_rsrc(ckvn);
#pragma nounroll
    for (int qq = 0; qq < 2; ++qq) {
        const int q = wid * 2 + qq, t = t0 + q;
        const int nsel = (t + 1 < 256) ? t + 1 : 256;
        const size_t tok = (size_t)b * SEQ + t;
        const unsigned short* selq = SEL + q * 256;
        bf16x8 qf[4];
#pragma unroll
        for (int kk = 0; kk < 4; ++kk) {
            uint4 v = make_uint4(0, 0, 0, 0);
            if (fr < 8) v = *(const uint4*)(q2 + (size_t)q * 1536 + fr * 128 + kk * 32 + fq * 8);
            qf[kk] = u4_as_frag(v);
        }
        asm volatile("" :: "v"(qf[0]), "v"(qf[1]), "v"(qf[2]), "v"(qf[3]));
        float m = -INFINITY, l = 0.f;
        f32x4 O[8];
#pragma unroll
        for (int ct = 0; ct < 8; ++ct) O[ct] = (f32x4){0.f, 0.f, 0.f, 0.f};
        const int nck = (nsel + 31) >> 5;
#define DSA_ISSUE(c) do { int sv_[8]; \
            _Pragma("unroll") for (int pc = 0; pc < 8; ++pc) sv_[pc] = (int)selq[(c) * 32 + pc * 4 + fq];     \
            _Pragma("unroll") for (int pc = 0; pc < 8; ++pc) { \
            const int row_ = pc * 4 + fq; const int k_ = (c) * 32 + row_; \
            const int s_ = (k_ < nsel) ? sv_[pc] : 0; \
            __builtin_amdgcn_raw_ptr_buffer_load_lds(rkv, (LAS void*)(vst + ((c) & 1) * 8192 + pc * 1024), 16, (unsigned)(s_ * 256 + ((fr ^ (row_ & 15)) << 4)), 0, 0, 0); } } while (0)
        DSA_ISSUE(0);
#pragma nounroll
        for (int ck = 0; ck < nck; ++ck) {
            if (ck + 1 < nck) { DSA_ISSUE(ck + 1); asm volatile("s_waitcnt vmcnt(8)" ::: "memory"); }
            else asm volatile("s_waitcnt vmcnt(0)" ::: "memory");
            const char* buf = vst + (ck & 1) * 8192;
            bf16x8 a0[4], a1[4];
#pragma unroll
            for (int kk = 0; kk < 4; ++kk) {
                const int ch = ((kk * 4 + fq) ^ fr) << 4;
                a0[kk] = *(const bf16x8*)(buf + fr * 256 + ch);
                a1[kk] = *(const bf16x8*)(buf + (16 + fr) * 256 + ch);
            }
            f32x4 d0 = (f32x4){0.f, 0.f, 0.f, 0.f}, d1 = (f32x4){0.f, 0.f, 0.f, 0.f};
#pragma unroll
            for (int kk = 0; kk < 4; ++kk) {
                d0 = __builtin_amdgcn_mfma_f32_16x16x32_bf16(a0[kk], qf[kk], d0, 0, 0, 0);
                d1 = __builtin_amdgcn_mfma_f32_16x16x32_bf16(a1[kk], qf[kk], d1, 0, 0, 0);
            }
            float lg0[4], lg1[4];
            {
                const int kb = ck * 32 + 4 * fq;
                const uint32_t bw0 = *(const uint32_t*)(SELB + q * 256 + kb), bw1 = *(const uint32_t*)(SELB + q * 256 + kb + 16);
#pragma unroll
                for (int r = 0; r < 4; ++r) {
                    const bool v0 = (kb + r) < nsel, v1 = (kb + 16 + r) < nsel;
                    const int b0 = (int)((bw0 >> (8 * r)) & 31u), b1 = (int)((bw1 >> (8 * r)) & 31u);
                    const float rb0 = RB[b0 * 8 + (fr & 7)], rb1 = RB[b1 * 8 + (fr & 7)];
                    lg0[r] = (d0[r] + rb0) + (v0 ? 0.f : -INFINITY);
                    lg1[r] = (d1[r] + rb1) + (v1 ? 0.f : -INFINITY);
                }
            }
            float cm = fmaxf(fmaxf(fmaxf(lg0[0], lg0[1]), fmaxf(lg0[2], lg0[3])), fmaxf(fmaxf(lg1[0], lg1[1]), fmaxf(lg1[2], lg1[3])));
            cm = xrow16_max(cm);
            const float mn = fmaxf(m, cm);
            const float scl = __builtin_amdgcn_exp2f(m - mn);
            float p0[4], p1[4], ls = 0.f;
#pragma unroll
            for (int r = 0; r < 4; ++r) { p0[r] = __builtin_amdgcn_exp2f(lg0[r] - mn); p1[r] = __builtin_amdgcn_exp2f(lg1[r] - mn); ls += p0[r] + p1[r]; }
            ls = xrow16_sum(ls);
            l = l * scl + ls; m = mn;
            if (__any(scl != 1.f)) {
#pragma unroll
                for (int ct = 0; ct < 8; ++ct) O[ct] = O[ct] * scl;
            }
            uint4 pf; pf.x = pk2(p0[0], p0[1]); pf.y = pk2(p0[2], p0[3]); pf.z = pk2(p1[0], p1[1]); pf.w = pk2(p1[2], p1[3]);
            const bf16x8 pfrag = u4_as_frag(pf);
            {
                s16x4 va[8], vb[8];
                const int r0 = 4 * fq + (fr >> 2), sub = 8 * (fr & 1);
                const unsigned bufa = (unsigned)(size_t)(LAS const char*)buf + (unsigned)(r0 * 256 + sub);
#pragma unroll
                for (int ct = 0; ct < 8; ++ct) {
                    const int chn = ct * 2 + ((fr & 3) >> 1);
                    const unsigned a32 = bufa + (unsigned)((chn ^ (r0 & 15)) << 4);
                    asm volatile("ds_read_b64_tr_b16 %0, %1" : "=v"(va[ct]) : "v"(a32));
                    asm volatile("ds_read_b64_tr_b16 %0, %1 offset:4096" : "=v"(vb[ct]) : "v"(a32));
                }
                asm volatile("s_waitcnt lgkmcnt(0)" : "+v"(va[0]), "+v"(va[1]), "+v"(va[2]), "+v"(va[3]), "+v"(va[4]), "+v"(va[5]), "+v"(va[6]), "+v"(va[7]),
                                                      "+v"(vb[0]), "+v"(vb[1]), "+v"(vb[2]), "+v"(vb[3]), "+v"(vb[4]), "+v"(vb[5]), "+v"(vb[6]), "+v"(vb[7]) :: "memory");
#pragma unroll
                for (int ct = 0; ct < 8; ++ct) {
                    bf16x8 vf; vf[0] = va[ct][0]; vf[1] = va[ct][1]; vf[2] = va[ct][2]; vf[3] = va[ct][3]; vf[4] = vb[ct][0]; vf[5] = vb[ct][1]; vf[6] = vb[ct][2]; vf[7] = vb[ct][3];
                    O[ct] = __builtin_amdgcn_mfma_f32_16x16x32_bf16(vf, pfrag, O[ct], 0, 0, 0);
                }
            }
            asm volatile("" ::: "memory");
        }
#undef DSA_ISSUE
        const float inv = 1.f / l;
        if (fr < 8) {
#pragma unroll
            for (int ct = 0; ct < 8; ++ct) {
                uint2 o; o.x = pk2(O[ct][0] * inv, O[ct][1] * inv); o.y = pk2(O[ct][2] * inv, O[ct][3] * inv);
                *(uint2*)(cat + km_off((int)tok, fr * 128 + ct * 16 + 4 * fq, T)) = o;
            }
        }
        asm volatile("s_waitcnt vmcnt(0)" ::: "memory");
    }
}

#define MA_SB() __builtin_amdgcn_sched_barrier(0)
__device__ __forceinline__ void memattn_wave(CParams& p, int b, size_t tok0, int h, int lane) {
    const int fr = lane & 15, fq = lane >> 4;
    unsigned char* ws = p.ws;
    const bf16_t* proj = (const bf16_t*)(ws + WS_PROJ) + (tok0 + fr) * NPROJ + PC_QM + h * 64;
    const bf16_t* km = (const bf16_t*)(ws + WS_KMEM) + (size_t)(b * 4 + h) * (16 * 2 * 64 * 8) + lane * 8;
    const bf16_t* vt = (const bf16_t*)(ws + WS_VTMEM) + (size_t)(b * 4 + h) * (8 * 4 * 64 * 8) + lane * 8;
    const bf16x8 qf0 = ld_frag(proj + fq * 8), qf1 = ld_frag(proj + 32 + fq * 8);
    f32x4 d[16];
    bf16x8 kb[2][8];
#pragma unroll
    for (int j = 0; j < 4; ++j) { kb[0][2 * j] = ld_frag(km + (j * 2) * 512); kb[0][2 * j + 1] = ld_frag(km + (j * 2 + 1) * 512); }
    MA_SB();
#pragma unroll
    for (int g = 0; g < 4; ++g) {
        if (g < 3) {
#pragma unroll
            for (int j = 0; j < 4; ++j) { kb[(g + 1) & 1][2 * j] = ld_frag(km + ((g * 4 + 4 + j) * 2) * 512); kb[(g + 1) & 1][2 * j + 1] = ld_frag(km + ((g * 4 + 4 + j) * 2 + 1) * 512); }
        }
        MA_SB();
#pragma unroll
        for (int j = 0; j < 4; ++j) {
            f32x4 z = (f32x4){0.f, 0.f, 0.f, 0.f};
            z = __builtin_amdgcn_mfma_f32_16x16x32_bf16(kb[g & 1][2 * j], qf0, z, 0, 0, 0);
            z = __builtin_amdgcn_mfma_f32_16x16x32_bf16(kb[g & 1][2 * j + 1], qf1, z, 0, 0, 0);
            d[g * 4 + j] = z * (0.125f * 1.4426950408889634f);
        }
        MA_SB();
    }
    bf16x8 vb[2][8];
#pragma unroll
    for (int i = 0; i < 8; ++i) vb[0][i] = ld_frag(vt + i * 512);
    MA_SB();
    float mx = -INFINITY;
#pragma unroll
    for (int kt = 0; kt < 16; ++kt) mx = fmaxf(mx, fmaxf(fmaxf(d[kt][0], d[kt][1]), fmaxf(d[kt][2], d[kt][3])));
    mx = xrow16_max(mx);
    float s = 0.f;
#pragma unroll
    for (int kt = 0; kt < 16; ++kt)
#pragma unroll
        for (int r = 0; r < 4; ++r) { d[kt][r] = __builtin_amdgcn_exp2f(d[kt][r] - mx); s += d[kt][r]; }
    s = xrow16_sum(s);
    const float inv = 1.f / s;
    f32x4 O[4];
#pragma unroll
    for (int dt = 0; dt < 4; ++dt) O[dt] = (f32x4){0.f, 0.f, 0.f, 0.f};
    MA_SB();
#pragma unroll
    for (int g = 0; g < 4; ++g) {
        if (g < 3) {
#pragma unroll
            for (int i = 0; i < 8; ++i) vb[(g + 1) & 1][i] = ld_frag(vt + ((g + 1) * 8 + i) * 512);
        }
        MA_SB();
#pragma unroll
        for (int cc = 0; cc < 2; ++cc) {
            const int c32 = g * 2 + cc;
            uint4 pf; pf.x = pk2(d[2 * c32][0], d[2 * c32][1]); pf.y = pk2(d[2 * c32][2], d[2 * c32][3]); pf.z = pk2(d[2 * c32 + 1][0], d[2 * c32 + 1][1]); pf.w = pk2(d[2 * c32 + 1][2], d[2 * c32 + 1][3]);
            const bf16x8 pfrag = u4_as_frag(pf);
#pragma unroll
            for (int dt = 0; dt < 4; ++dt) O[dt] = __builtin_amdgcn_mfma_f32_16x16x32_bf16(vb[g & 1][cc * 4 + dt], pfrag, O[dt], 0, 0, 0);
        }
        MA_SB();
    }
    bf16_t* cat = (bf16_t*)(ws + WS_CAT2);
#pragma unroll
    for (int dt = 0; dt < 4; ++dt) {
        uint2 o; o.x = pk2(O[dt][0] * inv, O[dt][1] * inv); o.y = pk2(O[dt][2] * inv, O[dt][3] * inv);
        *(uint2*)(cat + km_off((int)tok0 + fr, 1280 + h * 64 + dt * 16 + 4 * fq, T)) = o;
    }
}

__device__ __forceinline__ void conv_tokens4(CParams& p, int b, int t0, int lane) {
    unsigned char* ws = p.ws;
    const bf16_t* proj = (const bf16_t*)(ws + WS_PROJ) + (size_t)b * SEQ * NPROJ;
    const float* cw = p.in[10];
    const int c = lane * 4;
    uint2 gc[6], hh[6], gb[4];
#pragma unroll
    for (int i = 0; i < 6; ++i) {
        const int tt = t0 - 2 + i, tc = tt < 0 ? 0 : tt;
        gc[i] = *(const uint2*)(proj + (size_t)tc * NPROJ + PC_GC + c); hh[i] = *(const uint2*)(proj + (size_t)tc * NPROJ + PC_H + c);
    }
#pragma unroll
    for (int i = 0; i < 4; ++i) gb[i] = *(const uint2*)(proj + (size_t)(t0 + i) * NPROJ + PC_GB + c);
    const float4 w0 = *(const float4*)(cw + c), w1 = *(const float4*)(cw + 256 + c), w2 = *(const float4*)(cw + 512 + c);
    float u[6][4];
#pragma unroll
    for (int i = 0; i < 6; ++i) {
        const float z = (t0 - 2 + i < 0) ? 0.f : 1.f;
        u[i][0] = bflo(gc[i].x) * bflo(hh[i].x) * z; u[i][1] = bfhi(gc[i].x) * bfhi(hh[i].x) * z;
        u[i][2] = bflo(gc[i].y) * bflo(hh[i].y) * z; u[i][3] = bfhi(gc[i].y) * bfhi(hh[i].y) * z;
    }
    bf16_t* cat = (bf16_t*)(ws + WS_CAT2);
#pragma unroll
    for (int i = 0; i < 4; ++i) {
        const float y0 = fmaf(w0.x, u[i][0], fmaf(w1.x, u[i + 1][0], w2.x * u[i + 2][0]));
        const float y1 = fmaf(w0.y, u[i][1], fmaf(w1.y, u[i + 1][1], w2.y * u[i + 2][1]));
        const float y2 = fmaf(w0.z, u[i][2], fmaf(w1.z, u[i + 1][2], w2.z * u[i + 2][2]));
        const float y3 = fmaf(w0.w, u[i][3], fmaf(w1.w, u[i + 1][3], w2.w * u[i + 2][3]));
        uint2 o; o.x = pk2(bflo(gb[i].x) * y0, bfhi(gb[i].x) * y1); o.y = pk2(bflo(gb[i].y) * y2, bfhi(gb[i].y) * y3);
        *(uint2*)(cat + km_off(b * SEQ + t0 + i, 1024 + c, T)) = o;
    }
}

__device__ __forceinline__ void phase4(CParams& p, char* lds, int wv) {
    const int tid = opaque_tid(wv), lane = tid & 63, wid = tid >> 6;
    if (tid < 256) ((float*)(lds + P4_RB))[tid] = p.in[9][tid] * 1.4426950408889634f;
    const int gw = blockIdx.x * 8 + wid, NW = gridDim.x * 8;
    const int ndsa = (T / 16 - (int)blockIdx.x + (int)gridDim.x - 1) / (int)gridDim.x;
    const int new_ = (EW_ITEMS - gw + NW - 1) / NW;
    const int per = (new_ + ndsa - 1) / (ndsa > 0 ? ndsa : 1);
    int ew = gw;
    for (int i = blockIdx.x; i < T / 16; i += gridDim.x) {
        const int b = i >> 7, tau = i & 127, tile = ((b >> 1) & 1) ? 127 - tau : tau;
        dsa_item(p, b, tile * 16, lds, tid, wv);
        for (int j = 0; j < per && ew < EW_ITEMS; ++j, ew += NW) expert_w_item(p, ew, (float*)(lds + wv * 16384), opaque_i(lane));
    }
    for (; ew < EW_ITEMS; ew += NW) expert_w_item(p, ew, (float*)(lds + wv * 16384), opaque_i(lane));
    for (int i = blockIdx.x; i < T / 32; i += gridDim.x) {
        const int b = i >> 6, t0 = (i & 63) * 32 + (wid >> 2) * 16;
        memattn_wave(p, b, (size_t)b * SEQ + t0, wid & 3, opaque_i(lane));
        conv_tokens4(p, b, t0 + (wid & 3) * 4, opaque_i(lane));
    }
}

#define XB_TMO      128
#define XB_XCNT(j)  (256  + 64 * (j))
#define XB_XSUB(j)  (1280 + 64 * (j))
#define XB_XGEN(j)  (2304 + 64 * (j))
#define XB_TOP      3328
#define XB_TOPGEN   3392
#define XCD_BAR_WORDS 3456
#define XB_SPIN_CAP (1u << 22)
__device__ __forceinline__ unsigned xb_ld(unsigned* p)              { return __hip_atomic_load(p, __ATOMIC_RELAXED, __HIP_MEMORY_SCOPE_AGENT); }
__device__ __forceinline__ unsigned xb_add(unsigned* p, unsigned v) { return __hip_atomic_fetch_add(p, v, __ATOMIC_RELAXED, __HIP_MEMORY_SCOPE_AGENT); }
__device__ __forceinline__ unsigned xb_xcc_id() { return (unsigned)__builtin_amdgcn_s_getreg((3 << 11) | 20) & 0xFu; }
#define XB_SPIN(cond, bar) do { unsigned _sp = 0; while (cond) { __builtin_amdgcn_s_sleep(1); \
    if ((++_sp & 255u) == 0u) { if (xb_ld(&(bar)[XB_TMO])) break; if (_sp > XB_SPIN_CAP) { atomicAdd(&(bar)[XB_TMO], 1u); break; } } } } while (0)
__device__ __forceinline__ void phase5(CParams& p, char* lds, int wv) {
    const int tid = opaque_tid(wv);
    unsigned char* ws = p.ws;
    const float* x = p.in[0];
    constexpr int I1 = (T / 256) * 4;
    unsigned* bar = (unsigned*)(ws + WS_BAR);
    unsigned long long* lnst = (unsigned long long*)(ws + WS_LNST);
    bf16_t* x1h = (bf16_t*)(ws + WS_X1H); bf16_t* x1l = (bf16_t*)(ws + WS_X1L); unsigned char* x1f8 = ws + WS_X1F8;
    for (int it = vblock(); it < I1; it += gridDim.x) {
        const int pm = it >> 2, pn = it & 3;
        const int brow = pm * 256, bcol = pn * 256;
        g8::Src s; g8::km_src(s, (const bf16_t*)(ws + WS_CAT2), T, brow, (const bf16_t*)(ws + WS_W_OUT2_T), 1024, bcol, tid);
        g8::kloop_issue(s, lds, wv);
        f32x4 acc[2][2][4][2]; g8::acc_zero(acc);
        g8::kloop(acc, s, 48, lds, tid, wv);
        const int te = opaque_i(tid), lane = te & 63, wr = wv >> 2, wc = wv & 3, fr = lane & 15, fq = lane >> 4;
        char* stg = lds + LDS_STG;
        float2* PS = (float2*)(stg + 32 * 1040);
        float2* SR = PS + 256;
        f32x4 vr[2][4][4];
        float4 xn[4];
#pragma unroll
        for (int i = 0; i < 4; ++i) { const int lr = wv + 8 * i; xn[i] = ldnt4(x + (size_t)(brow + (lr >> 4) * 64 + (lr & 15)) * 1024 + bcol + lane * 4); }
#pragma unroll
        for (int ai = 0; ai < 2; ++ai)
#pragma unroll
            for (int m = 0; m < 4; ++m) {
                char* rp = stg + (wr * 16 + fr) * 1040 + (wc * 32 + 4 * fq) * 4;
#pragma unroll
                for (int bj = 0; bj < 2; ++bj)
#pragma unroll
                    for (int n = 0; n < 2; ++n) *(f32x4*)(rp + (bj * 128 + n * 16) * 4) = acc[ai][bj][m][n];
                asm volatile("s_waitcnt lgkmcnt(0)" ::: "memory"); __builtin_amdgcn_s_barrier(); asm volatile("" ::: "memory");
                float4 xc[4];
#pragma unroll
                for (int i = 0; i < 4; ++i) xc[i] = xn[i];
                if (ai * 4 + m < 7) {
                    const int ai2 = (ai * 4 + m + 1) >> 2, m2 = (ai * 4 + m + 1) & 3;
#pragma unroll
                    for (int i = 0; i < 4; ++i) { const int lr = wv + 8 * i; xn[i] = ldnt4(x + (size_t)(brow + ai2 * 128 + (lr >> 4) * 64 + m2 * 16 + (lr & 15)) * 1024 + bcol + lane * 4); }
                }
#pragma unroll
                for (int i = 0; i < 4; ++i) {
                    const int lr = wv + 8 * i;
                    const f32x4 a = *(const f32x4*)(stg + lr * 1040 + lane * 16);
                    f32x4 o; o[0] = fmaf(ALPHA, xc[i].x, a[0]); o[1] = fmaf(ALPHA, xc[i].y, a[1]); o[2] = fmaf(ALPHA, xc[i].z, a[2]); o[3] = fmaf(ALPHA, xc[i].w, a[3]);
                    vr[ai][m][i] = o;
                    const float s1 = wave_sum((o[0] + o[1]) + (o[2] + o[3]));
                    const float s2 = wave_sum((o[0] * o[0] + o[1] * o[1]) + (o[2] * o[2] + o[3] * o[3]));
                    if (lane == 0) PS[ai * 128 + (lr >> 4) * 64 + m * 16 + (lr & 15)] = make_float2(s1, s2);
                }
                asm volatile("s_waitcnt lgkmcnt(0)" ::: "memory"); __builtin_amdgcn_s_barrier(); asm volatile("" ::: "memory");
            }
        if (wv < 4) {
            const float2 ps = PS[te];
            __hip_atomic_store(lnst + (size_t)(pm * 4 + pn) * 256 + te, ((unsigned long long)__float_as_uint(ps.y) << 32) | __float_as_uint(ps.x), __ATOMIC_RELAXED, __HIP_MEMORY_SCOPE_AGENT);
            asm volatile("s_waitcnt vmcnt(0)" ::: "memory");
            if (lane == 0) (void)xb_add(&bar[XCD_BAR_WORDS + 4 * pm], 1u);
            if (wv == 0) {
                XB_SPIN(xb_ld(&bar[XCD_BAR_WORDS + 4 * pm]) < 16u, bar);
                __builtin_amdgcn_fence(__ATOMIC_ACQUIRE, "agent");
            }
        }
        asm volatile("s_waitcnt vmcnt(0) lgkmcnt(0)" ::: "memory"); __builtin_amdgcn_s_barrier(); asm volatile("" ::: "memory");
        if (wv < 4) {
            float s1 = 0.f, s2 = 0.f;
#pragma unroll
            for (int t4 = 0; t4 < 4; ++t4) {
                const unsigned long long w = __hip_atomic_load(lnst + (size_t)(pm * 4 + t4) * 256 + te, __ATOMIC_RELAXED, __HIP_MEMORY_SCOPE_AGENT);
                s1 += __uint_as_float((unsigned)w); s2 += __uint_as_float((unsigned)(w >> 32));
            }
            const float mean = s1 * (1.f / 1024.f);
            const float var = fmaxf(s2 * (1.f / 1024.f) - mean * mean, 0.f);
            SR[te] = make_float2(mean, rsqrtf(var + LN_EPS));
        }
        asm volatile("s_waitcnt lgkmcnt(0)" ::: "memory"); __builtin_amdgcn_s_barrier(); asm volatile("" ::: "memory");
        {
            const float4 gg = *(const float4*)(p.in[14] + bcol + lane * 4), be = *(const float4*)(p.in[15] + bcol + lane * 4);
#pragma unroll
            for (int ai = 0; ai < 2; ++ai)
#pragma unroll
                for (int m = 0; m < 4; ++m)
#pragma unroll
                    for (int i = 0; i < 4; ++i) {
                        const int lr = wv + 8 * i, trow = ai * 128 + (lr >> 4) * 64 + m * 16 + (lr & 15);
                        const float2 sr = SR[trow];
                        const size_t go = (size_t)(brow + trow) * 1024 + bcol + lane * 4;
                        const f32x4 a = vr[ai][m][i];
                        float4 o; o.x = (a[0] - sr.x) * sr.y * gg.x + be.x; o.y = (a[1] - sr.x) * sr.y * gg.y + be.y; o.z = (a[2] - sr.x) * sr.y * gg.z + be.z; o.w = (a[3] - sr.x) * sr.y * gg.w + be.w;
                        stnt4(p.out + go, o);
                        uint2 hi; hi.x = pk2(o.x, o.y); hi.y = pk2(o.z, o.w);
                        uint2 lo; lo.x = pk2(o.x - bflo(hi.x), o.y - bfhi(hi.x)); lo.y = pk2(o.z - bflo(hi.y), o.w - bfhi(hi.y));
                        *(uint2*)(x1h + go) = hi;
                        *(uint2*)(x1l + go) = lo;
                        *(uint32_t*)(x1f8 + go) = pk4_f8(o.x, o.y, o.z, o.w);
                    }
        }
        asm volatile("s_waitcnt lgkmcnt(0)" ::: "memory"); __builtin_amdgcn_s_barrier(); asm volatile("" ::: "memory");
    }
}

__device__ __forceinline__ void phase6(CParams& p, int wv) {
    const int tid = opaque_tid(wv), lane = tid & 63, wid = tid >> 6;
    unsigned char* ws = p.ws;
    const float* g = p.in[14]; const float* bb = p.in[15];
    bf16_t* x1b = (bf16_t*)(ws + WS_X1B); bf16_t* x1lo = (bf16_t*)(ws + WS_X1LO);
    for (int t0 = (blockIdx.x * 8 + wid) * 2; t0 < T; t0 += gridDim.x * 16) {
        float4 v[2][4];
#pragma unroll
        for (int u = 0; u < 2; ++u)
#pragma unroll
            for (int j = 0; j < 4; ++j) v[u][j] = ldnt4(p.out + (size_t)(t0 + u) * 1024 + lane * 4 + 256 * j);
#pragma unroll
        for (int u = 0; u < 2; ++u) {
            const int t = t0 + u;
            float* row = p.out + (size_t)t * 1024;
            float s = 0.f;
#pragma unroll
            for (int j = 0; j < 4; ++j) s += (v[u][j].x + v[u][j].y) + (v[u][j].z + v[u][j].w);
            const float mean = wave_sum(s) * (1.f / 1024.f);
            float q = 0.f;
#pragma unroll
            for (int j = 0; j < 4; ++j) { v[u][j].x -= mean; v[u][j].y -= mean; v[u][j].z -= mean; v[u][j].w -= mean; q += (v[u][j].x * v[u][j].x + v[u][j].y * v[u][j].y) + (v[u][j].z * v[u][j].z + v[u][j].w * v[u][j].w); }
            const float rstd = rsqrtf(wave_sum(q) * (1.f / 1024.f) + LN_EPS);
#pragma unroll
            for (int j = 0; j < 4; ++j) {
                const int cidx = lane * 4 + 256 * j;
                const float4 gg = *(const float4*)(g + cidx), be = *(const float4*)(bb + cidx);
                float4 o; o.x = v[u][j].x * rstd * gg.x + be.x; o.y = v[u][j].y * rstd * gg.y + be.y; o.z = v[u][j].z * rstd * gg.z + be.z; o.w = v[u][j].w * rstd * gg.w + be.w;
                stnt4(row + cidx, o);
                uint2 hi; hi.x = pk2(o.x, o.y); hi.y = pk2(o.z, o.w);
                uint2 lo; lo.x = pk2(o.x - bflo(hi.x), o.y - bfhi(hi.x)); lo.y = pk2(o.z - bflo(hi.y), o.w - bfhi(hi.y));
                *(uint2*)(x1b + (size_t)t * 1024 + cidx) = hi;
                *(uint2*)(x1lo + (size_t)t * 1024 + cidx) = lo;
            }
        }
    }
}

__device__ __forceinline__ float grp8_max(float v) {
    v = fmaxf(v, dpp_f<0xB1>(v)); v = fmaxf(v, dpp_f<0x4E>(v)); v = fmaxf(v, dpp_f<0x141>(v));
    return v;
}
constexpr int NTB = T / 128;
constexpr int TBR = NTB / NROUND;
__device__ __forceinline__ void phase7(CParams& p, char* lds, int wv) {
    const int tid = opaque_tid(wv), lane = tid & 63, wid = tid >> 6, wm = wid >> 2, wn = wid & 3;
    unsigned char* ws = p.ws;
    const int r0 = tid >> 3, c = tid & 7, fr = lane & 15, fq = lane >> 4;
    const bf16_t* Ah = (const bf16_t*)(ws + WS_X1H); const bf16_t* Al = (const bf16_t*)(ws + WS_X1L); const bf16_t* Bt = (const bf16_t*)(ws + WS_W_R_T);
    float* lg = (float*)(lds + LDS_STG);
    const float rbias = p.in[17][lane];
    int* tok_e = (int*)(ws + WS_TOK_E); float* tok_w = (float*)(ws + WS_TOK_W);
    int* tok_pos = (int*)(ws + WS_TOK_POS);
    int* cntb = (int*)(ws + WS_CNTB);
    int* hist = (int*)(lds + LDS_MISC);
    const int grp = lane >> 3;
    for (int tb = blockIdx.x; tb < NTB; tb += gridDim.x) {
        const int m0 = tb * 128;
        f32x4 acc[4][2]; acc_zero(acc);
        const bf16_t* a0 = Ah + (size_t)(m0 + r0) * 1024 + c * 8; const bf16_t* a1 = a0 + (size_t)64 * 1024;
        const bf16_t* a0b = Al + (size_t)(m0 + r0) * 1024 + c * 8; const bf16_t* a1b = a0b + (size_t)64 * 1024;
        const bf16_t* b0 = Bt + (size_t)r0 * 2048 + c * 8; const bf16_t* b1 = b0 + (size_t)64 * 2048;
        pf_kloop<32, true>(acc, a0, a1, a0b, a1b, b0, b1, lds, tid, lane, wm, wn);
        if (wn < 2) {
#pragma unroll
            for (int mi = 0; mi < 4; ++mi)
#pragma unroll
                for (int ni = 0; ni < 2; ++ni) {
                    const int m = wm * 64 + mi * 16 + fr, n = wn * 32 + ni * 16 + 4 * fq;
                    *(f32x4*)(lg + m * 64 + n) = acc[mi][ni];
                }
        }
        if (tid < 64) hist[tid] = 0;
        __syncthreads();
        if (wn >= 2) {
#pragma unroll
            for (int mi = 0; mi < 4; ++mi)
#pragma unroll
                for (int ni = 0; ni < 2; ++ni) {
                    const int m = wm * 64 + mi * 16 + fr, n = (wn - 2) * 32 + ni * 16 + 4 * fq;
                    f32x4 v = *(const f32x4*)(lg + m * 64 + n);
                    v = v + acc[mi][ni];
                    *(f32x4*)(lg + m * 64 + n) = v;
                }
        }
        __syncthreads();
        for (int j = 0; j < 16; ++j) {
            const int tl = wid * 16 + j, t = m0 + tl;
            const float lgt = lg[tl * 64 + lane];
            const float s = 1.f / (1.f + __expf(-lgt));
            const float sc = s + rbias;
            const float m1 = grp8_max(sc);
            const bool ismax = (sc == m1);
            const unsigned long long bm = __ballot(ismax);
            const int nmax = __popcll((bm >> (grp * 8)) & 0xFFull);
            const float m2 = grp8_max(ismax ? -INFINITY : sc);
            const float gscore = m1 + (nmax >= 2 ? m1 : m2);
            int grank = 0;
#pragma unroll
            for (int g2 = 0; g2 < 8; ++g2) {
                const float o = __builtin_bit_cast(float, __builtin_amdgcn_readlane(__builtin_bit_cast(int, gscore), g2 * 8));
                grank += (o > gscore || (o == gscore && g2 < grp)) ? 1 : 0;
            }
            float mv = (grank < 4) ? sc : -INFINITY;
            unsigned long long selm = 0ull;
#pragma unroll
            for (int i8 = 0; i8 < 8; ++i8) {
                const float mx = wave_max(mv);
                const unsigned long long bmx = __ballot(mv == mx);
                const unsigned long long low = bmx & (0ull - bmx);
                selm |= low;
                if ((low >> lane) & 1ull) mv = -INFINITY;
            }
            const bool selq = (selm >> lane) & 1ull;
            const int rank = __popcll(selm & ((1ull << lane) - 1ull));
            const float ssum = wave_sum(selq ? s : 0.f);
            if (selq) {
                tok_e[(size_t)t * 8 + rank] = lane;
                tok_w[(size_t)t * 8 + rank] = s / ssum * 2.5f;
                tok_pos[(size_t)t * 9 + rank] = atomicAdd(&hist[lane], 1);
            }
        }
        __syncthreads();
        if (tid < 64) cntb[tb * 64 + tid] = hist[tid];
        __syncthreads();
    }
}

__device__ __forceinline__ int cntb_partial(const int* cntb, int i0, int i1, int tid) {
    const int e = tid & 63, part = tid >> 6;
    int c = 0;
#pragma unroll 8
    for (int i = i0 + part; i < i1; i += 8) c += cntb[i * 64 + e];
    return c;
}
__device__ __forceinline__ void round_tables(CParams& p, int r, int* misc, int tid) {
    const int* cntb = (const int*)(p.ws + WS_CNTB) + (size_t)r * TBR * 64;
    __syncthreads();
    if (tid < 64) misc[tid] = 0;
    if (tid == 64) misc[64] = TR;
    __syncthreads();
    { const int c = cntb_partial(cntb, 0, TBR, tid); atomicAdd(&misc[tid & 63], c); }
    __syncthreads();
    if (tid < 64) {
        const int nb = (misc[tid] + 255) >> 8;
        int incl = nb;
#pragma unroll
        for (int d = 1; d < 64; d <<= 1) { const int v = __shfl_up(incl, d); if (tid >= d) incl += v; }
        const int excl = incl - nb;
        misc[80 + tid] = excl * 256; misc[160 + tid] = excl;
        if (tid == 63) { misc[80 + 64] = incl * 256; misc[160 + 64] = incl; misc[160 + NE1] = incl + ((TR + 255) >> 8); }
    }
    __syncthreads();
}
__device__ __forceinline__ int find_expert(const int* misc, int blk) {
    int lo = 0, hi = NE1;
#pragma unroll
    for (int i = 0; i < 7; ++i) { const int mid = (lo + hi) >> 1; if (mid < hi && misc[160 + mid] <= blk) lo = mid; else hi = mid; if (hi - lo <= 1) break; }
    while (lo + 1 <= NEXP && misc[160 + lo + 1] <= blk) ++lo;
    return lo;
}

__device__ __forceinline__ void phase9(CParams& p, char* lds, int wv) {
    const int tid = opaque_tid(wv);
    unsigned char* ws = p.ws;
    int* misc = (int*)(lds + LDS_MISC);
    const int* tok_e = (const int*)(ws + WS_TOK_E); const float* tok_w = (const float*)(ws + WS_TOK_W);
    int* tok_pos = (int*)(ws + WS_TOK_POS);
    const int* cntb = (const int*)(ws + WS_CNTB);
    for (int tb = blockIdx.x; tb < NTB; tb += gridDim.x) {
        const int r = tb / TBR;
        round_tables(p, r, misc, tid);
        if (tid < 64) misc[256 + tid] = 0;
        __syncthreads();
        { const int c = cntb_partial(cntb, r * TBR, tb, tid); atomicAdd(&misc[256 + (tid & 63)], c); }
        __syncthreads();
        int* slot_tok = (int*)(ws + WS_SLOT_TOK) + (size_t)r * CAP; float* slot_w = (float*)(ws + WS_SLOT_W) + (size_t)r * CAP;
        for (int i = tid; i < 128 * 8; i += NTHREADS) {
            const int t = tb * 128 + (i >> 3), k = i & 7;
            const int e = tok_e[(size_t)t * 8 + k];
            const int pos = misc[80 + e] + misc[256 + e] + tok_pos[(size_t)t * 9 + k];
            slot_tok[pos] = t; slot_w[pos] = tok_w[(size_t)t * 8 + k];
            tok_pos[(size_t)t * 9 + k] = pos;
        }
        if (tid < 128) {
            const int t = tb * 128 + tid, pos = misc[80 + NEXP] + (t - r * TR);
            slot_tok[pos] = t; slot_w[pos] = 1.f;
            tok_pos[(size_t)t * 9 + 8] = pos;
        }
    }
}

struct GuItem { int r, pos0, e, nt2, nvalid; };
__device__ __forceinline__ GuItem gu_decode(const int* misc0, const int (&nbase)[NROUND + 1], int git) {
    GuItem d;
    int r = 0;
#pragma unroll
    for (int rr = 1; rr < NROUND; ++rr) r += (git >= nbase[rr]) ? 1 : 0;
    int lbase = nbase[0];
#pragma unroll
    for (int rr = 1; rr < NROUND; ++rr) lbase = (r >= rr) ? nbase[rr] : lbase;
    const int it = git - lbase;
    const int* misc = misc0 + r * 256;
    const int blk = it >> 1; d.nt2 = it & 1; d.r = r;
    const int e = find_expert(misc, blk);
    d.e = __builtin_amdgcn_readfirstlane(e);
    const int rb = __builtin_amdgcn_readfirstlane(blk - misc[160 + d.e]);
    d.pos0 = __builtin_amdgcn_readfirstlane(misc[80 + d.e] + rb * 256);
    d.nvalid = __builtin_amdgcn_readfirstlane(min(256, misc[d.e] - rb * 256));
    return d;
}
__device__ __forceinline__ void phase_gu(CParams& p, char* lds, int wv) {
    const int tid = opaque_tid(wv);
    unsigned char* ws = p.ws;
    int* misc0 = (int*)(lds + LDS_MISC);
    int nbase[NROUND + 1]; nbase[0] = 0;
#pragma unroll
    for (int r = 0; r < NROUND; ++r) { round_tables(p, r, misc0 + r * 256, tid); nbase[r + 1] = nbase[r] + __builtin_amdgcn_readfirstlane(misc0[r * 256 + 160 + NE1]) * 2; }
    const int nitems = nbase[NROUND];
    const int lane_ = tid & 63;
    const int sR = (wv >> 1) * 32 + (lane_ & 31), sCb = (2 * (wv & 1) + (lane_ >> 5)) * 16;
    const __amdgpu_buffer_rsrc_t rx = g8::make_rsrc(ws + WS_X1F8);
    int git = vblock();
    GuItem d; d.r = 0; d.pos0 = 0; d.e = 0; d.nt2 = 0; d.nvalid = 1;
    int tok0 = 0, tok1 = 0;
    g8::Src s;
    if (git < nitems) {
        d = gu_decode(misc0, nbase, git);
        const int* slot_tok = (const int*)(ws + WS_SLOT_TOK) + (size_t)d.r * CAP;
        tok0 = slot_tok[d.pos0 + min(sR, d.nvalid - 1)]; tok1 = slot_tok[d.pos0 + min(128 + sR, d.nvalid - 1)];
        s.ra = rx; s.rb = g8::make_rsrc(ws + WS_W_EGU_T + (size_t)d.e * 524288); s.bh = 8192u; s.akt = 64u; s.bkt = 32768u;
        s.ao[0] = (unsigned)(tok0 * 1024 + sCb); s.ao[1] = (unsigned)(tok1 * 1024 + sCb);
        s.bo = (unsigned)(d.nt2 * 16384 + tid * 16);
        g8::kloop_issue<0>(s, lds, wv);
    }
    while (git < nitems) {
        const GuItem c = d;
        const int gnext = git + gridDim.x;
        if (gnext < nitems) {
            d = gu_decode(misc0, nbase, gnext);
            const int* slot_tok = (const int*)(ws + WS_SLOT_TOK) + (size_t)d.r * CAP;
            tok0 = slot_tok[d.pos0 + min(sR, d.nvalid - 1)]; tok1 = slot_tok[d.pos0 + min(128 + sR, d.nvalid - 1)];
        }
        g8::f32x16 acc[2][2][2]; g8::acc_zero_f8(acc);
        g8::kloop_f8(acc, s, 16, lds, tid, wv);
        git = gnext;
        if (git < nitems) {
            s.rb = g8::make_rsrc(ws + WS_W_EGU_T + (size_t)d.e * 524288);
            s.ao[0] = (unsigned)(tok0 * 1024 + sCb); s.ao[1] = (unsigned)(tok1 * 1024 + sCb);
            s.bo = (unsigned)(d.nt2 * 16384 + tid * 16);
            g8::kloop_issue<0>(s, lds, wv);
        }
        bf16_t* hslot = (bf16_t*)(ws + WS_HSLOT) + (size_t)c.r * CAP * 256;
        {
            const int te = opaque_i(tid), lane = te & 63, wr = wv >> 2, wc = wv & 3, tc = lane & 31, hh = lane >> 5;
            char* stg = lds + LDS_STG;
            constexpr float ws8 = 1.f / W8_SCALE;
#pragma unroll
            for (int ai = 0; ai < 2; ++ai)
#pragma unroll
                for (int m = 0; m < 2; ++m) {
                    char* rp = stg + (ai * 128 + wr * 64 + m * 32 + tc) * 272 + (wc * 16 + 4 * hh) * 2;
#pragma unroll
                    for (int bj = 0; bj < 2; ++bj)
#pragma unroll
                        for (int pq = 0; pq < 2; ++pq) {
                            float hv[4];
#pragma unroll
                            for (int j = 0; j < 4; ++j) { const float g = acc[ai][bj][m][(2 * pq) * 4 + j] * ws8, u = acc[ai][bj][m][(2 * pq + 1) * 4 + j] * ws8; hv[j] = g * __builtin_amdgcn_rcpf(1.f + __expf(-g)) * u; }
                            uint2 o; o.x = pk2(hv[0], hv[1]); o.y = pk2(hv[2], hv[3]);
                            *(uint2*)(rp + bj * 128 + pq * 16) = o;
                        }
                }
            asm volatile("s_waitcnt lgkmcnt(0)" ::: "memory"); __builtin_amdgcn_s_barrier(); asm volatile("" ::: "memory");
            uint4 v[8];
#pragma unroll
            for (int i = 0; i < 8; ++i) { const int id = te + i * 512; v[i] = *(const uint4*)(stg + (id >> 4) * 272 + (id & 15) * 16); }
#pragma unroll
            for (int i = 0; i < 8; ++i) { const int id = te + i * 512; typedef unsigned u32x4_t __attribute__((ext_vector_type(4))); const u32x4_t ov = {v[i].x, v[i].y, v[i].z, v[i].w};
                __builtin_nontemporal_store(ov, (u32x4_t*)(hslot + km_off(c.pos0 + (id >> 4), c.nt2 * 128 + (id & 15) * 8, CAP))); }
            asm volatile("s_waitcnt lgkmcnt(0)" ::: "memory"); __builtin_amdgcn_s_barrier(); asm volatile("" ::: "memory");
        }
    }
    asm volatile("s_waitcnt vmcnt(0)" ::: "memory");
}
struct DownItem { int pos0, e, half; };
__device__ __forceinline__ DownItem down_decode(const int* misc, int it, int n2) {
    DownItem d; int blk = it >> 1; d.half = it & 1;
    if (it >= n2) { const int q = (n2 << 1) + (it - n2); blk = q >> 2; d.half = 2 + (q & 3); }
    const int e = find_expert(misc, blk);
    d.e = __builtin_amdgcn_readfirstlane(e);
    const int rb = __builtin_amdgcn_readfirstlane(blk - misc[160 + d.e]);
    d.pos0 = __builtin_amdgcn_readfirstlane(misc[80 + d.e] + rb * 256);
    return d;
}
struct DownFlush {
    bf16_t* yslot; char* lds; int pos0, half, tid, wv; float w[8];
    __device__ __forceinline__ void operator()(f32x4 (&acc)[2][2][4][2], int seg) const {
        g8_store_tile<true>(acc, yslot, 1024, pos0, (half * 2 + seg) * 256, w, lds, tid, wv);
    }
    __device__ __forceinline__ void last(f32x4 (&acc)[2][2][4][2]) const {
        g8_store_tile<false>(acc, yslot, 1024, pos0, (half * 2 + 1) * 256, w, lds, tid, wv);
    }
};
__device__ __forceinline__ void phase_down(CParams& p, int r, char* lds, int wv) {
    const int tid = opaque_tid(wv);
    unsigned char* ws = p.ws;
    int* misc = (int*)(lds + LDS_MISC);
    round_tables(p, r, misc, tid);
    const int nit2 = __builtin_amdgcn_readfirstlane(misc[160 + NE1]) * 2;
    const int n2 = (nit2 / (int)gridDim.x) * (int)gridDim.x;
    const int nitems = n2 + (nit2 - n2) * 2;
    const float* slot_w = (const float*)(ws + WS_SLOT_W) + (size_t)r * CAP;
    const bf16_t* hs = (const bf16_t*)(ws + WS_HSLOT) + (size_t)r * CAP * 256;
    const bf16_t* wed = (const bf16_t*)(ws + WS_W_ED_T);
    const int lane0 = tid & 63, wr0 = wv >> 2, fr0 = lane0 & 15;
    g8::Seg sg; sg.mask = 7; sg.lg = 3; sg.aseg = 0u; sg.bseg = 256u * 64u;
    int it = vblock();
    g8::Src s; DownItem d; float w[8];
    d.pos0 = 0; d.e = 0; d.half = 0;
#pragma unroll
    for (int i = 0; i < 8; ++i) w[i] = 0.f;
    if (it < nitems) {
        d = down_decode(misc, it, n2);
#pragma unroll
        for (int i = 0; i < 8; ++i) w[i] = slot_w[d.pos0 + (i >> 2) * 128 + wr0 * 64 + (i & 3) * 16 + fr0];
        g8::km_src(s, hs, CAP, d.pos0, wed + (size_t)d.e * 1024 * 256, 1024, d.half < 2 ? d.half * 512 : (d.half - 2) * 256, tid);
        g8::kloop_issue(s, lds, wv, sg);
        asm volatile("" :: "v"(w[0]), "v"(w[1]), "v"(w[2]), "v"(w[3]), "v"(w[4]), "v"(w[5]), "v"(w[6]), "v"(w[7]));
    }
    while (it < nitems) {
        const int single = d.half >= 2;
        const int ct_last = single ? d.half - 2 : d.half * 2 + 1;
        DownFlush fl; fl.yslot = (bf16_t*)(ws + WS_YSLOT); fl.lds = lds; fl.pos0 = d.pos0; fl.half = d.half; fl.tid = tid; fl.wv = wv;
#pragma unroll
        for (int i = 0; i < 8; ++i) fl.w[i] = w[i];
        f32x4 acc[2][2][4][2]; g8::acc_zero(acc);
        g8::kloop_ms(acc, s, single ? 8 : 16, lds, tid, wv, sg, fl);
        it += gridDim.x;
        if (it < nitems) {
            d = down_decode(misc, it, n2);
#pragma unroll
            for (int i = 0; i < 8; ++i) w[i] = slot_w[d.pos0 + (i >> 2) * 128 + wr0 * 64 + (i & 3) * 16 + fr0];
            g8::km_src(s, hs, CAP, d.pos0, wed + (size_t)d.e * 1024 * 256, 1024, d.half < 2 ? d.half * 512 : (d.half - 2) * 256, tid);
            g8::kloop_issue(s, lds, wv, sg);
        }
        g8_store_tile<false>(acc, fl.yslot, 1024, fl.pos0, ct_last * 256, fl.w, lds, tid, wv);
        if (it < nitems) asm volatile("" :: "v"(w[0]), "v"(w[1]), "v"(w[2]), "v"(w[3]), "v"(w[4]), "v"(w[5]), "v"(w[6]), "v"(w[7]));
    }
    asm volatile("s_waitcnt vmcnt(0)" ::: "memory");
}

__device__ __forceinline__ void phase_combine(CParams& p, int r, int wv) {
    const int tid = opaque_tid(wv), lane = tid & 63, wid = tid >> 6;
    unsigned char* ws = p.ws;
    const float* g = p.in[24]; const float* bb = p.in[25];
    const int* tok_pos = (const int*)(ws + WS_TOK_POS);
    const bf16_t* yslot = (const bf16_t*)(ws + WS_YSLOT);
    for (int i = blockIdx.x * 8 + wid; i < TR; i += gridDim.x * 8) {
        const int t = r * TR + i;
        float* row = p.out + (size_t)t * 1024;
        float4 v[4];
#pragma unroll
        for (int j = 0; j < 4; ++j) { v[j] = ldnt4(row + lane * 4 + 256 * j); v[j].x *= ALPHA; v[j].y *= ALPHA; v[j].z *= ALPHA; v[j].w *= ALPHA; }
        int pos[9];
#pragma unroll
        for (int k = 0; k < 9; ++k) pos[k] = tok_pos[(size_t)t * 9 + k];
        uint2 y[9][4];
#pragma unroll
        for (int k = 0; k < 9; ++k)
#pragma unroll
            for (int j = 0; j < 4; ++j) { const unsigned long long w64 = __builtin_nontemporal_load((const unsigned long long*)(yslot + (size_t)pos[k] * 1024 + lane * 4 + 256 * j)); y[k][j].x = (uint32_t)w64; y[k][j].y = (uint32_t)(w64 >> 32); }
#pragma unroll
        for (int k = 0; k < 9; ++k)
#pragma unroll
            for (int j = 0; j < 4; ++j) { v[j].x += bflo(y[k][j].x); v[j].y += bfhi(y[k][j].x); v[j].z += bflo(y[k][j].y); v[j].w += bfhi(y[k][j].y); }
        float s = 0.f;
#pragma unroll
        for (int j = 0; j < 4; ++j) s += (v[j].x + v[j].y) + (v[j].z + v[j].w);
        const float mean = wave_sum(s) * (1.f / 1024.f);
        float q = 0.f;
#pragma unroll
        for (int j = 0; j < 4; ++j) { v[j].x -= mean; v[j].y -= mean; v[j].z -= mean; v[j].w -= mean; q += (v[j].x * v[j].x + v[j].y * v[j].y) + (v[j].z * v[j].z + v[j].w * v[j].w); }
        const float rstd = rsqrtf(wave_sum(q) * (1.f / 1024.f) + LN_EPS);
#pragma unroll
        for (int j = 0; j < 4; ++j) {
            const int cidx = lane * 4 + 256 * j;
            const float4 gg = *(const float4*)(g + cidx), be = *(const float4*)(bb + cidx);
            float4 o; o.x = v[j].x * rstd * gg.x + be.x; o.y = v[j].y * rstd * gg.y + be.y; o.z = v[j].z * rstd * gg.z + be.z; o.w = v[j].w * rstd * gg.w + be.w;
            stnt4(row + cidx, o);
        }
    }
}

struct XcdBarrier { unsigned* bar; unsigned x; volatile LAS unsigned* st; };
__device__ __forceinline__ XcdBarrier xcd_barrier_post(unsigned* bar, volatile LAS unsigned* st) {
    XcdBarrier b; b.bar = bar; b.x = xb_xcc_id(); b.st = st;
    if (threadIdx.x == 0) (void)xb_add(&bar[XB_XCNT(b.x)], 1u);
    return b;
}
__device__ __forceinline__ void xcd_barrier_complete(unsigned* bar, unsigned x, unsigned& nloc, unsigned& nx) {
    const unsigned G = gridDim.x * gridDim.y * gridDim.z;
    unsigned sum, cnt, mine, sp = 0u;
    for (;;) {
        sum = 0u; cnt = 0u; mine = 0u;
#pragma unroll
        for (unsigned j = 0; j < 16; ++j) { const unsigned c = xb_ld(&bar[XB_XCNT(j)]); sum += c; cnt += (c > 0u) ? 1u : 0u; mine = (j == x) ? c : mine; }
        if (sum == G) break;
        __builtin_amdgcn_s_sleep(1);
        if ((++sp & 255u) == 0u) { if (xb_ld(&bar[XB_TMO])) break; if (sp > XB_SPIN_CAP) { atomicAdd(&bar[XB_TMO], 1u); break; } }
    }
    nloc = mine > 0u ? mine : 1u; nx = cnt > 0u ? cnt : 1u;
}
__device__ __forceinline__ void xcd_barrier(const XcdBarrier& b, int wv) {
    asm volatile("s_waitcnt vmcnt(0)" ::: "memory");
    __syncthreads();
    if (wv == 0 && lane_id() == 0) {
        unsigned* bar = b.bar;
        __builtin_amdgcn_s_waitcnt(0);
        unsigned nloc = b.st[0], nx = b.st[1];
        if (nloc == 0u) { xcd_barrier_complete(bar, b.x, nloc, nx); b.st[0] = nloc; b.st[1] = nx; }
        const unsigned old = xb_add(&bar[XB_XSUB(b.x)], 1u);
        const unsigned gen = old / nloc;
        if (old + 1u == (gen + 1u) * nloc) {
            __builtin_amdgcn_fence(__ATOMIC_RELEASE, "agent");
            asm volatile("s_waitcnt vmcnt(0)" ::: "memory");
            const unsigned og = xb_add(&bar[XB_TOP], 1u);
            const unsigned tg = og / nx;
            if (og + 1u == (tg + 1u) * nx) xb_add(&bar[XB_TOPGEN], 1u);
            else XB_SPIN(xb_ld(&bar[XB_TOPGEN]) == tg, bar);
            __builtin_amdgcn_fence(__ATOMIC_ACQUIRE, "agent");
            xb_add(&bar[XB_XGEN(b.x)], 1u);
            asm volatile("s_waitcnt vmcnt(0)" ::: "memory");
        } else {
            XB_SPIN(xb_ld(&bar[XB_XGEN(b.x)]) == gen, bar);
            __builtin_amdgcn_fence(__ATOMIC_ACQUIRE, "agent");
            asm volatile("s_waitcnt vmcnt(0)" ::: "memory");
        }
    }
    __syncthreads();
}

__global__ void __launch_bounds__(NTHREADS) fwd_megakernel(Params p_unused) {
    extern __shared__ __attribute__((aligned(16))) char lds[];
    volatile LAS unsigned* st = (volatile LAS unsigned*)(lds + LDS_BARW);
    const int wv = __builtin_amdgcn_readfirstlane((int)(threadIdx.x >> 6));
    if (threadIdx.x == 0) { st[0] = 0u; st[1] = 0u; st[2] = 0u; st[3] = 0u; }
    __syncthreads();
    const XcdBarrier gb = xcd_barrier_post((unsigned*)(kargs()->ws + WS_BAR), st);
    phase0(*kargs(), lds, wv);
    xcd_barrier(gb, wv);
    phase1(*kargs(), lds, wv);
    xcd_barrier(gb, wv);
    phase3(*kargs(), lds, wv);
    xcd_barrier(gb, wv);
    phase4(*kargs(), lds, wv);
    xcd_barrier(gb, wv);
    phase5(*kargs(), lds, wv);
    xcd_barrier(gb, wv);
    phase7(*kargs(), lds, wv);
    xcd_barrier(gb, wv);
    phase9(*kargs(), lds, wv);
    xcd_barrier(gb, wv);
    phase_gu(*kargs(), lds, wv);
    xcd_barrier(gb, wv);
    for (int r = 0; r < NROUND; ++r) {
        phase_down(*kargs(), r, lds, wv);
        xcd_barrier(gb, wv);
        phase_combine(*kargs(), r, wv);
        if (r + 1 < NROUND) xcd_barrier(gb, wv);
    }
}

extern "C" void kernel_launch(void* const* d_in, const int* in_sizes, int n_in, void* d_out, int out_size, void* d_ws, size_t ws_size, hipStream_t stream) {
    static int grid_blocks = 0;
    if (grid_blocks == 0) {
        if (n_in != 26 || out_size != T * DM || ws_size < WS_NEED) {
            fprintf(stderr, "kernel_launch: unexpected shapes (n_in %d out %d ws %zu need %zu)\n", n_in, out_size, ws_size, (size_t)WS_NEED);
            grid_blocks = -1; return;
        }
        int dev = 0, cus = 0, per_cu = 0;
        hipGetDevice(&dev);
        hipDeviceGetAttribute(&cus, hipDeviceAttributeMultiprocessorCount, dev);
        hipFuncSetAttribute((const void*)fwd_megakernel, hipFuncAttributeMaxDynamicSharedMemorySize, LDS_BYTES);
        hipOccupancyMaxActiveBlocksPerMultiprocessor(&per_cu, (const void*)fwd_megakernel, NTHREADS, LDS_BYTES);
        if (per_cu < 1) { fprintf(stderr, "kernel_launch: occupancy query says %d blocks per CU\n", per_cu); grid_blocks = -1; return; }
        grid_blocks = cus * 1;
    }
    if (grid_blocks < 0) return;
    Params p{};
    for (int i = 0; i < 26; ++i) p.in[i] = (const float*)d_in[i];
    p.out = (float*)d_out; p.ws = (unsigned char*)d_ws;
    if (hipMemsetAsync((char*)d_ws + WS_BAR, 0, 16384, stream) != hipSuccess) { fprintf(stderr, "kernel_launch: memset of barrier words failed\n"); return; }
    void* args[] = {&p};
    hipError_t e = hipLaunchCooperativeKernel((const void*)fwd_megakernel, dim3(grid_blocks), dim3(NTHREADS), args, LDS_BYTES, stream);
    if (e != hipSuccess) fprintf(stderr, "cooperative launch failed: %s (grid %d)\n", hipGetErrorString(e), grid_blocks);
}
```

```cpp
#include <hip/hip_runtime.h>
#include <stdint.h>
#include <stdio.h>

typedef unsigned short bf16_t;
typedef short bf16x8 __attribute__((ext_vector_type(8)));
typedef float f32x4 __attribute__((ext_vector_type(4)));
__device__ __forceinline__ float4 ldnt4(const float* p) { const f32x4 v = __builtin_nontemporal_load((const f32x4*)p); return make_float4(v[0], v[1], v[2], v[3]); }
__device__ __forceinline__ void stnt4(float* p, const float4& o) { const f32x4 v = {o.x, o.y, o.z, o.w}; __builtin_nontemporal_store(v, (f32x4*)p); }
#define LAS __attribute__((address_space(3)))

constexpr int DM = 1024, NB = 16, SEQ = 2048, T = NB * SEQ;
constexpr int NPROJ = 1536;
constexpr int NMEM = 256;
constexpr int NEXP = 64, NE1 = 65;
constexpr int DEXP = 256;
constexpr int NROUND = 1, TR = T / NROUND;
constexpr int CAP = ((TR * 9 + 65 * 255 + 255) / 256) * 256;
constexpr float ALPHA = 1.189207115002721f;
constexpr float LN_EPS = 1e-5f, RMS_EPS = 1e-6f;
constexpr float IDXW_SCALE = 0.04419417382415922f;
constexpr int PC_CQ = 0, PC_CKV = 256, PC_KIDX = 384, PC_IDXW = 448, PC_GB = 512, PC_GC = 768, PC_H = 1024, PC_QM = 1280;

constexpr size_t al256(size_t x) { return (x + 255) & ~(size_t)255; }
constexpr size_t WS_W_IN_T = 0;
constexpr size_t WS_W_Q2_T = WS_W_IN_T + (size_t)1536 * 1024 * 2;
constexpr size_t WS_W_MKV_T = WS_W_Q2_T + (size_t)1536 * 256 * 2;
constexpr size_t WS_W_OUT2_T = WS_W_MKV_T + (size_t)512 * 1024 * 2;
constexpr size_t WS_W_R_T = WS_W_OUT2_T + (size_t)1024 * 1536 * 2;
constexpr size_t WS_W_EGU_T = WS_W_R_T + (size_t)128 * 3072 * 2;
constexpr size_t WS_W_ED_T = WS_W_EGU_T + (size_t)NE1 * 512 * 1024 * 2;
constexpr size_t WS_CNT = WS_W_ED_T + (size_t)NE1 * 1024 * 256 * 2;
constexpr size_t WS_CNTB = WS_CNT + 4096;
constexpr size_t WS_BAR = WS_CNTB + (size_t)256 * 64 * 4;
constexpr size_t WS_TOK_E = WS_BAR + 16384;
constexpr size_t WS_TOK_W = WS_TOK_E + (size_t)T * 8 * 4;
constexpr size_t WS_TOK_POS = WS_TOK_W + (size_t)T * 8 * 4;
constexpr size_t WS_SLOT_TOK = al256(WS_TOK_POS + (size_t)T * 9 * 4);
constexpr size_t WS_SLOT_W = WS_SLOT_TOK + (size_t)NROUND * CAP * 4;
constexpr size_t WS_X1B = al256(WS_SLOT_W + (size_t)NROUND * CAP * 4);
constexpr size_t WS_B = al256(WS_X1B + (size_t)T * 1024 * 2);
constexpr size_t WS_XB = WS_B;
constexpr size_t WS_CAT2 = WS_X1B;
constexpr size_t WS_MEMB = WS_XB + (size_t)T * 1024 * 2;
constexpr size_t WS_PROJ = WS_MEMB + (size_t)4096 * 1024 * 2;
constexpr size_t WS_KMEM = WS_PROJ + (size_t)T * NPROJ * 2;
constexpr size_t WS_VTMEM = WS_KMEM + (size_t)4096 * 256 * 2;
constexpr size_t WS_KIDX = WS_VTMEM + (size_t)256 * 4096 * 2;
constexpr size_t WS_CQN = WS_KIDX + (size_t)T * 64 * 2;
constexpr size_t WS_CKVN = WS_CQN + (size_t)T * 256 * 2;
constexpr size_t WS_Q2 = WS_CKVN + (size_t)T * 128 * 2;
constexpr size_t WS_END_EARLY = WS_Q2 + (size_t)T * 1536 * 2;
constexpr size_t WS_X1LO = WS_B;
constexpr size_t WS_LOGITS = WS_X1LO + (size_t)T * 1024 * 2;
constexpr size_t WS_X1F8 = al256(WS_CAT2 + (size_t)T * 1536 * 2);
constexpr size_t WS_X1H = WS_X1F8 + (size_t)T * 1024;
constexpr size_t WS_X1L = WS_X1H + (size_t)T * 1024 * 2;
constexpr size_t WS_LNST = WS_X1L + (size_t)T * 1024 * 2;
constexpr size_t WS_YSLOT = WS_X1B;
constexpr size_t WS_HSLOT = al256(WS_YSLOT + (size_t)(CAP > 134 * 1024 ? CAP : 134 * 1024) * 1024);
constexpr size_t WS_END_MOE = WS_HSLOT + (size_t)NROUND * CAP * 256;
static_assert(WS_X1F8 + (size_t)T * 1024 <= WS_HSLOT, "x1 fp8 must end below HSLOT");
static_assert(WS_LNST + (size_t)128 * 4 * 256 * 8 <= WS_END_EARLY, "LN statistics must fit the early region");
constexpr size_t WS_NEED = WS_END_EARLY > WS_END_MOE ? WS_END_EARLY : WS_END_MOE;

constexpr int NTHREADS = 512;
constexpr int LDS_GEMM_H = 65536;
constexpr int LDS_MISC = 139264;
constexpr int LDS_STG = 65536;
constexpr int LDS_BYTES = 155648;
constexpr int LDS_BARW = LDS_BYTES - 16;
constexpr int WAVE_LDS = 15360;

struct Params {
    const float* in[26];
    float* out;
    unsigned char* ws;
};
typedef const __attribute__((address_space(4))) Params CParams;
__device__ __forceinline__ CParams* kargs() {
    CParams* q = (CParams*)__builtin_amdgcn_kernarg_segment_ptr();
    asm volatile("" : "+s"(q));
    return q;
}

typedef __bf16 bf16x2_t __attribute__((ext_vector_type(2)));
typedef float f32x2_t __attribute__((ext_vector_type(2)));
__device__ __forceinline__ uint32_t pk2(float a, float b) {
    const f32x2_t v = {a, b};
    return __builtin_bit_cast(uint32_t, __builtin_convertvector(v, bf16x2_t));
}
__device__ __forceinline__ bf16_t f2bf(float f) { return (bf16_t)(pk2(f, 0.f) & 0xFFFFu); }
__device__ __forceinline__ float bf2f(bf16_t h) { return __uint_as_float(((uint32_t)h) << 16); }
__device__ __forceinline__ float bflo(uint32_t w) { return __uint_as_float(w << 16); }
__device__ __forceinline__ float bfhi(uint32_t w) { return __uint_as_float(w & 0xFFFF0000u); }
__device__ __forceinline__ int lane_id() { return (int)__builtin_amdgcn_mbcnt_hi(~0u, __builtin_amdgcn_mbcnt_lo(~0u, 0u)); }
__device__ __forceinline__ int opaque_tid(int wv) { int t = wv * 64 + lane_id(); asm volatile("" : "+v"(t)); return t; }
__device__ __forceinline__ int opaque_i(int t) { asm volatile("" : "+v"(t)); return t; }
__device__ __forceinline__ size_t km_off(int row, int k, int nrows) { return ((size_t)(k >> 5) * nrows + row) * 32 + (k & 31); }
__device__ __forceinline__ void wave_sync() {
    __builtin_amdgcn_fence(__ATOMIC_RELEASE, "wavefront");
    __builtin_amdgcn_wave_barrier();
    __builtin_amdgcn_fence(__ATOMIC_ACQUIRE, "wavefront");
}
template <int CTRL> __device__ __forceinline__ float dpp_f(float x) {
    return __builtin_bit_cast(float, __builtin_amdgcn_mov_dpp(__builtin_bit_cast(int, x), CTRL, 0xf, 0xf, true));
}
__device__ __forceinline__ float fmax_nc(float a, float b) { return __builtin_amdgcn_fmed3f(a, b, 3.0e38f); }
__device__ __forceinline__ float xrow16_max(float x) {
    auto s = __builtin_amdgcn_permlane16_swap(__float_as_uint(x), __float_as_uint(x), false, false);
    x = fmax_nc(__uint_as_float(s[0]), __uint_as_float(s[1]));
    auto t = __builtin_amdgcn_permlane32_swap(__float_as_uint(x), __float_as_uint(x), false, false);
    return fmax_nc(__uint_as_float(t[0]), __uint_as_float(t[1]));
}
__device__ __forceinline__ float xrow16_sum(float x) {
    auto s = __builtin_amdgcn_permlane16_swap(__float_as_uint(x), __float_as_uint(x), false, false);
    x = __uint_as_float(s[0]) + __uint_as_float(s[1]);
    auto t = __builtin_amdgcn_permlane32_swap(__float_as_uint(x), __float_as_uint(x), false, false);
    return __uint_as_float(t[0]) + __uint_as_float(t[1]);
}
__device__ __forceinline__ float wave_sum(float v) {
    v += dpp_f<0xB1>(v); v += dpp_f<0x4E>(v); v += dpp_f<0x141>(v); v += dpp_f<0x128>(v);
    return xrow16_sum(v);
}
__device__ __forceinline__ float wave_max(float v) {
    v = fmax_nc(v, dpp_f<0xB1>(v)); v = fmax_nc(v, dpp_f<0x4E>(v)); v = fmax_nc(v, dpp_f<0x141>(v)); v = fmax_nc(v, dpp_f<0x128>(v));
    return xrow16_max(v);
}
typedef short s16x4_t __attribute__((ext_vector_type(4)));
__device__ __forceinline__ void lds_st8(char* p, const uint2& o) { union { uint2 u; s16x4_t s; } c; c.u = o; *(s16x4_t*)p = c.s; }
__device__ __forceinline__ uint4 lds_ld16(const char* p) { union { bf16x8 s; uint4 u; } c; c.s = *(const bf16x8*)p; return c.u; }
__device__ __forceinline__ uint32_t pk4_f8(float a, float b, float c, float d) {
    int p = __builtin_amdgcn_cvt_pk_fp8_f32(a, b, 0, false);
    p = __builtin_amdgcn_cvt_pk_fp8_f32(c, d, p, true);
    return (uint32_t)p;
}
__device__ __forceinline__ void unpack8(const uint4& v, float* f) {
    f[0] = bflo(v.x); f[1] = bfhi(v.x); f[2] = bflo(v.y); f[3] = bfhi(v.y);
    f[4] = bflo(v.z); f[5] = bfhi(v.z); f[6] = bflo(v.w); f[7] = bfhi(v.w);
}

template <int AMODE>
__device__ __forceinline__ void gemm_loop(f32x4 (&acc)[4][2], const bf16_t* a0, const bf16_t* a1, const bf16_t* a0b, const bf16_t* a1b,
                                          const bf16_t* b0, const bf16_t* b1, int nk, char* lds, const char* ldsH,
                                          int tid, int lane, int wm, int wn) {
    const int fr = lane & 15, fq = lane >> 4;
    const int r0 = tid >> 3, c = tid & 7;
    const int wo = r0 * 128 + ((c ^ ((r0 >> 1) & 7)) << 4);
    uint4 ra0, ra1, rb0, rb1;
    ra0 = ra1 = make_uint4(0, 0, 0, 0);
    if (AMODE != 1) { ra0 = *(const uint4*)a0; ra1 = *(const uint4*)a1; }
    rb0 = *(const uint4*)b0; rb1 = *(const uint4*)b1;
    __syncthreads();
    if (AMODE != 1) { *(uint4*)(lds + wo) = ra0; *(uint4*)(lds + wo + 8192) = ra1; }
    *(uint4*)(lds + 32768 + wo) = rb0; *(uint4*)(lds + 32768 + wo + 8192) = rb1;
    __syncthreads();
    const int swz = (fr >> 1) & 7;
    const int aoff = (wm * 64 + fr) * 128, boff = 32768 + (wn * 32 + fr) * 128;
    for (int kt = 0; kt < nk; ++kt) {
        const int cur = kt & 1;
        if (kt + 1 < nk) {
            const int k1 = kt + 1;
            if (AMODE == 0) { ra0 = *(const uint4*)(a0 + k1 * 64); ra1 = *(const uint4*)(a1 + k1 * 64); }
            if (AMODE == 2) {
                const int seg = k1 >> 4, ko = (k1 & 15) * 64;
                const bf16_t* p0 = (seg == 1) ? a0b : a0; const bf16_t* p1 = (seg == 1) ? a1b : a1;
                ra0 = *(const uint4*)(p0 + ko); ra1 = *(const uint4*)(p1 + ko);
            }
            rb0 = *(const uint4*)(b0 + k1 * 64); rb1 = *(const uint4*)(b1 + k1 * 64);
        }
        const char* pa = (AMODE == 1) ? (ldsH + kt * 16384 + aoff) : (lds + cur * 16384 + aoff);
        const char* pb = lds + cur * 16384 + boff;
#pragma unroll
        for (int kk = 0; kk < 2; ++kk) {
            const int ch = ((kk * 4 + fq) ^ swz) << 4;
            bf16x8 af[4], bfv[2];
#pragma unroll
            for (int mi = 0; mi < 4; ++mi) af[mi] = *(const bf16x8*)(pa + mi * 2048 + ch);
#pragma unroll
            for (int ni = 0; ni < 2; ++ni) bfv[ni] = *(const bf16x8*)(pb + ni * 2048 + ch);
#pragma unroll
            for (int mi = 0; mi < 4; ++mi)
#pragma unroll
                for (int ni = 0; ni < 2; ++ni)
                    acc[mi][ni] = __builtin_amdgcn_mfma_f32_16x16x32_bf16(bfv[ni], af[mi], acc[mi][ni], 0, 0, 0);
        }
        if (kt + 1 < nk) {
            const int nxt = cur ^ 1;
            if (AMODE != 1) { *(uint4*)(lds + nxt * 16384 + wo) = ra0; *(uint4*)(lds + nxt * 16384 + wo + 8192) = ra1; }
            *(uint4*)(lds + 32768 + nxt * 16384 + wo) = rb0; *(uint4*)(lds + 32768 + nxt * 16384 + wo + 8192) = rb1;
        }
        __syncthreads();
    }
}
template <int NK, bool ROUTER>
__device__ __forceinline__ void pf_kloop(f32x4 (&acc)[4][2], const bf16_t* a0, const bf16_t* a1, const bf16_t* a0b, const bf16_t* a1b,
                                             const bf16_t* b0, const bf16_t* b1, char* lds, int tid, int lane, int wm, int wn) {
    static_assert(NK % 4 == 0, "unrolled by 4");
    const int fr = lane & 15, fq = lane >> 4;
    const int r0 = tid >> 3, c = tid & 7;
    const int wo = r0 * 128 + ((c ^ ((r0 >> 1) & 7)) << 4);
    uint4 ra0_0, ra1_0, rb0_0, rb1_0, ra0_1, ra1_1, rb0_1, rb1_1, ra0_2, ra1_2, rb0_2, rb1_2, ra0_3, ra1_3, rb0_3, rb1_3;
#define RT_LOAD(s, k) do { const int k_ = (k); const int seg_ = ROUTER ? (k_ >> 4) : 0, ko_ = ROUTER ? (k_ & 15) * 64 : k_ * 64; const bf16_t* p0_ = (seg_ == 1) ? a0b : a0; const bf16_t* p1_ = (seg_ == 1) ? a1b : a1; \
        ra0_##s = *(const uint4*)(p0_ + ko_); ra1_##s = *(const uint4*)(p1_ + ko_); rb0_##s = *(const uint4*)(b0 + k_ * 64); rb1_##s = *(const uint4*)(b1 + k_ * 64); } while (0)
#define RT_STORE(s, buf) do { *(uint4*)(lds + (buf) * 16384 + wo) = ra0_##s; *(uint4*)(lds + (buf) * 16384 + wo + 8192) = ra1_##s; \
        *(uint4*)(lds + 32768 + (buf) * 16384 + wo) = rb0_##s; *(uint4*)(lds + 32768 + (buf) * 16384 + wo + 8192) = rb1_##s; } while (0)
#define RT_BAR() do { asm volatile("s_waitcnt lgkmcnt(0)" ::: "memory"); __builtin_amdgcn_s_barrier(); asm volatile("" ::: "memory"); } while (0)
    RT_LOAD(0, 0); RT_LOAD(1, 1); RT_LOAD(2, 2); RT_LOAD(3, 3);
    __syncthreads();
    RT_STORE(0, 0);
    RT_BAR();
    const int swz = (fr >> 1) & 7;
    const int aoff = (wm * 64 + fr) * 128, boff = 32768 + (wn * 32 + fr) * 128;
#define RT_STEP(j, jn) do { const int k = kt + (j); \
        RT_LOAD(j, (k + 4 < NK) ? k + 4 : NK - 1);     \
        const char* pa = lds + ((j) & 1) * 16384 + aoff; const char* pb = lds + ((j) & 1) * 16384 + boff; \
        _Pragma("unroll") for (int kk = 0; kk < 2; ++kk) { \
            const int ch = ((kk * 4 + fq) ^ swz) << 4; \
            bf16x8 af[4], bfv[2]; \
            _Pragma("unroll") for (int mi = 0; mi < 4; ++mi) af[mi] = *(const bf16x8*)(pa + mi * 2048 + ch); \
            _Pragma("unroll") for (int ni = 0; ni < 2; ++ni) bfv[ni] = *(const bf16x8*)(pb + ni * 2048 + ch); \
            _Pragma("unroll") for (int mi = 0; mi < 4; ++mi) _Pragma("unroll") for (int ni = 0; ni < 2; ++ni) \
                acc[mi][ni] = __builtin_amdgcn_mfma_f32_16x16x32_bf16(bfv[ni], af[mi], acc[mi][ni], 0, 0, 0); } \
        RT_STORE(jn, ((j) + 1) & 1); \
        RT_BAR(); } while (0)
    for (int kt = 0; kt < NK; kt += 4) {
        RT_STEP(0, 1); RT_STEP(1, 2); RT_STEP(2, 3); RT_STEP(3, 0);
    }
#undef RT_STEP
#undef RT_BAR
#undef RT_LOAD
#undef RT_STORE
}
__device__ __forceinline__ void acc_zero(f32x4 (&acc)[4][2]) {
#pragma unroll
    for (int mi = 0; mi < 4; ++mi)
#pragma unroll
        for (int ni = 0; ni < 2; ++ni) acc[mi][ni] = (f32x4){0.f, 0.f, 0.f, 0.f};
}
template <int OMODE>
__device__ __forceinline__ void gemm_item_bf16(const bf16_t* A, int lda, const bf16_t* Bt, int ldb, int nk, bf16_t* C, int ldc, int m0, int n0,
                                               char* lds, int tid, int lane, int wm, int wn) {
    const int r0 = tid >> 3, c = tid & 7;
    f32x4 acc[4][2]; acc_zero(acc);
    const bf16_t* a0 = A + (size_t)(m0 + r0) * lda + c * 8; const bf16_t* a1 = a0 + (size_t)64 * lda;
    const bf16_t* b0 = Bt + (size_t)(n0 + r0) * ldb + c * 8; const bf16_t* b1 = b0 + (size_t)64 * ldb;
    pf_kloop<16, false>(acc, a0, a1, a0, a1, b0, b1, lds, tid, lane, wm, wn);
    const int fr = lane & 15, fq = lane >> 4;
#pragma unroll
    for (int mi = 0; mi < 4; ++mi)
#pragma unroll
        for (int ni = 0; ni < 2; ++ni) {
            const int m = m0 + wm * 64 + mi * 16 + fr, n = n0 + wn * 32 + ni * 16 + 4 * fq;
            uint2 o; o.x = pk2(acc[mi][ni][0], acc[mi][ni][1]); o.y = pk2(acc[mi][ni][2], acc[mi][ni][3]);
            size_t off;
            if (OMODE == 0) off = (size_t)m * ldc + n;
            else if (OMODE == 1) {
                const int b = m >> 8, key = m & 255, h = n >> 6, d = n & 63;
                off = ((size_t)((((b * 4 + h) * 16 + (key >> 4)) * 2 + (d >> 5)) * 64 + ((d & 31) >> 3) * 16 + (key & 15))) * 8 + (d & 7);
            } else {
                const int h = m >> 6, d = m & 63, b = n >> 8, key = n & 255, k32 = key & 31;
                off = ((size_t)((((b * 4 + h) * 8 + (key >> 5)) * 4 + (d >> 4)) * 64 + ((k32 & 15) >> 2) * 16 + (d & 15))) * 8 + ((k32 >> 4) * 4);
            }
            *(uint2*)(C + off) = o;
        }
}

namespace g8 {
constexpr int HTB = 8192;
__device__ __forceinline__ int lds_byte(int r, int c) { const int ob = (r & 15) * 64 + c * 2; return (r >> 4) * 1024 + (ob ^ (((ob >> 9) & 1) << 5)); }
__device__ __forceinline__ void stage_rc(int b, int& R, int& C) { const int st = b / 1024, sb = b % 1024, swz = sb ^ (((sb >> 9) & 1) << 5); R = st * 16 + swz / 64; C = (swz % 64) / 2; }
struct Src { __amdgpu_buffer_rsrc_t ra, rb; unsigned ao[2]; unsigned bo; unsigned bh; unsigned akt, bkt; };
__device__ __forceinline__ __amdgpu_buffer_rsrc_t make_rsrc(const void* p) {
    const unsigned long long a = (unsigned long long)p;
    const unsigned lo = __builtin_amdgcn_readfirstlane((unsigned)a), hi = __builtin_amdgcn_readfirstlane((unsigned)(a >> 32));
    return __builtin_amdgcn_make_buffer_rsrc((void*)(((unsigned long long)hi << 32) | lo), 0, 0x7FFFFFFF, 0x00020000);
}
#define G8_SA(b,h) (lds + ((b) * 2 + (h)) * g8::HTB)
#define G8_SB(b,h) (lds + (4 + (b) * 2 + (h)) * g8::HTB)
#define G8_KOFF(kt, ktstride, segstride) ((((kt) & sg.mask) * (ktstride)) + (((kt) >> sg.lg) * (segstride)))
#define G8_STAGE_A(b,h,kt) __builtin_amdgcn_raw_ptr_buffer_load_lds(s.ra, (LAS void*)(G8_SA(b,h) + wv * 1024), 16, s.ao[h], G8_KOFF(kt, s.akt, sg.aseg), 0, AAUX)
#define G8_STAGE_B(b,h,kt) __builtin_amdgcn_raw_ptr_buffer_load_lds(s.rb, (LAS void*)(G8_SB(b,h) + wv * 1024), 16, s.bo, G8_KOFF(kt, s.bkt, sg.bseg) + (h) * s.bh, 0, 0)
#define G8_LDA(dst,b,h) do { _Pragma("unroll") for (int m = 0; m < 4; ++m) \
    dst[m] = *(const bf16x8*)(G8_SA(b,h) + g8::lds_byte(wr * 64 + m * 16 + fr, fq * 8)); } while (0)
#define G8_LDB(dst,b,h) do { _Pragma("unroll") for (int n = 0; n < 2; ++n) \
    dst[n] = *(const bf16x8*)(G8_SB(b,h) + g8::lds_byte(wc * 32 + n * 16 + fr, fq * 8)); } while (0)
#define G8_MMA(ai,bj,At,Bt) do { __builtin_amdgcn_s_setprio(1); \
    _Pragma("unroll") for (int m = 0; m < 4; ++m) _Pragma("unroll") for (int n = 0; n < 2; ++n) \
      acc[ai][bj][m][n] = __builtin_amdgcn_mfma_f32_16x16x32_bf16(Bt[n], At[m], acc[ai][bj][m][n], 0, 0, 0); \
    __builtin_amdgcn_s_setprio(0); } while (0)
#define G8_WAIT_V(n) asm volatile("s_waitcnt vmcnt(" #n ")" ::: "memory")
#define G8_WAIT_L(n) asm volatile("s_waitcnt lgkmcnt(" #n ")" ::: "memory")
#define G8_BAR __builtin_amdgcn_s_barrier()
#define G8_SCHED __builtin_amdgcn_sched_barrier(0)

__device__ __forceinline__ void zero_acc(f32x4 (&acc)[2][2][4][2]) {
#pragma unroll
    for (int a = 0; a < 2; ++a)
#pragma unroll
        for (int b = 0; b < 2; ++b)
#pragma unroll
            for (int m = 0; m < 4; ++m)
#pragma unroll
                for (int n = 0; n < 2; ++n) acc[a][b][m][n] = (f32x4){0.f, 0.f, 0.f, 0.f};
}
struct Seg { int mask, lg; unsigned aseg, bseg; };
__device__ __forceinline__ Seg one_seg() { Seg g; g.mask = 0x7FFFFFFF; g.lg = 30; g.aseg = 0u; g.bseg = 0u; return g; }
struct NoFlush { __device__ __forceinline__ void operator()(f32x4 (&)[2][2][4][2], int) const {} };
template <int AAUX = 0>
__device__ __forceinline__ void kloop_issue(const Src& s, char* lds, int wv, const Seg sg = one_seg()) {
    G8_STAGE_B(0, 0, 0); G8_STAGE_A(0, 0, 0);
    G8_STAGE_B(0, 1, 0); G8_STAGE_A(0, 1, 0);
}
template <class Flush, int AAUX = 0>
__device__ __forceinline__ void kloop_ms(f32x4 (&acc)[2][2][4][2], const Src& s, int nt, char* lds, int tid, int wv, const Seg sg, const Flush& flush) {
    const int lane = tid & 63, wr = wv >> 2, wc = wv & 3, fr = lane & 15, fq = lane >> 4;
    bf16x8 At[4], B0[2], B1[2];
    if (wr == 1) G8_BAR;
    G8_WAIT_V(0); G8_BAR;
    G8_STAGE_B(1, 0, 1); G8_STAGE_A(1, 0, 1); G8_STAGE_B(1, 1, 1);
    G8_WAIT_V(3); G8_BAR;
    bool drain = false;
    for (int t = 0; t < nt - 2; t += 2) {
        G8_LDB(B0, 0, 0); G8_SCHED; G8_LDA(At, 0, 0); G8_STAGE_A(1, 1, t + 1);
        G8_WAIT_L(4); G8_BAR; G8_WAIT_L(0); G8_MMA(0, 0, At, B0); G8_BAR; G8_SCHED;
        G8_LDB(B1, 0, 1); G8_STAGE_B(0, 0, t + 2);
        G8_BAR; G8_WAIT_L(0); G8_MMA(0, 1, At, B1); G8_BAR;
        G8_LDA(At, 0, 1); G8_STAGE_A(0, 0, t + 2);
        G8_BAR; G8_WAIT_L(0); G8_MMA(1, 0, At, B0); G8_BAR; G8_SCHED;
        G8_STAGE_B(0, 1, t + 2);
        if (drain) { G8_WAIT_V(0); drain = false; } else { G8_WAIT_V(3); }
        G8_BAR; G8_MMA(1, 1, At, B1); G8_BAR;
        G8_LDB(B0, 1, 0); G8_SCHED; G8_LDA(At, 1, 0); G8_STAGE_A(0, 1, t + 2);
        G8_WAIT_L(4); G8_BAR; G8_WAIT_L(0); G8_MMA(0, 0, At, B0); G8_BAR; G8_SCHED;
        G8_LDB(B1, 1, 1); G8_STAGE_B(1, 0, t + 3);
        G8_BAR; G8_WAIT_L(0); G8_MMA(0, 1, At, B1); G8_BAR;
        G8_LDA(At, 1, 1); G8_STAGE_A(1, 0, t + 3);
        G8_BAR; G8_WAIT_L(0); G8_MMA(1, 0, At, B0); G8_BAR; G8_SCHED;
        G8_STAGE_B(1, 1, t + 3);
        G8_WAIT_V(3); G8_BAR; G8_MMA(1, 1, At, B1); G8_BAR;
        if (((t + 2) & sg.mask) == 0) {
            flush(acc, ((t + 2) >> sg.lg) - 1);
            zero_acc(acc);
            drain = true;
        }
    }
    { G8_LDB(B0, 0, 0); G8_LDA(At, 0, 0); G8_STAGE_A(1, 1, nt - 1);
      G8_BAR; G8_WAIT_L(0); G8_MMA(0, 0, At, B0); G8_BAR;
      G8_LDB(B1, 0, 1); G8_BAR; G8_WAIT_L(0); G8_MMA(0, 1, At, B1); G8_BAR;
      G8_LDA(At, 0, 1); G8_WAIT_V(2); G8_BAR; G8_WAIT_L(0); G8_MMA(1, 0, At, B0); G8_MMA(1, 1, At, B1); G8_BAR; }
    { G8_LDB(B0, 1, 0); G8_LDA(At, 1, 0); G8_WAIT_V(1); G8_BAR; G8_WAIT_L(0); G8_MMA(0, 0, At, B0); G8_BAR;
      G8_LDB(B1, 1, 1); G8_WAIT_V(0); G8_BAR; G8_WAIT_L(0); G8_MMA(0, 1, At, B1); G8_BAR;
      G8_LDA(At, 1, 1); G8_BAR; G8_WAIT_L(0); G8_MMA(1, 0, At, B0); G8_MMA(1, 1, At, B1); G8_BAR; }
    if (wr == 0) G8_BAR;
}
typedef int v8i __attribute__((ext_vector_type(8)));
typedef float f32x16 __attribute__((ext_vector_type(16)));
typedef short s16x16 __attribute__((ext_vector_type(16)));
#define F8_LDFRAG(dst, base) do { const bf16x8 lo_ = *(const bf16x8*)(base), hi_ = *(const bf16x8*)((base) + 512); \
    dst = __builtin_bit_cast(v8i, __builtin_shufflevector(lo_, hi_, 0, 1, 2, 3, 4, 5, 6, 7, 8, 9, 10, 11, 12, 13, 14, 15)); } while (0)
#define F8_LDA(dst,b,h) do { _Pragma("unroll") for (int m = 0; m < 2; ++m) F8_LDFRAG(dst[m], G8_SA(b,h) + (wr * 2 + m) * 2048 + foff); } while (0)
#define F8_LDB(dst,b,h) do { F8_LDFRAG(dst, G8_SB(b,h) + wc * 2048 + foff); } while (0)
#define F8_MMA(ai,bj,At,Bt) do { __builtin_amdgcn_s_setprio(1); \
    _Pragma("unroll") for (int m = 0; m < 2; ++m) \
      acc[ai][bj][m] = __builtin_amdgcn_mfma_scale_f32_32x32x64_f8f6f4(Bt, At[m], acc[ai][bj][m], 0, 0, 0, 0x7F7F7F7F, 0, 0x7F7F7F7F); \
    __builtin_amdgcn_s_setprio(0); } while (0)
__device__ __forceinline__ void acc_zero_f8(f32x16 (&acc)[2][2][2]) {
#pragma unroll
    for (int a = 0; a < 2; ++a)
#pragma unroll
        for (int b = 0; b < 2; ++b)
#pragma unroll
            for (int m = 0; m < 2; ++m)
#pragma unroll
                for (int i = 0; i < 16; ++i) acc[a][b][m][i] = 0.f;
}
struct NoFlush8 { __device__ __forceinline__ void operator()(f32x16 (&)[2][2][2], int) const {} };
template <class Flush>
__device__ __forceinline__ void kloop_f8_ms(f32x16 (&acc)[2][2][2], const Src& s, int nt, char* lds, int tid, int wv, const Seg sg, const Flush& flush) {
    constexpr int AAUX = 0;
    const int lane = tid & 63, wr = wv >> 2, wc = wv & 3;
    const int foff = (lane >> 5) * 1024 + (lane & 31) * 16;
    v8i At[2], B0, B1;
    if (wr == 1) G8_BAR;
    G8_WAIT_V(0); G8_BAR;
    G8_STAGE_B(1, 0, 1); G8_STAGE_A(1, 0, 1); G8_STAGE_B(1, 1, 1);
    G8_WAIT_V(3); G8_BAR;
    bool drain = false;
    for (int t = 0; t < nt - 2; t += 2) {
        F8_LDB(B0, 0, 0); G8_SCHED; F8_LDA(At, 0, 0); G8_STAGE_A(1, 1, t + 1);
        G8_WAIT_L(4); G8_BAR; G8_WAIT_L(0); F8_MMA(0, 0, At, B0); G8_BAR; G8_SCHED;
        F8_LDB(B1, 0, 1); G8_STAGE_B(0, 0, t + 2);
        G8_BAR; G8_WAIT_L(0); F8_MMA(0, 1, At, B1); G8_BAR;
        F8_LDA(At, 0, 1); G8_STAGE_A(0, 0, t + 2);
        G8_BAR; G8_WAIT_L(0); F8_MMA(1, 0, At, B0); G8_BAR; G8_SCHED;
        G8_STAGE_B(0, 1, t + 2);
        if (drain) { G8_WAIT_V(0); drain = false; } else { G8_WAIT_V(3); }
        G8_BAR; F8_MMA(1, 1, At, B1); G8_BAR;
        F8_LDB(B0, 1, 0); G8_SCHED; F8_LDA(At, 1, 0); G8_STAGE_A(0, 1, t + 2);
        G8_WAIT_L(4); G8_BAR; G8_WAIT_L(0); F8_MMA(0, 0, At, B0); G8_BAR; G8_SCHED;
        F8_LDB(B1, 1, 1); G8_STAGE_B(1, 0, t + 3);
        G8_BAR; G8_WAIT_L(0); F8_MMA(0, 1, At, B1); G8_BAR;
        F8_LDA(At, 1, 1); G8_STAGE_A(1, 0, t + 3);
        G8_BAR; G8_WAIT_L(0); F8_MMA(1, 0, At, B0); G8_BAR; G8_SCHED;
        G8_STAGE_B(1, 1, t + 3);
        G8_WAIT_V(3); G8_BAR; F8_MMA(1, 1, At, B1); G8_BAR;
        if (((t + 2) & sg.mask) == 0) {
            flush(acc, ((t + 2) >> sg.lg) - 1);
            acc_zero_f8(acc);
            drain = true;
        }
    }
    { F8_LDB(B0, 0, 0); F8_LDA(At, 0, 0); G8_STAGE_A(1, 1, nt - 1);
      G8_BAR; G8_WAIT_L(0); F8_MMA(0, 0, At, B0); G8_BAR;
      F8_LDB(B1, 0, 1); G8_BAR; G8_WAIT_L(0); F8_MMA(0, 1, At, B1); G8_BAR;
      F8_LDA(At, 0, 1); G8_WAIT_V(2); G8_BAR; G8_WAIT_L(0); F8_MMA(1, 0, At, B0); F8_MMA(1, 1, At, B1); G8_BAR; }
    { F8_LDB(B0, 1, 0); F8_LDA(At, 1, 0); G8_WAIT_V(1); G8_BAR; G8_WAIT_L(0); F8_MMA(0, 0, At, B0); G8_BAR;
      F8_LDB(B1, 1, 1); G8_WAIT_V(0); G8_BAR; G8_WAIT_L(0); F8_MMA(0, 1, At, B1); G8_BAR;
      F8_LDA(At, 1, 1); G8_BAR; G8_WAIT_L(0); F8_MMA(1, 0, At, B0); F8_MMA(1, 1, At, B1); G8_BAR; }
    if (wr == 0) G8_BAR;
}
__device__ __forceinline__ void kloop_f8(f32x16 (&acc)[2][2][2], const Src& s, int nt, char* lds, int tid, int wv) {
    kloop_f8_ms<NoFlush8>(acc, s, nt, lds, tid, wv, one_seg(), NoFlush8());
}
template <int AAUX = 0>
__device__ __forceinline__ void kloop(f32x4 (&acc)[2][2][4][2], const Src& s, int nt, char* lds, int tid, int wv) {
    kloop_ms<NoFlush, AAUX>(acc, s, nt, lds, tid, wv, one_seg(), NoFlush());
}
__device__ __forceinline__ void acc_zero(f32x4 (&acc)[2][2][4][2]) {
#pragma unroll
    for (int a = 0; a < 2; ++a)
#pragma unroll
        for (int b = 0; b < 2; ++b)
#pragma unroll
            for (int m = 0; m < 4; ++m)
#pragma unroll
                for (int n = 0; n < 2; ++n) acc[a][b][m][n] = (f32x4){0.f, 0.f, 0.f, 0.f};
}
__device__ __forceinline__ void dense_src(Src& s, const bf16_t* A, int lda, int brow, const bf16_t* B, int ldb, int bcol, int tid) {
    s.ra = make_rsrc(A); s.rb = make_rsrc(B); s.bh = (unsigned)(128 * ldb * 2); s.akt = 64u; s.bkt = 64u;
    int R, C; stage_rc(tid * 16, R, C);
    s.bo = (unsigned)((bcol + R) * ldb + C) * 2u;
#pragma unroll
    for (int h = 0; h < 2; ++h) s.ao[h] = (unsigned)((brow + h * 128 + R) * lda + C) * 2u;
}
__device__ __forceinline__ void km_src(Src& s, const bf16_t* A, int anrows, int brow, const bf16_t* B, int bnrows, int bcol, int tid) {
    s.ra = make_rsrc(A); s.rb = make_rsrc(B); s.bh = 128u * 64u; s.akt = (unsigned)anrows * 64u; s.bkt = (unsigned)bnrows * 64u;
    int R, C; stage_rc(tid * 16, R, C);
    s.bo = (unsigned)((bcol + R) * 32 + C) * 2u;
#pragma unroll
    for (int h = 0; h < 2; ++h) s.ao[h] = (unsigned)((brow + h * 128 + R) * 32 + C) * 2u;
}
}

__device__ __forceinline__ void tconv_tile(const float* src, const float* src2, int ld_src, bf16_t* dst, int ld_dst, int k0, int n0, int mode, float* tl, int tid, int kmrows = 0, int kmrow0 = 0, int kmk0 = 0) {
    __syncthreads();
    {
        const int nn = tid & 63, kb = tid >> 6;
        const int np = n0 + nn;
        const float* s = src; int sc = np;
        if (mode == 1) sc = (np < 456) ? np : (np < 512 ? -1 : np - 56);
        if (mode == 2) { s = ((np >> 4) & 1) ? src2 : src; sc = 16 * (np >> 5) + (np & 15); }
#pragma unroll
        for (int i = 0; i < 8; ++i) {
            const int kk = kb + i * 8;
            tl[kk * 65 + nn] = (sc >= 0) ? s[(size_t)(k0 + kk) * ld_src + sc] : 0.f;
        }
    }
    __syncthreads();
    {
        const int n2 = tid >> 3, kc = tid & 7;
        const float* s = tl + (kc * 8) * 65 + n2;
        uint4 o; o.x = pk2(s[0], s[65]); o.y = pk2(s[130], s[195]); o.z = pk2(s[260], s[325]); o.w = pk2(s[390], s[455]);
        if (kmrows) *(uint4*)(dst + km_off(kmrow0 + n0 + n2, kmk0 + k0 + kc * 8, kmrows)) = o;
        else *(uint4*)(dst + (size_t)(n0 + n2) * ld_dst + k0 + kc * 8) = o;
    }
}

__device__ __forceinline__ void tconv_wave(const float* src, const float* src2, int ld_src, bf16_t* dst, int kmrows, int k0, int n0, int mode, float* scr, int lane) {
    const int nn = lane & 31, np = n0 + nn, par = lane >> 5;
    const float* s = src; int sc = np;
    if (mode == 2) { s = ((np >> 4) & 1) ? src2 : src; sc = 16 * (np >> 5) + (np & 15); }
    float v[32];
#pragma unroll
    for (int i = 0; i < 32; ++i) v[i] = __builtin_nontemporal_load(s + (size_t)(k0 + 2 * i + par) * ld_src + sc);
    wave_sync();
#pragma unroll
    for (int i = 0; i < 32; ++i) scr[(2 * i + par) * 33 + nn] = v[i];
    wave_sync();
    const int c = lane & 7;
#pragma unroll
    for (int j = 0; j < 4; ++j) {
        const int n = (lane >> 3) + 8 * j;
        const float* sp = scr + (8 * c) * 33 + n;
        uint4 o; o.x = pk2(sp[0], sp[33]); o.y = pk2(sp[66], sp[99]); o.z = pk2(sp[132], sp[165]); o.w = pk2(sp[198], sp[231]);
        { typedef unsigned u32x4_t __attribute__((ext_vector_type(4))); const u32x4_t ov = {o.x, o.y, o.z, o.w};
          __builtin_nontemporal_store(ov, (u32x4_t*)(dst + km_off(n0 + n, k0 + 8 * c, kmrows))); }
    }
}

constexpr int EW_GU = 16 * 16, EW_DN = 4 * 32, EW_EX = EW_GU + EW_DN, EW_ITEMS = NE1 * EW_EX;
constexpr float W8_SCALE = 32.f;
template <bool GU>
__device__ __forceinline__ void tconv_wave_f8(const float* src, const float* src2, unsigned char* dst8, int k0, int n0, float* scr, int lane) {
    constexpr int LD = GU ? 256 : 1024, NGRP = GU ? 16 : 32;
    const int nn = lane & 31, np = n0 + nn, par = lane >> 5;
    const float* s = (GU && ((np >> 3) & 1)) ? src2 : src; const int sc = GU ? 8 * (np >> 4) + (np & 7) : np;
    float v[32];
#pragma unroll
    for (int i = 0; i < 32; ++i) v[i] = __builtin_nontemporal_load(s + (size_t)(k0 + 2 * i + par) * LD + sc);
    wave_sync();
#pragma unroll
    for (int i = 0; i < 32; ++i) scr[(2 * i + par) * 33 + nn] = v[i];
    wave_sync();
    unsigned char* gb = dst8 + ((size_t)((k0 >> 6) * NGRP + (n0 >> 5)) * 4) * 512;
#pragma unroll
    for (int cc = 0; cc < 2; ++cc) {
        const int c = par * 2 + cc;
        const float* sp = scr + (c * 16) * 33 + nn;
        uint4 o;
        o.x = pk4_f8(sp[0] * W8_SCALE, sp[33] * W8_SCALE, sp[66] * W8_SCALE, sp[99] * W8_SCALE);
        o.y = pk4_f8(sp[132] * W8_SCALE, sp[165] * W8_SCALE, sp[198] * W8_SCALE, sp[231] * W8_SCALE);
        o.z = pk4_f8(sp[264] * W8_SCALE, sp[297] * W8_SCALE, sp[330] * W8_SCALE, sp[363] * W8_SCALE);
        o.w = pk4_f8(sp[396] * W8_SCALE, sp[429] * W8_SCALE, sp[462] * W8_SCALE, sp[495] * W8_SCALE);
        { typedef unsigned u32x4_t __attribute__((ext_vector_type(4))); const u32x4_t ov = {o.x, o.y, o.z, o.w};
          __builtin_nontemporal_store(ov, (u32x4_t*)(gb + c * 512 + nn * 16)); }
    }
}
__device__ __forceinline__ void expert_w_item(CParams& p, int it, float* scr, int lane) {
    unsigned char* ws = p.ws;
    const int e = it / EW_EX; int r = it - e * EW_EX;
    const float* wg = (e < NEXP) ? p.in[18] + (size_t)e * 1024 * 256 : p.in[21];
    const float* wu = (e < NEXP) ? p.in[19] + (size_t)e * 1024 * 256 : p.in[22];
    const float* wd = (e < NEXP) ? p.in[20] + (size_t)e * 256 * 1024 : p.in[23];
    if (r < EW_GU) tconv_wave_f8<true>(wg, wu, ws + WS_W_EGU_T + (size_t)e * 524288, (r & 15) * 64, (r >> 4) * 32, scr, lane);
    else { r -= EW_GU; tconv_wave_f8<false>(wd, nullptr, ws + WS_W_ED_T + (size_t)e * 262144, (r & 3) * 64, (r >> 2) * 32, scr, lane); }
}

__device__ __forceinline__ void phase0(CParams& p, char* lds, int wv) {
    const int tid = opaque_tid(wv), G = gridDim.x, bid = blockIdx.x;
    unsigned char* ws = p.ws;
    float* tl = (float*)lds;
    if (bid == 0) { int* cnt = (int*)(ws + WS_CNT); for (int i = tid; i < 1024; i += NTHREADS) cnt[i] = 0; }
    {
        const int lane = tid & 63, wid = tid >> 6;
        const float* x = p.in[0]; bf16_t* xb = (bf16_t*)(ws + WS_XB);
        const int tl = lane >> 3, c4 = lane & 7;
        for (int it = bid * 8 + wid; it < (T / 8) * 4; it += G * 8) {
            const int tg = it >> 2, kq = it & 3;
            const float* src = x + (size_t)(tg * 8 + tl) * 1024 + kq * 256 + c4 * 4;
            float4 v[8];
#pragma unroll
            for (int j = 0; j < 8; ++j) v[j] = ldnt4(src + j * 32);
#pragma unroll
            for (int j = 0; j < 8; ++j) {
                uint2 o; o.x = pk2(v[j].x, v[j].y); o.y = pk2(v[j].z, v[j].w);
                *(uint2*)(xb + km_off(tg * 8 + tl, (kq * 8 + j) * 32 + c4 * 4, T)) = o;
            }
        }
        const int NM = NB * NMEM * DM / 4096;
        for (int it = bid; it < NM; it += G) {
            const size_t off = (size_t)it * 4096;
            const float4 v0 = ldnt4(p.in[1] + off + tid * 8), v1 = ldnt4(p.in[1] + off + tid * 8 + 4);
            uint4 o; o.x = pk2(v0.x, v0.y); o.y = pk2(v0.z, v0.w); o.z = pk2(v1.x, v1.y); o.w = pk2(v1.z, v1.w);
            *(uint4*)((bf16_t*)(ws + WS_MEMB) + off + tid * 8) = o;
        }
    }
    {
        constexpr int I_IN = 24 * 16, I_QI = 8 * 4, I_MK = 4 * 16, I_MV = 4 * 16, I_OUT = 8 * 16;
        constexpr int NIT = I_IN + I_QI + I_MK + I_MV + I_OUT;
        for (int it = bid; it < NIT; it += G) {
            int r = it;
            if (r < I_IN) { tconv_tile(p.in[2], nullptr, 1480, (bf16_t*)(ws + WS_W_IN_T), 1024, (r % 16) * 64, (r / 16) * 64, 1, tl, tid, 1536, 0, 0); continue; } r -= I_IN;
            if (r < I_QI) { tconv_tile(p.in[8], nullptr, 512, (bf16_t*)(ws + WS_W_Q2_T), 256, (r % 4) * 64, (r / 4) * 64, 0, tl, tid, 1536, 1024, 0); continue; } r -= I_QI;
            if (r < I_MK) { tconv_tile(p.in[11], nullptr, 256, (bf16_t*)(ws + WS_W_MKV_T), 1024, (r % 16) * 64, (r / 16) * 64, 0, tl, tid); continue; } r -= I_MK;
            if (r < I_MV) { tconv_tile(p.in[12], nullptr, 256, (bf16_t*)(ws + WS_W_MKV_T) + (size_t)256 * 1024, 1024, (r % 16) * 64, (r / 16) * 64, 0, tl, tid); continue; } r -= I_MV;
            tconv_tile(p.in[13] + (size_t)512 * 1024, nullptr, 1024, (bf16_t*)(ws + WS_W_OUT2_T), 1536, (r % 8) * 64, (r / 8) * 64, 0, tl, tid, 1024, 0, 1024);
        }
        __syncthreads();
        __syncthreads();
    }
    {
        const float* wuq = p.in[5]; const float* wuk = p.in[6];
        bf16_t* dst = (bf16_t*)(ws + WS_W_Q2_T);
        for (int it = bid; it < 512; it += G) {
            const int o = it * 512 + tid, n = o >> 8, r = o & 255, h = n >> 7, cc = n & 127;
            const float* a = wuq + (size_t)r * 512 + h * 64; const float* b = wuk + (size_t)cc * 512 + h * 64;
            float s = 0.f;
#pragma unroll 4
            for (int d = 0; d < 64; d += 4) { const float4 x = *(const float4*)(a + d), y = *(const float4*)(b + d); s += x.x * y.x + x.y * y.y + x.z * y.z + x.w * y.w; }
            dst[km_off(n, r, 1536)] = f2bf(s * (0.125f * 1.4426950408889634f));
        }
    }
    {
        const float* wuv = p.in[7]; const float* wout = p.in[13];
        bf16_t* dst = (bf16_t*)(ws + WS_W_OUT2_T);
        float* Lu = tl;
        float* Lo = tl + 8192;
        for (int it = bid; it < 128; it += G) {
            const int h = it >> 4, nt = it & 15;
            __syncthreads();
#pragma unroll
            for (int i = 0; i < 16; ++i) { const int idx = tid + i * 512, cc = idx >> 6, d = idx & 63; Lu[idx] = wuv[(size_t)(cc * 8 + h) * 64 + d]; }
#pragma unroll
            for (int i = 0; i < 8; ++i) { const int idx = tid + i * 512, d = idx >> 6, n = idx & 63; Lo[idx] = wout[(size_t)(h * 64 + d) * 1024 + nt * 64 + n]; }
            __syncthreads();
            const int n = tid & 63, cg = tid >> 6;
            float acc[16];
#pragma unroll
            for (int i = 0; i < 16; ++i) acc[i] = 0.f;
            for (int d = 0; d < 64; ++d) {
                const float w = Lo[d * 64 + n];
#pragma unroll
                for (int i = 0; i < 16; ++i) acc[i] = fmaf(Lu[(cg * 16 + i) * 64 + d], w, acc[i]);
            }
            uint4 o0, o1;
            o0.x = pk2(acc[0], acc[1]); o0.y = pk2(acc[2], acc[3]); o0.z = pk2(acc[4], acc[5]); o0.w = pk2(acc[6], acc[7]);
            o1.x = pk2(acc[8], acc[9]); o1.y = pk2(acc[10], acc[11]); o1.z = pk2(acc[12], acc[13]); o1.w = pk2(acc[14], acc[15]);
            bf16_t* dp = dst + km_off(nt * 64 + n, h * 128 + cg * 16, 1024);
            *(uint4*)dp = o0; *(uint4*)(dp + 8) = o1;
        }
        __syncthreads();
    }
    {
        const float* wr = p.in[16]; bf16_t* dst = (bf16_t*)(ws + WS_W_R_T);
        for (int it = bid; it < 128; it += G) {
            const int o = it * 512 + tid, e = o >> 10, k = o & 1023;
            const float w = wr[(size_t)k * 64 + e]; const bf16_t hi = f2bf(w), lo = f2bf(w - bf2f(hi));
            dst[(size_t)e * 2048 + k] = hi; dst[(size_t)e * 2048 + 1024 + k] = hi;
            dst[(size_t)(64 + e) * 2048 + k] = lo; dst[(size_t)(64 + e) * 2048 + 1024 + k] = 0;
        }
    }
}

template <bool RESYNC>
__device__ __forceinline__ void g8_store_tile(const f32x4 (&acc)[2][2][4][2], bf16_t* C, size_t ldc, int row0, int col0, const float* w8, char* lds, int tid_, int wv) {
    const int tid = opaque_i(tid_);
    const int lane = tid & 63, wr = wv >> 2, wc = wv & 3, fr = lane & 15, fq = lane >> 4;
    char* stg = lds + LDS_STG;
    if (RESYNC) { if (wr == 0) __builtin_amdgcn_s_barrier(); }
#pragma unroll
    for (int ai = 0; ai < 2; ++ai) {
#pragma unroll
        for (int m = 0; m < 4; ++m) {
            const float sc = w8 ? w8[ai * 4 + m] : 1.f;
            char* rp = stg + (wr * 64 + m * 16 + fr) * 528 + (wc * 32 + 4 * fq) * 2;
#pragma unroll
            for (int bj = 0; bj < 2; ++bj)
#pragma unroll
                for (int n = 0; n < 2; ++n) {
                    uint2 o; o.x = pk2(acc[ai][bj][m][n][0] * sc, acc[ai][bj][m][n][1] * sc); o.y = pk2(acc[ai][bj][m][n][2] * sc, acc[ai][bj][m][n][3] * sc);
                    lds_st8(rp + (bj * 128 + n * 16) * 2, o);
                }
        }
        asm volatile("s_waitcnt lgkmcnt(0)" ::: "memory"); __builtin_amdgcn_s_barrier(); asm volatile("" ::: "memory");
        uint4 v[8];
#pragma unroll
        for (int i = 0; i < 8; ++i) { const int id = tid + i * 512; v[i] = lds_ld16(stg + (id >> 5) * 528 + (id & 31) * 16); }
#pragma unroll
        for (int i = 0; i < 8; ++i) { const int id = tid + i * 512; *(uint4*)(C + (size_t)(row0 + ai * 128 + (id >> 5)) * ldc + col0 + (id & 31) * 8) = v[i]; }
        asm volatile("s_waitcnt lgkmcnt(0)" ::: "memory"); __builtin_amdgcn_s_barrier(); asm volatile("" ::: "memory");
    }
    if (RESYNC) { if (wr == 1) __builtin_amdgcn_s_barrier(); }
}
__device__ __forceinline__ void g8_store_proj(const f32x4 (&acc)[2][2][4][2], CParams& p, int brow, int nt, char* lds, int tid_, int wv) {
    const int tid = opaque_i(tid_);
    const int lane = tid & 63, wr = wv >> 2, wc = wv & 3, fr = lane & 15, fq = lane >> 4;
    unsigned char* ws = p.ws;
    char* stg = lds + LDS_STG;
    float* rs = (float*)(stg + 128 * 528);
    bf16_t* proj = (bf16_t*)(ws + WS_PROJ);
#pragma unroll
    for (int ai = 0; ai < 2; ++ai) {
#pragma unroll
        for (int m = 0; m < 4; ++m) {
            char* rp = stg + (wr * 64 + m * 16 + fr) * 528 + (wc * 32 + 4 * fq) * 2;
#pragma unroll
            for (int bj = 0; bj < 2; ++bj)
#pragma unroll
                for (int n = 0; n < 2; ++n) {
                    uint2 o; o.x = pk2(acc[ai][bj][m][n][0], acc[ai][bj][m][n][1]); o.y = pk2(acc[ai][bj][m][n][2], acc[ai][bj][m][n][3]);
                    lds_st8(rp + (bj * 128 + n * 16) * 2, o);
                }
        }
        asm volatile("s_waitcnt lgkmcnt(0)" ::: "memory"); __builtin_amdgcn_s_barrier(); asm volatile("" ::: "memory");
        const int r0g = brow + ai * 128;
        if (nt != 0) {
            uint4 v[8];
#pragma unroll
            for (int i = 0; i < 8; ++i) { const int id = tid + i * 512; v[i] = lds_ld16(stg + (id >> 5) * 528 + (id & 31) * 16); }
#pragma unroll
            for (int i = 0; i < 8; ++i) { const int id = tid + i * 512; *(uint4*)(proj + (size_t)(r0g + (id >> 5)) * NPROJ + nt * 256 + (id & 31) * 8) = v[i]; }
        }
        if (nt <= 1) {
            const int row = tid >> 2, q = tid & 3;
            const int ncol = (nt == 0) ? 256 : 128, per = ncol >> 2;
            float ss = 0.f;
            for (int c = 0; c < per; c += 8) {
                float f[8]; const uint4 u = lds_ld16(stg + row * 528 + (q * per + c) * 2); unpack8(u, f);
#pragma unroll
                for (int j = 0; j < 8; ++j) ss = fmaf(f[j], f[j], ss);
            }
            ss += dpp_f<0xB1>(ss); ss += dpp_f<0x4E>(ss);
            if (q == 0) rs[row] = rsqrtf(ss / (float)ncol + RMS_EPS);
            asm volatile("s_waitcnt lgkmcnt(0)" ::: "memory"); __builtin_amdgcn_s_barrier(); asm volatile("" ::: "memory");
            if (nt == 0) {
                const float* gq = p.in[3]; bf16_t* cqn = (bf16_t*)(ws + WS_CQN);
#pragma unroll
                for (int i = 0; i < 8; ++i) {
                    const int id = tid + i * 512, c4 = id & 3, rw = (id >> 2) & 127, kt = id >> 9, col = kt * 32 + c4 * 8;
                    float f[8]; const uint4 u = lds_ld16(stg + rw * 528 + col * 2); unpack8(u, f);
                    const float r = rs[rw];
                    const float4 g0 = *(const float4*)(gq + col), g1 = *(const float4*)(gq + col + 4);
                    uint4 o; o.x = pk2(f[0] * r * g0.x, f[1] * r * g0.y); o.y = pk2(f[2] * r * g0.z, f[3] * r * g0.w); o.z = pk2(f[4] * r * g1.x, f[5] * r * g1.y); o.w = pk2(f[6] * r * g1.z, f[7] * r * g1.w);
                    *(uint4*)(cqn + km_off(r0g + rw, col, T)) = o;
                }
            } else {
                const float* gkv = p.in[4]; bf16_t* ckvn = (bf16_t*)(ws + WS_CKVN); bf16_t* kidxf = (bf16_t*)(ws + WS_KIDX);
#pragma unroll
                for (int i = 0; i < 4; ++i) {
                    const int id = tid + i * 512, rw = id >> 4, ch = id & 15, col = ch * 8;
                    float f[8]; const uint4 u = lds_ld16(stg + rw * 528 + col * 2); unpack8(u, f);
                    const float r = rs[rw];
                    const float4 g0 = *(const float4*)(gkv + col), g1 = *(const float4*)(gkv + col + 4);
                    uint4 o; o.x = pk2(f[0] * r * g0.x, f[1] * r * g0.y); o.y = pk2(f[2] * r * g0.z, f[3] * r * g0.w); o.z = pk2(f[4] * r * g1.x, f[5] * r * g1.y); o.w = pk2(f[6] * r * g1.z, f[7] * r * g1.w);
                    *(uint4*)(ckvn + (size_t)(r0g + rw) * 128 + col) = o;
                }
#pragma unroll
                for (int i = 0; i < 2; ++i) {
                    const int id = tid + i * 512, f16 = id & 15, fq2 = (id >> 4) & 3, kk = (id >> 6) & 1, t16 = id >> 7;
                    const uint4 u = lds_ld16(stg + (t16 * 16 + f16) * 528 + (128 + kk * 32 + fq2 * 8) * 2);
                    *(uint4*)(kidxf + ((size_t)(((r0g >> 4) + t16) * 2 + kk) * 64 + fq2 * 16 + f16) * 8) = u;
                }
            }
        }
        asm volatile("s_waitcnt lgkmcnt(0)" ::: "memory"); __builtin_amdgcn_s_barrier(); asm volatile("" ::: "memory");
    }
}
template <bool RESYNC>
__device__ __forceinline__ void g8_store_tile8(const g8::f32x16 (&acc)[2][2][2], bf16_t* C, size_t ldc, int row0, int col0, const float* w4, char* lds, int tid_, int wv) {
    const int tid = opaque_i(tid_);
    const int lane = tid & 63, wr = wv >> 2, wc = wv & 3, tc = lane & 31, hh = lane >> 5;
    char* stg = lds + LDS_STG;
    if (RESYNC) { if (wr == 0) __builtin_amdgcn_s_barrier(); }
#pragma unroll
    for (int ai = 0; ai < 2; ++ai) {
#pragma unroll
        for (int m = 0; m < 2; ++m) {
            const float sc = w4[ai * 2 + m];
            char* rp = stg + (wr * 64 + m * 32 + tc) * 528 + (wc * 32 + 4 * hh) * 2;
#pragma unroll
            for (int bj = 0; bj < 2; ++bj)
#pragma unroll
                for (int g = 0; g < 4; ++g) {
                    uint2 o; o.x = pk2(acc[ai][bj][m][g * 4 + 0] * sc, acc[ai][bj][m][g * 4 + 1] * sc); o.y = pk2(acc[ai][bj][m][g * 4 + 2] * sc, acc[ai][bj][m][g * 4 + 3] * sc);
                    lds_st8(rp + (bj * 128 + g * 8) * 2, o);
                }
        }
        asm volatile("s_waitcnt lgkmcnt(0)" ::: "memory"); __builtin_amdgcn_s_barrier(); asm volatile("" ::: "memory");
#pragma unroll
        for (int hb = 0; hb < 2; ++hb) {
            uint4 v[4];
#pragma unroll
            for (int i = 0; i < 4; ++i) { const int id = tid + (hb * 4 + i) * 512; v[i] = lds_ld16(stg + (id >> 5) * 528 + (id & 31) * 16); }
#pragma unroll
            for (int i = 0; i < 4; ++i) { const int id = tid + (hb * 4 + i) * 512; *(uint4*)(C + (size_t)(row0 + ai * 128 + (id >> 5)) * ldc + col0 + (id & 31) * 8) = v[i]; }
        }
        asm volatile("s_waitcnt lgkmcnt(0)" ::: "memory"); __builtin_amdgcn_s_barrier(); asm volatile("" ::: "memory");
    }
    if (RESYNC) { if (wr == 1) __builtin_amdgcn_s_barrier(); }
}
constexpr float Y8_SCALE = 16.f;
template <bool RESYNC>
__device__ __forceinline__ void g8_store_tile8_f8(const g8::f32x16 (&acc)[2][2][2], unsigned char* C8, int row0, int col0, const float* w4, char* lds, int tid_, int wv) {
    const int tid = opaque_i(tid_);
    const int lane = tid & 63, wr = wv >> 2, wc = wv & 3, tc = lane & 31, hh = lane >> 5;
    char* stg = lds + LDS_STG;
    if (RESYNC) { if (wr == 0) __builtin_amdgcn_s_barrier(); }
#pragma unroll
    for (int ai = 0; ai < 2; ++ai)
#pragma unroll
        for (int m = 0; m < 2; ++m) {
            const float sc = w4[ai * 2 + m];
            char* rp = stg + (ai * 128 + wr * 64 + m * 32 + tc) * 272 + 4 * hh;
            const int sw = (tc >> 3) & 3;
#pragma unroll
            for (int bj = 0; bj < 2; ++bj)
#pragma unroll
                for (int g = 0; g < 4; ++g)
                    *(float*)(rp + (((wc * 2 + bj * 8 + (g >> 1)) ^ sw) << 4) + (g & 1) * 8) = __uint_as_float(pk4_f8(acc[ai][bj][m][g * 4 + 0] * sc, acc[ai][bj][m][g * 4 + 1] * sc, acc[ai][bj][m][g * 4 + 2] * sc, acc[ai][bj][m][g * 4 + 3] * sc));
        }
    asm volatile("s_waitcnt lgkmcnt(0)" ::: "memory"); __builtin_amdgcn_s_barrier(); asm volatile("" ::: "memory");
#pragma unroll
    for (int hb = 0; hb < 2; ++hb) {
        uint4 v[4];
#pragma unroll
        for (int i = 0; i < 4; ++i) { const int id = tid + (hb * 4 + i) * 512; v[i] = lds_ld16(stg + (id >> 4) * 272 + (((id & 15) ^ ((id >> 7) & 3)) << 4)); }
#pragma unroll
        for (int i = 0; i < 4; ++i) { const int id = tid + (hb * 4 + i) * 512; *(uint4*)(C8 + (size_t)(row0 + (id >> 4)) * 1024 + col0 + (id & 15) * 16) = v[i]; }
    }
    asm volatile("s_waitcnt lgkmcnt(0)" ::: "memory"); __builtin_amdgcn_s_barrier(); asm volatile("" ::: "memory");
    if (RESYNC) { if (wr == 1) __builtin_amdgcn_s_barrier(); }
}
__device__ __forceinline__ int vblock() { const int G = gridDim.x, b = blockIdx.x; return ((G & 7) == 0) ? (b & 7) * (G >> 3) + (b >> 3) : b; }

__device__ __forceinline__ void phase1(CParams& p, char* lds, int wv) {
    const int tid = opaque_tid(wv), lane = tid & 63, wid = tid >> 6, wm = wid >> 2, wn = wid & 3;
    unsigned char* ws = p.ws;
    constexpr int I1 = (T / 256) * 6, I2 = (4096 / 128) * 2, I3 = 2 * (4096 / 128);
    {
        int it = vblock();
        g8::Src s;
        if (it < I1) { g8::km_src(s, (const bf16_t*)(ws + WS_XB), T, (it / 6) * 256, (const bf16_t*)(ws + WS_W_IN_T), 1536, (it % 6) * 256, tid); g8::kloop_issue(s, lds, wv); }
        while (it < I1) {
            const int brow = (it / 6) * 256, bcol = (it % 6) * 256;
            f32x4 acc[2][2][4][2]; g8::acc_zero(acc);
            g8::kloop(acc, s, 32, lds, tid, wv);
            it += gridDim.x;
            if (it < I1) { g8::km_src(s, (const bf16_t*)(ws + WS_XB), T, (it / 6) * 256, (const bf16_t*)(ws + WS_W_IN_T), 1536, (it % 6) * 256, tid); g8::kloop_issue(s, lds, wv); }
            g8_store_proj(acc, p, brow, bcol >> 8, lds, tid, wv);
        }
    }
    asm volatile("s_waitcnt vmcnt(0)" ::: "memory");
    __syncthreads();
    for (int it = blockIdx.x; it < I2 + I3; it += gridDim.x) {
        if (it < I2) { const int r = it; gemm_item_bf16<1>((const bf16_t*)(ws + WS_MEMB), 1024, (const bf16_t*)(ws + WS_W_MKV_T), 1024, 16, (bf16_t*)(ws + WS_KMEM), 256, (r / 2) * 128, (r % 2) * 128, lds, tid, lane, wm, wn); }
        else { const int r = it - I2;
            gemm_item_bf16<2>((const bf16_t*)(ws + WS_W_MKV_T) + (size_t)256 * 1024, 1024, (const bf16_t*)(ws + WS_MEMB), 1024, 16, (bf16_t*)(ws + WS_VTMEM), 4096, (r / 32) * 128, (r % 32) * 128, lds, tid, lane, wm, wn); }
    }
}

__device__ __forceinline__ void phase2(CParams& p, int wv) {
    const int tid = opaque_tid(wv), lane = tid & 63, wid = tid >> 6;
    unsigned char* ws = p.ws;
    const bf16_t* proj = (const bf16_t*)(ws + WS_PROJ);
    bf16_t* cqn = (bf16_t*)(ws + WS_CQN); bf16_t* ckvn = (bf16_t*)(ws + WS_CKVN);
    const float* gq = p.in[3]; const float* gkv = p.in[4];
    for (int t = blockIdx.x * 8 + wid; t < T; t += gridDim.x * 8) {
        const bf16_t* row = proj + (size_t)t * NPROJ;
        {
            const uint2 v = *(const uint2*)(row + PC_CQ + lane * 4);
            const float a = bflo(v.x), b = bfhi(v.x), c = bflo(v.y), d = bfhi(v.y);
            const float ss = wave_sum(a * a + b * b + c * c + d * d);
            const float r = rsqrtf(ss * (1.f / 256.f) + RMS_EPS);
            const float4 g = *(const float4*)(gq + lane * 4);
            uint2 o; o.x = pk2(a * r * g.x, b * r * g.y); o.y = pk2(c * r * g.z, d * r * g.w);
            *(uint2*)(cqn + km_off(t, lane * 4, T)) = o;
        }
        {
            const uint32_t v = *(const uint32_t*)(row + PC_CKV + lane * 2);
            const float a = bflo(v), b = bfhi(v);
            const float ss = wave_sum(a * a + b * b);
            const float r = rsqrtf(ss * (1.f / 128.f) + RMS_EPS);
            const float2 g = *(const float2*)(gkv + lane * 2);
            *(uint32_t*)(ckvn + (size_t)t * 128 + lane * 2) = pk2(a * r * g.x, b * r * g.y);
        }
        if (lane < 32) {
            const int dd = lane * 2;
            const size_t off = ((size_t)((t >> 4) * 2 + (dd >> 5)) * 64 + ((dd & 31) >> 3) * 16 + (t & 15)) * 8 + (dd & 7);
            *(uint32_t*)((bf16_t*)(ws + WS_KIDX) + off) = *(const uint32_t*)(row + PC_KIDX + dd);
        }
    }
}

__device__ __forceinline__ void phase3(CParams& p, char* lds, int wv) {
    const int tid = opaque_tid(wv);
    unsigned char* ws = p.ws;
    constexpr int I1 = (T / 256) * 6;
    int it = vblock();
    g8::Src s;
    if (it < I1) { g8::km_src(s, (const bf16_t*)(ws + WS_CQN), T, (it / 6) * 256, (const bf16_t*)(ws + WS_W_Q2_T), 1536, (it % 6) * 256, tid); g8::kloop_issue(s, lds, wv); }
    while (it < I1) {
        const int brow = (it / 6) * 256, bcol = (it % 6) * 256;
        f32x4 acc[2][2][4][2]; g8::acc_zero(acc);
        g8::kloop(acc, s, 8, lds, tid, wv);
        it += gridDim.x;
        if (it < I1) { g8::km_src(s, (const bf16_t*)(ws + WS_CQN), T, (it / 6) * 256, (const bf16_t*)(ws + WS_W_Q2_T), 1536, (it % 6) * 256, tid); g8::kloop_issue(s, lds, wv); }
        g8_store_tile<false>(acc, (bf16_t*)(ws + WS_Q2), 1536, brow, bcol, nullptr, lds, tid, wv);
    }
}

typedef short s16x4 __attribute__((ext_vector_type(4)));
__device__ __forceinline__ int t5_bucket(int n) {
    if (n < 16) return n;
    if (n >= 128) return 31;
    const int l = 16 + (int)(__log2f((float)n * 0.0625f) * (16.0f / 3.0f));
    return l < 31 ? l : 31;
}
__device__ __forceinline__ bf16x8 ld_frag(const bf16_t* p) { return *(const bf16x8*)p; }
__device__ __forceinline__ bf16x8 u4_as_frag(const uint4& v) { union { uint4 u; bf16x8 f; } c; c.u = v; return c.f; }

constexpr int SK_STRIDE = 2052;
constexpr int P4_SEL = 16 * SK_STRIDE * 4;
constexpr int P4_RB = P4_SEL + 16 * 256 * 2;
constexpr int P4_SELB = P4_RB + 1024;

constexpr int P4_CSCR = P4_SELB + 4096;
constexpr int P4_HIST = P4_CSCR + 2048;
template <int CTRL> __device__ __forceinline__ uint32_t dpp_u(uint32_t x) { return (uint32_t)__builtin_amdgcn_mov_dpp((int)x, CTRL, 0xf, 0xf, true); }
__device__ __forceinline__ uint32_t wave_and_u(uint32_t x) {
    x &= dpp_u<0xB1>(x); x &= dpp_u<0x4E>(x); x &= dpp_u<0x141>(x); x &= dpp_u<0x128>(x);
    auto s = __builtin_amdgcn_permlane16_swap(x, x, false, false); x = s[0] & s[1];
    auto t = __builtin_amdgcn_permlane32_swap(x, x, false, false); return t[0] & t[1];
}
__device__ __forceinline__ uint32_t wave_or_u(uint32_t x) {
    x |= dpp_u<0xB1>(x); x |= dpp_u<0x4E>(x); x |= dpp_u<0x141>(x); x |= dpp_u<0x128>(x);
    auto s = __builtin_amdgcn_permlane16_swap(x, x, false, false); x = s[0] | s[1];
    auto t = __builtin_amdgcn_permlane32_swap(x, x, false, false); return t[0] | t[1];
}
__device__ __forceinline__ int wave_prefix_incl(int v) {
    v += __builtin_amdgcn_update_dpp(0, v, 0x111, 0xf, 0xf, false);
    v += __builtin_amdgcn_update_dpp(0, v, 0x112, 0xf, 0xf, false);
    v += __builtin_amdgcn_update_dpp(0, v, 0x114, 0xf, 0xf, false);
    v += __builtin_amdgcn_update_dpp(0, v, 0x118, 0xf, 0xf, false);
    v += __builtin_amdgcn_update_dpp(0, v, 0x142, 0xa, 0xf, false);
    v += __builtin_amdgcn_update_dpp(0, v, 0x143, 0xc, 0xf, false);
    return v;
}
__device__ __forceinline__ int mbcnt64(unsigned long long m) { return (int)__builtin_amdgcn_mbcnt_hi((unsigned)(m >> 32), __builtin_amdgcn_mbcnt_lo((unsigned)m, 0u)); }
template <int NREG>
__device__ __forceinline__ void select_query(const uint32_t* skrow, unsigned short* sel, unsigned char* selb, uint32_t* cscr, uint32_t* hist, int t_in, int lane) {
    const int t = __builtin_amdgcn_readfirstlane(t_in);
    const unsigned long long ltmask = (1ull << lane) - 1ull;
    uint32_t key[NREG];
#pragma unroll
    for (int i = 0; i < NREG; ++i) { const int s = i * 64 + lane; const uint32_t kv = skrow[s]; key[i] = (s <= t) ? kv : 0u; }
    uint32_t prefix = 0; bool exact = false;
    int nS = 0, nU = t + 1, bit = 31;
    {
        const uint32_t cand = 0x80000000u;
        int cnt = 0;
#pragma unroll
        for (int i = 0; i < NREG; ++i) cnt += __popcll(__ballot(key[i] >= cand));
        if (cnt >= 256) { prefix = cand; nU = cnt; exact = (cnt == 256); } else { nU -= cnt; nS = cnt; }
        bit = 30;
        if (!exact && nU > 64) {
            uint32_t a = 0xFFFFFFFFu, o = 0u;
            if (prefix != 0u) {
#pragma unroll
                for (int i = 0; i < NREG; ++i) { const uint32_t mk = (uint32_t)((int)key[i] >> 31); a &= key[i] | ~mk; o |= key[i] & mk; }
            } else {
#pragma unroll
                for (int i = 0; i < NREG; ++i) { const uint32_t mk = ~(uint32_t)((int)(key[i] - 1u) >> 31); a &= key[i] | ~mk; o |= key[i] & mk; }
            }
            a = wave_and_u(a); o = wave_or_u(o);
            const uint32_t diff = (a ^ o) & 0x7FFFFFFFu;
            if (diff == 0u) { prefix = a; bit = -1; }
            else {
                const int top = 31 - __clz(diff);
                const uint32_t keep = (top >= 30) ? 0u : (0x7FFFFFFFu & ~((2u << top) - 1u));
                prefix |= a & keep;
                const int nb = (top + 1 < 8) ? top + 1 : 8, shift = top + 1 - nb;
                *(uint4*)(hist + lane * 4) = make_uint4(0u, 0u, 0u, 0u);
                wave_sync();
                {
                    const uint32_t hi = 2u << top, lo = prefix ? prefix : 1u, span = prefix ? hi : hi - 1u;
#pragma unroll
                    for (int i = 0; i < NREG; ++i) {
                        if ((key[i] - lo) < span) atomicAdd(&hist[(key[i] >> shift) & 255u], 1u);
                    }
                }
                wave_sync();
                const uint4 h4 = *(const uint4*)(hist + lane * 4);
                const int own = (int)(h4.x + h4.y + h4.z + h4.w);
                const int pin = wave_prefix_incl(own);
                const int suf = __builtin_amdgcn_readlane(pin, 63) - pin + own;
                const int need = 256 - nS;
                const int L = __popcll(__ballot(suf >= need)) - 1;
                const int above = (L < 63) ? __builtin_amdgcn_readlane(suf, (L + 1) & 63) : 0;
                const int hb[4] = {__builtin_amdgcn_readlane((int)h4.x, L), __builtin_amdgcn_readlane((int)h4.y, L), __builtin_amdgcn_readlane((int)h4.z, L), __builtin_amdgcn_readlane((int)h4.w, L)};
                int c = above, dig = 4 * L, inbin = 0, aboved = above;
                bool found = false;
#pragma unroll
                for (int j = 3; j >= 0; --j) { if (!found) { const int c2 = c + hb[j]; if (c2 >= need) { dig = 4 * L + j; inbin = hb[j]; aboved = c; found = true; } c = c2; } }
                prefix |= (uint32_t)dig << shift;
                nS += aboved; nU = inbin;
                exact = (nS + nU == 256);
                bit = shift - 1;
            }
        }
    }
    for (; !exact && bit >= 0 && nU > 64; --bit) {
        const uint32_t cand = prefix | (1u << bit);
        int cnt = 0;
#pragma unroll
        for (int i = 0; i < NREG; ++i) cnt += __popcll(__ballot(key[i] >= cand));
        if (cnt >= 256) { prefix = cand; nU = cnt - nS; if (cnt == 256) { exact = true; break; } }
        else { nU -= cnt - nS; nS = cnt; }
    }
    int quota = 0; bool have_quota = false;
    if (!exact && bit >= 0) {
        const int sh = bit + 1;
        int pos = 0;
        const uint32_t clo = prefix ? prefix : 1u, cspan = prefix ? (1u << sh) : (1u << sh) - 1u;
        wave_sync();
#pragma unroll
        for (int i = 0; i < NREG; ++i) {
            const bool inU = (key[i] - clo) < cspan;
            const unsigned long long bu = __builtin_amdgcn_ballot_w64(inU);
            if (inU) { const int d = pos + mbcnt64(bu); if (d < 64) cscr[d] = key[i]; }
            pos += __popcll(bu);
        }
        wave_sync();
        const uint32_t u = (lane < pos) ? cscr[lane] : 0u;
        for (; bit >= 0; --bit) {
            const uint32_t cand = prefix | (1u << bit);
            const int cnt = nS + __popcll(__ballot(u >= cand));
            if (cnt >= 256) { prefix = cand; if (cnt == 256) { exact = true; break; } }
        }
        if (!exact) {
            if (nS + __popcll(__ballot(u >= prefix)) == 256) exact = true;
            else { quota = 256 - (nS + __popcll(__ballot(u > prefix))); have_quota = true; }
        }
    }
    if (!exact && !have_quota) {
        int cgt = 0;
#pragma unroll
        for (int i = 0; i < NREG; ++i) cgt += __popcll(__ballot(key[i] > prefix));
        quota = 256 - cgt;
    }
    *(uint32_t*)(selb + lane * 4) = 0x1F1F1F1Fu;
    const bool ex = __builtin_amdgcn_readfirstlane((int)exact) != 0;
    int pos = 0;
    if (ex) {
#pragma unroll
        for (int i = 0; i < NREG; ++i) {
            const unsigned long long bt = __builtin_amdgcn_ballot_w64(key[i] >= prefix);
            if (key[i] >= prefix) {
                const int dst = pos + mbcnt64(bt); sel[dst] = (unsigned short)(i * 64 + lane);
                if (t - (i * 64 + 63) < 128) selb[dst] = (unsigned char)t5_bucket(t - (i * 64 + lane));
            }
            pos += __popcll(bt);
        }
    } else {
        int eqc = 0;
#pragma unroll
        for (int i = 0; i < NREG; ++i) {
            const uint32_t u = key[i];
            const unsigned long long beq = __builtin_amdgcn_ballot_w64(u == prefix);
            const bool take = (u > prefix) || ((u == prefix) && (eqc + mbcnt64(beq) < quota));
            eqc += __popcll(beq);
            const unsigned long long bt = __builtin_amdgcn_ballot_w64(take);
            if (take) {
                const int dst = pos + mbcnt64(bt); sel[dst] = (unsigned short)(i * 64 + lane);
                if (t - (i * 64 + 63) < 128) selb[dst] = (unsigned char)t5_bucket(t - (i * 64 + lane));
            }
            pos += __popcll(bt);
        }
    }
}

__device__ __forceinline__ void dsa_item(CParams& p, int b, int t0, char* lds, int tid_in, int wv) {
    const int tid = opaque_i(tid_in);
    const int wv_s = wv;
    const int lane = tid & 63, wid = tid >> 6, fr = lane & 15, fq = lane >> 4;
    unsigned char* ws = p.ws;
    uint32_t* SK = (uint32_t*)lds;
    unsigned short* SEL = (unsigned short*)(lds + P4_SEL);
    const float* RB = (const float*)(lds + P4_RB);
    unsigned char* SELB = (unsigned char*)(lds + P4_SELB);
    const bf16_t* q2 = (const bf16_t*)(ws + WS_Q2) + ((size_t)b * SEQ + t0) * 1536;
    const bf16_t* kidx = (const bf16_t*)(ws + WS_KIDX) + (size_t)b * SEQ * 64;
    const bf16_t* ckvn = (const bf16_t*)(ws + WS_CKVN) + (size_t)b * SEQ * 128;
    __syncthreads();
    if (t0 >= 256) {
        bf16x8 qf[8][2];
#pragma unroll
        for (int h = 0; h < 8; ++h)
#pragma unroll
            for (int kk = 0; kk < 2; ++kk) qf[h][kk] = ld_frag(q2 + (size_t)fr * 1536 + 1024 + h * 64 + kk * 32 + fq * 8);
        float wv[8];
        { const uint4 v = *(const uint4*)((const bf16_t*)(ws + WS_PROJ) + ((size_t)b * SEQ + t0 + fr) * NPROJ + PC_IDXW); unpack8(v, wv); }
#pragma unroll
        for (int i = 0; i < 8; ++i) wv[i] *= IDXW_SCALE;
        const int ntile = (t0 + 16) >> 4;
        const int tq = t0 + fr;
        bf16x8 kn0 = ld_frag(kidx + (size_t)(wid * 2) * 512 + lane * 8), kn1 = ld_frag(kidx + (size_t)(wid * 2 + 1) * 512 + lane * 8);
        for (int kt = wv_s; kt < ntile; kt += 8) {
            const int key0 = kt * 16;
            const bf16x8 kf0 = kn0, kf1 = kn1;
            { const int kx = (kt + 8 < ntile) ? kt + 8 : kt;
              kn0 = ld_frag(kidx + (size_t)(kx * 2) * 512 + lane * 8); kn1 = ld_frag(kidx + (size_t)(kx * 2 + 1) * 512 + lane * 8); }
            f32x4 dh[8];
#pragma unroll
            for (int h = 0; h < 8; ++h) dh[h] = __builtin_amdgcn_mfma_f32_16x16x32_bf16(kf0, qf[h][0], (f32x4){0.f, 0.f, 0.f, 0.f}, 0, 0, 0);
#pragma unroll
            for (int h = 0; h < 8; ++h) dh[h] = __builtin_amdgcn_mfma_f32_16x16x32_bf16(kf1, qf[h][1], dh[h], 0, 0, 0);
            float sacc[4] = {0.f, 0.f, 0.f, 0.f};
#pragma unroll
            for (int h = 0; h < 8; ++h)
#pragma unroll
                for (int r = 0; r < 4; ++r) sacc[r] = fmaf(wv[h], __builtin_amdgcn_fmed3f(dh[h][r], 0.f, 3.0e38f), sacc[r]);
            uint4 ko;
            uint32_t kk4[4];
#pragma unroll
            for (int r = 0; r < 4; ++r) {
                const uint32_t u = __float_as_uint(sacc[r]);
                kk4[r] = u ^ ((uint32_t)((int)u >> 31) | 0x80000000u);
            }
            if (key0 + 15 > t0) {
#pragma unroll
                for (int r = 0; r < 4; ++r) kk4[r] = (key0 + 4 * fq + r <= tq) ? kk4[r] : 0u;
            }
            ko.x = kk4[0]; ko.y = kk4[1]; ko.z = kk4[2]; ko.w = kk4[3];
            *(uint4*)(SK + fr * SK_STRIDE + key0 + 4 * fq) = ko;
        }
        __syncthreads();
#pragma nounroll
        for (int qq = 0; qq < 2; ++qq) {
            const int q = wid * 2 + qq, t = t0 + q;
            uint32_t* cscr = (uint32_t*)(lds + P4_CSCR) + wid * 64;
#define DSA_SEL(N) select_query<N>(SK + q * SK_STRIDE, SEL + q * 256, SELB + q * 256, cscr, (uint32_t*)(lds + P4_HIST) + wid * 256, t, lane)
            switch (__builtin_amdgcn_readfirstlane(t0 >> 8)) {
                case 1: DSA_SEL(8); break;
                case 2: DSA_SEL(12); break;
                case 3: DSA_SEL(16); break;
                case 4: DSA_SEL(20); break;
                case 5: DSA_SEL(24); break;
                case 6: DSA_SEL(28); break;
                default: DSA_SEL(32); break;
            }
#undef DSA_SEL
        }
    } else {
        for (int qq = 0; qq < 2; ++qq) {
            const int q = wid * 2 + qq, t = t0 + q;
            for (int k = lane; k <= t; k += 64) { SEL[q * 256 + k] = (unsigned short)k; SELB[q * 256 + k] = (unsigned char)t5_bucket(t - k); }
        }
    }
    bf16x8 qfa[4], qfb[4];
#pragma unroll
    for (int kk = 0; kk < 4; ++kk) {
        uint4 va_ = make_uint4(0, 0, 0, 0), vb_ = make_uint4(0, 0, 0, 0);
        if (fr < 8) { va_ = *(const uint4*)(q2 + (size_t)(wid * 2) * 1536 + fr * 128 + kk * 32 + fq * 8); vb_ = *(const uint4*)(q2 + (size_t)(wid * 2 + 1) * 1536 + fr * 128 + kk * 32 + fq * 8); }
        qfa[kk] = u4_as_frag(va_); qfb[kk] = u4_as_frag(vb_);
    }
    asm volatile("s_waitcnt lgkmcnt(0)" ::: "memory"); __builtin_amdgcn_s_barrier(); asm volatile("" ::: "memory");
    char* vst = lds + wv * 16384;
    bf16_t* cat = (bf16_t*)(ws + WS_CAT2);
    const __amdgpu_buffer_rsrc_t rkv = g8::make_rsrc(ckvn);
#define DSA_ISSUE(c) DSA_ISSUE_Q(selq, nsel, nsel_s, c)
#define DSA_ISSUE_Q(selq, nsel, nsel_s, c) do { int sv_[8]; \
            _Pragma("unroll") for (int pc = 0; pc < 8; ++pc) sv_[pc] = (int)(selq)[(c) * 32 + pc * 4 + fq];     \
            if ((c) * 32 + 32 <= nsel_s) {     \
            _Pragma("unroll") for (int pc = 0; pc < 8; ++pc) { \
            const int row_ = pc * 4 + fq; \
            __builtin_amdgcn_raw_ptr_buffer_load_lds(rkv, (LAS void*)(vst + ((c) & 1) * 8192 + pc * 1024), 16, (unsigned)(sv_[pc] * 256 + ((fr ^ (row_ & 15)) << 4)), 0, 0, 0); } \
            } else { \
            _Pragma("unroll") for (int pc = 0; pc < 8; ++pc) { \
            const int row_ = pc * 4 + fq; const int k_ = (c) * 32 + row_; \
            const int s_ = (k_ < nsel) ? sv_[pc] : 0; \
            __builtin_amdgcn_raw_ptr_buffer_load_lds(rkv, (LAS void*)(vst + ((c) & 1) * 8192 + pc * 1024), 16, (unsigned)(s_ * 256 + ((fr ^ (row_ & 15)) << 4)), 0, 0, 0); } } } while (0)
    {
        const int tq0 = t0 + wid * 2, nsel0 = (tq0 + 1 < 256) ? tq0 + 1 : 256, nsel0_s = __builtin_amdgcn_readfirstlane(nsel0);
        DSA_ISSUE_Q(SEL + (wid * 2) * 256, nsel0, nsel0_s, 0);
        if (nsel0_s > 32) DSA_ISSUE_Q(SEL + (wid * 2) * 256, nsel0, nsel0_s, 1);
    }
    asm volatile("" :: "v"(qfa[0]), "v"(qfa[1]), "v"(qfa[2]), "v"(qfa[3]), "v"(qfb[0]), "v"(qfb[1]), "v"(qfb[2]), "v"(qfb[3]));
#pragma nounroll
    for (int qq = 0; qq < 2; ++qq) {
        const int q = wid * 2 + qq, t = t0 + q;
        const int nsel = (t + 1 < 256) ? t + 1 : 256;
        const size_t tok = (size_t)b * SEQ + t;
        const unsigned short* selq = SEL + q * 256;
        bf16x8 qf[4];
#pragma unroll
        for (int kk = 0; kk < 4; ++kk) qf[kk] = qq ? qfb[kk] : qfa[kk];
        float m = -INFINITY, l = 0.f;
        const float rb31 = RB[31 * 8 + (fr & 7)];
        f32x4 O[8];
#pragma unroll
        for (int ct = 0; ct < 8; ++ct) O[ct] = (f32x4){0.f, 0.f, 0.f, 0.f};
        const int nck = __builtin_amdgcn_readfirstlane((nsel + 31) >> 5);
        const int nsel_s = __builtin_amdgcn_readfirstlane(nsel);
        int nfar;
        { const int c8 = lane & 7, kl = min(c8 * 32 + 31, nsel - 1);
          const bool f8 = (c8 < nck) && (t - (int)selq[kl] >= 128);
          nfar = __builtin_amdgcn_readfirstlane(__popcll(__builtin_amdgcn_ballot_w64(f8) & 0xFFull)); }
        asm volatile("" :: "v"(qf[0]), "v"(qf[1]), "v"(qf[2]), "v"(qf[3]));
#pragma nounroll
        for (int ck = 0; ck < nck; ++ck) {
            if (ck + 1 < nck) asm volatile("s_waitcnt vmcnt(8)" ::: "memory");
            else asm volatile("s_waitcnt vmcnt(0)" ::: "memory");
            const char* buf = vst + (ck & 1) * 8192;
            bf16x8 a0[4], a1[4];
#pragma unroll
            for (int kk = 0; kk < 4; ++kk) {
                const int ch = ((kk * 4 + fq) ^ fr) << 4;
                a0[kk] = *(const bf16x8*)(buf + fr * 256 + ch);
                a1[kk] = *(const bf16x8*)(buf + (16 + fr) * 256 + ch);
            }
            s16x4 va[8], vb[8];
            {
                const int r0 = 4 * fq + (fr >> 2), sub = 8 * (fr & 1);
                const unsigned bufa = (unsigned)(size_t)(LAS const char*)buf + (unsigned)(r0 * 256 + sub);
#pragma unroll
                for (int ct = 0; ct < 8; ++ct) {
                    const int chn = ct * 2 + ((fr & 3) >> 1);
                    const unsigned a32 = bufa + (unsigned)((chn ^ (r0 & 15)) << 4);
                    asm volatile("ds_read_b64_tr_b16 %0, %1" : "=v"(va[ct]) : "v"(a32));
                    asm volatile("ds_read_b64_tr_b16 %0, %1 offset:4096" : "=v"(vb[ct]) : "v"(a32));
                }
                asm volatile("s_waitcnt lgkmcnt(0)" : "+v"(va[0]), "+v"(va[1]), "+v"(va[2]), "+v"(va[3]), "+v"(va[4]), "+v"(va[5]), "+v"(va[6]), "+v"(va[7]),
                                                      "+v"(vb[0]), "+v"(vb[1]), "+v"(vb[2]), "+v"(vb[3]), "+v"(vb[4]), "+v"(vb[5]), "+v"(vb[6]), "+v"(vb[7]) :: "memory");
            }
            if (ck + 2 < nck) DSA_ISSUE(ck + 2);
            else if (ck + 1 == nck && qq == 0) {
                const int nsel1 = (t + 2 < 256) ? t + 2 : 256, nsel1_s = __builtin_amdgcn_readfirstlane(nsel1);
                DSA_ISSUE_Q(selq + 256, nsel1, nsel1_s, 0);
                if (nsel1_s > 32) DSA_ISSUE_Q(selq + 256, nsel1, nsel1_s, 1);
            }
            const bool farc = (ck < nfar);
            const float dinit = farc ? rb31 : 0.f;
            f32x4 d0 = (f32x4){dinit, dinit, dinit, dinit}, d1 = d0;
#pragma unroll
            for (int kk = 0; kk < 4; ++kk) {
                d0 = __builtin_amdgcn_mfma_f32_16x16x32_bf16(a0[kk], qf[kk], d0, 0, 0, 0);
                d1 = __builtin_amdgcn_mfma_f32_16x16x32_bf16(a1[kk], qf[kk], d1, 0, 0, 0);
            }
            float lg0[4], lg1[4];
            {
                const int kb = ck * 32 + 4 * fq;
                if (farc && ck * 32 + 32 <= nsel_s) {
#pragma unroll
                    for (int r = 0; r < 4; ++r) { lg0[r] = d0[r]; lg1[r] = d1[r]; }
                } else if (farc) {
#pragma unroll
                    for (int r = 0; r < 4; ++r) {
                        const bool v0 = (kb + r) < nsel, v1 = (kb + 16 + r) < nsel;
                        lg0[r] = d0[r] + (v0 ? 0.f : -INFINITY);
                        lg1[r] = d1[r] + (v1 ? 0.f : -INFINITY);
                    }
                } else {
                    const uint32_t bw0 = *(const uint32_t*)(SELB + q * 256 + kb), bw1 = *(const uint32_t*)(SELB + q * 256 + kb + 16);
#pragma unroll
                    for (int r = 0; r < 4; ++r) {
                        const bool v0 = (kb + r) < nsel, v1 = (kb + 16 + r) < nsel;
                        const int b0 = (int)((bw0 >> (8 * r)) & 31u), b1 = (int)((bw1 >> (8 * r)) & 31u);
                        const float rb0 = RB[b0 * 8 + (fr & 7)], rb1 = RB[b1 * 8 + (fr & 7)];
                        lg0[r] = (d0[r] + rb0) + (v0 ? 0.f : -INFINITY);
                        lg1[r] = (d1[r] + rb1) + (v1 ? 0.f : -INFINITY);
                    }
                }
            }
#define FMAX_NC(a_, b_) __builtin_amdgcn_fmed3f((a_), (b_), 3.0e38f)
            float cm = FMAX_NC(FMAX_NC(FMAX_NC(lg0[0], lg0[1]), FMAX_NC(lg0[2], lg0[3])), FMAX_NC(FMAX_NC(lg1[0], lg1[1]), FMAX_NC(lg1[2], lg1[3])));
#undef FMAX_NC
            cm = xrow16_max(cm);
            const float mn = (cm > m + 8.f) ? cm : m;
            const float scl = __builtin_amdgcn_exp2f(m - mn);
            float p0[4], p1[4], ls;
            {
                typedef float f32x2_t __attribute__((ext_vector_type(2)));
                const f32x2_t mn2 = {mn, mn};
                const f32x2_t e0 = (f32x2_t){lg0[0], lg0[1]} - mn2, e1 = (f32x2_t){lg0[2], lg0[3]} - mn2, e2 = (f32x2_t){lg1[0], lg1[1]} - mn2, e3 = (f32x2_t){lg1[2], lg1[3]} - mn2;
                p0[0] = __builtin_amdgcn_exp2f(e0[0]); p0[1] = __builtin_amdgcn_exp2f(e0[1]); p0[2] = __builtin_amdgcn_exp2f(e1[0]); p0[3] = __builtin_amdgcn_exp2f(e1[1]);
                p1[0] = __builtin_amdgcn_exp2f(e2[0]); p1[1] = __builtin_amdgcn_exp2f(e2[1]); p1[2] = __builtin_amdgcn_exp2f(e3[0]); p1[3] = __builtin_amdgcn_exp2f(e3[1]);
                const f32x2_t s2 = ((f32x2_t){p0[0], p0[1]} + (f32x2_t){p0[2], p0[3]}) + ((f32x2_t){p1[0], p1[1]} + (f32x2_t){p1[2], p1[3]});
                ls = s2[0] + s2[1];
            }
            ls = xrow16_sum(ls);
            l = l * scl + ls; m = mn;
            if (__any(scl != 1.f)) {
#pragma unroll
                for (int ct = 0; ct < 8; ++ct) O[ct] = O[ct] * scl;
            }
            uint4 pf; pf.x = pk2(p0[0], p0[1]); pf.y = pk2(p0[2], p0[3]); pf.z = pk2(p1[0], p1[1]); pf.w = pk2(p1[2], p1[3]);
            const bf16x8 pfrag = u4_as_frag(pf);
            {
#pragma unroll
                for (int ct = 0; ct < 8; ++ct) {
                    bf16x8 vf; vf[0] = va[ct][0]; vf[1] = va[ct][1]; vf[2] = va[ct][2]; vf[3] = va[ct][3]; vf[4] = vb[ct][0]; vf[5] = vb[ct][1]; vf[6] = vb[ct][2]; vf[7] = vb[ct][3];
                    O[ct] = __builtin_amdgcn_mfma_f32_16x16x32_bf16(vf, pfrag, O[ct], 0, 0, 0);
                }
            }
            asm volatile("" ::: "memory");
        }
#undef DSA_ISSUE
#undef DSA_ISSUE_Q
        const float inv = 1.f / l;
        if (fr < 8) {
#pragma unroll
            for (int ct = 0; ct < 8; ++ct) {
                uint2 o; o.x = pk2(O[ct][0] * inv, O[ct][1] * inv); o.y = pk2(O[ct][2] * inv, O[ct][3] * inv);
                *(uint2*)(cat + km_off((int)tok, fr * 128 + ct * 16 + 4 * fq, T)) = o;
            }
        }
    }
}

#define MA_SB() __builtin_amdgcn_sched_barrier(0)
__device__ __forceinline__ void memattn_wave(CParams& p, int b, size_t tok0, int h, int lane) {
    const int fr = lane & 15, fq = lane >> 4;
    unsigned char* ws = p.ws;
    const bf16_t* proj = (const bf16_t*)(ws + WS_PROJ) + (tok0 + fr) * NPROJ + PC_QM + h * 64;
    const bf16_t* km = (const bf16_t*)(ws + WS_KMEM) + (size_t)(b * 4 + h) * (16 * 2 * 64 * 8) + lane * 8;
    const bf16_t* vt = (const bf16_t*)(ws + WS_VTMEM) + (size_t)(b * 4 + h) * (8 * 4 * 64 * 8) + lane * 8;
    const bf16x8 qf0 = ld_frag(proj + fq * 8), qf1 = ld_frag(proj + 32 + fq * 8);
    f32x4 d[16];
    bf16x8 kb[2][8];
#pragma unroll
    for (int j = 0; j < 4; ++j) { kb[0][2 * j] = ld_frag(km + (j * 2) * 512); kb[0][2 * j + 1] = ld_frag(km + (j * 2 + 1) * 512); }
    MA_SB();
#pragma unroll
    for (int g = 0; g < 4; ++g) {
        if (g < 3) {
#pragma unroll
            for (int j = 0; j < 4; ++j) { kb[(g + 1) & 1][2 * j] = ld_frag(km + ((g * 4 + 4 + j) * 2) * 512); kb[(g + 1) & 1][2 * j + 1] = ld_frag(km + ((g * 4 + 4 + j) * 2 + 1) * 512); }
        }
        MA_SB();
#pragma unroll
        for (int j = 0; j < 4; ++j) {
            f32x4 z = (f32x4){0.f, 0.f, 0.f, 0.f};
            z = __builtin_amdgcn_mfma_f32_16x16x32_bf16(kb[g & 1][2 * j], qf0, z, 0, 0, 0);
            z = __builtin_amdgcn_mfma_f32_16x16x32_bf16(kb[g & 1][2 * j + 1], qf1, z, 0, 0, 0);
            d[g * 4 + j] = z * (0.125f * 1.4426950408889634f);
        }
        MA_SB();
    }
    bf16x8 vb[2][8];
#pragma unroll
    for (int i = 0; i < 8; ++i) vb[0][i] = ld_frag(vt + i * 512);
    MA_SB();
    float mx = -INFINITY;
#pragma unroll
    for (int kt = 0; kt < 16; ++kt) mx = fmaxf(mx, fmaxf(fmaxf(d[kt][0], d[kt][1]), fmaxf(d[kt][2], d[kt][3])));
    mx = xrow16_max(mx);
    float s = 0.f;
#pragma unroll
    for (int kt = 0; kt < 16; ++kt)
#pragma unroll
        for (int r = 0; r < 4; ++r) { d[kt][r] = __builtin_amdgcn_exp2f(d[kt][r] - mx); s += d[kt][r]; }
    s = xrow16_sum(s);
    const float inv = 1.f / s;
    f32x4 O[4];
#pragma unroll
    for (int dt = 0; dt < 4; ++dt) O[dt] = (f32x4){0.f, 0.f, 0.f, 0.f};
    MA_SB();
#pragma unroll
    for (int g = 0; g < 4; ++g) {
        if (g < 3) {
#pragma unroll
            for (int i = 0; i < 8; ++i) vb[(g + 1) & 1][i] = ld_frag(vt + ((g + 1) * 8 + i) * 512);
        }
        MA_SB();
#pragma unroll
        for (int cc = 0; cc < 2; ++cc) {
            const int c32 = g * 2 + cc;
            uint4 pf; pf.x = pk2(d[2 * c32][0], d[2 * c32][1]); pf.y = pk2(d[2 * c32][2], d[2 * c32][3]); pf.z = pk2(d[2 * c32 + 1][0], d[2 * c32 + 1][1]); pf.w = pk2(d[2 * c32 + 1][2], d[2 * c32 + 1][3]);
            const bf16x8 pfrag = u4_as_frag(pf);
#pragma unroll
            for (int dt = 0; dt < 4; ++dt) O[dt] = __builtin_amdgcn_mfma_f32_16x16x32_bf16(vb[g & 1][cc * 4 + dt], pfrag, O[dt], 0, 0, 0);
        }
        MA_SB();
    }
    bf16_t* cat = (bf16_t*)(ws + WS_CAT2);
#pragma unroll
    for (int dt = 0; dt < 4; ++dt) {
        uint2 o; o.x = pk2(O[dt][0] * inv, O[dt][1] * inv); o.y = pk2(O[dt][2] * inv, O[dt][3] * inv);
        *(uint2*)(cat + km_off((int)tok0 + fr, 1280 + h * 64 + dt * 16 + 4 * fq, T)) = o;
    }
}

__device__ __forceinline__ void conv_tokens4(CParams& p, int b, int t0, int lane) {
    unsigned char* ws = p.ws;
    const bf16_t* proj = (const bf16_t*)(ws + WS_PROJ) + (size_t)b * SEQ * NPROJ;
    const float* cw = p.in[10];
    const int c = lane * 4;
    uint2 gc[6], hh[6], gb[4];
#pragma unroll
    for (int i = 0; i < 6; ++i) {
        const int tt = t0 - 2 + i, tc = tt < 0 ? 0 : tt;
        gc[i] = *(const uint2*)(proj + (size_t)tc * NPROJ + PC_GC + c); hh[i] = *(const uint2*)(proj + (size_t)tc * NPROJ + PC_H + c);
    }
#pragma unroll
    for (int i = 0; i < 4; ++i) gb[i] = *(const uint2*)(proj + (size_t)(t0 + i) * NPROJ + PC_GB + c);
    const float4 w0 = *(const float4*)(cw + c), w1 = *(const float4*)(cw + 256 + c), w2 = *(const float4*)(cw + 512 + c);
    float u[6][4];
#pragma unroll
    for (int i = 0; i < 6; ++i) {
        const float z = (t0 - 2 + i < 0) ? 0.f : 1.f;
        u[i][0] = bflo(gc[i].x) * bflo(hh[i].x) * z; u[i][1] = bfhi(gc[i].x) * bfhi(hh[i].x) * z;
        u[i][2] = bflo(gc[i].y) * bflo(hh[i].y) * z; u[i][3] = bfhi(gc[i].y) * bfhi(hh[i].y) * z;
    }
    bf16_t* cat = (bf16_t*)(ws + WS_CAT2);
#pragma unroll
    for (int i = 0; i < 4; ++i) {
        const float y0 = fmaf(w0.x, u[i][0], fmaf(w1.x, u[i + 1][0], w2.x * u[i + 2][0]));
        const float y1 = fmaf(w0.y, u[i][1], fmaf(w1.y, u[i + 1][1], w2.y * u[i + 2][1]));
        const float y2 = fmaf(w0.z, u[i][2], fmaf(w1.z, u[i + 1][2], w2.z * u[i + 2][2]));
        const float y3 = fmaf(w0.w, u[i][3], fmaf(w1.w, u[i + 1][3], w2.w * u[i + 2][3]));
        uint2 o; o.x = pk2(bflo(gb[i].x) * y0, bfhi(gb[i].x) * y1); o.y = pk2(bflo(gb[i].y) * y2, bfhi(gb[i].y) * y3);
        *(uint2*)(cat + km_off(b * SEQ + t0 + i, 1024 + c, T)) = o;
    }
}

__device__ __forceinline__ void phase4(CParams& p, char* lds, int wv) {
    const int tid = opaque_tid(wv), lane = tid & 63, wid = tid >> 6;
    if (tid < 256) ((float*)(lds + P4_RB))[tid] = p.in[9][tid] * 1.4426950408889634f;
    const int gw = blockIdx.x * 8 + wid, NW = gridDim.x * 8;
    const int ndsa = (T / 16 - (int)blockIdx.x + (int)gridDim.x - 1) / (int)gridDim.x;
    const int new_ = (EW_ITEMS - gw + NW - 1) / NW;
    const int per = (new_ + ndsa - 1) / (ndsa > 0 ? ndsa : 1);
    int ew = gw;
    for (int i = blockIdx.x; i < T / 16; i += gridDim.x) {
        const int b = i >> 7, tau = i & 127, tile = ((b >> 1) & 1) ? 127 - tau : tau;
        dsa_item(p, b, tile * 16, lds, tid, wv);
        for (int j = 0; j < per && ew < EW_ITEMS; ++j, ew += NW) expert_w_item(p, ew, (float*)(lds + wv * 16384), opaque_i(lane));
    }
    for (; ew < EW_ITEMS; ew += NW) expert_w_item(p, ew, (float*)(lds + wv * 16384), opaque_i(lane));
    for (int i = blockIdx.x; i < T / 32; i += gridDim.x) {
        const int b = i >> 6, t0 = (i & 63) * 32 + (wid >> 2) * 16;
        memattn_wave(p, b, (size_t)b * SEQ + t0, wid & 3, opaque_i(lane));
        conv_tokens4(p, b, t0 + (wid & 3) * 4, opaque_i(lane));
    }
}

#define XB_TMO      128
#define XB_XCNT(j)  (256  + 64 * (j))
#define XB_XSUB(j)  (1280 + 64 * (j))
#define XB_XGEN(j)  (2304 + 64 * (j))
#define XB_TOP      3328
#define XB_TOPGEN   3392
#define XCD_BAR_WORDS 3456
#define XB_SPIN_CAP (1u << 22)
__device__ __forceinline__ unsigned xb_ld(unsigned* p)              { return __hip_atomic_load(p, __ATOMIC_RELAXED, __HIP_MEMORY_SCOPE_AGENT); }
__device__ __forceinline__ unsigned xb_add(unsigned* p, unsigned v) { return __hip_atomic_fetch_add(p, v, __ATOMIC_RELAXED, __HIP_MEMORY_SCOPE_AGENT); }
__device__ __forceinline__ unsigned xb_xcc_id() { return (unsigned)__builtin_amdgcn_s_getreg((3 << 11) | 20) & 0xFu; }
#define XB_SPIN(cond, bar) do { unsigned _sp = 0; while (cond) { __builtin_amdgcn_s_sleep(1); \
    if ((++_sp & 255u) == 0u) { if (xb_ld(&(bar)[XB_TMO])) break; if (_sp > XB_SPIN_CAP) { atomicAdd(&(bar)[XB_TMO], 1u); break; } } } } while (0)
__device__ __forceinline__ void phase5(CParams& p, char* lds, int wv) {
    const int tid = opaque_tid(wv);
    unsigned char* ws = p.ws;
    const float* x = p.in[0];
    constexpr int I1 = (T / 256) * 4;
    unsigned* bar = (unsigned*)(ws + WS_BAR);
    unsigned long long* lnst = (unsigned long long*)(ws + WS_LNST);
    bf16_t* x1h = (bf16_t*)p.out; bf16_t* x1l = (bf16_t*)(ws + WS_X1L); unsigned char* x1f8 = ws + WS_X1F8;
    for (int it = vblock(); it < I1; it += gridDim.x) {
        const int pm = it >> 2, pn = it & 3;
        const int brow = pm * 256, bcol = pn * 256;
        g8::Src s; g8::km_src(s, (const bf16_t*)(ws + WS_CAT2), T, brow, (const bf16_t*)(ws + WS_W_OUT2_T), 1024, bcol, tid);
        g8::kloop_issue(s, lds, wv);
        f32x4 acc[2][2][4][2]; g8::acc_zero(acc);
        g8::kloop(acc, s, 48, lds, tid, wv);
        const int te = opaque_i(tid), lane = te & 63, wr = wv >> 2, wc = wv & 3, fr = lane & 15, fq = lane >> 4;
        char* stg = lds + LDS_STG;
        float2* PS = (float2*)(stg + 32 * 1040);
        float2* SR = PS + 256;
        f32x4 vr[2][4][4];
        float4 xn[4];
#pragma unroll
        for (int i = 0; i < 4; ++i) { const int lr = wv + 8 * i; xn[i] = ldnt4(x + (size_t)(brow + (lr >> 4) * 64 + (lr & 15)) * 1024 + bcol + lane * 4); }
#pragma unroll
        for (int ai = 0; ai < 2; ++ai)
#pragma unroll
            for (int m = 0; m < 4; ++m) {
                char* rp = stg + (wr * 16 + fr) * 1040 + (wc * 32 + 4 * fq) * 4;
#pragma unroll
                for (int bj = 0; bj < 2; ++bj)
#pragma unroll
                    for (int n = 0; n < 2; ++n) *(f32x4*)(rp + (bj * 128 + n * 16) * 4) = acc[ai][bj][m][n];
                asm volatile("s_waitcnt lgkmcnt(0)" ::: "memory"); __builtin_amdgcn_s_barrier(); asm volatile("" ::: "memory");
                float4 xc[4];
#pragma unroll
                for (int i = 0; i < 4; ++i) xc[i] = xn[i];
                if (ai * 4 + m < 7) {
                    const int ai2 = (ai * 4 + m + 1) >> 2, m2 = (ai * 4 + m + 1) & 3;
#pragma unroll
                    for (int i = 0; i < 4; ++i) { const int lr = wv + 8 * i; xn[i] = ldnt4(x + (size_t)(brow + ai2 * 128 + (lr >> 4) * 64 + m2 * 16 + (lr & 15)) * 1024 + bcol + lane * 4); }
                }
#pragma unroll
                for (int i = 0; i < 4; ++i) {
                    const int lr = wv + 8 * i;
                    const f32x4 a = *(const f32x4*)(stg + lr * 1040 + lane * 16);
                    f32x4 o; o[0] = fmaf(ALPHA, xc[i].x, a[0]); o[1] = fmaf(ALPHA, xc[i].y, a[1]); o[2] = fmaf(ALPHA, xc[i].z, a[2]); o[3] = fmaf(ALPHA, xc[i].w, a[3]);
                    vr[ai][m][i] = o;
                    const float s1 = wave_sum((o[0] + o[1]) + (o[2] + o[3]));
                    const float s2 = wave_sum((o[0] * o[0] + o[1] * o[1]) + (o[2] * o[2] + o[3] * o[3]));
                    if (lane == 0) PS[ai * 128 + (lr >> 4) * 64 + m * 16 + (lr & 15)] = make_float2(s1, s2);
                }
                asm volatile("s_waitcnt lgkmcnt(0)" ::: "memory"); __builtin_amdgcn_s_barrier(); asm volatile("" ::: "memory");
            }
        if (wv < 4) {
            const float2 ps = PS[te];
            __hip_atomic_store(lnst + (size_t)(pm * 4 + pn) * 256 + te, ((unsigned long long)__float_as_uint(ps.y) << 32) | __float_as_uint(ps.x), __ATOMIC_RELAXED, __HIP_MEMORY_SCOPE_AGENT);
            asm volatile("s_waitcnt vmcnt(0)" ::: "memory");
            if (lane == 0) (void)xb_add(&bar[XCD_BAR_WORDS + 4 * pm], 1u);
            if (wv == 0) {
                XB_SPIN(xb_ld(&bar[XCD_BAR_WORDS + 4 * pm]) < 16u, bar);
                __builtin_amdgcn_fence(__ATOMIC_ACQUIRE, "agent");
            }
        }
        asm volatile("s_waitcnt vmcnt(0) lgkmcnt(0)" ::: "memory"); __builtin_amdgcn_s_barrier(); asm volatile("" ::: "memory");
        if (wv < 4) {
            float s1 = 0.f, s2 = 0.f;
#pragma unroll
            for (int t4 = 0; t4 < 4; ++t4) {
                const unsigned long long w = __hip_atomic_load(lnst + (size_t)(pm * 4 + t4) * 256 + te, __ATOMIC_RELAXED, __HIP_MEMORY_SCOPE_AGENT);
                s1 += __uint_as_float((unsigned)w); s2 += __uint_as_float((unsigned)(w >> 32));
            }
            const float mean = s1 * (1.f / 1024.f);
            const float var = fmaxf(s2 * (1.f / 1024.f) - mean * mean, 0.f);
            SR[te] = make_float2(mean, rsqrtf(var + LN_EPS));
        }
        asm volatile("s_waitcnt lgkmcnt(0)" ::: "memory"); __builtin_amdgcn_s_barrier(); asm volatile("" ::: "memory");
        {
            const float4 gg = *(const float4*)(p.in[14] + bcol + lane * 4), be = *(const float4*)(p.in[15] + bcol + lane * 4);
#pragma unroll
            for (int ai = 0; ai < 2; ++ai)
#pragma unroll
                for (int m = 0; m < 4; ++m)
#pragma unroll
                    for (int i = 0; i < 4; ++i) {
                        const int lr = wv + 8 * i, trow = ai * 128 + (lr >> 4) * 64 + m * 16 + (lr & 15);
                        const float2 sr = SR[trow];
                        const size_t go = (size_t)(brow + trow) * 1024 + bcol + lane * 4;
                        const f32x4 a = vr[ai][m][i];
                        float4 o; o.x = (a[0] - sr.x) * sr.y * gg.x + be.x; o.y = (a[1] - sr.x) * sr.y * gg.y + be.y; o.z = (a[2] - sr.x) * sr.y * gg.z + be.z; o.w = (a[3] - sr.x) * sr.y * gg.w + be.w;
                        uint2 hi; hi.x = pk2(o.x, o.y); hi.y = pk2(o.z, o.w);
                        uint2 lo; lo.x = pk2(o.x - bflo(hi.x), o.y - bfhi(hi.x)); lo.y = pk2(o.z - bflo(hi.y), o.w - bfhi(hi.y));
                        *(uint2*)(x1h + go + (size_t)(brow + trow) * 1024) = hi;
                        *(uint2*)(x1l + go) = lo;
                        *(uint32_t*)(x1f8 + go) = pk4_f8(o.x, o.y, o.z, o.w);
                    }
        }
        asm volatile("s_waitcnt lgkmcnt(0)" ::: "memory"); __builtin_amdgcn_s_barrier(); asm volatile("" ::: "memory");
    }
}

__device__ __forceinline__ void phase6(CParams& p, int wv) {
    const int tid = opaque_tid(wv), lane = tid & 63, wid = tid >> 6;
    unsigned char* ws = p.ws;
    const float* g = p.in[14]; const float* bb = p.in[15];
    bf16_t* x1b = (bf16_t*)(ws + WS_X1B); bf16_t* x1lo = (bf16_t*)(ws + WS_X1LO);
    for (int t0 = (blockIdx.x * 8 + wid) * 2; t0 < T; t0 += gridDim.x * 16) {
        float4 v[2][4];
#pragma unroll
        for (int u = 0; u < 2; ++u)
#pragma unroll
            for (int j = 0; j < 4; ++j) v[u][j] = ldnt4(p.out + (size_t)(t0 + u) * 1024 + lane * 4 + 256 * j);
#pragma unroll
        for (int u = 0; u < 2; ++u) {
            const int t = t0 + u;
            float* row = p.out + (size_t)t * 1024;
            float s = 0.f;
#pragma unroll
            for (int j = 0; j < 4; ++j) s += (v[u][j].x + v[u][j].y) + (v[u][j].z + v[u][j].w);
            const float mean = wave_sum(s) * (1.f / 1024.f);
            float q = 0.f;
#pragma unroll
            for (int j = 0; j < 4; ++j) { v[u][j].x -= mean; v[u][j].y -= mean; v[u][j].z -= mean; v[u][j].w -= mean; q += (v[u][j].x * v[u][j].x + v[u][j].y * v[u][j].y) + (v[u][j].z * v[u][j].z + v[u][j].w * v[u][j].w); }
            const float rstd = rsqrtf(wave_sum(q) * (1.f / 1024.f) + LN_EPS);
#pragma unroll
            for (int j = 0; j < 4; ++j) {
                const int cidx = lane * 4 + 256 * j;
                const float4 gg = *(const float4*)(g + cidx), be = *(const float4*)(bb + cidx);
                float4 o; o.x = v[u][j].x * rstd * gg.x + be.x; o.y = v[u][j].y * rstd * gg.y + be.y; o.z = v[u][j].z * rstd * gg.z + be.z; o.w = v[u][j].w * rstd * gg.w + be.w;
                stnt4(row + cidx, o);
                uint2 hi; hi.x = pk2(o.x, o.y); hi.y = pk2(o.z, o.w);
                uint2 lo; lo.x = pk2(o.x - bflo(hi.x), o.y - bfhi(hi.x)); lo.y = pk2(o.z - bflo(hi.y), o.w - bfhi(hi.y));
                *(uint2*)(x1b + (size_t)t * 1024 + cidx) = hi;
                *(uint2*)(x1lo + (size_t)t * 1024 + cidx) = lo;
            }
        }
    }
}

__device__ __forceinline__ float grp8_max(float v) {
    v = fmaxf(v, dpp_f<0xB1>(v)); v = fmaxf(v, dpp_f<0x4E>(v)); v = fmaxf(v, dpp_f<0x141>(v));
    return v;
}
constexpr int NTB = T / 128;
constexpr int TBR = NTB / NROUND;
__device__ __forceinline__ void phase7(CParams& p, char* lds, int wv) {
    const int tid = opaque_tid(wv), lane = tid & 63, wid = tid >> 6, wm = wid >> 2, wn = wid & 3;
    unsigned char* ws = p.ws;
    const int r0 = tid >> 3, c = tid & 7, fr = lane & 15, fq = lane >> 4;
    const bf16_t* Ah = (const bf16_t*)p.out; const bf16_t* Al = (const bf16_t*)(ws + WS_X1L); const bf16_t* Bt = (const bf16_t*)(ws + WS_W_R_T);
    float* lg = (float*)(lds + LDS_STG);
    const float rbias = p.in[17][lane];
    int* tok_e = (int*)(ws + WS_TOK_E); float* tok_w = (float*)(ws + WS_TOK_W);
    int* tok_pos = (int*)(ws + WS_TOK_POS);
    int* cntb = (int*)(ws + WS_CNTB);
    int* hist = (int*)(lds + LDS_MISC);
    const int grp = lane >> 3;
    for (int tb = blockIdx.x; tb < NTB; tb += gridDim.x) {
        const int m0 = tb * 128;
        f32x4 acc[4][2]; acc_zero(acc);
        const bf16_t* a0 = Ah + (size_t)(m0 + r0) * 2048 + c * 8; const bf16_t* a1 = a0 + (size_t)64 * 2048;
        const bf16_t* a0b = Al + (size_t)(m0 + r0) * 1024 + c * 8; const bf16_t* a1b = a0b + (size_t)64 * 1024;
        const bf16_t* b0 = Bt + (size_t)r0 * 2048 + c * 8; const bf16_t* b1 = b0 + (size_t)64 * 2048;
        pf_kloop<32, true>(acc, a0, a1, a0b, a1b, b0, b1, lds, tid, lane, wm, wn);
        if (wn < 2) {
#pragma unroll
            for (int mi = 0; mi < 4; ++mi)
#pragma unroll
                for (int ni = 0; ni < 2; ++ni) {
                    const int m = wm * 64 + mi * 16 + fr, n = wn * 32 + ni * 16 + 4 * fq;
                    *(f32x4*)(lg + m * 64 + n) = acc[mi][ni];
                }
        }
        if (tid < 64) hist[tid] = 0;
        __syncthreads();
        if (wn >= 2) {
#pragma unroll
            for (int mi = 0; mi < 4; ++mi)
#pragma unroll
                for (int ni = 0; ni < 2; ++ni) {
                    const int m = wm * 64 + mi * 16 + fr, n = (wn - 2) * 32 + ni * 16 + 4 * fq;
                    f32x4 v = *(const f32x4*)(lg + m * 64 + n);
                    v = v + acc[mi][ni];
                    *(f32x4*)(lg + m * 64 + n) = v;
                }
        }
        __syncthreads();
        for (int j = 0; j < 16; ++j) {
            const int tl = wid * 16 + j, t = m0 + tl;
            const float lgt = lg[tl * 64 + lane];
            const float s = 1.f / (1.f + __expf(-lgt));
            const float sc = s + rbias;
            const float m1 = grp8_max(sc);
            const bool ismax = (sc == m1);
            const unsigned long long bm = __ballot(ismax);
            const int nmax = __popcll((bm >> (grp * 8)) & 0xFFull);
            const float m2 = grp8_max(ismax ? -INFINITY : sc);
            const float gscore = m1 + (nmax >= 2 ? m1 : m2);
            int grank = 0;
#pragma unroll
            for (int g2 = 0; g2 < 8; ++g2) {
                const float o = __builtin_bit_cast(float, __builtin_amdgcn_readlane(__builtin_bit_cast(int, gscore), g2 * 8));
                grank += (o > gscore || (o == gscore && g2 < grp)) ? 1 : 0;
            }
            float mv = (grank < 4) ? sc : -INFINITY;
            unsigned long long selm = 0ull;
#pragma unroll
            for (int i8 = 0; i8 < 8; ++i8) {
                const float mx = wave_max(mv);
                const unsigned long long bmx = __ballot(mv == mx);
                const unsigned long long low = bmx & (0ull - bmx);
                selm |= low;
                if ((low >> lane) & 1ull) mv = -INFINITY;
            }
            const bool selq = (selm >> lane) & 1ull;
            const int rank = __popcll(selm & ((1ull << lane) - 1ull));
            const float ssum = wave_sum(selq ? s : 0.f);
            if (selq) {
                tok_e[(size_t)t * 8 + rank] = lane;
                tok_w[(size_t)t * 8 + rank] = s / ssum * 2.5f;
                tok_pos[(size_t)t * 9 + rank] = atomicAdd(&hist[lane], 1);
            }
        }
        __syncthreads();
        if (tid < 64) cntb[tb * 64 + tid] = hist[tid];
        __syncthreads();
    }
}

__device__ __forceinline__ int cntb_partial(const int* cntb, int i0, int i1, int tid) {
    const int e = tid & 63, part = tid >> 6;
    int c = 0;
#pragma unroll 8
    for (int i = i0 + part; i < i1; i += 8) c += cntb[i * 64 + e];
    return c;
}
__device__ __forceinline__ void round_tables(CParams& p, int r, int* misc, int tid) {
    const int* cntb = (const int*)(p.ws + WS_CNTB) + (size_t)r * TBR * 64;
    __syncthreads();
    if (tid < 64) misc[tid] = 0;
    if (tid == 64) misc[64] = TR;
    __syncthreads();
    { const int c = cntb_partial(cntb, 0, TBR, tid); atomicAdd(&misc[tid & 63], c); }
    __syncthreads();
    if (tid < 64) {
        const int nb = (misc[tid] + 255) >> 8;
        int incl = nb;
        const int ln4 = opaque_i(tid) << 2;
#pragma unroll
        for (int d = 1; d < 64; d <<= 1) { const int v = __builtin_amdgcn_ds_bpermute((ln4 - 4 * d) & 252, incl); if (tid >= d) incl += v; }
        const int excl = incl - nb;
        misc[80 + tid] = excl * 256; misc[160 + tid] = excl;
        if (tid == 63) { misc[80 + 64] = incl * 256; misc[160 + 64] = incl; misc[160 + NE1] = incl + ((TR + 255) >> 8); }
    }
    __syncthreads();
}
__device__ __forceinline__ int find_expert(const int* misc, int blk) {
    int lo = 0, hi = NE1;
#pragma unroll
    for (int i = 0; i < 7; ++i) { const int mid = (lo + hi) >> 1; if (mid < hi && misc[160 + mid] <= blk) lo = mid; else hi = mid; if (hi - lo <= 1) break; }
    while (lo + 1 <= NEXP && misc[160 + lo + 1] <= blk) ++lo;
    return lo;
}

__device__ __forceinline__ void phase9(CParams& p, char* lds, int wv) {
    const int tid = opaque_tid(wv);
    unsigned char* ws = p.ws;
    int* misc = (int*)(lds + LDS_MISC);
    const int* tok_e = (const int*)(ws + WS_TOK_E); const float* tok_w = (const float*)(ws + WS_TOK_W);
    int* tok_pos = (int*)(ws + WS_TOK_POS);
    const int* cntb = (const int*)(ws + WS_CNTB);
    for (int tb = blockIdx.x; tb < NTB; tb += gridDim.x) {
        const int r = tb / TBR;
        round_tables(p, r, misc, tid);
        if (tid < 64) misc[256 + tid] = 0;
        __syncthreads();
        { const int c = cntb_partial(cntb, r * TBR, tb, tid); atomicAdd(&misc[256 + (tid & 63)], c); }
        __syncthreads();
        int* slot_tok = (int*)(ws + WS_SLOT_TOK) + (size_t)r * CAP; float* slot_w = (float*)(ws + WS_SLOT_W) + (size_t)r * CAP;
        for (int i = tid; i < 128 * 8; i += NTHREADS) {
            const int t = tb * 128 + (i >> 3), k = i & 7;
            const int e = tok_e[(size_t)t * 8 + k];
            const int pos = misc[80 + e] + misc[256 + e] + tok_pos[(size_t)t * 9 + k];
            slot_tok[pos] = t; slot_w[pos] = tok_w[(size_t)t * 8 + k];
            tok_pos[(size_t)t * 9 + k] = pos;
        }
        if (tid < 128) {
            const int t = tb * 128 + tid, pos = misc[80 + NEXP] + (t - r * TR);
            slot_tok[pos] = t; slot_w[pos] = 1.f;
            tok_pos[(size_t)t * 9 + 8] = pos;
        }
    }
}

struct GuItem { int r, pos0, e, nt2, nvalid; };
__device__ __forceinline__ GuItem gu_decode(const int* misc0, const int (&nbase)[NROUND + 1], int git) {
    GuItem d;
    int r = 0;
#pragma unroll
    for (int rr = 1; rr < NROUND; ++rr) r += (git >= nbase[rr]) ? 1 : 0;
    int lbase = nbase[0];
#pragma unroll
    for (int rr = 1; rr < NROUND; ++rr) lbase = (r >= rr) ? nbase[rr] : lbase;
    const int it = git - lbase;
    const int* misc = misc0 + r * 256;
    const int blk = it >> 1; d.nt2 = it & 1; d.r = r;
    const int e = find_expert(misc, blk);
    d.e = __builtin_amdgcn_readfirstlane(e);
    const int rb = __builtin_amdgcn_readfirstlane(blk - misc[160 + d.e]);
    d.pos0 = __builtin_amdgcn_readfirstlane(misc[80 + d.e] + rb * 256);
    d.nvalid = __builtin_amdgcn_readfirstlane(min(256, misc[d.e] - rb * 256));
    return d;
}
__device__ __forceinline__ void phase_gu(CParams& p, char* lds, int wv) {
    const int tid = opaque_tid(wv);
    unsigned char* ws = p.ws;
    int* misc0 = (int*)(lds + LDS_MISC);
    int nbase[NROUND + 1]; nbase[0] = 0;
#pragma unroll
    for (int r = 0; r < NROUND; ++r) { round_tables(p, r, misc0 + r * 256, tid); nbase[r + 1] = nbase[r] + __builtin_amdgcn_readfirstlane(misc0[r * 256 + 160 + NE1]) * 2; }
    const int nitems = nbase[NROUND];
    const int lane_ = tid & 63;
    const int sR = (wv >> 1) * 32 + (lane_ & 31), sCb = (2 * (wv & 1) + (lane_ >> 5)) * 16;
    const __amdgpu_buffer_rsrc_t rx = g8::make_rsrc(ws + WS_X1F8);
    int git = vblock();
    GuItem d; d.r = 0; d.pos0 = 0; d.e = 0; d.nt2 = 0; d.nvalid = 1;
    int tok0 = 0, tok1 = 0;
    g8::Src s;
    if (git < nitems) {
        d = gu_decode(misc0, nbase, git);
        const int* slot_tok = (const int*)(ws + WS_SLOT_TOK) + (size_t)d.r * CAP;
        tok0 = slot_tok[d.pos0 + min(sR, d.nvalid - 1)]; tok1 = slot_tok[d.pos0 + min(128 + sR, d.nvalid - 1)];
        s.ra = rx; s.rb = g8::make_rsrc(ws + WS_W_EGU_T + (size_t)d.e * 524288); s.bh = 8192u; s.akt = 64u; s.bkt = 32768u;
        s.ao[0] = (unsigned)(tok0 * 1024 + sCb); s.ao[1] = (unsigned)(tok1 * 1024 + sCb);
        s.bo = (unsigned)(d.nt2 * 16384 + tid * 16);
        g8::kloop_issue<0>(s, lds, wv);
    }
    while (git < nitems) {
        const GuItem c = d;
        const int gnext = git + gridDim.x;
        if (gnext < nitems) {
            d = gu_decode(misc0, nbase, gnext);
            const int* slot_tok = (const int*)(ws + WS_SLOT_TOK) + (size_t)d.r * CAP;
            tok0 = slot_tok[d.pos0 + min(sR, d.nvalid - 1)]; tok1 = slot_tok[d.pos0 + min(128 + sR, d.nvalid - 1)];
        }
        g8::f32x16 acc[2][2][2]; g8::acc_zero_f8(acc);
        g8::kloop_f8(acc, s, 16, lds, tid, wv);
        git = gnext;
        if (git < nitems) {
            s.rb = g8::make_rsrc(ws + WS_W_EGU_T + (size_t)d.e * 524288);
            s.ao[0] = (unsigned)(tok0 * 1024 + sCb); s.ao[1] = (unsigned)(tok1 * 1024 + sCb);
            s.bo = (unsigned)(d.nt2 * 16384 + tid * 16);
            g8::kloop_issue<0>(s, lds, wv);
        }
        unsigned char* hs8 = ws + WS_HSLOT + (size_t)c.r * CAP * 256;
        {
            const int te = opaque_i(tid), lane = te & 63, wr = wv >> 2, wc = wv & 3, tc = lane & 31, hh = lane >> 5;
            char* stg = lds + LDS_STG;
            constexpr float ws8 = 1.f / W8_SCALE;
#pragma unroll
            for (int ai = 0; ai < 2; ++ai)
#pragma unroll
                for (int m = 0; m < 2; ++m) {
                    char* rp = stg + (ai * 128 + wr * 64 + m * 32 + tc) * 144 + 4 * hh;
                    const int sw = (tc >> 3) & 3;
#pragma unroll
                    for (int bj = 0; bj < 2; ++bj)
#pragma unroll
                        for (int pq = 0; pq < 2; ++pq) {
                            float hv[4];
#pragma unroll
                            for (int j = 0; j < 4; ++j) { const float g = acc[ai][bj][m][(2 * pq) * 4 + j] * ws8, u = acc[ai][bj][m][(2 * pq + 1) * 4 + j] * ws8; hv[j] = g * __builtin_amdgcn_rcpf(1.f + __expf(-g)) * u; }
                            *(float*)(rp + (((wc + bj * 4) ^ sw) << 4) + pq * 8) = __uint_as_float(pk4_f8(hv[0], hv[1], hv[2], hv[3]));
                        }
                }
            asm volatile("s_waitcnt lgkmcnt(0)" ::: "memory"); __builtin_amdgcn_s_barrier(); asm volatile("" ::: "memory");
            uint4 v[4];
#pragma unroll
            for (int i = 0; i < 4; ++i) { const int id = te + i * 512, r5 = id & 31, c4 = (id >> 5) & 3, g8i = (id >> 7) & 7, ktl = id >> 10; v[i] = lds_ld16(stg + (g8i * 32 + r5) * 144 + (((ktl * 4 + c4) ^ ((r5 >> 3) & 3)) << 4)); }
#pragma unroll
            for (int i = 0; i < 4; ++i) { const int id = te + i * 512, r5 = id & 31, c4 = (id >> 5) & 3, g8i = (id >> 7) & 7, ktl = id >> 10;
                typedef unsigned u32x4_t __attribute__((ext_vector_type(4))); const u32x4_t ov = {v[i].x, v[i].y, v[i].z, v[i].w};
                __builtin_nontemporal_store(ov, (u32x4_t*)(hs8 + ((size_t)(c.nt2 * 2 + ktl) * (CAP >> 5) + (c.pos0 >> 5) + g8i) * 2048 + c4 * 512 + r5 * 16)); }
            asm volatile("s_waitcnt lgkmcnt(0)" ::: "memory"); __builtin_amdgcn_s_barrier(); asm volatile("" ::: "memory");
        }
    }
    asm volatile("s_waitcnt vmcnt(0)" ::: "memory");
}
struct DownItem { int pos0, e, half; };
__device__ __forceinline__ DownItem down_decode(const int* misc, int it, int n2) {
    DownItem d; int blk = it >> 1; d.half = it & 1;
    if (it >= n2) { const int q = (n2 << 1) + (it - n2); blk = q >> 2; d.half = 2 + (q & 3); }
    const int e = find_expert(misc, blk);
    d.e = __builtin_amdgcn_readfirstlane(e);
    const int rb = __builtin_amdgcn_readfirstlane(blk - misc[160 + d.e]);
    d.pos0 = __builtin_amdgcn_readfirstlane(misc[80 + d.e] + rb * 256);
    return d;
}
struct DownFlush {
    unsigned char* yslot; char* lds; int pos0, half, tid, wv; float w[4];
    __device__ __forceinline__ void operator()(g8::f32x16 (&acc)[2][2][2], int seg) const {
        g8_store_tile8_f8<true>(acc, yslot, pos0, (half * 2 + seg) * 256, w, lds, tid, wv);
    }
};
__device__ __forceinline__ void phase_down(CParams& p, int r, char* lds, int wv) {
    const int tid = opaque_tid(wv);
    unsigned char* ws = p.ws;
    int* misc = (int*)(lds + LDS_MISC);
    round_tables(p, r, misc, tid);
    const int nit2 = __builtin_amdgcn_readfirstlane(misc[160 + NE1]) * 2;
    const int n2 = (nit2 / (int)gridDim.x) * (int)gridDim.x;
    const int nitems = n2 + (nit2 - n2) * 2;
    const float* slot_w = (const float*)(ws + WS_SLOT_W) + (size_t)r * CAP;
    const __amdgpu_buffer_rsrc_t rh = g8::make_rsrc(ws + WS_HSLOT + (size_t)r * CAP * 256);
    const int lane0 = tid & 63, wr0 = wv >> 2, tc0 = lane0 & 31;
    g8::Seg sg; sg.mask = 3; sg.lg = 2; sg.aseg = 0u; sg.bseg = 16384u;
    constexpr float ws8 = Y8_SCALE / W8_SCALE;
    int it = vblock();
    g8::Src s; DownItem d; float w[4];
    d.pos0 = 0; d.e = 0; d.half = 0;
#pragma unroll
    for (int i = 0; i < 4; ++i) w[i] = 0.f;
    s.ra = rh; s.rb = rh; s.bh = 8192u; s.akt = (unsigned)(CAP >> 5) * 2048u; s.bkt = 65536u; s.ao[0] = 0u; s.ao[1] = 0u; s.bo = 0u;
    if (it < nitems) {
        d = down_decode(misc, it, n2);
#pragma unroll
        for (int i = 0; i < 4; ++i) w[i] = slot_w[d.pos0 + (i >> 1) * 128 + (i & 1) * 32 + opaque_i(wr0 * 64 + tc0)] * ws8;
        s.rb = g8::make_rsrc(ws + WS_W_ED_T + (size_t)d.e * 262144);
        s.ao[0] = (unsigned)((d.pos0 >> 5) * 2048 + tid * 16); s.ao[1] = s.ao[0] + 8192u;
        s.bo = (unsigned)((d.half < 2 ? d.half * 2 : d.half - 2) * 16384 + tid * 16);
        g8::kloop_issue(s, lds, wv, sg);
        asm volatile("" :: "v"(w[0]), "v"(w[1]), "v"(w[2]), "v"(w[3]));
    }
    while (it < nitems) {
        const int single = d.half >= 2;
        const int ct_last = single ? d.half - 2 : d.half * 2 + 1;
        DownFlush fl; fl.yslot = ws + WS_YSLOT; fl.lds = lds; fl.pos0 = d.pos0; fl.half = d.half; fl.tid = tid; fl.wv = wv;
#pragma unroll
        for (int i = 0; i < 4; ++i) fl.w[i] = w[i];
        g8::f32x16 acc[2][2][2]; g8::acc_zero_f8(acc);
        g8::kloop_f8_ms(acc, s, single ? 4 : 8, lds, tid, wv, sg, fl);
        it += gridDim.x;
        if (it < nitems) {
            d = down_decode(misc, it, n2);
#pragma unroll
            for (int i = 0; i < 4; ++i) w[i] = slot_w[d.pos0 + (i >> 1) * 128 + (i & 1) * 32 + opaque_i(wr0 * 64 + tc0)] * ws8;
            s.rb = g8::make_rsrc(ws + WS_W_ED_T + (size_t)d.e * 262144);
            s.ao[0] = (unsigned)((d.pos0 >> 5) * 2048 + tid * 16); s.ao[1] = s.ao[0] + 8192u;
            s.bo = (unsigned)((d.half < 2 ? d.half * 2 : d.half - 2) * 16384 + tid * 16);
            g8::kloop_issue(s, lds, wv, sg);
        }
        g8_store_tile8_f8<false>(acc, fl.yslot, fl.pos0, ct_last * 256, fl.w, lds, tid, wv);
        if (it < nitems) asm volatile("" :: "v"(w[0]), "v"(w[1]), "v"(w[2]), "v"(w[3]));
    }
    asm volatile("s_waitcnt vmcnt(0)" ::: "memory");
}

__device__ __forceinline__ void phase_combine(CParams& p, int r, int wv) {
    const int tid = opaque_tid(wv), lane = tid & 63, wid = tid >> 6;
    unsigned char* ws = p.ws;
    const float* g = p.in[24]; const float* bb = p.in[25];
    const int* tok_pos = (const int*)(ws + WS_TOK_POS);
    const unsigned char* yslot = ws + WS_YSLOT;
    float4 gg[4], be[4];
#pragma unroll
    for (int j = 0; j < 4; ++j) { gg[j] = *(const float4*)(g + lane * 4 + 256 * j); be[j] = *(const float4*)(bb + lane * 4 + 256 * j); }
    for (int i = blockIdx.x * 8 + wid; i < TR; i += gridDim.x * 8) {
        const int t = r * TR + i;
        float* row = p.out + (size_t)t * 1024;
        float4 v[4];
#pragma unroll
        for (int j = 0; j < 4; ++j) {
            const unsigned long long h64 = __builtin_nontemporal_load((const unsigned long long*)((const bf16_t*)row + lane * 4 + 256 * j));
            const uint32_t h0 = (uint32_t)h64, h1 = (uint32_t)(h64 >> 32);
            v[j].x = bflo(h0) * ALPHA; v[j].y = bfhi(h0) * ALPHA; v[j].z = bflo(h1) * ALPHA; v[j].w = bfhi(h1) * ALPHA;
        }
        int pos[9];
#pragma unroll
        for (int k = 0; k < 9; ++k) pos[k] = tok_pos[(size_t)t * 9 + k];
        uint32_t y[9][4];
#pragma unroll
        for (int k = 0; k < 9; ++k)
#pragma unroll
            for (int j = 0; j < 4; ++j) y[k][j] = __builtin_nontemporal_load((const uint32_t*)(yslot + (size_t)pos[k] * 1024 + lane * 4 + 256 * j));
#pragma unroll
        for (int j = 0; j < 4; ++j) {
            typedef float f32x2_t __attribute__((ext_vector_type(2)));
            f32x2_t a01 = {0.f, 0.f}, a23 = {0.f, 0.f};
#pragma unroll
            for (int k = 0; k < 9; ++k) { a01 += __builtin_amdgcn_cvt_pk_f32_fp8((int)y[k][j], false); a23 += __builtin_amdgcn_cvt_pk_f32_fp8((int)y[k][j], true); }
            v[j].x += a01[0] * (1.f / Y8_SCALE); v[j].y += a01[1] * (1.f / Y8_SCALE); v[j].z += a23[0] * (1.f / Y8_SCALE); v[j].w += a23[1] * (1.f / Y8_SCALE);
        }
        float s = 0.f;
#pragma unroll
        for (int j = 0; j < 4; ++j) s += (v[j].x + v[j].y) + (v[j].z + v[j].w);
        const float mean = wave_sum(s) * (1.f / 1024.f);
        float q = 0.f;
#pragma unroll
        for (int j = 0; j < 4; ++j) { v[j].x -= mean; v[j].y -= mean; v[j].z -= mean; v[j].w -= mean; q += (v[j].x * v[j].x + v[j].y * v[j].y) + (v[j].z * v[j].z + v[j].w * v[j].w); }
        const float rstd = rsqrtf(wave_sum(q) * (1.f / 1024.f) + LN_EPS);
#pragma unroll
        for (int j = 0; j < 4; ++j) {
            const int cidx = lane * 4 + 256 * j;
            float4 o; o.x = v[j].x * rstd * gg[j].x + be[j].x; o.y = v[j].y * rstd * gg[j].y + be[j].y; o.z = v[j].z * rstd * gg[j].z + be[j].z; o.w = v[j].w * rstd * gg[j].w + be[j].w;
            stnt4(row + cidx, o);
        }
    }
}

struct XcdBarrier { unsigned* bar; unsigned x; volatile LAS unsigned* st; };
__device__ __forceinline__ XcdBarrier xcd_barrier_post(unsigned* bar, volatile LAS unsigned* st) {
    XcdBarrier b; b.bar = bar; b.x = xb_xcc_id(); b.st = st;
    if (threadIdx.x == 0) (void)xb_add(&bar[XB_XCNT(b.x)], 1u);
    return b;
}
__device__ __forceinline__ void xcd_barrier_complete(unsigned* bar, unsigned x, unsigned& nloc, unsigned& nx) {
    const unsigned G = gridDim.x * gridDim.y * gridDim.z;
    unsigned sum, cnt, mine, sp = 0u;
    for (;;) {
        sum = 0u; cnt = 0u; mine = 0u;
#pragma unroll
        for (unsigned j = 0; j < 16; ++j) { const unsigned c = xb_ld(&bar[XB_XCNT(j)]); sum += c; cnt += (c > 0u) ? 1u : 0u; mine = (j == x) ? c : mine; }
        if (sum == G) break;
        __builtin_amdgcn_s_sleep(1);
        if ((++sp & 255u) == 0u) { if (xb_ld(&bar[XB_TMO])) break; if (sp > XB_SPIN_CAP) { atomicAdd(&bar[XB_TMO], 1u); break; } }
    }
    nloc = mine > 0u ? mine : 1u; nx = cnt > 0u ? cnt : 1u;
}
__device__ __forceinline__ void xcd_barrier(const XcdBarrier& b, int wv) {
    asm volatile("s_waitcnt vmcnt(0)" ::: "memory");
    __syncthreads();
    if (wv == 0 && lane_id() == 0) {
        unsigned* bar = b.bar;
        unsigned bx = b.x; asm volatile("" : "+s"(bx));
        __builtin_amdgcn_s_waitcnt(0);
        unsigned nloc = b.st[0], nx = b.st[1];
        if (nloc == 0u) { xcd_barrier_complete(bar, bx, nloc, nx); b.st[0] = nloc; b.st[1] = nx; }
        const unsigned old = xb_add(&bar[XB_XSUB(bx)], 1u);
        const unsigned gen = old / nloc;
        if (old + 1u == (gen + 1u) * nloc) {
            __builtin_amdgcn_fence(__ATOMIC_RELEASE, "agent");
            asm volatile("s_waitcnt vmcnt(0)" ::: "memory");
            const unsigned og = xb_add(&bar[XB_TOP], 1u);
            const unsigned tg = og / nx;
            if (og + 1u == (tg + 1u) * nx) xb_add(&bar[XB_TOPGEN], 1u);
            else XB_SPIN(xb_ld(&bar[XB_TOPGEN]) == tg, bar);
            __builtin_amdgcn_fence(__ATOMIC_ACQUIRE, "agent");
            xb_add(&bar[XB_XGEN(bx)], 1u);
            asm volatile("s_waitcnt vmcnt(0)" ::: "memory");
        } else {
            __builtin_amdgcn_fence(__ATOMIC_ACQUIRE, "agent");
            XB_SPIN(xb_ld(&bar[XB_XGEN(bx)]) == gen, bar);
            asm volatile("s_waitcnt vmcnt(0)" ::: "memory");
        }
    }
    __syncthreads();
}

__global__ void __launch_bounds__(NTHREADS) fwd_megakernel(Params p_unused) {
    extern __shared__ __attribute__((aligned(16))) char lds[];
    volatile LAS unsigned* st = (volatile LAS unsigned*)(lds + LDS_BARW);
    const int wv = __builtin_amdgcn_readfirstlane((int)(threadIdx.x >> 6));
    if (threadIdx.x == 0) { st[0] = 0u; st[1] = 0u; st[2] = 0u; st[3] = 0u; }
    __syncthreads();
    const XcdBarrier gb = xcd_barrier_post((unsigned*)(kargs()->ws + WS_BAR), st);
    phase0(*kargs(), lds, wv);
    xcd_barrier(gb, wv);
    phase1(*kargs(), lds, wv);
    xcd_barrier(gb, wv);
    phase3(*kargs(), lds, wv);
    xcd_barrier(gb, wv);
    phase4(*kargs(), lds, wv);
    xcd_barrier(gb, wv);
    phase5(*kargs(), lds, wv);
    xcd_barrier(gb, wv);
    phase7(*kargs(), lds, wv);
    xcd_barrier(gb, wv);
    phase9(*kargs(), lds, wv);
    xcd_barrier(gb, wv);
    phase_gu(*kargs(), lds, wv);
    xcd_barrier(gb, wv);
    for (int r = 0; r < NROUND; ++r) {
        phase_down(*kargs(), r, lds, wv);
        xcd_barrier(gb, wv);
        phase_combine(*kargs(), r, wv);
        if (r + 1 < NROUND) xcd_barrier(gb, wv);
    }
}

extern "C" void kernel_launch(void* const* d_in, const int* in_sizes, int n_in, void* d_out, int out_size, void* d_ws, size_t ws_size, hipStream_t stream) {
    static int grid_blocks = 0;
    if (grid_blocks == 0) {
        if (n_in != 26 || out_size != T * DM || ws_size < WS_NEED) {
            fprintf(stderr, "kernel_launch: unexpected shapes (n_in %d out %d ws %zu need %zu)\n", n_in, out_size, ws_size, (size_t)WS_NEED);
            grid_blocks = -1; return;
        }
        int dev = 0, cus = 0, per_cu = 0;
        hipGetDevice(&dev);
        hipDeviceGetAttribute(&cus, hipDeviceAttributeMultiprocessorCount, dev);
        hipFuncSetAttribute((const void*)fwd_megakernel, hipFuncAttributeMaxDynamicSharedMemorySize, LDS_BYTES);
        hipOccupancyMaxActiveBlocksPerMultiprocessor(&per_cu, (const void*)fwd_megakernel, NTHREADS, LDS_BYTES);
        if (per_cu < 1) { fprintf(stderr, "kernel_launch: occupancy query says %d blocks per CU\n", per_cu); grid_blocks = -1; return; }
        grid_blocks = cus * 1;
    }
    if (grid_blocks < 0) return;
    Params p{};
    for (int i = 0; i < 26; ++i) p.in[i] = (const float*)d_in[i];
    p.out = (float*)d_out; p.ws = (unsigned char*)d_ws;
    if (hipMemsetAsync((char*)d_ws + WS_BAR, 0, 16384, stream) != hipSuccess) { fprintf(stderr, "kernel_launch: memset of barrier words failed\n"); return; }
    void* args[] = {&p};
    hipError_t e = hipLaunchCooperativeKernel((const void*)fwd_megakernel, dim3(grid_blocks), dim3(NTHREADS), args, LDS_BYTES, stream);
    if (e != hipSuccess) fprintf(stderr, "cooperative launch failed: %s (grid %d)\n", hipGetErrorString(e), grid_blocks);
}
```
